# Optimizing an MI355X kernel written in HIP

```python
import jax, jax.numpy as jnp
from jax import lax
import numpy as np

D_MODEL = 1024
BATCH = 8
SEQ = 8192
DEPTH = 2

GRID_W = 64
NORM_EPS = 1e-6
RWKV_HEADS = 8
RWKV_HEAD = 64
RWKV_W = RWKV_HEADS * RWKV_HEAD
DECAY_LORA = 64
ICLR_LORA = 64
GATE_LORA = 128
VRES_LORA = 32
RWKV_LN_EPS = 64e-5
N_DIR = 2
RWKV_COLS = 3 * RWKV_W + N_DIR * DECAY_LORA + N_DIR * ICLR_LORA + GATE_LORA
POOL_WINDOWS = (2, 4, 8, 16)
POOL_GROUPS = len(POOL_WINDOWS)
POOL_GROUP_W = 128
POOL_W = POOL_GROUPS * POOL_GROUP_W
ATT_HEADS = 8
ATT_KV_HEADS = 2
ATT_GROUP = ATT_HEADS // ATT_KV_HEADS
ATT_HEAD = 64
ATT_W = ATT_HEADS * ATT_HEAD
ATT_COLS = (ATT_HEADS + 2 * ATT_KV_HEADS) * ATT_HEAD
ROPE_AXIS_DIM = ATT_HEAD // 2
ROPE_THETA = 10000.0
Q_BLOCK = 128
N_BRANCH = 3
GATE_COLS = N_BRANCH * D_MODEL
N_PROJ = RWKV_COLS + POOL_W + ATT_COLS + GATE_COLS
N_EXPERTS = 16
EXPERT_FF = 1024
CAPACITY_FACTOR = 2

kernel_name = 'hybrid_rwkv7_pool_gqa_ecmoe_encoder'


def rms_norm(x, g, eps=NORM_EPS):
    xf = x.astype(jnp.float32)
    y = xf * lax.rsqrt(jnp.mean(xf * xf, axis=-1, keepdims=True) + eps)
    return (y * g.astype(jnp.float32)).astype(x.dtype)


def centred_token_shift(p, mu_prev, mu_next):
    zero = jnp.zeros_like(p[:, :1])
    p_prev = jnp.concatenate([zero, p[:, :-1]], axis=1)
    p_next = jnp.concatenate([p[:, 1:], zero], axis=1)
    return p + mu_prev * (p_prev - p) + mu_next * (p_next - p)


def _heads(z):
    return z.reshape(z.shape[:-1] + (RWKV_HEADS, RWKV_HEAD))


def rwkv7_bidir(p, hn, vres, v_first, w0, w2, a0, a2, g2, k_k, k_a, r_k, ln_w, ln_b):
    B, S, _ = p.shape
    f32 = jnp.float32
    dt = p.dtype
    pf = p.astype(f32)
    offs = np.cumsum([RWKV_W, RWKV_W, RWKV_W, N_DIR * DECAY_LORA, N_DIR * ICLR_LORA]).tolist()
    r, k, v, wd, ad, gd = jnp.split(pf, offs, axis=-1)
    wd = wd.reshape(B, S, N_DIR, DECAY_LORA)
    ad = ad.reshape(B, S, N_DIR, ICLR_LORA)
    w_raw = w0.astype(f32) + jnp.einsum('bsel,elc->bsec', jnp.tanh(wd), w2.astype(f32))
    decay = jnp.exp(-jnp.exp(-jax.nn.softplus(-w_raw) - 0.5))
    a = jax.nn.sigmoid(a0.astype(f32) + jnp.einsum('bsel,elc->bsec', ad, a2.astype(f32)))
    g = jnp.einsum('bsl,lc->bsc', jax.nn.sigmoid(gd), g2.astype(f32))
    if v_first is None:
        v_first = v
    else:
        v0, v1, v2 = vres
        mix = jax.nn.sigmoid(v0.astype(f32) + jnp.einsum('bsd,dl,lc->bsc', hn.astype(f32), v1.astype(f32), v2.astype(f32)))
        v = v + (v_first - v) * mix
    kk = _heads(k * k_k.astype(f32))
    kk = kk / jnp.maximum(jnp.linalg.norm(kk, axis=-1, keepdims=True), 1e-12)
    k_dir = k[:, :, None, :] * (1.0 + (a - 1.0) * k_a.astype(f32))

    def both(z):
        return jnp.stack([z, jnp.flip(z, 1)], axis=2)

    def per_dir(z):
        return jnp.stack([z[:, :, 0], jnp.flip(z[:, :, 1], 1)], axis=2)

    def time_major(z):
        return _heads(z).transpose(1, 2, 0, 3, 4)

    inputs = (time_major(both(r)), time_major(per_dir(decay)), time_major(per_dir(k_dir)),
              time_major(both(v)), both(kk).transpose(1, 2, 0, 3, 4), time_major(per_dir(a)))

    def step(state, inp):
        r_t, w_t, k_t, v_t, kk_t, a_t = inp
        sa = jnp.einsum('dbhij,dbhj->dbhi', state, -kk_t)
        state = (state * w_t[..., None, :] + sa[..., :, None] * (kk_t * a_t)[..., None, :]
                 + v_t[..., :, None] * k_t[..., None, :])
        return state, jnp.einsum('dbhij,dbhj->dbhi', state, r_t)

    state0 = jnp.zeros((N_DIR, B, RWKV_HEADS, RWKV_HEAD, RWKV_HEAD), f32)
    _, ys = lax.scan(step, state0, inputs)
    y = (ys[:, 0] + jnp.flip(ys[:, 1], 0)).transpose(1, 0, 2, 3)
    mu = jnp.mean(y, axis=-1, keepdims=True)
    var = jnp.mean(jnp.square(y - mu), axis=-1, keepdims=True)
    yn = (y - mu) * lax.rsqrt(var + RWKV_LN_EPS) * _heads(ln_w.astype(f32)) + _heads(ln_b.astype(f32))
    bonus = jnp.sum(_heads(r) * _heads(k_dir.sum(axis=2)) * _heads(r_k.astype(f32)), axis=-1, keepdims=True) * _heads(v)
    out = (yn + bonus).reshape(B, S, RWKV_W) * g
    return out.astype(dt), v_first


def multiscale_pool(z, pool_w, pool_scale):
    B, S, _ = z.shape
    zg = z.astype(jnp.float32).reshape(B, S, POOL_GROUPS, POOL_GROUP_W)
    csum = jnp.concatenate([jnp.zeros((B, 1, POOL_GROUPS, POOL_GROUP_W), jnp.float32), jnp.cumsum(zg, axis=1)], axis=1)
    t = jnp.arange(S)
    outs = []
    for gi, w in enumerate(POOL_WINDOWS):
        lo = w // 2
        hi = w - lo - 1
        start = jnp.clip(t - lo, 0, S)
        end = jnp.clip(t + hi + 1, 0, S)
        cnt = (end - start).astype(jnp.float32)
        outs.append((csum[:, end, gi] - csum[:, start, gi]) / cnt[None, :, None] - zg[:, :, gi])
    pooled = jnp.stack(outs, axis=2)
    y = jnp.einsum('bsgc,gcd->bsgd', pooled, pool_w.astype(jnp.float32)).reshape(B, S, POOL_W)
    return (y * pool_scale.astype(jnp.float32)).astype(z.dtype)


def axial_rope(seq):
    rows = seq // GRID_W
    row = jnp.repeat(jnp.arange(rows, dtype=jnp.float32), GRID_W)
    col = jnp.tile(jnp.arange(GRID_W, dtype=jnp.float32), rows)
    freqs = ROPE_THETA ** (-jnp.arange(0, ROPE_AXIS_DIM, 2, dtype=jnp.float32) / ROPE_AXIS_DIM)
    ang = jnp.concatenate([row[:, None] * freqs, col[:, None] * freqs], axis=-1)
    return jnp.cos(ang), jnp.sin(ang)


def apply_rope(x, cos, sin):
    xp = x.reshape(x.shape[:-1] + (ATT_HEAD // 2, 2))
    x0, x1 = xp[..., 0], xp[..., 1]
    c = cos[None, :, None, :]
    s = sin[None, :, None, :]
    return jnp.stack([x0 * c - x1 * s, x0 * s + x1 * c], axis=-1).reshape(x.shape)


def gqa_axial(p_att, q_norm, k_norm):
    B, S, _ = p_att.shape
    dt = p_att.dtype
    q, k, v = jnp.split(p_att, [ATT_W, ATT_W + ATT_KV_HEADS * ATT_HEAD], axis=-1)
    q = rms_norm(q.reshape(B, S, ATT_HEADS, ATT_HEAD), q_norm).astype(jnp.float32)
    k = rms_norm(k.reshape(B, S, ATT_KV_HEADS, ATT_HEAD), k_norm).astype(jnp.float32)
    cos, sin = axial_rope(S)
    q = (apply_rope(q, cos, sin) * (ATT_HEAD ** -0.5)).astype(dt)
    k = apply_rope(k, cos, sin).astype(dt)
    v = v.reshape(B, S, ATT_KV_HEADS, ATT_HEAD)
    n_blocks = S // Q_BLOCK
    q_blocks = q.reshape(B, n_blocks, Q_BLOCK, ATT_KV_HEADS, ATT_GROUP, ATT_HEAD).transpose(1, 0, 3, 4, 2, 5)
    k_t = k.transpose(0, 2, 1, 3)
    v_t = v.transpose(0, 2, 1, 3)

    def block(qb):
        s = jnp.einsum('bkgqd,bksd->bkgqs', qb, k_t).astype(jnp.float32)
        pr = jax.nn.softmax(s, axis=-1).astype(dt)
        return jnp.einsum('bkgqs,bksd->bkgqd', pr, v_t)

    o = lax.map(block, q_blocks)
    return o.transpose(1, 0, 4, 2, 3, 5).reshape(B, S, ATT_W)


def expert_choice_ffn(h, router, w_gate, w_up, w_down):
    B, S, D = h.shape
    cap = CAPACITY_FACTOR * S // N_EXPERTS
    aff = jax.nn.softmax(jnp.einsum('bsd,de->bse', h, router).astype(jnp.float32), axis=-1)
    vals, idx = lax.top_k(aff.transpose(0, 2, 1), cap)
    xg = jax.vmap(lambda hb, ib: hb[ib])(h, idx)
    hid = jax.nn.silu(jnp.einsum('becd,edf->becf', xg, w_gate)) * jnp.einsum('becd,edf->becf', xg, w_up)
    y = jnp.einsum('becf,efd->becd', hid, w_down) * vals[..., None].astype(h.dtype)
    return jax.vmap(lambda ib, yb: jnp.zeros((S, D), yb.dtype).at[ib.reshape(-1)].add(yb.reshape(-1, D)))(idx, y)


def setup_inputs(seed: int = 0) -> dict:
    key = jax.random.key(seed)
    ks = iter(jax.random.split(key, 40))

    def nrm(shape, scale):
        return jax.random.normal(next(ks), shape, jnp.float32) * scale

    def uni(shape, lo, hi):
        return jax.random.uniform(next(ks), shape, jnp.float32, lo, hi)

    L = DEPTH
    Lv = DEPTH - 1
    return {
        'x': nrm((BATCH, SEQ, D_MODEL), 1.0),
        'norm_mix': 1.0 + nrm((L, D_MODEL), 0.05),
        'w_in': nrm((L, D_MODEL, N_PROJ), D_MODEL ** -0.5),
        'shift_prev': uni((L, RWKV_COLS), 0.0, 0.5),
        'shift_next': uni((L, RWKV_COLS), 0.0, 0.5),
        'rwkv_w0': uni((L, N_DIR, RWKV_W), -5.0, 1.0),
        'rwkv_w2': nrm((L, N_DIR, DECAY_LORA, RWKV_W), 0.5 * DECAY_LORA ** -0.5),
        'rwkv_a0': nrm((L, N_DIR, RWKV_W), 0.5),
        'rwkv_a2': nrm((L, N_DIR, ICLR_LORA, RWKV_W), ICLR_LORA ** -0.5),
        'rwkv_g2': nrm((L, GATE_LORA, RWKV_W), GATE_LORA ** -0.5),
        'rwkv_k_k': 0.85 + nrm((L, RWKV_W), 0.05),
        'rwkv_k_a': 1.0 + nrm((L, RWKV_W), 0.05),
        'rwkv_r_k': nrm((L, RWKV_W), 0.1),
        'rwkv_ln_w': 1.0 + nrm((L, RWKV_W), 0.05),
        'rwkv_ln_b': nrm((L, RWKV_W), 0.02),
        'vres_v0': 0.5 + nrm((Lv, RWKV_W), 0.3),
        'vres_w1': nrm((Lv, D_MODEL, VRES_LORA), D_MODEL ** -0.5),
        'vres_w2': nrm((Lv, VRES_LORA, RWKV_W), VRES_LORA ** -0.5),
        'pool_w': nrm((L, POOL_GROUPS, POOL_GROUP_W, POOL_GROUP_W), POOL_GROUP_W ** -0.5),
        'pool_scale': 1.0 + nrm((L, POOL_W), 0.1),
        'q_norm': 1.0 + nrm((L, ATT_HEAD), 0.05),
        'k_norm': 1.0 + nrm((L, ATT_HEAD), 0.05),
        'w_branch_rwkv': nrm((L, RWKV_W, D_MODEL), RWKV_W ** -0.5),
        'w_branch_pool': nrm((L, POOL_W, D_MODEL), POOL_W ** -0.5),
        'w_branch_attn': nrm((L, ATT_W, D_MODEL), ATT_W ** -0.5),
        'w_out': nrm((L, D_MODEL, D_MODEL), D_MODEL ** -0.5),
        'norm_ffn': 1.0 + nrm((L, D_MODEL), 0.05),
        'router': nrm((L, D_MODEL, N_EXPERTS), D_MODEL ** -0.5),
        'exp_gate': nrm((L, N_EXPERTS, D_MODEL, EXPERT_FF), D_MODEL ** -0.5),
        'exp_up': nrm((L, N_EXPERTS, D_MODEL, EXPERT_FF), D_MODEL ** -0.5),
        'exp_down': nrm((L, N_EXPERTS, EXPERT_FF, D_MODEL), EXPERT_FF ** -0.5),
        'norm_final': 1.0 + nrm((D_MODEL,), 0.05),
    }


def reference(x, norm_mix, w_in, shift_prev, shift_next, rwkv_w0, rwkv_w2, rwkv_a0, rwkv_a2, rwkv_g2,
              rwkv_k_k, rwkv_k_a, rwkv_r_k, rwkv_ln_w, rwkv_ln_b, vres_v0, vres_w1, vres_w2,
              pool_w, pool_scale, q_norm, k_norm, w_branch_rwkv, w_branch_pool, w_branch_attn, w_out,
              norm_ffn, router, exp_gate, exp_up, exp_down, norm_final):
    B, S, D = x.shape
    split_at = [RWKV_COLS, RWKV_COLS + POOL_W, RWKV_COLS + POOL_W + ATT_COLS]
    v_first = None
    for l in range(DEPTH):
        hn = rms_norm(x, norm_mix[l])
        proj = jnp.einsum('bsd,dn->bsn', hn, w_in[l])
        p_rwkv, p_pool, p_att, p_gate = jnp.split(proj, split_at, axis=-1)
        p_rwkv = centred_token_shift(p_rwkv, shift_prev[l], shift_next[l])
        vres = None if l == 0 else (vres_v0[l - 1], vres_w1[l - 1], vres_w2[l - 1])
        y_a, v_first = rwkv7_bidir(p_rwkv, hn, vres, v_first, rwkv_w0[l], rwkv_w2[l], rwkv_a0[l], rwkv_a2[l],
                                   rwkv_g2[l], rwkv_k_k[l], rwkv_k_a[l], rwkv_r_k[l], rwkv_ln_w[l], rwkv_ln_b[l])
        y_b = multiscale_pool(p_pool, pool_w[l], pool_scale[l])
        y_c = gqa_axial(p_att, q_norm[l], k_norm[l])
        gates = jax.nn.sigmoid(p_gate).reshape(B, S, N_BRANCH, D)
        merged = (gates[:, :, 0] * (y_a @ w_branch_rwkv[l]) + gates[:, :, 1] * (y_b @ w_branch_pool[l])
                  + gates[:, :, 2] * (y_c @ w_branch_attn[l]))
        x = x + merged @ w_out[l]
        x = x + expert_choice_ffn(rms_norm(x, norm_ffn[l]), router[l], exp_gate[l], exp_up[l], exp_down[l])
    return rms_norm(x, norm_final)
```

```cpp
#include <hip/hip_runtime.h>
#include <cstdio>
#include <cstdint>
namespace pg8 {
#define PG8_LAS __attribute__((address_space(3)))
typedef unsigned short bf16_t;
typedef short bf16x8 __attribute__((ext_vector_type(8)));
typedef float f32x4 __attribute__((ext_vector_type(4)));
typedef unsigned u32x4 __attribute__((ext_vector_type(4)));
constexpr int BM = 256, BK = 64, HALF = 128, HTB = HALF * BK * 2  , STAGE_BYTES = 8 * HTB, NXCD = 8, WGM = 8;

__host__ __device__ __forceinline__ int lds_byte(int r, int c) { const int st = (r >> 4) * 2 + (c >> 5), rr = r & 15, cc = c & 31, ob = rr * 64 + cc * 2; return st * 1024 + (ob ^ (((ob >> 9) & 1) << 5)); }
__host__ __device__ __forceinline__ void stage_rc(int b, int& R, int& C) { const int st = b / 1024, sb = b % 1024, swz = sb ^ (((sb >> 9) & 1) << 5); R = (st >> 1) * 16 + swz / 64; C = (st & 1) * 32 + (swz % 64) / 2; }
__host__ __device__ __forceinline__ int perm32(int rho) { const int n = rho >> 4, i = rho & 15; return 8 * (i >> 2) + 4 * n + (i & 3); }

struct Unit { int pm, pn, sub; };

__device__ __forceinline__ bool tile_of(int i, int G, int c, int nM, int nN, int& pm, int& pn) {
    const long L = (long)i * G + c; const int nwg = nM * nN; if (L >= nwg) return false;
    int wgid = (int)L; { const int q = nwg / NXCD, r = nwg % NXCD, xcd = wgid % NXCD, off = wgid / NXCD; wgid = (xcd < r ? xcd * (q + 1) : r * (q + 1) + (xcd - r) * q) + off; }
    const int nig = WGM * nN, gid = wgid / nig, fm = gid * WGM, gsz = (nM - fm) < WGM ? (nM - fm) : WGM;
    pm = fm + ((wgid % nig) % gsz); pn = (wgid % nig) / gsz; return true;
}
struct PlainOrder {
    const char* A; const char* B; int lda, ldb, K, nM, nN, G, c, grp_panels, ngrp; size_t grp_stride;
    __device__ __forceinline__ int grow(const Unit&, int) const { return 0; }
    __device__ __forceinline__ bool next(int i, Unit& u) const { u.sub = 0; return tile_of(i, G, c, nM, nN, u.pm, u.pn); }
    __device__ __forceinline__ void ops(const Unit& u, const char*& a, const char*& b, int& nt, bool& asel) const {
        nt = K / BK; asel = false;
        a = A + (size_t)u.pm * BM * lda * 2;
        b = B + (size_t)u.pn * BM * ldb * 2 + (grp_panels ? (size_t)((u.pm / grp_panels) % ngrp) * grp_stride : (size_t)0);
    }
};
struct ProjOrder {
    const char* A; const char* B; size_t a8_off, b8_off; int lda, ldb, K, nM, nN, pn8, a8_pitch, G, c;
    __device__ __forceinline__ int grow(const Unit&, int) const { return 0; }
    __device__ __forceinline__ bool next(int i, Unit& u) const { u.sub = 0; return tile_of(i, G, c, nM, nN, u.pm, u.pn); }
    __device__ __forceinline__ void ops(const Unit& u, const char*& a, const char*& b, int& nt, bool& asel) const {
        asel = u.pn >= pn8; nt = asel ? K / (2 * BK) : K / BK;
        a = A + (asel ? a8_off + (size_t)u.pm * BM * a8_pitch : (size_t)u.pm * BM * lda * 2);
        b = B + (asel ? b8_off + (size_t)(u.pn - pn8) * BM * ldb * 2 : (size_t)u.pn * BM * ldb * 2);
    }
};
struct LoraOrder {
    const char* A; const char* B; int G, c;
    __device__ __forceinline__ int grow(const Unit&, int) const { return 0; }
    __device__ __forceinline__ bool next(int i, Unit& u) const { u.sub = 0; return tile_of(i, G, c, 256, 8, u.pm, u.pn); }
    __device__ __forceinline__ void ops(const Unit& u, const char*& a, const char*& b, int& nt, bool& asel) const {
        nt = 2; asel = false; a = A + (size_t)u.pm * BM * 384 * 2 + (u.pn >= 4 ? 256 : 0); b = B + (size_t)u.pn * BM * 128 * 2; }
};
struct GatherOrder {
    const char* A; const char* B; const int* idx; int lda, ldb, K, nM, nN, G, c, grp_panels, ngrp, panels_per_batch, seq; size_t grp_stride;
    __device__ __forceinline__ bool next(int i, Unit& u) const { u.sub = 0; return tile_of(i, G, c, nM, nN, u.pm, u.pn); }
    __device__ __forceinline__ void ops(const Unit& u, const char*& a, const char*& b, int& nt, bool& asel) const {
        nt = K / BK; asel = false; a = A;
        b = B + (size_t)u.pn * BM * ldb * 2 + (size_t)((u.pm / grp_panels) % ngrp) * grp_stride;
    }
    __device__ __forceinline__ int grow(const Unit& u, int row) const { return (u.pm / panels_per_batch) * seq + idx[u.pm * BM + row]; }
};
template <size_t OHN, size_t OYA, size_t OYB, size_t OYC, size_t OWG, size_t OWBR>
struct MergeOrder {
    const char* base; const char* wbase; int G, c; size_t hn_off, hn_pitch;
    __device__ __forceinline__ int grow(const Unit&, int) const { return 0; }
#ifndef MERGE_NSUB
#define MERGE_NSUB 6
#endif
    __device__ __forceinline__ bool next(int i, Unit& u) const { const int ti = i / MERGE_NSUB; u.sub = i - ti * MERGE_NSUB; return tile_of(ti, G, c, 256, 4, u.pm, u.pn); }
    __device__ __forceinline__ void ops(const Unit& u, const char*& a, const char*& b, int& nt, bool& asel) const {
        const int bb = u.sub >> 1; const size_t wrow = (size_t)(bb * 1024 + u.pn * BM) * 1024, arow = (size_t)u.pm * BM * 1024; nt = 8;
        if (!(u.sub & 1)) { a = base + (hn_off + (size_t)u.pm * BM * hn_pitch); b = wbase + OWG + wrow; asel = true; }
        else if (bb == 2) { a = base + (hn_off + 1024 + (size_t)u.pm * BM * hn_pitch); b = wbase + OYC + (size_t)u.pn * BM * 1024; asel = true; nt = 4; }
        else { const size_t yo = (bb == 0) ? OYA : OYB; a = base + yo + arow; b = wbase + OWBR + wrow; asel = false; }
    }
};

typedef float f32x2_t __attribute__((ext_vector_type(2))); typedef __bf16 bf16x2_t __attribute__((ext_vector_type(2)));
__device__ __forceinline__ unsigned cvt_pk_bf16(float lo, float hi) { const f32x2_t v = {lo, hi}; const bf16x2_t b = __builtin_convertvector(v, bf16x2_t); return __builtin_bit_cast(unsigned, b); }
__device__ __forceinline__ u32x4 pack8(const f32x4& v0, const f32x4& v1) { u32x4 w; w.x = cvt_pk_bf16(v0[0], v0[1]); w.y = cvt_pk_bf16(v0[2], v0[3]); w.z = cvt_pk_bf16(v1[0], v1[1]); w.w = cvt_pk_bf16(v1[2], v1[3]); return w; }
__device__ __forceinline__ void unpack8(const u32x4& w, f32x4& v0, f32x4& v1) {
    v0[0] = __uint_as_float(w.x << 16); v0[1] = __uint_as_float(w.x & 0xffff0000u); v0[2] = __uint_as_float(w.y << 16); v0[3] = __uint_as_float(w.y & 0xffff0000u);
    v1[0] = __uint_as_float(w.z << 16); v1[1] = __uint_as_float(w.z & 0xffff0000u); v1[2] = __uint_as_float(w.w << 16); v1[3] = __uint_as_float(w.w & 0xffff0000u); }
__device__ __forceinline__ float sigm(float x) { return __builtin_amdgcn_rcpf(1.0f + __builtin_amdgcn_exp2f(-1.4426950408889634f * x)); }
__device__ __forceinline__ f32x4 sigm4(const f32x4& v) { f32x4 r; r[0] = sigm(v[0]); r[1] = sigm(v[1]); r[2] = sigm(v[2]); r[3] = sigm(v[3]); return r; }

struct EpiPlain {
    static constexpr bool PERM = true;
    bf16_t* O; int ldc;
    __device__ __forceinline__ void operator()(const f32x4 (&acc)[2][2][4][2], const Unit& u, int wr, int wc, int fr, int fq) const {
        const int row0 = u.pm * BM + wr * 64 + fr, col0 = u.pn * BM + wc * 32 + 8 * fq;
#pragma unroll
        for (int ai = 0; ai < 2; ++ai)
#pragma unroll
            for (int m = 0; m < 4; ++m) { bf16_t* rowp = O + (size_t)(row0 + ai * HALF + m * 16) * ldc + col0;
#pragma unroll
                for (int bj = 0; bj < 2; ++bj) *(u32x4*)(rowp + bj * HALF) = pack8(acc[ai][bj][m][0], acc[ai][bj][m][1]); }
    }
};
struct EpiSink {
    static constexpr bool PERM = true;
    __device__ __forceinline__ void operator()(const f32x4 (&acc)[2][2][4][2], const Unit&, int, int, int, int) const {
#pragma unroll
        for (int ai = 0; ai < 2; ++ai)
#pragma unroll
            for (int bj = 0; bj < 2; ++bj)
#pragma unroll
                for (int m = 0; m < 4; ++m) { asm volatile("" :: "v"(acc[ai][bj][m][0]), "v"(acc[ai][bj][m][1])); }
    }
};
struct EpiPlainS {
    static constexpr bool PERM = true;
    bf16_t* O; int ldc, pn8; float s8;
    __device__ __forceinline__ void operator()(const f32x4 (&acc)[2][2][4][2], const Unit& u, int wr, int wc, int fr, int fq) const {
        const int row0 = u.pm * BM + wr * 64 + fr, col0 = u.pn * BM + wc * 32 + 8 * fq; const float sc = (u.pn >= pn8) ? s8 : 1.0f;
#pragma unroll
        for (int ai = 0; ai < 2; ++ai)
#pragma unroll
            for (int m = 0; m < 4; ++m) { bf16_t* rowp = O + (size_t)(row0 + ai * HALF + m * 16) * ldc + col0;
#pragma unroll
                for (int bj = 0; bj < 2; ++bj) *(u32x4*)(rowp + bj * HALF) = pack8(acc[ai][bj][m][0] * sc, acc[ai][bj][m][1] * sc); }
    }
};
struct EpiColScale {
    static constexpr bool PERM = true;
    bf16_t* O; int ldc; const float* scale;
    __device__ __forceinline__ void operator()(const f32x4 (&acc)[2][2][4][2], const Unit& u, int wr, int wc, int fr, int fq) const {
        const int row0 = u.pm * BM + wr * 64 + fr, col0 = u.pn * BM + wc * 32 + 8 * fq;
        f32x4 sv[2][2];
#pragma unroll
        for (int bj = 0; bj < 2; ++bj)
#pragma unroll
            for (int n = 0; n < 2; ++n) sv[bj][n] = *(const f32x4*)(scale + col0 + bj * HALF + 4 * n);
#pragma unroll
        for (int ai = 0; ai < 2; ++ai)
#pragma unroll
            for (int m = 0; m < 4; ++m) { bf16_t* rowp = O + (size_t)(row0 + ai * HALF + m * 16) * ldc + col0;
#pragma unroll
                for (int bj = 0; bj < 2; ++bj) {
#ifdef PROBE_YB8
                    f32x4 a0 = acc[ai][bj][m][0] * sv[bj][0], a1 = acc[ai][bj][m][1] * sv[bj][1];
#pragma unroll
                    for (int e = 0; e < 4; ++e) { a0[e] = __builtin_amdgcn_cvt_f32_fp8(__builtin_amdgcn_cvt_pk_fp8_f32(a0[e], a0[e], 0, false), 0); a1[e] = __builtin_amdgcn_cvt_f32_fp8(__builtin_amdgcn_cvt_pk_fp8_f32(a1[e], a1[e], 0, false), 0); }
                    *(u32x4*)(rowp + bj * HALF) = pack8(a0, a1);
#else
                    *(u32x4*)(rowp + bj * HALF) = pack8(acc[ai][bj][m][0] * sv[bj][0], acc[ai][bj][m][1] * sv[bj][1]);
#endif
                } }
    }
};
struct EpiLora {
    static constexpr bool PERM = true;
    bf16_t* LW; bf16_t* AA; const float* w0; const float* a0;
    __device__ __forceinline__ void operator()(const f32x4 (&acc)[2][2][4][2], const Unit& u, int wr, int wc, int fr, int fq) const {
        const bool isw = u.pn < 4; const int ct = (u.pn & 3) * BM;
        bf16_t* O = isw ? LW : AA; const float* bias = isw ? w0 : a0; const float sc = isw ? -0.6065306597126334f : 1.0f;
        const int row0 = u.pm * BM + wr * 64 + fr, col0 = ct + wc * 32 + 8 * fq;
        f32x4 bv[2][2];
#pragma unroll
        for (int bj = 0; bj < 2; ++bj)
#pragma unroll
            for (int n = 0; n < 2; ++n) bv[bj][n] = *(const f32x4*)(bias + col0 + bj * HALF + 4 * n);
#pragma unroll
        for (int ai = 0; ai < 2; ++ai)
#pragma unroll
            for (int m = 0; m < 4; ++m) { bf16_t* rowp = O + (size_t)(row0 + ai * HALF + m * 16) * 1024 + col0;
#pragma unroll
                for (int bj = 0; bj < 2; ++bj) { const f32x4 v0 = sigm4(acc[ai][bj][m][0] + bv[bj][0]) * sc, v1 = sigm4(acc[ai][bj][m][1] + bv[bj][1]) * sc;
                    *(u32x4*)(rowp + bj * HALF) = pack8(v0, v1); } }
    }
};
__device__ __forceinline__ u32x4 ld16_dev(const void* p) { u32x4 v; asm volatile("global_load_dwordx4 %0, %1, off sc0 sc1\n\ts_waitcnt vmcnt(0)" : "=v"(v) : "v"(p) : "memory"); return v; }
struct EpiMerge {
    static constexpr bool PERM = true;
    bf16_t* TS; bf16_t* MG; float gs, s5;
    __device__ __forceinline__ void operator()(const f32x4 (&acc)[2][2][4][2], const Unit& u, int wr, int wc, int fr, int fq) const {
        const int lr0 = wr * 64 + fr, lc0 = wc * 32 + 8 * fq;
        if (!(u.sub & 1)) {
#pragma unroll
            for (int ai = 0; ai < 2; ++ai)
#pragma unroll
                for (int m = 0; m < 4; ++m) { bf16_t* rowp = TS + (size_t)(lr0 + ai * HALF + m * 16) * 256 + lc0;
#pragma unroll
                    for (int bj = 0; bj < 2; ++bj) *(u32x4*)(rowp + bj * HALF) = pack8(sigm4(acc[ai][bj][m][0] * gs), sigm4(acc[ai][bj][m][1] * gs)); }
        } else {
            const bool first = (u.sub == 1); const float bs = (u.sub == 5) ? s5 : 1.0f;
#pragma unroll
            for (int ai = 0; ai < 2; ++ai)
#pragma unroll
                for (int m = 0; m < 4; ++m) { const bf16_t* trow = TS + (size_t)(lr0 + ai * HALF + m * 16) * 256 + lc0;
                    bf16_t* grow = MG + (size_t)(u.pm * BM + lr0 + ai * HALF + m * 16) * 1024 + u.pn * BM + lc0;
#pragma unroll
                    for (int bj = 0; bj < 2; ++bj) { f32x4 t0, t1; unpack8(*(const u32x4*)(trow + bj * HALF), t0, t1);
                        f32x4 r0 = t0 * (acc[ai][bj][m][0] * bs), r1 = t1 * (acc[ai][bj][m][1] * bs);
                        if (!first) { f32x4 g0, g1; unpack8(*(const u32x4*)(grow + bj * HALF), g0, g1); r0 += g0; r1 += g1; }
                        *(u32x4*)(grow + bj * HALF) = pack8(r0, r1); }
                    asm volatile("" ::: "memory"); }
        }
    }
};
struct EpiResF32 {
    static constexpr bool PERM = false;
    const float* base; float* out; int ldc;
    __device__ __forceinline__ void operator()(const f32x4 (&acc)[2][2][4][2], const Unit& u, int wr, int wc, int fr, int fq) const {
        const int row0 = u.pm * BM + wr * 64 + fr, col0 = u.pn * BM + wc * 32 + 4 * fq;
#pragma unroll
        for (int ai = 0; ai < 2; ++ai)
#pragma unroll
            for (int m = 0; m < 4; ++m) { const size_t off = (size_t)(row0 + ai * HALF + m * 16) * ldc + col0;
#pragma unroll
                for (int bj = 0; bj < 2; ++bj)
#pragma unroll
                    for (int n = 0; n < 2; ++n) { const f32x4 b = *(const f32x4*)(base + off + bj * HALF + n * 16); *(f32x4*)(out + off + bj * HALF + n * 16) = b + acc[ai][bj][m][n]; } }
    }
};
struct EpiResBf {
    static constexpr bool PERM = false;
    const float* srcf; bf16_t* xb; int ldo;
    __device__ __forceinline__ void operator()(const f32x4 (&acc)[2][2][4][2], const Unit& u, int wr, int wc, int fr, int fq) const {
        const int row0 = u.pm * BM + wr * 64 + fr, col0 = u.pn * BM + wc * 32 + 4 * fq;
        typedef unsigned u32x2 __attribute__((ext_vector_type(2)));
#pragma unroll
        for (int ai = 0; ai < 2; ++ai)
#pragma unroll
            for (int m = 0; m < 4; ++m) { const int row = row0 + ai * HALF + m * 16;
#pragma unroll
                for (int bj = 0; bj < 2; ++bj)
#pragma unroll
                    for (int n = 0; n < 2; ++n) { const int col = col0 + bj * HALF + n * 16; bf16_t* xp = xb + (size_t)row * ldo + col; f32x4 b;
                        if (srcf) b = *(const f32x4*)(srcf + (size_t)row * 1024 + col);
                        else { const u32x2 w = *(const u32x2*)xp; b = (f32x4){__uint_as_float(w.x << 16), __uint_as_float(w.x & 0xffff0000u), __uint_as_float(w.y << 16), __uint_as_float(w.y & 0xffff0000u)}; }
                        const f32x4 r = b + acc[ai][bj][m][n]; *(u32x2*)xp = (u32x2){cvt_pk_bf16(r[0], r[1]), cvt_pk_bf16(r[2], r[3])}; } }
    }
};
__device__ __forceinline__ float clamp_e4m3(float v) { return __builtin_amdgcn_fmed3f(v, -448.0f, 448.0f); }
__device__ __forceinline__ unsigned pk4_fp8(float a, float b, float c, float d) { unsigned w = 0u; w = __builtin_amdgcn_cvt_pk_fp8_f32(clamp_e4m3(a), clamp_e4m3(b), w, false); w = __builtin_amdgcn_cvt_pk_fp8_f32(clamp_e4m3(c), clamp_e4m3(d), w, true); return w; }
template <bool OUT8> struct EpiSwiGLU {
    static constexpr bool PERM = true;
    bf16_t* HID; int ldc; float s, so;
    __device__ __forceinline__ void operator()(const f32x4 (&acc)[2][2][4][2], const Unit& u, int wr, int wc, int fr, int fq) const {
        const int row0 = u.pm * BM + wr * 64 + fr, col0 = u.pn * HALF + wc * 32 + 8 * fq;
#pragma unroll
        for (int ai = 0; ai < 2; ++ai)
#pragma unroll
            for (int m = 0; m < 4; ++m) {
                const f32x4 g0 = acc[ai][0][m][0] * s, g1 = acc[ai][0][m][1] * s;
                const f32x4 h0 = g0 * sigm4(g0) * (acc[ai][1][m][0] * (s * so)), h1 = g1 * sigm4(g1) * (acc[ai][1][m][1] * (s * so));
                if constexpr (OUT8) { unsigned char* rowp = (unsigned char*)HID + (size_t)(row0 + ai * HALF + m * 16) * ldc + col0;
                    typedef unsigned u32x2 __attribute__((ext_vector_type(2))); *(u32x2*)rowp = (u32x2){pk4_fp8(h0[0], h0[1], h0[2], h0[3]), pk4_fp8(h1[0], h1[1], h1[2], h1[3])}; }
                else { bf16_t* rowp = HID + (size_t)(row0 + ai * HALF + m * 16) * ldc + col0; *(u32x4*)rowp = pack8(h0, h1); } }
    }
};
struct EpiRowScale {
    static constexpr bool PERM = true;
    bf16_t* O; int ldc; const float* rscale; float cs;
    __device__ __forceinline__ void operator()(const f32x4 (&acc)[2][2][4][2], const Unit& u, int wr, int wc, int fr, int fq) const {
        const int row0 = u.pm * BM + wr * 64 + fr, col0 = u.pn * BM + wc * 32 + 8 * fq;
#pragma unroll
        for (int ai = 0; ai < 2; ++ai)
#pragma unroll
            for (int m = 0; m < 4; ++m) { const int row = row0 + ai * HALF + m * 16; const float s = rscale[row] * cs; bf16_t* rowp = O + (size_t)row * ldc + col0;
#pragma unroll
                for (int bj = 0; bj < 2; ++bj) *(u32x4*)(rowp + bj * HALF) = pack8(acc[ai][bj][m][0] * s, acc[ai][bj][m][1] * s); }
    }
};

typedef int v8i32_t __attribute__((ext_vector_type(8))); typedef int v4i32_t __attribute__((ext_vector_type(4)));
__device__ __forceinline__ v8i32_t cat16(const bf16x8& a, const bf16x8& b) { typedef short s16_t __attribute__((ext_vector_type(16))); const s16_t c = __builtin_shufflevector(a, b, 0, 1, 2, 3, 4, 5, 6, 7, 8, 9, 10, 11, 12, 13, 14, 15); return __builtin_bit_cast(v8i32_t, c); }
template <class Epi, class Sched, bool ALIGN_EPI, bool TWO_LDA = false, bool GATHER = false, bool FP8 = false, bool MIXED = false>
__device__ __forceinline__ void gemm_phase(PG8_LAS unsigned char* lds, const int tid, const int lda0, const int lda1, const int ldb, const Sched& S, const Epi& E) {
    const int wid = __builtin_amdgcn_readfirstlane(tid >> 6), lane = tid & 63, wr = wid >> 2, wc = wid & 3, fr = lane & 15, fq = lane >> 4;
    unsigned voffA0[2], voffA1[2], voffB[2]; int gR[2], gC[2];
#pragma unroll
    for (int i = 0; i < 2; ++i) { int R, C; stage_rc(tid * 16 + i * 8192, R, C); gR[i] = R; gC[i] = C; const int Rb = Epi::PERM ? ((R & ~31) + perm32(R & 31)) : R;
        voffA0[i] = (unsigned)(R * lda0 + C) * 2u; voffA1[i] = TWO_LDA ? (unsigned)(R * lda1 + C) * 2u : 0u; voffB[i] = (unsigned)(Rb * ldb + C) * 2u; }
    const size_t kstep = (size_t)(BK * 2);
    const unsigned hsB = (unsigned)HALF * ldb * 2, hsA0 = (unsigned)HALF * lda0 * 2, hsA1 = (unsigned)HALF * lda1 * 2;
    const unsigned ldsw = (unsigned)wid * 1024u;
    const int aoff = lds_byte(wr * 64 + fr, fq * 8), boff = lds_byte(wc * 32 + fr, fq * 8);
#define PG8_SA(b, h) (((b) * 2 + (h)) * HTB)
#define PG8_SB(b, h) ((4 + (b) * 2 + (h)) * HTB)
#define PG8_STAGE(bufoff, gbase, voff) do { _Pragma("unroll") for (int _i = 0; _i < 2; ++_i) \
        __builtin_amdgcn_global_load_lds((const unsigned*)((const char*)(gbase) + (voff)[_i]), (PG8_LAS unsigned*)(lds + (bufoff) + ldsw + _i * 8192), 16, 0, 0); } while (0)
#define PG8_LDA4(dst, b, h) do { _Pragma("unroll") for (int m = 0; m < 4; ++m) _Pragma("unroll") for (int k = 0; k < 2; ++k) dst[m][k] = *(const PG8_LAS bf16x8*)(lds + PG8_SA(b, h) + aoff + m * 2048 + k * 1024); } while (0)
#define PG8_LDB4(dst, b, h) do { _Pragma("unroll") for (int n = 0; n < 2; ++n) _Pragma("unroll") for (int k = 0; k < 2; ++k) dst[n][k] = *(const PG8_LAS bf16x8*)(lds + PG8_SB(b, h) + boff + n * 2048 + k * 1024); } while (0)
#define PG8_LDA8(dst, b, h) do { _Pragma("unroll") for (int m = 0; m < 4; ++m) { const bf16x8 l0_ = *(const PG8_LAS bf16x8*)(lds + PG8_SA(b, h) + aoff + m * 2048), l1_ = *(const PG8_LAS bf16x8*)(lds + PG8_SA(b, h) + aoff + m * 2048 + 1024); dst##8[m] = cat16(l0_, l1_); } } while (0)
#define PG8_LDB8(dst, b, h) do { _Pragma("unroll") for (int n = 0; n < 2; ++n) { const bf16x8 l0_ = *(const PG8_LAS bf16x8*)(lds + PG8_SB(b, h) + boff + n * 2048), l1_ = *(const PG8_LAS bf16x8*)(lds + PG8_SB(b, h) + boff + n * 2048 + 1024); dst##8[n] = cat16(l0_, l1_); } } while (0)
#define PG8_MMAB(ai, bj, At, Bt) do { __builtin_amdgcn_s_setprio(1); _Pragma("unroll") for (int m = 0; m < 4; ++m) _Pragma("unroll") for (int n = 0; n < 2; ++n) _Pragma("unroll") for (int k = 0; k < 2; ++k) \
        acc[ai][bj][m][n] = __builtin_amdgcn_mfma_f32_16x16x32_bf16(Bt[n][k], At[m][k], acc[ai][bj][m][n], 0, 0, 0); __builtin_amdgcn_s_setprio(0); } while (0)
#define PG8_MMA16A(ai, bj, At, Bt) do { __builtin_amdgcn_s_setprio(1); _Pragma("unroll") for (int m = 0; m < 4; ++m) _Pragma("unroll") for (int n = 0; n < 2; ++n) _Pragma("unroll") for (int k = 0; k < 2; ++k) \
        asm volatile("v_mfma_f32_16x16x32_bf16 %0, %1, %2, %0" : "+v"(acc[ai][bj][m][n]) : "v"(Bt[n][k]), "v"(At[m][k])); __builtin_amdgcn_s_setprio(0); } while (0)
#define PG8_MMA8(ai, bj, At, Bt) do { __builtin_amdgcn_s_setprio(1); _Pragma("unroll") for (int m = 0; m < 4; ++m) _Pragma("unroll") for (int n = 0; n < 2; ++n) \
        asm volatile("v_mfma_scale_f32_16x16x128_f8f6f4 %0, %1, %2, %0, %3, %3 op_sel_hi:[0,0,0]" : "+v"(acc[ai][bj][m][n]) : "v"(Bt##8[n]), "v"(At##8[m]), "v"(sc127)); __builtin_amdgcn_s_setprio(0); } while (0)
#define PG8_WAIT_V(n) asm volatile("s_waitcnt vmcnt(" #n ")" ::: "memory")
#define PG8_WAIT_L(n) asm volatile("s_waitcnt lgkmcnt(" #n ")" ::: "memory")
#define PG8_BAR __builtin_amdgcn_s_barrier()
#define PG8_SCHED __builtin_amdgcn_sched_barrier(0)
#define PG8_KLOOP(LDA_, LDB_, MMA_) \
        for (int t = 0; t < nt; t += 2) { \
            const bool last = (t == nt - 2); \
            const char* a1 = cA + (size_t)(t + 1) * kstep; \
            const char* a2 = last ? nA : cA + (size_t)(t + 2) * kstep; const char* b2 = last ? nB : cB + (size_t)(t + 2) * kstep; \
            const char* a3 = a2 + kstep; const char* b3 = b2 + kstep; \
            LDB_(B0, 0, 0); LDB_(B1, 0, 1); PG8_SCHED; LDA_(At, 0, 0); PG8_STAGE_A(PG8_SA(1, 1), a1, 1, false); \
            PG8_WAIT_V(8); PG8_WAIT_L(0); PG8_BAR; MMA_(0, 0, At, B0); MMA_(0, 1, At, B1); PG8_BAR; PG8_SCHED; \
            LDA_(At, 0, 1); PG8_STAGE(PG8_SB(0, 0), b2, voffB); PG8_STAGE(PG8_SB(0, 1), b2 + hsB, voffB); PG8_STAGE_A(PG8_SA(0, 0), a2, 0, last); \
            PG8_WAIT_V(8); PG8_WAIT_L(0); PG8_BAR; MMA_(1, 0, At, B0); MMA_(1, 1, At, B1); PG8_BAR; PG8_SCHED; \
            LDB_(B0, 1, 0); LDB_(B1, 1, 1); PG8_SCHED; LDA_(At, 1, 0); PG8_STAGE_A(PG8_SA(0, 1), a2, 1, last); \
            PG8_WAIT_V(8); PG8_WAIT_L(0); PG8_BAR; MMA_(0, 0, At, B0); MMA_(0, 1, At, B1); PG8_BAR; PG8_SCHED; \
            LDA_(At, 1, 1); PG8_STAGE(PG8_SB(1, 0), b3, voffB); PG8_STAGE(PG8_SB(1, 1), b3 + hsB, voffB); PG8_STAGE_A(PG8_SA(1, 0), a3, 0, last); \
            PG8_WAIT_V(8); PG8_WAIT_L(0); PG8_BAR; MMA_(1, 0, At, B0); MMA_(1, 1, At, B1); PG8_BAR; PG8_SCHED; \
        }
    Unit cur, nxt; int ui = 0;
    if (!S.next(0, cur)) return;
    f32x4 acc[2][2][4][2];
#pragma unroll
    for (int a = 0; a < 2; ++a)
#pragma unroll
        for (int b = 0; b < 2; ++b)
#pragma unroll
            for (int m = 0; m < 4; ++m)
#pragma unroll
                for (int n = 0; n < 2; ++n) acc[a][b][m][n] = (f32x4){0.f, 0.f, 0.f, 0.f};
    const int sc127 = 127;
    bf16x8 At[4][2], B0[2][2], B1[2][2]; v8i32_t At8[4], B08[2], B18[2];
    const char* cA; const char* cB; int nt; bool selc;
    S.ops(cur, cA, cB, nt, selc); selc = (TWO_LDA || MIXED) && selc;
    nt = __builtin_amdgcn_readfirstlane(nt); asm volatile("" : "+s"(nt));
    unsigned hsAc = selc ? hsA1 : hsA0;
    unsigned vgc0[2] = {0u, 0u}, vgc1[2] = {0u, 0u}, vgn0[2] = {0u, 0u}, vgn1[2] = {0u, 0u};
    if constexpr (GATHER) {
#pragma unroll
        for (int i = 0; i < 2; ++i) { vgc0[i] = (unsigned)(S.grow(cur, gR[i]) * lda0 + gC[i]) * 2u; vgc1[i] = (unsigned)(S.grow(cur, HALF + gR[i]) * lda0 + gC[i]) * 2u; } }
#define PG8_STAGE_A(bufoff, gbase, hf, nx) do { if constexpr (GATHER) { const unsigned v_[2] = { (nx) ? vgn##hf[0] : vgc##hf[0], (nx) ? vgn##hf[1] : vgc##hf[1] }; PG8_STAGE(bufoff, gbase, v_); } \
        else { const unsigned v_[2] = PG8_VA((nx) ? seln : selc); PG8_STAGE(bufoff, (gbase) + ((hf) ? ((nx) ? hsAn : hsAc) : 0u), v_); } } while (0)
#define PG8_VA(sel) { (TWO_LDA && (sel)) ? voffA1[0] : voffA0[0], (TWO_LDA && (sel)) ? voffA1[1] : voffA0[1] }
    { const bool seln = selc; const unsigned hsAn = hsAc;
    PG8_STAGE(PG8_SB(0, 0), cB, voffB); PG8_STAGE(PG8_SB(0, 1), cB + hsB, voffB); PG8_STAGE_A(PG8_SA(0, 0), cA, 0, false); PG8_STAGE_A(PG8_SA(0, 1), cA, 1, false);
    if (wr == 1) PG8_BAR;
    PG8_WAIT_V(2); PG8_BAR;
    PG8_STAGE(PG8_SB(1, 0), cB + kstep, voffB); PG8_STAGE_A(PG8_SA(1, 0), cA + kstep, 0, false); PG8_STAGE(PG8_SB(1, 1), cB + hsB + kstep, voffB); }
    PG8_WAIT_V(6); PG8_BAR;
    for (;;) {
        const bool has_next = S.next(ui + 1, nxt);
        const char* nA = cA; const char* nB = cB; int ntn = nt; bool seln = selc;
        if (has_next) { S.ops(nxt, nA, nB, ntn, seln); seln = (TWO_LDA || MIXED) && seln; }
        const unsigned hsAn = seln ? hsA1 : hsA0;
        if constexpr (GATHER) {
#pragma unroll
            for (int i = 0; i < 2; ++i) { vgn0[i] = has_next ? (unsigned)(S.grow(nxt, gR[i]) * lda0 + gC[i]) * 2u : vgc0[i]; vgn1[i] = has_next ? (unsigned)(S.grow(nxt, HALF + gR[i]) * lda0 + gC[i]) * 2u : vgc1[i]; } }
        if constexpr (MIXED) { if (selc) { PG8_KLOOP(PG8_LDA8, PG8_LDB8, PG8_MMA8) } else { PG8_KLOOP(PG8_LDA4, PG8_LDB4, PG8_MMA16A) } }
        else if constexpr (FP8) { PG8_KLOOP(PG8_LDA8, PG8_LDB8, PG8_MMA8) }
        else { PG8_KLOOP(PG8_LDA4, PG8_LDB4, PG8_MMAB) }
        if constexpr (ALIGN_EPI) { if (wr == 0) PG8_BAR; }
        if constexpr (FP8 || MIXED) asm volatile("s_nop 15\n\ts_nop 15" ::: "memory");
        { int t_ = tid; asm volatile("" : "+v"(t_)); const int fr_ = t_ & 15, fq_ = (t_ >> 4) & 3; E(acc, cur, wr, wc, fr_, fq_); }
        if (!has_next) break;
#pragma unroll
        for (int a = 0; a < 2; ++a)
#pragma unroll
            for (int b = 0; b < 2; ++b)
#pragma unroll
                for (int m = 0; m < 4; ++m)
#pragma unroll
                    for (int n = 0; n < 2; ++n) acc[a][b][m][n] = (f32x4){0.f, 0.f, 0.f, 0.f};
        cur = nxt; cA = nA; cB = nB; selc = seln; hsAc = hsAn; nt = ntn; ++ui;
        if constexpr (GATHER) { vgc0[0] = vgn0[0]; vgc0[1] = vgn0[1]; vgc1[0] = vgn1[0]; vgc1[1] = vgn1[1]; }
        if constexpr (ALIGN_EPI) { if (wr == 1) PG8_BAR; }
    }
    PG8_WAIT_V(0);
    if constexpr (!ALIGN_EPI) { if (wr == 0) PG8_BAR; }
    PG8_BAR;
#undef PG8_VA
#undef PG8_STAGE_A
#undef PG8_SA
#undef PG8_SB
#undef PG8_STAGE
#undef PG8_MMAB
#undef PG8_MMA8
#undef PG8_MMA16A
#undef PG8_KLOOP
#undef PG8_LDA4
#undef PG8_LDB4
#undef PG8_LDA8
#undef PG8_LDB8
#undef PG8_WAIT_V
#undef PG8_WAIT_L
#undef PG8_BAR
#undef PG8_SCHED
}
}

#include <hip/hip_bf16.h>
#include <cmath>
namespace attn_body {
using bf16=__hip_bfloat16;
using i32x8=__attribute__((ext_vector_type(8)))int;
using i32x4=__attribute__((ext_vector_type(4)))int;
using f32x16=__attribute__((ext_vector_type(16)))float;
using u32x4=__attribute__((ext_vector_type(4)))unsigned;
constexpr int BATCH=8,NHEAD=8,SEQ=8192,D=64,DM=NHEAD*D;
constexpr int Q8P=1024,O8P=4096; constexpr float OSC=64.0f;
constexpr int NW=8,QBLK=32,QB=QBLK*NW,KVBLK=64,NQB=SEQ/QB;
__device__ __forceinline__ int crow(int r,int hi){return (r&3)+8*(r>>2)+4*hi;}
#define SBAR() __builtin_amdgcn_sched_barrier(0)
constexpr int NSLOT=3, SLOTB=4096;
constexpr int LDS_K=0, LDS_V=NSLOT*SLOTB, LDS_WS=2*NSLOT*SLOTB, LDS_OST=LDS_WS+NW*64*4, LDS_BYTES=LDS_OST+NW*4096;
__device__ __forceinline__ void glds16(const void*gsrc,unsigned lds_dst){unsigned keep;
  asm volatile("s_mov_b32 %0, m0\n\ts_mov_b32 m0, %2\n\ts_nop 0\n\tglobal_load_lds_dwordx4 %1, off\n\ts_mov_b32 m0, %0":"=&s"(keep):"v"(gsrc),"s"(lds_dst):"memory");}
#define WAIT_BAR(N) asm volatile("s_waitcnt vmcnt(" #N ") lgkmcnt(0)\n\ts_barrier":::"memory")
typedef __attribute__((address_space(3))) const char* lds_cptr;
__device__ __forceinline__ i32x8 frag32(lds_cptr p){ const i32x4 a=*(const __attribute__((address_space(3))) i32x4*)(p), b=*(const __attribute__((address_space(3))) i32x4*)(p+1024); return (i32x8){a[0],a[1],a[2],a[3],b[0],b[1],b[2],b[3]}; }
#define MFMA_QK(D_,A,B,C) asm volatile("v_mfma_scale_f32_32x32x64_f8f6f4 %0, %1, %2, %3, %4, %5 op_sel_hi:[0,0,0]":"=&v"(D_):"v"(A),"v"(B),"v"(C),"v"(scA),"v"(scB))
#define MFMA_PV(D_,A,B) asm volatile("v_mfma_f32_32x32x64_f8f6f4 %0, %1, %2, %0 cbsz:1":"+v"(D_):"v"(A),"v"(B))

#ifndef ATTN_STORE16
#define ATTN_STORE16(p,v) (*(u32x4*)(p)=(v))
#endif
__device__ __forceinline__ void attn_unit(int tid_in,float negM,int b,int h,int qb,const unsigned char*Q8,const unsigned char*__restrict__ K8,const unsigned char*__restrict__ Vt8,unsigned char*O8,char*shm,const bool do_store=true){
  const int tid=tid_in,lane=tid&63,r32=lane&31,hi=lane>>5; const int wid=__builtin_amdgcn_readfirstlane(tid>>6);
  const long rowbase=(long)b*SEQ; const int q0=qb*QB; const int kvh=h>>2;
  const unsigned lds0=(unsigned)(uintptr_t)shm;
  const bool kw=wid<4;
  const int ki=lane&31, kkey=32*((ki>>2)&1)+16*(lane>>5)+(ki&3)+4*(ki>>3);
  const unsigned char*ksrc=K8+((long)(b*2+kvh)*SEQ+kkey)*64+(wid&3)*16;
  const unsigned char*vsrc=Vt8+((long)(b*2+kvh)*64+lane)*SEQ+(wid&3)*16;
  const unsigned char*dsrc=kw?ksrc:vsrc; const int dstep=kw?KVBLK*64:KVBLK;
  const unsigned ddst=lds0+(kw?LDS_K:LDS_V)+(wid&3)*1024;
  const int NT=SEQ/KVBLK;
  #define DMA(tt,slot) do{ int ti_=(tt); ti_=ti_<NT?ti_:NT-1; glds16(dsrc+(long)ti_*dstep,(unsigned)__builtin_amdgcn_readfirstlane(ddst+(slot))); }while(0)
  const lds_cptr shm3=(lds_cptr)shm; const lds_cptr kp0=shm3+LDS_K+hi*2048+r32*16; const lds_cptr vp0=shm3+LDS_V+hi*2048+r32*16;
  const unsigned char*Qw=Q8+(rowbase+q0+wid*QBLK+r32)*Q8P+h*128+hi*32;
  const i32x4 qa=*(const i32x4*)Qw, qb_=*(const i32x4*)(Qw+16);
  const i32x8 qf=(i32x8){qa[0],qa[1],qa[2],qa[3],qb_[0],qb_[1],qb_[2],qb_[3]};
  if(kw){DMA(0,0);DMA(1,SLOTB);DMA(2,2*SLOTB);}
  f32x16 o[2],ol;o[0]=f32x16{};o[1]=f32x16{};ol=f32x16{};f32x16 negm;
  #pragma unroll
  for(int r=0;r<16;++r)negm[r]=negM;
  asm volatile("":"+v"(negm));
  f32x16 pA0,pA1,pB0,pB1; i32x8 kf0,kf1,vf0,vf1,pw0=(i32x8){0,0,0,0,0,0,0,0},pw1=(i32x8){0,0,0,0,0,0,0,0};
  i32x8 ones; _Pragma("unroll") for(int r=0;r<8;++r)ones[r]=0x38383838; asm volatile("":"+v"(ones));
#ifdef ATT_CODE_EXP
  int scA=127,scB=125; asm volatile("":"+v"(scA),"+v"(scB));
#else
  int scA=127,scB=123; asm volatile("":"+v"(scA),"+v"(scB));
#endif
  int sl_cur=0,sl_next=SLOTB;
  #define ROT() do{sl_cur=sl_next;sl_next=(sl_next==(NSLOT-1)*SLOTB)?0:sl_next+SLOTB;}while(0)
  #define EX(v) __builtin_amdgcn_exp2f(v)
  #define PIN(x) asm volatile("":"+v"(x))
#ifdef ATT_CODE_EXP
  #define PACK2(P,PW,J,LO) do{ _Pragma("unroll") for(int j_=0;j_<2;++j_){ unsigned w_=(unsigned)PW[(J)+j_]; _Pragma("unroll") for(int b_=0;b_<4;++b_) w_=__builtin_amdgcn_cvt_pk_u8_f32(P[(LO)+4*j_+b_],b_,w_); PW[(J)+j_]=(int)w_; } }while(0)
  #define PACK(P,PW,J) do{ PACK2(P,PW,J,0); PACK2(P,PW,(J)+2,8); }while(0)
  #define EXPS(P,LO) do{}while(0)
  #define G1(Y0,Y1,PWN) do{ PACK2(Y0,PWN,0,0); PIN(PWN); }while(0)
  #define G2(Y0,Y1,PWN) do{ PACK2(Y0,PWN,2,8); PIN(PWN); }while(0)
  #define G3(Y0,Y1,PWN) do{ PACK2(Y1,PWN,4,0); PIN(PWN); }while(0)
  #define G4(Y0,Y1,PWN) do{ PACK2(Y1,PWN,6,8); PIN(PWN); }while(0)
  #define G5(Y0,Y1,PWN) do{}while(0)
#else
  #define PK2(P,B,OLD,HIW) __builtin_amdgcn_cvt_pk_bf8_f32(P[B],P[B+1],OLD,HIW)
  #define PACK(P,PW,J) do{ _Pragma("unroll") for(int j_=0;j_<4;++j_){ int w_=PK2(P,4*j_,PW[(J)+j_],false); w_=PK2(P,4*j_+2,w_,true); PW[(J)+j_]=w_; } }while(0)
  #define EXPS(P,LO) do{ _Pragma("unroll") for(int r_=(LO);r_<(LO)+8;++r_)P[r_]=EX(P[r_]); PIN(P); }while(0)
  #define G1(Y0,Y1,PWN) EXPS(Y0,0)
  #define G2(Y0,Y1,PWN) EXPS(Y0,8)
  #define G3(Y0,Y1,PWN) EXPS(Y1,0)
  #define G4(Y0,Y1,PWN) EXPS(Y1,8)
  #define G5(Y0,Y1,PWN) do{ PACK(Y0,PWN,0); PACK(Y1,PWN,4); PIN(PWN); }while(0)
#endif
  if(kw){asm volatile("s_waitcnt vmcnt(2)":::"memory");}else{asm volatile("s_waitcnt vmcnt(0)":::"memory");}
  asm volatile("s_barrier":::"memory");
  kf0=frag32(kp0);kf1=frag32(kp0+512);
  MFMA_QK(pA0,kf0,qf,negm);MFMA_QK(pA1,kf1,qf,negm);asm volatile("s_nop 15\n\ts_nop 7":"+v"(pA0),"+v"(pA1));
  WAIT_BAR(1);
  DMA(kw?3:0,0);
  ROT();
  kf0=frag32(kp0+sl_cur);kf1=frag32(kp0+sl_cur+512);
  WAIT_BAR(1);
  MFMA_QK(pB0,kf0,qf,negm); EXPS(pA0,0); EXPS(pA0,8); SBAR();
  MFMA_QK(pB1,kf1,qf,negm); EXPS(pA1,0); EXPS(pA1,8); SBAR();
  DMA(kw?4:1,sl_cur);
  kf0=frag32(kp0+sl_next);kf1=frag32(kp0+sl_next+512);
  PACK(pA0,pw0,0); PACK(pA1,pw0,4); PIN(pw0);
  WAIT_BAR(1); ROT();
  #define STEP(X0,X1,Y0,Y1,PWN,PWO,t) do{ SBAR(); \
    vf0=frag32(vp0+sl_next); vf1=frag32(vp0+sl_next+512); SBAR(); \
    MFMA_QK(X0,kf0,qf,negm); G1(Y0,Y1,PWN); SBAR(); \
    MFMA_QK(X1,kf1,qf,negm); G2(Y0,Y1,PWN); SBAR(); \
    DMA(kw?(t)+3:(t),sl_cur); \
    kf0=frag32(kp0+sl_next); kf1=frag32(kp0+sl_next+512); SBAR(); \
    MFMA_PV(o[0],PWO,vf0); G3(Y0,Y1,PWN); SBAR(); \
    MFMA_PV(o[1],PWO,vf1); G4(Y0,Y1,PWN); SBAR(); \
    MFMA_PV(ol,PWO,ones); G5(Y0,Y1,PWN); SBAR(); \
    }while(0)
  for(int t=2;t<NT;t+=2){
    STEP(pA0,pA1,pB0,pB1,pw1,pw0,t);     WAIT_BAR(1); ROT();
    STEP(pB0,pB1,pA0,pA1,pw0,pw1,t+1);   WAIT_BAR(1); ROT();
  }
  { vf0=frag32(vp0+sl_next); vf1=frag32(vp0+sl_next+512);
    MFMA_PV(o[0],pw0,vf0); EXPS(pB0,0); EXPS(pB0,8); SBAR();
    MFMA_PV(o[1],pw0,vf1); EXPS(pB1,0); EXPS(pB1,8); SBAR();
    DMA(NT,sl_cur);
    MFMA_PV(ol,pw0,ones); PACK(pB0,pw1,0); PACK(pB1,pw1,4); PIN(pw1);
    WAIT_BAR(1); ROT(); }
  { vf0=frag32(vp0+sl_next); vf1=frag32(vp0+sl_next+512);
    MFMA_PV(o[0],pw1,vf0); MFMA_PV(o[1],pw1,vf1); MFMA_PV(ol,pw1,ones); asm volatile("s_nop 15\n\ts_nop 7":"+v"(o[0]),"+v"(o[1]),"+v"(ol)); }
#ifndef ATT_CODE_EXP
  #undef PK2
#else
  #undef PACK2
#endif
  #undef PACK
  #undef G1
  #undef G2
  #undef G3
  #undef G4
  #undef G5
  #undef EXPS
  #undef PIN
  #undef EX
  #undef STEP
  float rli[16];
  #pragma unroll
  for(int r=0;r<16;++r)rli[r]=__builtin_amdgcn_rcpf(ol[r])*OSC;
  unsigned char*Ow=O8+(rowbase+q0+wid*QBLK)*(long)O8P+h*D;
  { unsigned char*stg=(unsigned char*)(shm+LDS_OST)+wid*2048;
    #pragma unroll
    for(int r=0;r<16;++r){const int orow=crow(r,hi);
      #pragma unroll
      for(int d0=0;d0<2;++d0){ const float v_=__builtin_amdgcn_fmed3f(o[d0][r]*rli[r],-448.0f,448.0f); stg[orow*64+d0*32+r32]=(unsigned char)__builtin_amdgcn_cvt_pk_fp8_f32(v_,v_,0,false); } }
    asm volatile("s_waitcnt lgkmcnt(0)":::"memory");
    #pragma unroll
    for(int i=0;i<2;++i){const int idx=i*64+lane,row=idx>>2,ch=idx&3; const u32x4 v=*(const u32x4*)(stg+row*64+ch*16); if(do_store)ATTN_STORE16(Ow+(long)row*O8P+ch*16,v);} }
  asm volatile("s_waitcnt vmcnt(0) lgkmcnt(0)\n\ts_barrier":::"memory");
  #undef DMA
  #undef ROT
}
constexpr int ATTN_LDS_BYTES=LDS_BYTES;
#undef SBAR
#undef WAIT_BAR
#undef MFMA_QK
#undef MFMA_PV
}

constexpr int NWAVES = 8, NTHR = NWAVES * 64;
constexpr int BATCH = 8, SEQ = 8192, DMODEL = 1024, M = BATCH * SEQ;
constexpr int NPJ = 3328;
constexpr int COL_VL = 1920, COL_POOL = 2048, COL_Q = 2560, COL_K = 3072, COL_V = 3200;
constexpr int NEXP = 16, CAP = 1024, MR = BATCH * NEXP * CAP;
constexpr int NPROJ_IN = 6272;
constexpr float C2Q = 0.125f * 1.4426950408889634f;
constexpr int N_PHASES = 28, PH_PER_LAYER = 13;
constexpr int XBP = 2048;

constexpr size_t MiB = 1u << 20;
constexpr size_t WS_CTL = 0, CTL_ZERO_BYTES = 1 * MiB;
constexpr size_t WS_ROPE = 1 * MiB;
constexpr size_t WS_W = 3 * MiB, WL_STRIDE = 23 * MiB;
constexpr size_t WO_IN = 0, WO_G = 6656 * 1024, WO_LORA = WO_G + 6 * MiB, WO_G2 = WO_LORA + 1 * MiB, WO_PW = WO_G2 + 256 * 1024, WO_BR = WO_PW + 512 * 1024, WO_OUT = WO_BR + 6 * MiB;
constexpr size_t WO_BRA8 = WO_BR + 3 * MiB;
constexpr size_t WO_QKV8 = WO_G + 3 * MiB;
static_assert(WO_OUT + 2 * MiB <= WL_STRIDE && WO_QKV8 + 768 * 2048 <= WO_LORA, "weight map");
constexpr size_t WS_VF = 49 * MiB, WS_AFFT = 113 * MiB, WS_IDX = 117 * MiB, WS_VAL = WS_IDX + 512 * 1024, WS_INV = 118 * MiB, WS_CFB = 122 * MiB;
constexpr size_t ACT = 128 * MiB;
constexpr size_t A_PRJ = ACT, A_R = ACT + 416 * MiB, A_KS = ACT + 480 * MiB, A_VS = ACT + 544 * MiB, A_Q = ACT + 608 * MiB, A_K = ACT + 672 * MiB, A_V = ACT + 688 * MiB,
                 A_TW = ACT + 704 * MiB, A_PL = ACT + 752 * MiB, A_HN1 = ACT + 672 * MiB;
constexpr size_t A_LW = ACT, A_AA = ACT + 128 * MiB, A_G = ACT + 256 * MiB, A_YB = ACT + 320 * MiB, A_YSF = ACT + 704 * MiB, A_YSB = ACT + 768 * MiB;
constexpr size_t A_HN = ACT, A_YA = ACT + 128 * MiB, A_TS = ACT + 192 * MiB, A_MG = ACT + 416 * MiB;
constexpr size_t A_WGU = ACT + 832 * MiB, A_WD = ACT + 384 * MiB, A_XG = ACT + 416 * MiB, A_HID = ACT + 128 * MiB, A_YE = ACT + 416 * MiB;
constexpr size_t WS_END = ACT + 896 * MiB;
constexpr int CW_BAR = 4096;
constexpr int CW_ATTQ = 200000;

constexpr int RING_OFF = 0, RING_BYTES = 131072;
constexpr int LDSCTL_OFF = RING_BYTES, MISC_OFF = LDSCTL_OFF + 320;
constexpr int LDS_BYTES = 147456;

#define GAS __attribute__((address_space(1)))
#define LAS __attribute__((address_space(3)))
typedef unsigned short bf16;
typedef unsigned v4u __attribute__((ext_vector_type(4)));
typedef unsigned v2u __attribute__((ext_vector_type(2)));
typedef float f32x4 __attribute__((ext_vector_type(4)));
typedef float f32x2 __attribute__((ext_vector_type(2)));
typedef GAS unsigned gu32;
#define RLX_AGENT __ATOMIC_RELAXED, __HIP_MEMORY_SCOPE_AGENT
#define LDS_WAIT() asm volatile("s_waitcnt lgkmcnt(0)" ::: "memory")
typedef float f32x2c_t __attribute__((ext_vector_type(2))); typedef __bf16 bf16x2c_t __attribute__((ext_vector_type(2)));
__device__ __forceinline__ unsigned pk2(float lo, float hi) { const f32x2c_t v = {lo, hi}; const bf16x2c_t b = __builtin_convertvector(v, bf16x2c_t); return __builtin_bit_cast(unsigned, b); }
__device__ __forceinline__ unsigned f2bf(float f) { return pk2(f, 0.f) & 0xffffu; }
__device__ __forceinline__ void unp8(const v4u& p, float (&f)[8]) {
    f[0] = __uint_as_float(p.x << 16); f[1] = __uint_as_float(p.x & 0xffff0000u); f[2] = __uint_as_float(p.y << 16); f[3] = __uint_as_float(p.y & 0xffff0000u);
    f[4] = __uint_as_float(p.z << 16); f[5] = __uint_as_float(p.z & 0xffff0000u); f[6] = __uint_as_float(p.w << 16); f[7] = __uint_as_float(p.w & 0xffff0000u); }
__device__ __forceinline__ v4u pk8(const float (&f)[8]) { v4u o; o.x = pk2(f[0], f[1]); o.y = pk2(f[2], f[3]); o.z = pk2(f[4], f[5]); o.w = pk2(f[6], f[7]); return o; }
__device__ __forceinline__ v4u ld16(const bf16* p) { return *(const v4u*)p; }
__device__ __forceinline__ void st16(bf16* p, const v4u& v) { *(v4u*)p = v; }
__device__ __forceinline__ void ldf8(const float* p, float (&f)[8]) { const f32x4 a = *(const f32x4*)p, b = *(const f32x4*)(p + 4); f[0] = a[0]; f[1] = a[1]; f[2] = a[2]; f[3] = a[3]; f[4] = b[0]; f[5] = b[1]; f[6] = b[2]; f[7] = b[3]; }
__device__ __forceinline__ float sigmf(float x) { return __builtin_amdgcn_rcpf(1.0f + __builtin_amdgcn_exp2f(-1.4426950408889634f * x)); }
__device__ __forceinline__ float shx(float v, int m, int lane) { return __builtin_bit_cast(float, __builtin_amdgcn_ds_bpermute((lane ^ m) << 2, __builtin_bit_cast(int, v))); }
__device__ __forceinline__ float shx_from(float v, int src, int lane) { (void)lane; return __builtin_bit_cast(float, __builtin_amdgcn_ds_bpermute((src & 63) << 2, __builtin_bit_cast(int, v))); }
__device__ __forceinline__ int shxi(int v, int m, int lane) { return __builtin_amdgcn_ds_bpermute((lane ^ m) << 2, v); }
__device__ __forceinline__ int shupi(int v, int o, int lane) { return __builtin_amdgcn_ds_bpermute((lane >= o ? lane - o : lane) << 2, v); }
template <int CTRL> __device__ __forceinline__ float dppf(float v) { return __builtin_bit_cast(float, __builtin_amdgcn_update_dpp(0, __builtin_bit_cast(int, v), CTRL, 0xf, 0xf, true)); }
__device__ __forceinline__ float sum8(float v, int lane) { (void)lane; v += dppf<0xB1>(v); v += dppf<0x4E>(v); v += dppf<0x141>(v); return v; }
__device__ __forceinline__ float sum16(float v) { v += dppf<0xB1>(v); v += dppf<0x4E>(v); v += dppf<0x141>(v); v += dppf<0x140>(v); return v; }
__device__ __forceinline__ float max16(float v) { v = fmaxf(v, dppf<0xB1>(v)); v = fmaxf(v, dppf<0x4E>(v)); v = fmaxf(v, dppf<0x141>(v)); v = fmaxf(v, dppf<0x140>(v)); return v; }
__device__ __forceinline__ float sum_rows(float v) {
    { const auto r = __builtin_amdgcn_permlane16_swap(__builtin_bit_cast(unsigned, v), __builtin_bit_cast(unsigned, v), false, false); v = __uint_as_float(r[0]) + __uint_as_float(r[1]); }
    { const auto r = __builtin_amdgcn_permlane32_swap(__builtin_bit_cast(unsigned, v), __builtin_bit_cast(unsigned, v), false, false); v = __uint_as_float(r[0]) + __uint_as_float(r[1]); }
    return v; }
__device__ __forceinline__ float wave_sum(float v, int lane) { (void)lane; return sum_rows(sum16(v)); }


#define XB_TMO      128
#define XB_XCNT(j)  (256  + 64 * (j))
#define XB_XSUB(j)  (1280 + 64 * (j))
#define XB_XGEN(j)  (2304 + 64 * (j))
#define XB_TOP      3328
#define XB_TOPGEN   3392
#define XCD_BAR_WORDS 3456
#define XB_SPIN_CAP (1u << 22)

__device__ __forceinline__ unsigned xb_ld(unsigned* p)              { return __hip_atomic_load(p, __ATOMIC_RELAXED, __HIP_MEMORY_SCOPE_AGENT); }
__device__ __forceinline__ unsigned xb_add(unsigned* p, unsigned v) { return __hip_atomic_fetch_add(p, v, __ATOMIC_RELAXED, __HIP_MEMORY_SCOPE_AGENT); }
__device__ __forceinline__ unsigned xb_xcc_id() { return (unsigned)__builtin_amdgcn_s_getreg((3 << 11) | 20) & 0xFu; }
#define XB_SPIN(cond, bar) do { unsigned _sp = 0; while (cond) { __builtin_amdgcn_s_sleep(1); \
    if ((++_sp & 255u) == 0u) { if (xb_ld(&(bar)[XB_TMO])) break; if (_sp > XB_SPIN_CAP) { atomicAdd(&(bar)[XB_TMO], 1u); break; } } } } while (0)

struct XcdBarrier {
    unsigned* bar; unsigned x;
    volatile LAS unsigned* st;
};

__device__ __forceinline__ XcdBarrier xcd_barrier_post(unsigned* bar, volatile LAS unsigned* st) {
    XcdBarrier b; b.bar = bar; b.x = xb_xcc_id(); b.st = st;
    if (threadIdx.x == 0) (void)xb_add(&bar[XB_XCNT(b.x)], 1u);
    return b;
}
__device__ __forceinline__ void xcd_barrier_complete(unsigned* bar, unsigned x, unsigned& nloc, unsigned& nx) {
    const unsigned G = gridDim.x * gridDim.y * gridDim.z;
    unsigned sum, cnt, mine, sp = 0u;
    for (;;) {
        sum = 0u; cnt = 0u; mine = 0u;
#pragma unroll
        for (unsigned j = 0; j < 16; ++j) { const unsigned c = xb_ld(&bar[XB_XCNT(j)]); sum += c; cnt += (c > 0u) ? 1u : 0u; mine = (j == x) ? c : mine; }
        if (sum == G) break;
        __builtin_amdgcn_s_sleep(1);
        if ((++sp & 255u) == 0u) { if (xb_ld(&bar[XB_TMO])) break; if (sp > XB_SPIN_CAP) { atomicAdd(&bar[XB_TMO], 1u); break; } }
    }
    nloc = mine > 0u ? mine : 1u; nx = cnt > 0u ? cnt : 1u;
}

__device__ __forceinline__ void xcd_barrier(const XcdBarrier& b) {
    asm volatile("s_waitcnt vmcnt(0)" ::: "memory");
    __syncthreads();
    if (threadIdx.x == 0) {
        unsigned* bar = b.bar;
        __builtin_amdgcn_s_waitcnt(0);
        unsigned nloc = b.st[0], nx = b.st[1];
        if (nloc == 0u) { xcd_barrier_complete(bar, b.x, nloc, nx); b.st[0] = nloc; b.st[1] = nx; }
        const unsigned old = xb_add(&bar[XB_XSUB(b.x)], 1u);
        const unsigned gen = old / nloc;
        if (old + 1u == (gen + 1u) * nloc) {
            __builtin_amdgcn_fence(__ATOMIC_RELEASE, "agent");
            asm volatile("s_waitcnt vmcnt(0)" ::: "memory");
            const unsigned og = xb_add(&bar[XB_TOP], 1u);
            const unsigned tg = og / nx;
            if (og + 1u == (tg + 1u) * nx) xb_add(&bar[XB_TOPGEN], 1u);
            else XB_SPIN(xb_ld(&bar[XB_TOPGEN]) == tg, bar);
            __builtin_amdgcn_fence(__ATOMIC_ACQUIRE, "agent");
            xb_add(&bar[XB_XGEN(b.x)], 1u);
            asm volatile("s_waitcnt vmcnt(0)" ::: "memory");
        } else {
            XB_SPIN(xb_ld(&bar[XB_XGEN(b.x)]) == gen, bar);
            __builtin_amdgcn_fence(__ATOMIC_ACQUIRE, "agent");
            asm volatile("s_waitcnt vmcnt(0)" ::: "memory");
        }
    }
    __syncthreads();
}

__device__ __forceinline__ void tr_item(const float* W, int src_ld, int k0, int n0, bf16* WT, int dst_ld, int dst_row0, LAS float* scr, int lane, float sc = 1.0f) {
    float t_[32];
#pragma unroll
    for (int i = 0; i < 32; ++i) t_[i] = W[(size_t)(k0 + 2 * i + (lane >> 5)) * src_ld + n0 + (lane & 31)];
#pragma unroll
    for (int i = 0; i < 32; ++i) scr[(2 * i + (lane >> 5)) * 33 + (lane & 31)] = t_[i] * sc;
    LDS_WAIT(); asm volatile("" ::: "memory");
    const int c = lane & 7;
#pragma unroll
    for (int j = 0; j < 4; ++j) { const int n = (lane >> 3) + 8 * j; const LAS float* s = scr + (8 * c) * 33 + n;
        v4u o; o.x = pk2(s[0 * 33], s[1 * 33]); o.y = pk2(s[2 * 33], s[3 * 33]); o.z = pk2(s[4 * 33], s[5 * 33]); o.w = pk2(s[6 * 33], s[7 * 33]);
        *(GAS v4u*)(WT + (size_t)(dst_row0 + n) * dst_ld + k0 + 8 * c) = o; }
    LDS_WAIT(); asm volatile("" ::: "memory");
}
__device__ __forceinline__ void tr_item8(const float* W, int src_ld, int k0, int n0, unsigned char* WT8, int dst_ld, int dst_row0, float sc, LAS float* scr, int lane) {
    float t_[32];
#pragma unroll
    for (int i = 0; i < 32; ++i) t_[i] = W[(size_t)(k0 + 2 * i + (lane >> 5)) * src_ld + n0 + (lane & 31)];
#pragma unroll
    for (int i = 0; i < 32; ++i) scr[(2 * i + (lane >> 5)) * 33 + (lane & 31)] = t_[i] * sc;
    LDS_WAIT(); asm volatile("" ::: "memory");
#pragma unroll
    for (int j = 0; j < 2; ++j) { const int q = lane + 64 * j, n = q >> 2, c = q & 3; const LAS float* s = scr + (16 * c) * 33 + n; v4u o;
        o.x = pg8::pk4_fp8(s[0 * 33], s[1 * 33], s[2 * 33], s[3 * 33]); o.y = pg8::pk4_fp8(s[4 * 33], s[5 * 33], s[6 * 33], s[7 * 33]);
        o.z = pg8::pk4_fp8(s[8 * 33], s[9 * 33], s[10 * 33], s[11 * 33]); o.w = pg8::pk4_fp8(s[12 * 33], s[13 * 33], s[14 * 33], s[15 * 33]);
        *(GAS v4u*)(WT8 + (size_t)(dst_row0 + n) * dst_ld + k0 + 16 * c) = o; }
    LDS_WAIT(); asm volatile("" ::: "memory");
}
__device__ __forceinline__ void tr_job(const float* W, int src_ld, int col0, int K, int ncols, bf16* WT, int dst_ld, int dst_row0, LAS float* scr, int gw, int NGW, int lane, float sc = 1.0f) {
    const int nblk = ncols / 32, nitems = (K / 64) * nblk;
    for (int it = gw; it < nitems; it += NGW) { const int kb = it / nblk, nb = it - kb * nblk; tr_item(W, src_ld, 64 * kb, col0 + 32 * nb, WT, dst_ld, dst_row0 + 32 * nb, scr, lane, sc); }
}
__device__ __forceinline__ void zero_rows(bf16* WT, int row0, int nrows, int ld, int gtid, int NGT) {
    const int per = ld / 8, n = nrows * per;
    for (int i = gtid; i < n; i += NGT) *(GAS v4u*)(WT + (size_t)(row0 + i / per) * ld + (i % per) * 8) = (v4u){0u, 0u, 0u, 0u};
}

__device__ __forceinline__ void p0_prologue(const float* const* in, unsigned char* ws, LAS unsigned char* lds, int vcu, int G, int tid, int wave, int lane) {
    LAS float* scr = (LAS float*)(lds + RING_OFF + wave * 16384);
    const int gw = vcu * NWAVES + wave, NGW = G * NWAVES, gtid = vcu * NTHR + tid, NGT = G * NTHR;
    { f32x2* rope = (f32x2*)(ws + WS_ROPE);
      for (int i = gtid; i < SEQ * 32; i += NGT) { const int s = i >> 5, p = i & 31, fi = p & 15; const float freq = exp2f(-(float)(2 * fi) * (13.287712379549449f / 32.0f));
          const float pos = (p < 16) ? (float)(s >> 6) : (float)(s & 63); float sn, cs; sincosf(pos * freq, &sn, &cs); rope[i] = (f32x2){cs, sn}; } }
    for (int l = 0; l < 2; ++l) {
        unsigned char* wl = ws + WS_W + (size_t)l * WL_STRIDE;
        const float* w_in = in[2] + (size_t)l * DMODEL * NPROJ_IN;
        bf16* Win_t = (bf16*)(wl + WO_IN); bf16* Wg_t = (bf16*)(wl + WO_G); bf16* Wlo_t = (bf16*)(wl + WO_LORA); bf16* Wg2_t = (bf16*)(wl + WO_G2); bf16* PW_t = (bf16*)(wl + WO_PW);
        bf16* Wbr_t = (bf16*)(wl + WO_BR); bf16* Wout_t = (bf16*)(wl + WO_OUT);
        tr_job(w_in, NPROJ_IN, 0, DMODEL, 1920, Win_t, DMODEL, 0, scr, gw, NGW, lane);
        tr_job(w_in, NPROJ_IN, 1920, DMODEL, 512, Win_t, DMODEL, COL_POOL, scr, gw, NGW, lane);
        { const int nblk = 768 / 32, nitems = (DMODEL / 64) * nblk; unsigned char* Wq8 = wl + WO_QKV8;
          for (int it = gw; it < nitems; it += NGW) { const int kb = it / nblk, nb = it - kb * nblk; tr_item8(w_in, NPROJ_IN, 64 * kb, 2432 + 32 * nb, Wq8, 2048, 32 * nb, 32.0f, scr, lane); } }
        { const int nblk = 3072 / 32, nitems = (DMODEL / 64) * nblk;
          for (int it = gw; it < nitems; it += NGW) { const int kb = it / nblk, nb = it - kb * nblk; tr_item8(w_in, NPROJ_IN, 64 * kb, 3200 + 32 * nb, (unsigned char*)Wg_t, DMODEL, 32 * nb, 32.0f, scr, lane); } }
        if (l == 0) zero_rows(Win_t, 1920, 128, DMODEL, gtid, NGT);
        else { tr_job(in[16], 32, 0, DMODEL, 32, Win_t, DMODEL, COL_VL, scr, gw, NGW, lane); zero_rows(Win_t, 1952, 96, DMODEL, gtid, NGT); }
        tr_job(in[22] + (size_t)l * 512 * 1024, 1024, 0, 512, 1024, Wbr_t, 512, 0, scr, gw, NGW, lane);
        tr_job(in[23] + (size_t)l * 512 * 1024, 1024, 0, 512, 1024, Wbr_t, 512, 1024, scr, gw, NGW, lane);
        #ifndef PROBE_ATT_AMP
#define PROBE_ATT_AMP 1.0f
#endif
        { const float* wa = in[24] + (size_t)l * 512 * 1024; unsigned char* Wa8 = wl + WO_BRA8;
          const int nblk = 1024 / 32, nitems = (512 / 64) * nblk;
          for (int it = gw; it < nitems; it += NGW) { const int kb = it / nblk, nb = it - kb * nblk; tr_item8(wa, 1024, 64 * kb, 32 * nb, Wa8, 1024, 32 * nb, 32.0f, scr, lane); } }
        tr_job(in[25] + (size_t)l * 1024 * 1024, 1024, 0, 1024, 1024, Wout_t, 1024, 0, scr, gw, NGW, lane);
        { const float* w2 = in[6] + (size_t)l * 2 * 64 * 512; const float* a2 = in[8] + (size_t)l * 2 * 64 * 512;
          for (int i = gtid; i < 2048 * 16; i += NGT) { const int n = i >> 4, k0 = (i & 15) * 8; const bool isa = n >= 1024; const int nn = n & 1023, dir = nn >> 9, c = nn & 511, kb = 64 * dir;
              float f[8];
#pragma unroll
              for (int j = 0; j < 8; ++j) { const int k = k0 + j; f[j] = (k >= kb && k < kb + 64) ? (isa ? a2 : w2)[((size_t)dir * 64 + (k - kb)) * 512 + c] : 0.f; }
              *(GAS v4u*)(Wlo_t + (size_t)n * 128 + k0) = pk8(f); } }
        { const float* g2 = in[9] + (size_t)l * 128 * 512;
          for (int i = gtid; i < 512 * 16; i += NGT) { const int n = i >> 4, k0 = (i & 15) * 8; float f[8];
#pragma unroll
              for (int j = 0; j < 8; ++j) f[j] = g2[(size_t)(k0 + j) * 512 + n];
              *(GAS v4u*)(Wg2_t + (size_t)n * 128 + k0) = pk8(f); } }
        { const float* pw = in[18] + (size_t)l * 4 * 128 * 128;
          for (int i = gtid; i < 512 * 64; i += NGT) { const int n = i >> 6, k0 = (i & 63) * 8, g = n >> 7, d = n & 127; float f[8];
#pragma unroll
              for (int j = 0; j < 8; ++j) { const int k = k0 + j; f[j] = ((k >> 7) == g) ? pw[((size_t)g * 128 + (k & 127)) * 128 + d] : 0.f; }
              *(GAS v4u*)(PW_t + (size_t)n * 512 + k0) = pk8(f); } }
    }
}
__device__ __forceinline__ void convert_experts_items(const float* const* in, int l, unsigned char* ws, LAS unsigned char* lds, int it0, int nit, int wave, int lane) {
    LAS float* scr = (LAS float*)(lds + RING_OFF + wave * 16384);
    bf16* Wgu = (bf16*)(ws + A_WGU); bf16* Wd = (bf16*)(ws + A_WD);
    const float* eg = in[28] + (size_t)l * NEXP * 1024 * 1024; const float* eu = in[29] + (size_t)l * NEXP * 1024 * 1024; const float* ed = in[30] + (size_t)l * NEXP * 1024 * 1024;
    for (int it = it0 + wave; it < it0 + nit; it += NWAVES) {
        const int mat = it / (NEXP * 512), r = it - mat * (NEXP * 512), e = r >> 9, q = r & 511, kb = q >> 5, nb = q & 31, n0 = 32 * nb;
        if (mat == 0)      tr_item8(eg + (size_t)e * 1024 * 1024, 1024, 64 * kb, n0, (unsigned char*)Wgu, 1024, e * 2048 + (n0 >> 7) * 256 + (n0 & 127), 32.0f, scr, lane);
        else if (mat == 1) tr_item8(eu + (size_t)e * 1024 * 1024, 1024, 64 * kb, n0, (unsigned char*)Wgu, 1024, e * 2048 + (n0 >> 7) * 256 + 128 + (n0 & 127), 32.0f, scr, lane);
        else               tr_item8(ed + (size_t)e * 1024 * 1024, 1024, 64 * kb, n0, (unsigned char*)Wd, 1024, e * 1024 + n0, 32.0f, scr, lane);
    }
}

template <int MODE, bool XB = false, int NR = 2>
__device__ __forceinline__ void norm_rows(const float* xsrc, float* xdst, bool combine, const bf16* YE, const int* INV, const float* gain, bf16* obf, float* of32, int gw, int NGW, int lane, unsigned char* o8 = nullptr) {
    f32x4 g[4];
#pragma unroll
    for (int j = 0; j < 4; ++j) g[j] = *(const f32x4*)(gain + 4 * lane + 256 * j);
    for (int t0 = gw; t0 < M; t0 += NR * NGW) {
        f32x4 v[NR][4]; int inv[NR];
#pragma unroll
        for (int q = 0; q < NR; ++q) { const int t = t0 + q * NGW;
            if (XB) { const v2u* xr = (const v2u*)((const bf16*)xsrc + (size_t)t * XBP) + lane;
#pragma unroll
                for (int j = 0; j < 4; ++j) { const v2u w = xr[64 * j]; v[q][j] = (f32x4){__uint_as_float(w.x << 16), __uint_as_float(w.x & 0xffff0000u), __uint_as_float(w.y << 16), __uint_as_float(w.y & 0xffff0000u)}; } }
            else { const f32x4* xr = (const f32x4*)(xsrc + (size_t)t * DMODEL) + lane;
#pragma unroll
                for (int j = 0; j < 4; ++j) v[q][j] = xr[64 * j]; }
            inv[q] = (combine && lane < NEXP) ? INV[(size_t)t * NEXP + lane] : -1; }
#pragma unroll
        for (int q = 0; q < NR; ++q) { const int t = t0 + q * NGW;
            if (combine) {
                const int b = t / SEQ;
#pragma unroll
                for (int e = 0; e < NEXP; ++e) { const int c = __builtin_amdgcn_readlane(inv[q], e);
                    if (c >= 0) { const bf16* yr = YE + ((size_t)((b * NEXP + e) * CAP + c)) * DMODEL + 4 * lane;
#pragma unroll
                        for (int j = 0; j < 4; ++j) { const v2u w = *(const v2u*)(yr + 256 * j);
                            v[q][j][0] += __uint_as_float(w.x << 16); v[q][j][1] += __uint_as_float(w.x & 0xffff0000u); v[q][j][2] += __uint_as_float(w.y << 16); v[q][j][3] += __uint_as_float(w.y & 0xffff0000u); } } }
                if (xdst) {
                    if (XB) { v2u* xw = (v2u*)((bf16*)xdst + (size_t)t * XBP) + lane;
#pragma unroll
                        for (int j = 0; j < 4; ++j) xw[64 * j] = (v2u){pk2(v[q][j][0], v[q][j][1]), pk2(v[q][j][2], v[q][j][3])}; }
                    else { f32x4* xw = (f32x4*)(xdst + (size_t)t * DMODEL) + lane;
#pragma unroll
                        for (int j = 0; j < 4; ++j) xw[64 * j] = v[q][j]; } }
            }
            float ss = 0.f;
#pragma unroll
            for (int j = 0; j < 4; ++j) ss += (v[q][j][0] * v[q][j][0] + v[q][j][1] * v[q][j][1]) + (v[q][j][2] * v[q][j][2] + v[q][j][3] * v[q][j][3]);
            const float rstd = __builtin_amdgcn_rsqf(wave_sum(ss, lane) * (1.0f / DMODEL) + 1e-6f);
            if (MODE == 2) { unsigned* o4 = (unsigned*)((unsigned char*)obf + (size_t)t * DMODEL) + lane;
#pragma unroll
                for (int j = 0; j < 4; ++j) { const f32x4 o = v[q][j] * rstd * g[j]; o4[64 * j] = pg8::pk4_fp8(o[0], o[1], o[2], o[3]); } }
            else if (MODE == 0) { v2u* ob_ = (v2u*)(obf + (size_t)t * DMODEL) + lane;
#pragma unroll
                for (int j = 0; j < 4; ++j) { const f32x4 o = v[q][j] * rstd * g[j]; ob_[64 * j] = (v2u){pk2(o[0], o[1]), pk2(o[2], o[3])}; }
                if (o8) { unsigned* e4 = (unsigned*)(o8 + (size_t)t * 4096) + lane;
#pragma unroll
                    for (int j = 0; j < 4; ++j) { const f32x4 o = v[q][j] * rstd * g[j]; e4[64 * j] = pg8::pk4_fp8(o[0], o[1], o[2], o[3]); } } }
            else { f32x4* o4 = (f32x4*)(of32 + (size_t)t * DMODEL) + lane;
#pragma unroll
                for (int j = 0; j < 4; ++j) o4[64 * j] = v[q][j] * rstd * g[j]; }
        }
    }
}

__device__ __forceinline__ v2u pk8_e4m3(const float (&f)[8]) { v2u o; o.x = pg8::pk4_fp8(f[0], f[1], f[2], f[3]); o.y = pg8::pk4_fp8(f[4], f[5], f[6], f[7]); return o; }
__device__ __forceinline__ void p3_prep(int l, const float* const* in, unsigned char* ws, LAS unsigned char* lds, int gw, int NGW, int tid, int lane) {
    const bf16* PRJ = (const bf16*)(ws + A_PRJ);
    bf16* R = (bf16*)(ws + A_R); bf16* KS = (bf16*)(ws + A_KS); bf16* VS = (bf16*)(ws + A_VS); bf16* VF = (bf16*)(ws + WS_VF); bf16* TW = (bf16*)(ws + A_TW); bf16* PL = (bf16*)(ws + A_PL);
    unsigned char* Q8 = ws + A_Q; unsigned char* K8 = ws + A_K; unsigned char* Vt8 = ws + A_V;
    const f32x2* rope = (const f32x2*)(ws + WS_ROPE);
    LAS float* v2L = (LAS float*)(lds + RING_OFF);
    LAS float* mpL = (LAS float*)(lds + RING_OFF + 65536); LAS float* mnL = mpL + 1920;
    if (l == 1) { for (int i = tid; i < 32 * 512; i += NTHR) v2L[i] = in[17][i]; }
    LAS float* gqL = mnL + 1920; LAS float* gkL = gqL + 64; LAS float* v0L = gkL + 64;
    for (int i = tid; i < 1920; i += NTHR) { mpL[i] = in[3][(size_t)l * 1920 + i]; mnL[i] = in[4][(size_t)l * 1920 + i]; }
    if (tid < 64) { gqL[tid] = in[20][(size_t)l * 64 + tid]; gkL[tid] = in[21][(size_t)l * 64 + tid]; }
    v0L[tid] = in[15][tid];
    __syncthreads();
    const int gi = lane >> 4, lo = 1 << gi, hi = lo - 1, pcol = COL_POOL + lane * 8;
    const float tw_k = (lane < 16) ? -2.0f * 1.4426950408889634f : -1.4426950408889634f, tw_m = (lane < 16) ? 2.0f : 1.0f, tw_c = (lane < 16) ? -1.0f : 0.0f; const bool tw_id = (lane >= 16 && lane < 32);
    for (int run = gw; run < M / 32; run += NGW) {
        const int t0 = run * 32, s0 = t0 & (SEQ - 1);
        const bf16* row0 = PRJ + (size_t)t0 * NPJ;
        { unsigned char* vrow = Vt8 + ((size_t)((t0 >> 13) * 2 + (lane >> 5)) * 64 + 2 * (lane & 31)) * SEQ + s0;
#pragma unroll
          for (int hf = 0; hf < 2; ++hf) { unsigned w[16];
#pragma unroll
              for (int i = 0; i < 16; ++i) w[i] = *(const unsigned*)(row0 + (size_t)(hf * 16 + i) * NPJ + COL_V + 2 * lane);
              v4u a, b_;
#pragma unroll
              for (int j = 0; j < 4; ++j) {
                  a[j] = pg8::pk4_fp8(__uint_as_float(w[4 * j] << 16), __uint_as_float(w[4 * j + 1] << 16), __uint_as_float(w[4 * j + 2] << 16), __uint_as_float(w[4 * j + 3] << 16));
                  b_[j] = pg8::pk4_fp8(__uint_as_float(w[4 * j] & 0xffff0000u), __uint_as_float(w[4 * j + 1] & 0xffff0000u), __uint_as_float(w[4 * j + 2] & 0xffff0000u), __uint_as_float(w[4 * j + 3] & 0xffff0000u)); }
              *(v4u*)(vrow + hf * 16) = a; *(v4u*)(vrow + SEQ + hf * 16) = b_; } }
        v4u prv[4], cur[4];
#pragma unroll
        for (int j = 0; j < 4; ++j) { const int c8 = lane + 64 * j, col = (c8 < 240 ? c8 : 0) * 8;
            prv[j] = (s0 > 0) ? ld16(row0 - NPJ + col) : (v4u){0u, 0u, 0u, 0u}; cur[j] = ld16(row0 + col); }
        float psum[8]; int pcnt = 0;
#pragma unroll
        for (int i = 0; i < 8; ++i) psum[i] = 0.f;
#pragma unroll
        for (int hf = 0; hf < 2; ++hf) { v4u pw_[8];
#pragma unroll
            for (int q = 0; q < 8; ++q) { const int dd = hf * 8 + q - 8; const bool ok = (dd >= -lo && dd <= hi && s0 + dd >= 0); pw_[q] = ld16(row0 + (long)(ok ? dd : 0) * NPJ + pcol); }
#pragma unroll
            for (int q = 0; q < 8; ++q) asm volatile("" : "+v"(pw_[q]));
#pragma unroll
            for (int q = 0; q < 8; ++q) { const int dd = hf * 8 + q - 8; const bool ok = (dd >= -lo && dd <= hi && s0 + dd >= 0); float x[8]; unp8(pw_[q], x); const float m_ = ok ? 1.0f : 0.0f; pcnt += ok ? 1 : 0;
#pragma unroll
                for (int i = 0; i < 8; ++i) psum[i] += m_ * x[i]; } }
        for (int ti = 0; ti < 32; ++ti) {
            const int t = t0 + ti, s = s0 + ti; const bf16* rowp = row0 + (size_t)ti * NPJ;
            v4u nxt[4];
#pragma unroll
            for (int j = 0; j < 4; ++j) { const int c8 = lane + 64 * j, col = (c8 < 240 ? c8 : 0) * 8; nxt[j] = (s + 1 < SEQ) ? ld16(rowp + NPJ + col) : (v4u){0u, 0u, 0u, 0u}; }
            const v4u pself = ld16(rowp + pcol);
            const bool padd = (s + 1 + hi < SEQ), psub = (s - lo >= 0);
            const v4u pin = padd ? ld16(rowp + (long)(1 + hi) * NPJ + pcol) : (v4u){0u, 0u, 0u, 0u};
            const v4u pout = psub ? ld16(rowp - (long)lo * NPJ + pcol) : (v4u){0u, 0u, 0u, 0u};
            const v4u qraw = ld16(rowp + COL_Q + lane * 8), kraw = ld16(rowp + COL_K + (lane & 15) * 8);
            const f32x4 rp0 = *(const f32x4*)(rope + (size_t)s * 32 + (lane & 7) * 4), rp1 = *(const f32x4*)(rope + (size_t)s * 32 + (lane & 7) * 4 + 2);
            { float self[8], o[8]; unp8(pself, self); const float ic = __builtin_amdgcn_rcpf((float)pcnt);
#pragma unroll
              for (int i = 0; i < 8; ++i) o[i] = psum[i] * ic - self[i];
              st16(PL + (size_t)t * 512 + lane * 8, pk8(o));
              float xin[8], xout[8]; unp8(pin, xin); unp8(pout, xout);
#pragma unroll
              for (int i = 0; i < 8; ++i) psum[i] += xin[i] - xout[i];
              pcnt += (padd ? 1 : 0) - (psub ? 1 : 0); }
            { float x[8], o[8]; const float cs[8] = {rp0[0], rp0[1], rp0[2], rp0[3], rp1[0], rp1[1], rp1[2], rp1[3]};
              unp8(qraw, x);
              float ss = 0.f;
#pragma unroll
              for (int i = 0; i < 8; ++i) ss += x[i] * x[i];
              ss = sum8(ss, lane); const float rms = __builtin_amdgcn_rsqf(ss * (1.0f / 64.0f) + 1e-6f);
#pragma unroll
              for (int i = 0; i < 8; ++i) x[i] = x[i] * rms * gqL[(lane & 7) * 8 + i];
#pragma unroll
              for (int ii = 0; ii < 4; ++ii) { o[2 * ii] = (x[2 * ii] * cs[2 * ii] - x[2 * ii + 1] * cs[2 * ii + 1]) * (C2Q * 16.0f); o[2 * ii + 1] = (x[2 * ii] * cs[2 * ii + 1] + x[2 * ii + 1] * cs[2 * ii]) * (C2Q * 16.0f); }
              *(v2u*)(Q8 + (size_t)t * 1024 + (lane >> 3) * 128 + (lane & 7) * 8) = pk8_e4m3(o);
              unp8(kraw, x);
              ss = 0.f;
#pragma unroll
              for (int i = 0; i < 8; ++i) ss += x[i] * x[i];
              ss = sum8(ss, lane); const float rmk = __builtin_amdgcn_rsqf(ss * (1.0f / 64.0f) + 1e-6f);
#pragma unroll
              for (int i = 0; i < 8; ++i) x[i] = x[i] * rmk * gkL[(lane & 7) * 8 + i];
#pragma unroll
              for (int ii = 0; ii < 4; ++ii) { o[2 * ii] = x[2 * ii] * cs[2 * ii] - x[2 * ii + 1] * cs[2 * ii + 1]; o[2 * ii + 1] = x[2 * ii] * cs[2 * ii + 1] + x[2 * ii + 1] * cs[2 * ii]; }
              if (lane < 16) *(v2u*)(K8 + ((size_t)((t >> 13) * 2 + (lane >> 3)) * SEQ + s) * 64 + (lane & 7) * 8) = pk8_e4m3(o); }
            asm volatile("" ::: "memory");
#pragma unroll
            for (int j = 0; j < 4; ++j) {
                const int c8 = lane + 64 * j, col = c8 * 8;
                if (c8 < 240) {
                    float cu[8], pv[8], nx[8], ps[8];
                    unp8(cur[j], cu); unp8(prv[j], pv); unp8(nxt[j], nx);
                    float a_[8], b_[8]; { const f32x4 m0 = *(const LAS f32x4*)(mpL + col), m1 = *(const LAS f32x4*)(mpL + col + 4), n0 = *(const LAS f32x4*)(mnL + col), n1 = *(const LAS f32x4*)(mnL + col + 4);
                        a_[0] = m0[0]; a_[1] = m0[1]; a_[2] = m0[2]; a_[3] = m0[3]; a_[4] = m1[0]; a_[5] = m1[1]; a_[6] = m1[2]; a_[7] = m1[3]; b_[0] = n0[0]; b_[1] = n0[1]; b_[2] = n0[2]; b_[3] = n0[3]; b_[4] = n1[0]; b_[5] = n1[1]; b_[6] = n1[2]; b_[7] = n1[3]; }
#pragma unroll
                    for (int i = 0; i < 8; ++i) ps[i] = cu[i] + a_[i] * (pv[i] - cu[i]) + b_[i] * (nx[i] - cu[i]);
                    if (j == 0) st16(R + (size_t)t * 512 + col, pk8(ps));
                    else if (j == 1) st16(KS + (size_t)t * 512 + (col - 512), pk8(ps));
                    else if (j == 2) { const int cc = col - 1024;
                        if (l == 0) { const v4u o = pk8(ps); st16(VS + (size_t)t * 512 + cc, o); st16(VF + (size_t)t * 512 + cc, o); }
                        else { float vl[32], mx[8], vf[8];
                            { float t8[8]; unp8(ld16(rowp + COL_VL), t8);
#pragma unroll
                              for (int i = 0; i < 8; ++i) vl[i] = t8[i];
                              unp8(ld16(rowp + COL_VL + 8), t8);
#pragma unroll
                              for (int i = 0; i < 8; ++i) vl[8 + i] = t8[i];
                              unp8(ld16(rowp + COL_VL + 16), t8);
#pragma unroll
                              for (int i = 0; i < 8; ++i) vl[16 + i] = t8[i];
                              unp8(ld16(rowp + COL_VL + 24), t8);
#pragma unroll
                              for (int i = 0; i < 8; ++i) vl[24 + i] = t8[i]; }
                            { const f32x4 z0 = *(const LAS f32x4*)(v0L + cc), z1 = *(const LAS f32x4*)(v0L + cc + 4); mx[0] = z0[0]; mx[1] = z0[1]; mx[2] = z0[2]; mx[3] = z0[3]; mx[4] = z1[0]; mx[5] = z1[1]; mx[6] = z1[2]; mx[7] = z1[3]; }
#pragma unroll
                            for (int k = 0; k < 32; ++k) { const f32x4 w0 = *(const LAS f32x4*)(v2L + k * 512 + cc), w1 = *(const LAS f32x4*)(v2L + k * 512 + cc + 4);
                                mx[0] += vl[k] * w0[0]; mx[1] += vl[k] * w0[1]; mx[2] += vl[k] * w0[2]; mx[3] += vl[k] * w0[3]; mx[4] += vl[k] * w1[0]; mx[5] += vl[k] * w1[1]; mx[6] += vl[k] * w1[2]; mx[7] += vl[k] * w1[3]; }
                            unp8(ld16(VF + (size_t)t * 512 + cc), vf);
#pragma unroll
                            for (int i = 0; i < 8; ++i) ps[i] = ps[i] + (vf[i] - ps[i]) * sigmf(mx[i]);
                            st16(VS + (size_t)t * 512 + cc, pk8(ps)); } }
                    else { float o[8];
#pragma unroll
                        for (int i = 0; i < 8; ++i) { const float x = ps[i];
                            const float sg = __builtin_amdgcn_rcpf(1.0f + __builtin_amdgcn_exp2f(tw_k * __builtin_amdgcn_fmed3f(x, -15.f, 15.f)));
                            const float y = tw_m * sg + tw_c; o[i] = tw_id ? x : y; }
                        st16(TW + (size_t)t * 384 + lane * 8, pk8(o)); }
                }
                prv[j] = cur[j]; cur[j] = nxt[j];
            }
        }
    }
}

__device__ __forceinline__ float dpp_add(float x, float y) { return x + y; }
template <int CTRL> __device__ __forceinline__ float dppx(float x) { return __builtin_bit_cast(float, __builtin_amdgcn_update_dpp(0, __builtin_bit_cast(int, x), CTRL, 0xF, 0xF, true)); }
__device__ __forceinline__ float red16(float x) {
    x += dppx<0xB1>(x);
    x += dppx<0x4E>(x);
    x += dppx<0x141>(x);
    x += dppx<0x140>(x);
    return x;
}
__device__ __forceinline__ void scan_chain(int l, int chain, const float* const* in, unsigned char* ws, LAS unsigned char* lds, int tid, int wave, int lane) {
    const int d = chain >> 6, b = (chain >> 3) & 7, h = chain & 7;
    const bf16* R = (const bf16*)(ws + A_R); const bf16* KS = (const bf16*)(ws + A_KS); const bf16* VS = (const bf16*)(ws + A_VS);
    const bf16* LW = (const bf16*)(ws + A_LW); const bf16* AA = (const bf16*)(ws + A_AA);
    bf16* YS = (bf16*)(ws + (d ? A_YSB : A_YSF)); float* CFB = (float*)(ws + WS_CFB) + (size_t)d * M * 8;
    LAS float* kkL = (LAS float*)(lds + RING_OFF); LAS float* wL = kkL + 4096; LAS float* nbL = wL + 4096; LAS float* kdL = nbL + 4096; LAS float* rL = kdL + 4096; LAS float* vL = rL + 4096; LAS float* yL = vL + 4096;
    const int ps = tid >> 3, pc = tid & 7;
    const int pl = lane >> 4, jg = lane & 15, i0 = 2 * (4 * wave + pl);
    float kkc[8], kac[8], rkc[8];
    ldf8(in[10] + (size_t)l * 512 + h * 64 + pc * 8, kkc); ldf8(in[11] + (size_t)l * 512 + h * 64 + pc * 8, kac); ldf8(in[12] + (size_t)l * 512 + h * 64 + pc * 8, rkc);
    float st[2][4];
#pragma unroll
    for (int r = 0; r < 2; ++r)
#pragma unroll
        for (int j = 0; j < 4; ++j) st[r][j] = 0.f;
    v4u rr, kr, vr, lwr, ar;
    { const int tok = d ? (SEQ - 1 - ps) : ps; const size_t t = (size_t)b * SEQ + tok;
      rr = ld16(R + t * 512 + h * 64 + pc * 8); kr = ld16(KS + t * 512 + h * 64 + pc * 8); vr = ld16(VS + t * 512 + h * 64 + pc * 8);
      lwr = ld16(LW + t * 1024 + d * 512 + h * 64 + pc * 8); ar = ld16(AA + t * 1024 + d * 512 + h * 64 + pc * 8); }
    for (int blk = 0; blk < SEQ / 64; ++blk) {
        const int tokp = d ? (SEQ - 1 - (blk * 64 + ps)) : (blk * 64 + ps); const size_t tp = (size_t)b * SEQ + tokp;
        { float r8[8], k8[8], v8[8], lw8[8], a8[8], kk8[8], o[8];
          unp8(rr, r8); unp8(kr, k8); unp8(vr, v8); unp8(lwr, lw8); unp8(ar, a8);
          float ss = 0.f;
#pragma unroll
          for (int i = 0; i < 8; ++i) { kk8[i] = k8[i] * kkc[i]; ss += kk8[i] * kk8[i]; }
          ss = sum8(ss, lane); const float inv = 1.0f / fmaxf(sqrtf(ss), 1e-12f);
          float cf = 0.f;
#pragma unroll
          for (int i = 0; i < 8; ++i) { kk8[i] *= inv; const float kd = k8[i] * (1.0f + (a8[i] - 1.0f) * kac[i]); cf += r8[i] * kd * rkc[i]; o[i] = kd; }
          cf = sum8(cf, lane); if (pc == 0) CFB[tp * 8 + h] = cf;
          LAS float* p;
          p = kkL + ps * 64 + pc * 8; *(LAS f32x4*)p = (f32x4){kk8[0], kk8[1], kk8[2], kk8[3]}; *(LAS f32x4*)(p + 4) = (f32x4){kk8[4], kk8[5], kk8[6], kk8[7]};
          p = kdL + ps * 64 + pc * 8; *(LAS f32x4*)p = (f32x4){o[0], o[1], o[2], o[3]}; *(LAS f32x4*)(p + 4) = (f32x4){o[4], o[5], o[6], o[7]};
          p = wL + ps * 64 + pc * 8; *(LAS f32x4*)p = (f32x4){__expf(lw8[0]), __expf(lw8[1]), __expf(lw8[2]), __expf(lw8[3])}; *(LAS f32x4*)(p + 4) = (f32x4){__expf(lw8[4]), __expf(lw8[5]), __expf(lw8[6]), __expf(lw8[7])};
          p = nbL + ps * 64 + pc * 8; *(LAS f32x4*)p = (f32x4){-kk8[0] * a8[0], -kk8[1] * a8[1], -kk8[2] * a8[2], -kk8[3] * a8[3]}; *(LAS f32x4*)(p + 4) = (f32x4){-kk8[4] * a8[4], -kk8[5] * a8[5], -kk8[6] * a8[6], -kk8[7] * a8[7]};
          p = rL + ps * 64 + pc * 8; *(LAS f32x4*)p = (f32x4){r8[0], r8[1], r8[2], r8[3]}; *(LAS f32x4*)(p + 4) = (f32x4){r8[4], r8[5], r8[6], r8[7]};
          p = vL + ps * 64 + pc * 8; *(LAS f32x4*)p = (f32x4){v8[0], v8[1], v8[2], v8[3]}; *(LAS f32x4*)(p + 4) = (f32x4){v8[4], v8[5], v8[6], v8[7]}; }
        __syncthreads();
        if (blk + 1 < SEQ / 64) { const int tok = d ? (SEQ - 1 - ((blk + 1) * 64 + ps)) : ((blk + 1) * 64 + ps); const size_t t = (size_t)b * SEQ + tok;
            rr = ld16(R + t * 512 + h * 64 + pc * 8); kr = ld16(KS + t * 512 + h * 64 + pc * 8); vr = ld16(VS + t * 512 + h * 64 + pc * 8);
            lwr = ld16(LW + t * 1024 + d * 512 + h * 64 + pc * 8); ar = ld16(AA + t * 1024 + d * 512 + h * 64 + pc * 8); }
#pragma unroll 2
        for (int s = 0; s < 64; ++s) {
            const f32x4 kk4 = *(const LAS f32x4*)(kkL + s * 64 + jg * 4), w4 = *(const LAS f32x4*)(wL + s * 64 + jg * 4), nb4 = *(const LAS f32x4*)(nbL + s * 64 + jg * 4);
            const f32x4 kd4 = *(const LAS f32x4*)(kdL + s * 64 + jg * 4), r4 = *(const LAS f32x4*)(rL + s * 64 + jg * 4);
            const f32x2 v2 = *(const LAS f32x2*)(vL + s * 64 + i0);
            float y[2];
#pragma unroll
            for (int r = 0; r < 2; ++r) {
                float dq = (st[r][0] * kk4[0] + st[r][1] * kk4[1]) + (st[r][2] * kk4[2] + st[r][3] * kk4[3]);
                dq = red16(dq);
                const float vv = v2[r];
#pragma unroll
                for (int j = 0; j < 4; ++j) st[r][j] = st[r][j] * w4[j] + dq * nb4[j] + vv * kd4[j];
                float yq = (st[r][0] * r4[0] + st[r][1] * r4[1]) + (st[r][2] * r4[2] + st[r][3] * r4[3]);
                y[r] = red16(yq);
            }
            if (jg == 0) *(LAS f32x2*)(yL + s * 64 + i0) = (f32x2){y[0], y[1]};
        }
        __syncthreads();
        { const LAS float* p = yL + ps * 64 + pc * 8; const f32x4 a = *(const LAS f32x4*)p, c = *(const LAS f32x4*)(p + 4);
          v4u o; o.x = pk2(a[0], a[1]); o.y = pk2(a[2], a[3]); o.z = pk2(c[0], c[1]); o.w = pk2(c[2], c[3]);
          st16(YS + tp * 512 + h * 64 + pc * 8, o); }
    }
    __syncthreads();
}

__device__ __forceinline__ void p6a_rows(int l, const float* const* in, unsigned char* ws, int gw, int NGW, int lane) {
    const bf16* YSF = (const bf16*)(ws + A_YSF); const bf16* YSB = (const bf16*)(ws + A_YSB); const bf16* VS = (const bf16*)(ws + A_VS); const bf16* Gb = (const bf16*)(ws + A_G);
    const float* CFB = (const float*)(ws + WS_CFB); bf16* YA = (bf16*)(ws + A_YA);
    float lw[8], lb[8]; ldf8(in[13] + (size_t)l * 512 + lane * 8, lw); ldf8(in[14] + (size_t)l * 512 + lane * 8, lb);
    const int head = lane >> 3;
    for (int t0 = gw; t0 < M; t0 += 4 * NGW) {
        v4u ra[4], rb_[4], rv[4], rg[4]; float cfa[4], cfb[4];
#pragma unroll
        for (int q = 0; q < 4; ++q) { const size_t t = (size_t)(t0 + q * NGW);
            ra[q] = ld16(YSF + t * 512 + lane * 8); rb_[q] = ld16(YSB + t * 512 + lane * 8); rv[q] = ld16(VS + t * 512 + lane * 8); rg[q] = ld16(Gb + t * 512 + lane * 8);
            cfa[q] = CFB[t * 8 + head]; cfb[q] = CFB[((size_t)M + t) * 8 + head]; }
#pragma unroll
        for (int q = 0; q < 4; ++q) { const size_t t = (size_t)(t0 + q * NGW);
            float yf[8], yb[8], v[8], g[8], o[8];
            unp8(ra[q], yf); unp8(rb_[q], yb); unp8(rv[q], v); unp8(rg[q], g);
            const float cf = cfa[q] + cfb[q];
            float sm = 0.f;
#pragma unroll
            for (int i = 0; i < 8; ++i) { yf[i] += yb[i]; sm += yf[i]; }
            const float mu = sum8(sm, lane) * (1.0f / 64.0f); float sq = 0.f;
#pragma unroll
            for (int i = 0; i < 8; ++i) { yf[i] -= mu; sq += yf[i] * yf[i]; }
            const float rs = __builtin_amdgcn_rsqf(sum8(sq, lane) * (1.0f / 64.0f) + 64e-5f);
#pragma unroll
            for (int i = 0; i < 8; ++i) o[i] = (yf[i] * rs * lw[i] + lb[i] + cf * v[i]) * g[i];
            st16(YA + t * 512 + lane * 8, pk8(o)); }
    }
}

__device__ __forceinline__ void p8_router(int l, const float* const* in, const float* X, unsigned char* ws, LAS unsigned char* lds, int gw, int NGW, int tid, int lane) {
    LAS bf16* Bh = (LAS bf16*)(lds + RING_OFF); LAS bf16* Bl = Bh + 32 * 64 * 8;
    LAS float* gL = (LAS float*)(lds + RING_OFF + 65536);
    const float* rw = in[27] + (size_t)l * DMODEL * NEXP; const float* gain = in[26] + (size_t)l * DMODEL;
    for (int i = tid; i < 32 * 64; i += NTHR) { const int kk = i >> 6, ln = i & 63, e = ln & 15, kg_ = ln >> 4; float hi8[8], lo8[8];
#pragma unroll
        for (int j = 0; j < 8; ++j) { const int k = 32 * kk + 8 * kg_ + j; const float w = rw[(size_t)k * NEXP + e] * gain[k]; const float wh = __uint_as_float(f2bf(w) << 16); hi8[j] = wh; lo8[j] = w - wh; }
        *(LAS v4u*)(Bh + i * 8) = pk8(hi8); *(LAS v4u*)(Bl + i * 8) = pk8(lo8); }
    for (int i = tid; i < DMODEL; i += NTHR) gL[i] = gain[i];
    __syncthreads();
    unsigned char* HN2 = ws + A_HN; float* AFFT = (float*)(ws + WS_AFFT);
    typedef short bf16x8_t __attribute__((ext_vector_type(8)));
    const int m = lane & 15, kg = lane >> 4;
    for (int tr = gw; tr < M / 16; tr += NGW) {
        const int t0 = tr * 16; const bf16* xrow = (const bf16*)X + (size_t)(t0 + m) * XBP + 8 * kg;
        f32x4 D = {0.f, 0.f, 0.f, 0.f}; float ss = 0.f;
#define P8_LD(XB_, c_) do { _Pragma("unroll") for (int q = 0; q < 8; ++q) XB_[q] = ld16(xrow + 32 * (8 * (c_) + q)); } while (0)
#define P8_MM(XB_, c_) do { _Pragma("unroll") for (int q = 0; q < 8; ++q) { const int kk = 8 * (c_) + q; const bf16x8_t a = __builtin_bit_cast(bf16x8_t, XB_[q]); \
                const bf16x8_t bh = *(const LAS bf16x8_t*)(Bh + (kk * 64 + lane) * 8), bl = *(const LAS bf16x8_t*)(Bl + (kk * 64 + lane) * 8); \
                D = __builtin_amdgcn_mfma_f32_16x16x32_bf16(a, bh, D, 0, 0, 0); D = __builtin_amdgcn_mfma_f32_16x16x32_bf16(a, bl, D, 0, 0, 0); \
                float x[8]; unp8(XB_[q], x); _Pragma("unroll") for (int j = 0; j < 8; ++j) ss += x[j] * x[j]; } } while (0)
#define P8_HN(XB_, c_) do { _Pragma("unroll") for (int q = 0; q < 8; ++q) { const int kk = 8 * (c_) + q; float x[8]; unp8(XB_[q], x); const f32x4 g0 = *(const LAS f32x4*)(gL + 32 * kk + 8 * kg), g1 = *(const LAS f32x4*)(gL + 32 * kk + 8 * kg + 4); \
                x[0] *= rstd * g0[0]; x[1] *= rstd * g0[1]; x[2] *= rstd * g0[2]; x[3] *= rstd * g0[3]; x[4] *= rstd * g1[0]; x[5] *= rstd * g1[1]; x[6] *= rstd * g1[2]; x[7] *= rstd * g1[3]; \
                *(v2u*)(hrow + 32 * kk) = pk8_e4m3(x); } } while (0)
        v4u xa[8], xb[8];
        P8_LD(xa, 0);
#pragma nounroll
        for (int c = 0; c < 4; c += 2) { P8_LD(xb, c + 1); P8_MM(xa, c); if (c + 2 < 4) P8_LD(xa, c + 2); else P8_LD(xa, 0); P8_MM(xb, c + 1); }
        ss = sum_rows(ss);
        const float rstd = __builtin_amdgcn_rsqf(ss * (1.0f / DMODEL) + 1e-6f);
        unsigned char* hrow = HN2 + (size_t)(t0 + m) * DMODEL + 8 * kg;
#pragma nounroll
        for (int c = 0; c < 4; c += 2) { P8_LD(xb, c + 1); P8_HN(xa, c); if (c + 2 < 4) P8_LD(xa, c + 2); P8_HN(xb, c + 1); }
#undef P8_LD
#undef P8_MM
#undef P8_HN
        f32x4 aff;
#pragma unroll
        for (int r = 0; r < 4; ++r) { const float rs = shx_from(rstd, 4 * kg + r, lane); const float lg = D[r] * rs; float mx = lg;
#pragma unroll
            for (int o = 0; o < 1; ++o) mx = max16(mx);
            const float ex = __expf(lg - mx); float se = ex;
#pragma unroll
            for (int o = 0; o < 1; ++o) se = sum16(se);
            aff[r] = ex * __builtin_amdgcn_rcpf(se); }
        const int b = t0 / SEQ, s0 = t0 & (SEQ - 1);
        *(f32x4*)(AFFT + ((size_t)(b * NEXP + m)) * SEQ + s0 + 4 * kg) = aff;
    }
    __syncthreads();
}

__device__ __forceinline__ int block_sum_i(int v, LAS int* tmp, int wave, int lane) {
#pragma unroll
    for (int o = 1; o < 64; o <<= 1) v += shxi(v, o, lane);
    if (lane == 0) tmp[wave] = v;
    __syncthreads();
    int tot = 0;
#pragma unroll
    for (int i = 0; i < NWAVES; ++i) tot += tmp[i];
    __syncthreads();
    return tot;
}
__device__ __forceinline__ int block_excl_scan_i(int v, LAS int* tmp, int wave, int lane) {
    int inc = v;
#pragma unroll
    for (int o = 1; o < 64; o <<= 1) { const int t = shupi(inc, o, lane); if (lane >= o) inc += t; }
    if (lane == 63) tmp[wave] = inc;
    __syncthreads();
    int base = 0;
#pragma unroll
    for (int i = 0; i < NWAVES; ++i) { const int x = tmp[i]; if (i < wave) base += x; }
    __syncthreads();
    return base + inc - v;
}
__device__ __forceinline__ void p9_topk(int be, unsigned char* ws, LAS unsigned char* lds, int tid, int wave, int lane) {
    const float* AFFT = (const float*)(ws + WS_AFFT) + (size_t)be * SEQ; int* IDX = (int*)(ws + WS_IDX) + (size_t)be * CAP; float* VAL = (float*)(ws + WS_VAL) + (size_t)be * CAP;
    int* INV = (int*)(ws + WS_INV); const int b = be / NEXP, e = be - b * NEXP;
    LAS int* tmp = (LAS int*)(lds + RING_OFF);
    unsigned key[16];
#pragma unroll
    for (int q = 0; q < 4; ++q) { const v4u w = *(const v4u*)(AFFT + tid * 16 + q * 4); key[4 * q] = w.x; key[4 * q + 1] = w.y; key[4 * q + 2] = w.z; key[4 * q + 3] = w.w; }
    unsigned T = 0u;
#pragma nounroll
    for (int bit = 30; bit >= 0; --bit) { const unsigned cand = T | (1u << bit); int c = 0;
#pragma unroll
        for (int i = 0; i < 16; ++i) c += (key[i] >= cand) ? 1 : 0;
        if (block_sum_i(c, tmp, wave, lane) >= CAP) T = cand; }
    int ngt = 0, neq = 0;
#pragma unroll
    for (int i = 0; i < 16; ++i) { ngt += (key[i] > T) ? 1 : 0; neq += (key[i] == T) ? 1 : 0; }
    const int need = CAP - block_sum_i(ngt, tmp, wave, lane);
    const int eqb = block_excl_scan_i(neq, tmp, wave, lane);
    int take = need - eqb; take = take < 0 ? 0 : (take > neq ? neq : take);
    int pos = block_excl_scan_i(ngt + take, tmp, wave, lane);
    int er = eqb;
#pragma unroll
    for (int i = 0; i < 16; ++i) { const int s = tid * 16 + i; bool sel = key[i] > T; if (key[i] == T) { sel = er < need; ++er; }
        int w = -1; if (sel) { IDX[pos] = s; VAL[pos] = __uint_as_float(key[i]); w = pos; ++pos; }
        INV[((size_t)b * SEQ + s) * NEXP + e] = w; }
}

__device__ __forceinline__ void p10_gather(unsigned char* ws, int gw, int NGW, int lane) {
    const bf16* HN2 = (const bf16*)(ws + A_HN); bf16* XG = (bf16*)(ws + A_XG); const int* IDX = (const int*)(ws + WS_IDX);
    for (int r = gw; r < MR; r += NGW) { const int b = r / (NEXP * CAP); const int tok = IDX[r];
        const v4u* src = (const v4u*)(HN2 + ((size_t)b * SEQ + tok) * DMODEL); v4u* dst = (v4u*)(XG + (size_t)r * DMODEL);
        const v4u a = src[lane], c = src[lane + 64]; dst[lane] = a; dst[lane + 64] = c; }
}

namespace cs {
typedef short bf16x8 __attribute__((ext_vector_type(8)));
typedef short s16x4 __attribute__((ext_vector_type(4)));
typedef float f32x16 __attribute__((ext_vector_type(16)));
constexpr int LWL = 0;
constexpr int CH0 = 16384, CH_STRIDE = 20992;
constexpr int O_QR = 0, O_BK = 4608, O_BH = 9216, O_KH = 11520, O_V = 13824, O_QH = 16128, O_XX = 18432, O_BNK = 19584, O_GC = 20736;
constexpr int P144 = 72, P72 = 36;
constexpr int YL0 = CH0 + 4 * CH_STRIDE;
static_assert(YL0 + 64 * 144 <= RING_BYTES, "chunk-scan LDS map");
__device__ __forceinline__ int crow(int reg, int h) { return (reg & 3) + 8 * (reg >> 2) + 4 * h; }
__device__ __forceinline__ bf16x8 ld8(const LAS bf16* p) { const s16x4 lo = *(const LAS s16x4*)p, hi = *(const LAS s16x4*)(p + 8); return __builtin_shufflevector(lo, hi, 0, 1, 2, 3, 4, 5, 6, 7); }
__device__ __forceinline__ bf16x8 ld8c(const LAS bf16* p) { const s16x4 lo = *(const LAS s16x4*)p, hi = *(const LAS s16x4*)(p + 4); return __builtin_shufflevector(lo, hi, 0, 1, 2, 3, 4, 5, 6, 7); }
template <bool PERM> __device__ __forceinline__ bf16x8 ldcol(const LAS bf16* p, int h) {
    const LAS bf16* q = p + (PERM ? 4 * h : 8 * h) * P144;
    unsigned e[8];
#pragma unroll
    for (int jj = 0; jj < 8; ++jj) e[jj] = q[((PERM && jj >= 4) ? jj + 4 : jj) * P144];
    v4u w; w.x = e[0] | (e[1] << 16); w.y = e[2] | (e[3] << 16); w.z = e[4] | (e[5] << 16); w.w = e[6] | (e[7] << 16);
    return __builtin_bit_cast(bf16x8, w); }
typedef short v4i16_tr_t __attribute__((ext_vector_type(4)));
template <bool PERM> __device__ __forceinline__ bf16x8 ldcol_tr(const LAS bf16* p0, int r, int h) {
    const int i = r & 15, q = i >> 2, pp = i & 3;
    const LAS bf16* a = p0 + ((PERM ? 4 * h : 8 * h) + q) * P144 + (r & 16) + 4 * pp;
    const s16x4 lo = __builtin_bit_cast(s16x4, __builtin_amdgcn_ds_read_tr16_b64_v4i16((LAS v4i16_tr_t*)a));
    const s16x4 hi = __builtin_bit_cast(s16x4, __builtin_amdgcn_ds_read_tr16_b64_v4i16((LAS v4i16_tr_t*)(a + (PERM ? 8 : 4) * P144)));
    return __builtin_shufflevector(lo, hi, 0, 1, 2, 3, 4, 5, 6, 7); }
__device__ __forceinline__ bf16x8 pack8r(const f32x16& x, int s) {
    v4u p; p.x = pg8::cvt_pk_bf16(x[8 * s], x[8 * s + 1]); p.y = pg8::cvt_pk_bf16(x[8 * s + 2], x[8 * s + 3]); p.z = pg8::cvt_pk_bf16(x[8 * s + 4], x[8 * s + 5]); p.w = pg8::cvt_pk_bf16(x[8 * s + 6], x[8 * s + 7]);
    return __builtin_bit_cast(bf16x8, p); }
#define CS_SYNC() do { asm volatile("s_waitcnt lgkmcnt(0)" ::: "memory"); __builtin_amdgcn_s_barrier(); asm volatile("" ::: "memory"); } while (0)
#define CS_MFMA(a, b, c) __builtin_amdgcn_mfma_f32_32x32x16_bf16((a), (b), (c), 0, 0, 0)
}
__device__ __forceinline__ void scan_chain_chunked(int l, int chain, const float* const* in, unsigned char* ws, LAS unsigned char* lds, int tid, int wave, int lane) {
    using namespace cs;
    const int d = chain >> 6, b = (chain >> 3) & 7, hd = chain & 7;
    const bf16* R = (const bf16*)(ws + A_R); const bf16* KS = (const bf16*)(ws + A_KS); const bf16* VS = (const bf16*)(ws + A_VS);
    const bf16* LW = (const bf16*)(ws + A_LW); const bf16* AA = (const bf16*)(ws + A_AA);
    bf16* YS = (bf16*)(ws + (d ? A_YSB : A_YSF)); float* CFB = (float*)(ws + WS_CFB) + (size_t)d * M * 8;
    LAS float* lwL = (LAS float*)(lds + RING_OFF + LWL);
    const int ps0 = tid >> 3, pc0 = tid & 7;
    const int r0 = lane & 31, h0 = lane >> 5;
    const float* kkcp = in[10] + (size_t)l * 512 + hd * 64; const float* kacp = in[11] + (size_t)l * 512 + hd * 64; const float* rkcp = in[12] + (size_t)l * 512 + hd * 64;
    f32x16 st0, st1;
#pragma unroll
    for (int i = 0; i < 16; ++i) { st0[i] = 0.f; st1[i] = 0.f; }
    v4u rr, kr, vr, lwr, ar;
    { const int tok = d ? (SEQ - 1 - ps0) : ps0; const size_t t = (size_t)b * SEQ + tok;
      rr = ld16(R + t * 512 + hd * 64 + pc0 * 8); kr = ld16(KS + t * 512 + hd * 64 + pc0 * 8); vr = ld16(VS + t * 512 + hd * 64 + pc0 * 8);
      lwr = ld16(LW + t * 1024 + d * 512 + hd * 64 + pc0 * 8); ar = ld16(AA + t * 1024 + d * 512 + hd * 64 + pc0 * 8); }
    for (int blk = 0; blk < SEQ / 64; ++blk) {
        int ps = ps0, pc = pc0, r = r0, h = h0; asm volatile("" : "+v"(ps), "+v"(pc), "+v"(r), "+v"(h));
        const int ch = ps >> 4, sl = ps & 15;

        const int tokp = d ? (SEQ - 1 - (blk * 64 + ps)) : (blk * 64 + ps); const size_t tp = (size_t)b * SEQ + tokp;
        LAS unsigned char* cbase = lds + RING_OFF + CH0 + ch * CH_STRIDE;
        if (blk > 0) { const int tl = (blk - 1) * 64 + ps; const int tok = d ? (SEQ - 1 - tl) : tl;
            const v4u yv = *(const LAS v4u*)((const LAS bf16*)(lds + RING_OFF + YL0) + ps * P144 + pc * 8); st16(YS + ((size_t)b * SEQ + tok) * 512 + hd * 64 + pc * 8, yv); }
        float r8[8], k8[8], v8[8], lw8[8], a8[8], kk8[8], kd8[8], nb8[8], kkc[8], kac[8], rkc[8];
        ldf8(kkcp + pc * 8, kkc); ldf8(kacp + pc * 8, kac); ldf8(rkcp + pc * 8, rkc);
        unp8(rr, r8); unp8(kr, k8); unp8(vr, v8); unp8(lwr, lw8); unp8(ar, a8); const v4u vraw_ = vr; (void)v8;
        { float ss = 0.f;
#pragma unroll
          for (int i = 0; i < 8; ++i) { kk8[i] = k8[i] * kkc[i]; ss += kk8[i] * kk8[i]; }
          ss = sum8(ss, lane); const float inv = 1.0f / fmaxf(sqrtf(ss), 1e-12f);
          float cf = 0.f;
#pragma unroll
          for (int i = 0; i < 8; ++i) { kk8[i] *= inv; kd8[i] = k8[i] * (1.0f + (a8[i] - 1.0f) * kac[i]); cf += r8[i] * kd8[i] * rkc[i]; nb8[i] = -kk8[i] * a8[i]; }
          cf = sum8(cf, lane); if (pc == 0) CFB[tp * 8 + hd] = cf; }
        { LAS float* p = lwL + ps * 64 + pc * 8; *(LAS f32x4*)p = (f32x4){lw8[0], lw8[1], lw8[2], lw8[3]}; *(LAS f32x4*)(p + 4) = (f32x4){lw8[4], lw8[5], lw8[6], lw8[7]}; }
        CS_SYNC();
        if (blk + 1 < SEQ / 64) { const int tok = d ? (SEQ - 1 - ((blk + 1) * 64 + ps)) : ((blk + 1) * 64 + ps); const size_t t = (size_t)b * SEQ + tok;
            rr = ld16(R + t * 512 + hd * 64 + pc * 8); kr = ld16(KS + t * 512 + hd * 64 + pc * 8); vr = ld16(VS + t * 512 + hd * 64 + pc * 8);
            lwr = ld16(LW + t * 1024 + d * 512 + hd * 64 + pc * 8); ar = ld16(AA + t * 1024 + d * 512 + hd * 64 + pc * 8); }
        { float Lex[8], Lt[8];
#pragma unroll
          for (int i = 0; i < 8; ++i) { Lex[i] = 0.f; Lt[i] = 0.f; }
#pragma unroll 4
          for (int u = 0; u < 16; ++u) { const LAS float* p = lwL + (ch * 16 + u) * 64 + pc * 8; const f32x4 x0 = *(const LAS f32x4*)p, x1 = *(const LAS f32x4*)(p + 4);
              const float m = (u < sl) ? 1.0f : 0.0f;
#pragma unroll
              for (int i = 0; i < 4; ++i) { Lt[i] += x0[i]; Lt[4 + i] += x1[i]; Lex[i] += m * x0[i]; Lex[4 + i] += m * x1[i]; } }
          LAS bf16* QRp = (LAS bf16*)(cbase + O_QR); LAS bf16* BKp = (LAS bf16*)(cbase + O_BK);
          float Lin[8], tmp[8], tm2[8];
#pragma unroll
          for (int i = 0; i < 8; ++i) { Lin[i] = Lex[i] + lw8[i]; tmp[i] = kk8[i] * __expf(Lex[i]); }
          *(LAS v4u*)(QRp + sl * P144 + pc * 8) = pk8(tmp);
          asm volatile("" ::: "memory");
#pragma unroll
          for (int i = 0; i < 8; ++i) tmp[i] = r8[i] * __expf(Lin[i]);
          *(LAS v4u*)(QRp + (16 + sl) * P144 + pc * 8) = pk8(tmp);
          asm volatile("" ::: "memory");
#pragma unroll
          for (int i = 0; i < 8; ++i) { const float ig = __expf(-Lin[i]); tmp[i] = nb8[i] * ig; tm2[i] = kd8[i] * ig; }
          *(LAS v4u*)(BKp + sl * P144 + pc * 8) = pk8(tmp); *(LAS v4u*)(BKp + (16 + sl) * P144 + pc * 8) = pk8(tm2);
          asm volatile("" ::: "memory");
#pragma unroll
          for (int i = 0; i < 8; ++i) { const float igc = __expf(Lt[i] - Lin[i]); tmp[i] = nb8[i] * igc; tm2[i] = kd8[i] * igc; }
          *(LAS v4u*)((LAS bf16*)(cbase + O_BH) + sl * P144 + pc * 8) = pk8(tmp); *(LAS v4u*)((LAS bf16*)(cbase + O_KH) + sl * P144 + pc * 8) = pk8(tm2);
          *(LAS v4u*)((LAS bf16*)(cbase + O_V) + sl * P144 + pc * 8) = vraw_;
          if (sl == 15) { LAS float* gp = (LAS float*)(cbase + O_GC) + pc * 8; *(LAS f32x4*)gp = (f32x4){__expf(Lt[0]), __expf(Lt[1]), __expf(Lt[2]), __expf(Lt[3])}; *(LAS f32x4*)(gp + 4) = (f32x4){__expf(Lt[4]), __expf(Lt[5]), __expf(Lt[6]), __expf(Lt[7])}; } }
        CS_SYNC();
#ifndef CS_NO_A
#ifndef CS_REP_A
#define CS_REP_A 1
#endif
        for (int repa_ = 0; repa_ < CS_REP_A; ++repa_) if (wave < 4) {
            LAS unsigned char* cb = lds + RING_OFF + CH0 + wave * CH_STRIDE;
            const LAS bf16* QRp = (const LAS bf16*)(cb + O_QR); const LAS bf16* BKp = (const LAS bf16*)(cb + O_BK); LAS float* AD = (LAS float*)(cb + O_BK);
            f32x16 D;
#pragma unroll
            for (int i = 0; i < 16; ++i) D[i] = 0.f;
#pragma unroll
            for (int ks = 0; ks < 4; ++ks) { const bf16x8 A = *(const LAS bf16x8*)(QRp + r * P144 + ks * 16 + h * 8), B = *(const LAS bf16x8*)(BKp + r * P144 + ks * 16 + h * 8); D = CS_MFMA(A, B, D); }
            asm volatile("s_waitcnt lgkmcnt(0)" ::: "memory");
            LAS float* AnT = (LAS float*)(cb + O_QH);
#pragma unroll
            for (int i = 0; i < 16; ++i) { const int row = crow(i, h), s_ = row & 15, u_ = r & 15; const bool keep = (i < 8) ? (u_ < s_) : (u_ <= s_); const float v = keep ? D[i] : 0.f;
                AD[row * 32 + r] = v; if (i < 8) AnT[r * 16 + row] = v; }
            asm volatile("s_waitcnt lgkmcnt(0)" ::: "memory");
            float x[16];
#pragma unroll
            for (int t = 0; t < 16; ++t) { const float ldv = AD[t * 32 + r]; x[t] = (r < 16) ? ((t == r) ? 1.0f : 0.0f) : ldv; }
#pragma unroll
            for (int s = 0; s < 15; ++s) { const f32x4 a0 = *(const LAS f32x4*)(AnT + s * 16), a1 = *(const LAS f32x4*)(AnT + s * 16 + 4), a2 = *(const LAS f32x4*)(AnT + s * 16 + 8), a3 = *(const LAS f32x4*)(AnT + s * 16 + 12);
                const float an[16] = {a0[0], a0[1], a0[2], a0[3], a1[0], a1[1], a1[2], a1[3], a2[0], a2[1], a2[2], a2[3], a3[0], a3[1], a3[2], a3[3]};
                const float xs = x[s];
#pragma unroll
                for (int t = 0; t < 16; ++t) if (t > s) x[t] += an[t] * xs; }
            LAS bf16* XXp = (LAS bf16*)(cb + O_XX);
            if (h == 0) {
#pragma unroll
                for (int s = 0; s < 16; ++s) XXp[s * P72 + r] = (bf16)f2bf(x[s]); }
            { const int s = lane >> 2, c8 = (lane & 3) * 8; const LAS float* ap = AD + (16 + s) * 32 + c8; const f32x4 y0 = *(const LAS f32x4*)ap, y1 = *(const LAS f32x4*)(ap + 4);
              LAS v2u* bp = (LAS v2u*)((LAS bf16*)(cb + O_BNK) + s * P72 + c8); bp[0] = (v2u){pk2(y0[0], y0[1]), pk2(y0[2], y0[3])}; bp[1] = (v2u){pk2(y1[0], y1[1]), pk2(y1[2], y1[3])}; }
            asm volatile("s_waitcnt lgkmcnt(0)" ::: "memory");
            { LAS bf16* QHp = (LAS bf16*)(cb + O_QH);
              const bf16x8 A = ld8c(XXp + (r & 15) * P72 + 8 * h);
#pragma unroll
              for (int ct = 0; ct < 2; ++ct) { const bf16x8 B = ldcol<false>(QRp + 32 * ct + r, h); f32x16 z;
#pragma unroll
                  for (int i = 0; i < 16; ++i) z[i] = 0.f;
                  z = CS_MFMA(A, B, z);
#pragma unroll
                  for (int i = 0; i < 8; ++i) QHp[crow(i, h) * P144 + 32 * ct + r] = (bf16)f2bf(z[i]); } }
        }
#endif
        CS_SYNC();
#ifndef CS_NO_B
        if (wave < 2) {
            const int c0 = 32 * wave;
#pragma unroll 1
            for (int cc = 0; cc < 4; ++cc) {
                LAS unsigned char* cb = lds + RING_OFF + CH0 + cc * CH_STRIDE;
                const LAS bf16* QRp = (const LAS bf16*)(cb + O_QR); const LAS bf16* QHp = (const LAS bf16*)(cb + O_QH); const LAS bf16* XXp = (const LAS bf16*)(cb + O_XX); const LAS bf16* BNp = (const LAS bf16*)(cb + O_BNK);
                const LAS bf16* Vp = (const LAS bf16*)(cb + O_V); const LAS bf16* BHp = (const LAS bf16*)(cb + O_BH); const LAS bf16* KHp = (const LAS bf16*)(cb + O_KH); const LAS float* GCp = (const LAS float*)(cb + O_GC);
                const int ra = (r & 15) * P144 + 4 * h, rb = (16 + (r & 15)) * P144 + 4 * h, rx = (r & 15) * P72 + 4 * h;
                const bf16x8 qh0 = ld8(QHp + ra), qh1 = ld8(QHp + ra + 16), qh2 = ld8(QHp + ra + 32), qh3 = ld8(QHp + ra + 48);
                const bf16x8 taf = ld8(XXp + rx + 16), vf = ldcol<true>(Vp + c0 + r, h);
                const bf16x8 sb00 = pack8r(st0, 0), sb01 = pack8r(st0, 1), sb10 = pack8r(st1, 0), sb11 = pack8r(st1, 1);
                f32x16 dq;
#pragma unroll
                for (int i = 0; i < 16; ++i) dq[i] = 0.f;
                dq = CS_MFMA(qh0, sb00, dq); dq = CS_MFMA(qh1, sb01, dq); dq = CS_MFMA(qh2, sb10, dq); dq = CS_MFMA(qh3, sb11, dq); dq = CS_MFMA(taf, vf, dq);
                const bf16x8 kh0 = ldcol<true>(KHp + r, h), kh1 = ldcol<true>(KHp + 32 + r, h), bh0 = ldcol<true>(BHp + r, h), bh1 = ldcol<true>(BHp + 32 + r, h);
                { f32x16 acc0, acc1;
#pragma unroll
                  for (int g = 0; g < 4; ++g) { const f32x4 ga = *(const LAS f32x4*)(GCp + 8 * g + 4 * h), gb = *(const LAS f32x4*)(GCp + 32 + 8 * g + 4 * h);
                      acc0[4 * g] = st0[4 * g] * ga[0]; acc0[4 * g + 1] = st0[4 * g + 1] * ga[1]; acc0[4 * g + 2] = st0[4 * g + 2] * ga[2]; acc0[4 * g + 3] = st0[4 * g + 3] * ga[3];
                      acc1[4 * g] = st1[4 * g] * gb[0]; acc1[4 * g + 1] = st1[4 * g + 1] * gb[1]; acc1[4 * g + 2] = st1[4 * g + 2] * gb[2]; acc1[4 * g + 3] = st1[4 * g + 3] * gb[3]; }
                  acc0 = CS_MFMA(kh0, vf, acc0); acc1 = CS_MFMA(kh1, vf, acc1);
                  const bf16x8 dqb = pack8r(dq, 0);
                  acc0 = CS_MFMA(bh0, dqb, acc0); acc1 = CS_MFMA(bh1, dqb, acc1);
                  st0 = acc0; st1 = acc1;
                  f32x16 y;
#pragma unroll
                  for (int i = 0; i < 16; ++i) y[i] = 0.f;
                  y = CS_MFMA(ld8(QRp + rb), sb00, y); y = CS_MFMA(ld8(QRp + rb + 16), sb01, y); y = CS_MFMA(ld8(QRp + rb + 32), sb10, y); y = CS_MFMA(ld8(QRp + rb + 48), sb11, y);
                  y = CS_MFMA(ld8(BNp + rx + 16), vf, y); y = CS_MFMA(ld8(BNp + rx), dqb, y);
                  { LAS bf16* YLp = (LAS bf16*)(lds + RING_OFF + YL0) + (cc * 16) * P144 + c0 + r;
#pragma unroll
                    for (int i = 0; i < 8; i += 2) { const unsigned w = pg8::cvt_pk_bf16(y[i], y[i + 1]); YLp[crow(i, h) * P144] = (bf16)(w & 0xffffu); YLp[crow(i + 1, h) * P144] = (bf16)(w >> 16); } } }
            }
        }
#endif
        CS_SYNC();
    }
    { const int tl = (SEQ / 64 - 1) * 64 + ps0; const int tok = d ? (SEQ - 1 - tl) : tl;
      const v4u yv = *(const LAS v4u*)((const LAS bf16*)(lds + RING_OFF + YL0) + ps0 * P144 + pc0 * 8); st16(YS + ((size_t)b * SEQ + tok) * 512 + hd * 64 + pc0 * 8, yv); }
    CS_SYNC();
}

namespace cp {
constexpr int REG = 16384;
constexpr int O_QR = 0, O_BK = 4608, O_V = 9216, O_QH = 11520, O_XX = 13824, O_BNK = 14976, O_GC = 16128;
constexpr int AD0 = 6 * REG, LW0 = AD0 + 8192, YL0 = LW0 + 16384;
static_assert(YL0 + 8192 <= RING_BYTES, "pipelined chunk-scan LDS map");
}
__device__ __forceinline__ void scan_chain_pipe(int l, int chain, const float* const* in, unsigned char* ws, LAS unsigned char* lds, int tid, int wave, int lane) {
    using namespace cs;
    const int d = chain >> 6, b = (chain >> 3) & 7, hd = chain & 7;
    const bf16* R = (const bf16*)(ws + A_R); const bf16* KS = (const bf16*)(ws + A_KS); const bf16* VS = (const bf16*)(ws + A_VS);
    const bf16* LW = (const bf16*)(ws + A_LW); const bf16* AA = (const bf16*)(ws + A_AA);
    bf16* YS = (bf16*)(ws + (d ? A_YSB : A_YSF)); float* CFB = (float*)(ws + WS_CFB) + (size_t)d * M * 8;
    LAS unsigned char* ring = lds + RING_OFF;
    constexpr int NB = SEQ / 32;
    const bool isprep = wave >= 4;
    const int ps0 = (tid & 255) >> 3, pc0 = tid & 7, r0 = lane & 31, h0 = lane >> 5;
    const float* kkcp = in[10] + (size_t)l * 512 + hd * 64; const float* kacp = in[11] + (size_t)l * 512 + hd * 64; const float* rkcp = in[12] + (size_t)l * 512 + hd * 64;
    f32x16 st0, st1;
#pragma unroll
    for (int i = 0; i < 16; ++i) { st0[i] = 0.f; st1[i] = 0.f; }
#define kk8(i) st0[(i)]
#define r8(i) st0[8 + (i)]
#define nb8(i) st1[(i)]
#define kd8(i) st1[8 + (i)]
    float lw8[8], inc8[8]; v4u vkeep = {0u, 0u, 0u, 0u};
#pragma unroll
    for (int i = 0; i < 8; ++i) { lw8[i] = 0.f; inc8[i] = 0.f; }
    v4u rr = {0u, 0u, 0u, 0u}, kr = rr, vr = rr, lwr = rr, ar = rr;
#define CP_LOADRAW(j) do { const int tok_ = d ? (SEQ - 1 - ((j) * 32 + ps)) : ((j) * 32 + ps); const size_t t_ = (size_t)b * SEQ + tok_; \
        rr = ld16(R + t_ * 512 + hd * 64 + pc * 8); kr = ld16(KS + t_ * 512 + hd * 64 + pc * 8); vr = ld16(VS + t_ * 512 + hd * 64 + pc * 8); \
        lwr = ld16(LW + t_ * 1024 + d * 512 + hd * 64 + pc * 8); ar = ld16(AA + t_ * 1024 + d * 512 + hd * 64 + pc * 8); } while (0)
#define CP_PREP1(j) do { float k8_[8], a8_[8], kkc_[8], kac_[8], rkc_[8]; \
        { const LAS float* c_ = cstL + pc * 8; const f32x4 a0_ = *(const LAS f32x4*)c_, a1_ = *(const LAS f32x4*)(c_ + 4), b0_ = *(const LAS f32x4*)(c_ + 64), b1_ = *(const LAS f32x4*)(c_ + 68), c0_ = *(const LAS f32x4*)(c_ + 128), c1_ = *(const LAS f32x4*)(c_ + 132); \
          _Pragma("unroll") for (int i = 0; i < 4; ++i) { kkc_[i] = a0_[i]; kkc_[4 + i] = a1_[i]; kac_[i] = b0_[i]; kac_[4 + i] = b1_[i]; rkc_[i] = c0_[i]; rkc_[4 + i] = c1_[i]; } } \
        { float r_[8]; unp8(rr, r_); _Pragma("unroll") for (int i = 0; i < 8; ++i) r8(i) = r_[i]; } unp8(kr, k8_); unp8(lwr, lw8); unp8(ar, a8_); vkeep = vr; \
        float ss_ = 0.f, cf_ = 0.f; _Pragma("unroll") for (int i = 0; i < 8; ++i) { kk8(i) = k8_[i] * kkc_[i]; ss_ += kk8(i) * kk8(i); kd8(i) = k8_[i] * (1.0f + (a8_[i] - 1.0f) * kac_[i]); cf_ += r8(i) * kd8(i) * rkc_[i]; } \
        ss_ = sum8(ss_, lane); cf_ = sum8(cf_, lane); \
        const float inv_ = fminf(__builtin_amdgcn_rsqf(ss_), 1e12f); \
        _Pragma("unroll") for (int i = 0; i < 8; ++i) { kk8(i) *= inv_; nb8(i) = -kk8(i) * a8_[i]; } \
        { const int tok_ = d ? (SEQ - 1 - ((j) * 32 + ps)) : ((j) * 32 + ps); if (pc == 0) CFB[((size_t)b * SEQ + tok_) * 8 + hd] = cf_; } \
        _Pragma("unroll") for (int i = 0; i < 8; ++i) inc8[i] = lw8[i]; \
        _Pragma("unroll") for (int off_ = 8; off_ < 64; off_ <<= 1) { float t8_[8]; _Pragma("unroll") for (int i = 0; i < 8; ++i) t8_[i] = shx_from(inc8[i], lane - off_, lane); \
            __builtin_amdgcn_sched_barrier(0);     \
            _Pragma("unroll") for (int i = 0; i < 8; ++i) inc8[i] += (lane >= off_) ? t8_[i] : 0.f; } \
        if ((lane >> 3) == 7) { LAS float* p_ = (LAS float*)(ring + cp::LW0) + ((j) & 1) * 256 + (wave & 3) * 64 + pc * 8; *(LAS f32x4*)p_ = (f32x4){inc8[0], inc8[1], inc8[2], inc8[3]}; *(LAS f32x4*)(p_ + 4) = (f32x4){inc8[4], inc8[5], inc8[6], inc8[7]}; } \
        if ((j) + 1 < NB) CP_LOADRAW((j) + 1); } while (0)
    LAS float* cstL = (LAS float*)(lds + MISC_OFF + 1024);
    if (tid < 192) cstL[tid] = (tid < 64 ? kkcp : (tid < 128 ? kacp : rkcp))[tid & 63];
    CS_SYNC();
    if (isprep) { const int ps = ps0, pc = pc0; CP_LOADRAW(0); CP_PREP1(0); }
    CS_SYNC();
    for (int k = 0; k < NB + 3; ++k) {
        int ps = ps0, pc = pc0, r = r0, h = h0; asm volatile("" : "+v"(ps), "+v"(pc), "+v"(r), "+v"(h));
        if (isprep) {
            const int ch = ps >> 4, sl = ps & 15;
            if (k >= 3) { const int j = k - 3; const int tl = j * 32 + ps; const int tok = d ? (SEQ - 1 - tl) : tl;
                const v4u yv = *(const LAS v4u*)((const LAS bf16*)(ring + cp::YL0) + (j & 1) * 2048 + ps * 64 + pc * 8); st16(YS + ((size_t)b * SEQ + tok) * 512 + hd * 64 + pc * 8, yv); }
#ifndef CP_REP_P
#define CP_REP_P 1
#endif
            for (int repp_ = 0; repp_ < CP_REP_P; ++repp_) if (k < NB) {
                LAS unsigned char* cbase = ring + ((k % 3) * 2 + ch) * cp::REG;
                const LAS float* WT = (const LAS float*)(ring + cp::LW0) + (k & 1) * 256 + (ch * 2) * 64 + pc * 8;
                float Lex[8], Lt[8];
                { const f32x4 a0 = *(const LAS f32x4*)WT, a1 = *(const LAS f32x4*)(WT + 4), b0 = *(const LAS f32x4*)(WT + 64), b1 = *(const LAS f32x4*)(WT + 68);
                  const float w0[8] = {a0[0], a0[1], a0[2], a0[3], a1[0], a1[1], a1[2], a1[3]}, w1[8] = {b0[0], b0[1], b0[2], b0[3], b1[0], b1[1], b1[2], b1[3]};
                  const float m = (sl >= 8) ? 1.0f : 0.0f;
#pragma unroll
                  for (int i = 0; i < 8; ++i) { Lt[i] = w0[i] + w1[i]; Lex[i] = inc8[i] + m * w0[i] - lw8[i]; } }
                LAS bf16* QRp = (LAS bf16*)(cbase + cp::O_QR); LAS bf16* BKp = (LAS bf16*)(cbase + cp::O_BK);
                float Lin[8], tmp[8], tm2[8];
#pragma unroll
                for (int i = 0; i < 8; ++i) { Lin[i] = Lex[i] + lw8[i]; tmp[i] = kk8(i) * __expf(Lex[i]); }
                *(LAS v4u*)(QRp + sl * P144 + pc * 8) = pk8(tmp);
#pragma unroll
                for (int i = 0; i < 8; ++i) tmp[i] = r8(i) * __expf(Lin[i]);
                *(LAS v4u*)(QRp + (16 + sl) * P144 + pc * 8) = pk8(tmp);
#pragma unroll
                for (int i = 0; i < 8; ++i) { const float ig = __expf(-Lin[i]); tmp[i] = nb8(i) * ig; tm2[i] = kd8(i) * ig; }
                *(LAS v4u*)(BKp + sl * P144 + pc * 8) = pk8(tmp); *(LAS v4u*)(BKp + (16 + sl) * P144 + pc * 8) = pk8(tm2);
                *(LAS v4u*)((LAS bf16*)(cbase + cp::O_V) + sl * P144 + pc * 8) = vkeep;
                if (sl == 15) { LAS float* gp = (LAS float*)(cbase + cp::O_GC) + pc * 8; *(LAS f32x4*)gp = (f32x4){__expf(Lt[0]), __expf(Lt[1]), __expf(Lt[2]), __expf(Lt[3])}; *(LAS f32x4*)(gp + 4) = (f32x4){__expf(Lt[4]), __expf(Lt[5]), __expf(Lt[6]), __expf(Lt[7])}; }
            }
            if (k + 1 < NB) CP_PREP1(k + 1);
        }
        if (wave == 2 || wave == 3) {
#ifndef CP_REP_A
#define CP_REP_A 1
#endif
            for (int repa_ = 0; repa_ < CP_REP_A; ++repa_) if (k >= 1 && k <= NB) {
                const int j = k - 1, ca = wave - 2;
                LAS unsigned char* cb = ring + ((j % 3) * 2 + ca) * cp::REG;
                const LAS bf16* QRp = (const LAS bf16*)(cb + cp::O_QR); const LAS bf16* BKp = (const LAS bf16*)(cb + cp::O_BK); LAS float* AD = (LAS float*)(ring + cp::AD0 + ca * 4096);
                f32x16 D;
#pragma unroll
                for (int i = 0; i < 16; ++i) D[i] = 0.f;
#pragma unroll
                for (int ks = 0; ks < 4; ++ks) { const bf16x8 A = *(const LAS bf16x8*)(QRp + r * P144 + ks * 16 + h * 8), B = *(const LAS bf16x8*)(BKp + r * P144 + ks * 16 + h * 8); D = CS_MFMA(A, B, D); }
                LAS float* AnT = (LAS float*)(cb + cp::O_QH);
#pragma unroll
                for (int i = 0; i < 16; ++i) { const int row = crow(i, h), s_ = row & 15, u_ = r & 15; const bool keep = (i < 8) ? (u_ < s_) : (u_ <= s_); const float v = keep ? D[i] : 0.f;
                    AD[row * 32 + r] = v; if (i < 8) AnT[r * 16 + row] = v; }
                asm volatile("s_waitcnt lgkmcnt(0)" ::: "memory");
                float x[16];
#pragma unroll
                for (int t = 0; t < 16; ++t) x[t] = AD[t * 32 + r];
#pragma unroll
                for (int t = 0; t < 16; ++t) asm volatile("" : "+v"(x[t]));
#pragma unroll
                for (int t = 0; t < 16; ++t) x[t] = (r < 16) ? ((t == r) ? 1.0f : 0.0f) : x[t];
#pragma unroll
                for (int s = 0; s < 15; ++s) { const f32x4 a0 = *(const LAS f32x4*)(AnT + s * 16), a1 = *(const LAS f32x4*)(AnT + s * 16 + 4), a2 = *(const LAS f32x4*)(AnT + s * 16 + 8), a3 = *(const LAS f32x4*)(AnT + s * 16 + 12);
                    const float an[16] = {a0[0], a0[1], a0[2], a0[3], a1[0], a1[1], a1[2], a1[3], a2[0], a2[1], a2[2], a2[3], a3[0], a3[1], a3[2], a3[3]};
                    const float xs = x[s];
#pragma unroll
                    for (int t = 0; t < 16; ++t) if (t > s) x[t] += an[t] * xs; }
                LAS bf16* XXp = (LAS bf16*)(cb + cp::O_XX);
                if (h == 0) {
#pragma unroll
                    for (int s = 0; s < 16; ++s) XXp[s * P72 + r] = (bf16)f2bf(x[s]); }
                { const int s = lane >> 2, c8 = (lane & 3) * 8; const LAS float* ap = AD + (16 + s) * 32 + c8; const f32x4 y0 = *(const LAS f32x4*)ap, y1 = *(const LAS f32x4*)(ap + 4);
                  LAS v2u* bp = (LAS v2u*)((LAS bf16*)(cb + cp::O_BNK) + s * P72 + c8); bp[0] = (v2u){pk2(y0[0], y0[1]), pk2(y0[2], y0[3])}; bp[1] = (v2u){pk2(y1[0], y1[1]), pk2(y1[2], y1[3])}; }
                asm volatile("s_waitcnt lgkmcnt(0)" ::: "memory");
                { LAS bf16* QHp = (LAS bf16*)(cb + cp::O_QH);
                  const bf16x8 A = ld8c(XXp + (r & 15) * P72 + 8 * h);
                  f32x16 z0, z1;
#pragma unroll
                  for (int i = 0; i < 16; ++i) { z0[i] = 0.f; z1[i] = 0.f; }
                  z0 = CS_MFMA(A, ldcol_tr<false>(QRp, r, h), z0); z1 = CS_MFMA(A, ldcol_tr<false>(QRp + 32, r, h), z1);
#pragma unroll
                  for (int i = 0; i < 8; ++i) { QHp[crow(i, h) * P144 + r] = (bf16)f2bf(z0[i]); QHp[crow(i, h) * P144 + 32 + r] = (bf16)f2bf(z1[i]); } }
            }
        }
        if (wave < 2) {
            if (k >= 2 && k <= NB + 1) {
                const int j = k - 2, c0 = 32 * wave;
                const int ra = (r & 15) * P144 + 4 * h, rb = (16 + (r & 15)) * P144 + 4 * h, rx = (r & 15) * P72 + 4 * h;
                LAS unsigned char* cb0 = ring + ((j % 3) * 2 + 0) * cp::REG; LAS unsigned char* cb1 = cb0 + cp::REG;
#define CP_P(cb, off) ((const LAS bf16*)((cb) + (off)))
#define CP_GC(cb, GA, GB) do { _Pragma("unroll") for (int g = 0; g < 4; ++g) { GA[g] = *(const LAS f32x4*)((const LAS float*)((cb) + cp::O_GC) + 8 * g + 4 * h); GB[g] = *(const LAS f32x4*)((const LAS float*)((cb) + cp::O_GC) + 32 + 8 * g + 4 * h); } } while (0)
#define CP_SCALE(GA, GB) do { _Pragma("unroll") for (int g = 0; g < 4; ++g) { \
                    st0[4 * g] = acc0[4 * g] * GA[g][0]; st0[4 * g + 1] = acc0[4 * g + 1] * GA[g][1]; st0[4 * g + 2] = acc0[4 * g + 2] * GA[g][2]; st0[4 * g + 3] = acc0[4 * g + 3] * GA[g][3]; \
                    st1[4 * g] = acc1[4 * g] * GB[g][0]; st1[4 * g + 1] = acc1[4 * g + 1] * GB[g][1]; st1[4 * g + 2] = acc1[4 * g + 2] * GB[g][2]; st1[4 * g + 3] = acc1[4 * g + 3] * GB[g][3]; } } while (0)
                const bf16x8 qh00 = ld8(CP_P(cb0, cp::O_QH) + ra), qh01 = ld8(CP_P(cb0, cp::O_QH) + ra + 16), qh02 = ld8(CP_P(cb0, cp::O_QH) + ra + 32), qh03 = ld8(CP_P(cb0, cp::O_QH) + ra + 48), ta0 = ld8(CP_P(cb0, cp::O_XX) + rx + 16);
                const bf16x8 vf0 = ldcol_tr<true>(CP_P(cb0, cp::O_V) + c0, r, h);
                const bf16x8 kt00 = ldcol_tr<true>(CP_P(cb0, cp::O_BK) + 16 * P144, r, h), kt01 = ldcol_tr<true>(CP_P(cb0, cp::O_BK) + 16 * P144 + 32, r, h), bt00 = ldcol_tr<true>(CP_P(cb0, cp::O_BK), r, h), bt01 = ldcol_tr<true>(CP_P(cb0, cp::O_BK) + 32, r, h);
                f32x4 ga[4], gb[4]; CP_GC(cb0, ga, gb);
                __builtin_amdgcn_sched_barrier(0);
                const bf16x8 s00 = pack8r(st0, 0), s01 = pack8r(st0, 1), s10 = pack8r(st1, 0), s11 = pack8r(st1, 1);
                f32x16 dq;
#pragma unroll
                for (int i = 0; i < 16; ++i) dq[i] = 0.f;
                dq = CS_MFMA(qh00, s00, dq); dq = CS_MFMA(qh01, s01, dq); dq = CS_MFMA(qh02, s10, dq); dq = CS_MFMA(qh03, s11, dq); dq = CS_MFMA(ta0, vf0, dq);
                f32x16 acc0 = st0, acc1 = st1;
                acc0 = CS_MFMA(kt00, vf0, acc0); acc1 = CS_MFMA(kt01, vf0, acc1);
                __builtin_amdgcn_sched_barrier(0);
                const bf16x8 qh10 = ld8(CP_P(cb1, cp::O_QH) + ra), qh11 = ld8(CP_P(cb1, cp::O_QH) + ra + 16), qh12 = ld8(CP_P(cb1, cp::O_QH) + ra + 32), qh13 = ld8(CP_P(cb1, cp::O_QH) + ra + 48), ta1 = ld8(CP_P(cb1, cp::O_XX) + rx + 16);
                const bf16x8 vf1 = ldcol_tr<true>(CP_P(cb1, cp::O_V) + c0, r, h);
                const bf16x8 kt10 = ldcol_tr<true>(CP_P(cb1, cp::O_BK) + 16 * P144, r, h), kt11 = ldcol_tr<true>(CP_P(cb1, cp::O_BK) + 16 * P144 + 32, r, h), bt10 = ldcol_tr<true>(CP_P(cb1, cp::O_BK), r, h), bt11 = ldcol_tr<true>(CP_P(cb1, cp::O_BK) + 32, r, h);
                __builtin_amdgcn_sched_barrier(0);
                const bf16x8 dqb0 = pack8r(dq, 0);
                acc0 = CS_MFMA(bt00, dqb0, acc0); acc1 = CS_MFMA(bt01, dqb0, acc1);
                CP_SCALE(ga, gb);
                __builtin_amdgcn_sched_barrier(0);
                const bf16x8 rt00 = ld8(CP_P(cb0, cp::O_QR) + rb), rt01 = ld8(CP_P(cb0, cp::O_QR) + rb + 16), rt02 = ld8(CP_P(cb0, cp::O_QR) + rb + 32), rt03 = ld8(CP_P(cb0, cp::O_QR) + rb + 48);
                const bf16x8 bn0v = ld8(CP_P(cb0, cp::O_BNK) + rx + 16), bn0d = ld8(CP_P(cb0, cp::O_BNK) + rx);
                __builtin_amdgcn_sched_barrier(0);
                const bf16x8 t00 = pack8r(st0, 0), t01 = pack8r(st0, 1), t10 = pack8r(st1, 0), t11 = pack8r(st1, 1);
                f32x16 dq1, y0;
#pragma unroll
                for (int i = 0; i < 16; ++i) { dq1[i] = 0.f; y0[i] = 0.f; }
                dq1 = CS_MFMA(qh10, t00, dq1);     y0 = CS_MFMA(rt00, s00, y0);
                dq1 = CS_MFMA(qh11, t01, dq1);     y0 = CS_MFMA(rt01, s01, y0);
                dq1 = CS_MFMA(qh12, t10, dq1);     y0 = CS_MFMA(rt02, s10, y0);
                dq1 = CS_MFMA(qh13, t11, dq1);     y0 = CS_MFMA(rt03, s11, y0);
                dq1 = CS_MFMA(ta1, vf1, dq1);      y0 = CS_MFMA(bn0v, vf0, y0);
                acc0 = st0; acc1 = st1;
                acc0 = CS_MFMA(kt10, vf1, acc0); acc1 = CS_MFMA(kt11, vf1, acc1);
                y0 = CS_MFMA(bn0d, dqb0, y0);
                __builtin_amdgcn_sched_barrier(0);
                CP_GC(cb1, ga, gb);
                const bf16x8 rt10 = ld8(CP_P(cb1, cp::O_QR) + rb), rt11 = ld8(CP_P(cb1, cp::O_QR) + rb + 16), rt12 = ld8(CP_P(cb1, cp::O_QR) + rb + 32), rt13 = ld8(CP_P(cb1, cp::O_QR) + rb + 48);
                const bf16x8 bn1v = ld8(CP_P(cb1, cp::O_BNK) + rx + 16), bn1d = ld8(CP_P(cb1, cp::O_BNK) + rx);
                __builtin_amdgcn_sched_barrier(0);
                const bf16x8 dqb1 = pack8r(dq1, 0);
                acc0 = CS_MFMA(bt10, dqb1, acc0); acc1 = CS_MFMA(bt11, dqb1, acc1);
                f32x16 y1;
#pragma unroll
                for (int i = 0; i < 16; ++i) y1[i] = 0.f;
                y1 = CS_MFMA(rt10, t00, y1); y1 = CS_MFMA(rt11, t01, y1); y1 = CS_MFMA(rt12, t10, y1); y1 = CS_MFMA(rt13, t11, y1);
                y1 = CS_MFMA(bn1v, vf1, y1); y1 = CS_MFMA(bn1d, dqb1, y1);
                CP_SCALE(ga, gb);
#undef CP_GC
#undef CP_SCALE
                { LAS bf16* YLp = (LAS bf16*)(ring + cp::YL0) + (j & 1) * 2048 + c0 + r;
#pragma unroll
                  for (int i = 0; i < 8; i += 2) { const unsigned w0 = pg8::cvt_pk_bf16(y0[i], y0[i + 1]), w1 = pg8::cvt_pk_bf16(y1[i], y1[i + 1]);
                      YLp[crow(i, h) * 64] = (bf16)(w0 & 0xffffu); YLp[crow(i + 1, h) * 64] = (bf16)(w0 >> 16); YLp[(16 + crow(i, h)) * 64] = (bf16)(w1 & 0xffffu); YLp[(16 + crow(i + 1, h)) * 64] = (bf16)(w1 >> 16); } }
#undef CP_P
            }
        }
        CS_SYNC();
    }
#undef CP_LOADRAW
#undef kk8
#undef r8
#undef nb8
#undef kd8
#undef CP_PREP1
}

struct Args { const float* in[32]; float* out; unsigned char* ws; int ph_lo, ph_hi, li, pad; };
#ifndef PHMASK
#define PHMASK 0xFFFF
#endif
#define PH_EN(i) (((PHMASK) >> (i)) & 1)
#ifndef DUPMASK
#define DUPMASK 0
#endif
#define REP(i) for (int rep_ = 0; rep_ < ((((DUPMASK) >> (i)) & 1) + 1); ++rep_)
#define PHASE_BEGIN() \
    const int z_ = __builtin_amdgcn_readfirstlane((int)*(volatile LAS unsigned*)(lds + LDSCTL_OFF + 32)); \
    unsigned char* const ws = args.ws + z_; const float* const* const in = args.in + z_; float* const out = args.out + z_; \
    const int tid = (int)threadIdx.x + z_, lane = tid & 63, wave = __builtin_amdgcn_readfirstlane(tid >> 6); \
    const int G = (int)gridDim.x + z_, bx = (int)blockIdx.x + z_, vcu = (G % 8 == 0) ? (bx % 8) * (G / 8) + bx / 8 : bx; \
    const int gw = vcu * NWAVES + wave, NGW = G * NWAVES; (void)ws; (void)in; (void)out; (void)lane; (void)gw; (void)NGW; (void)vcu
#define LAYER_VARS() const float* const xcur = (l == 0) ? in[0] : (const float*)out; unsigned char* const wl = ws + WS_W + (size_t)l * WL_STRIDE; (void)xcur; (void)wl
#define IN(k) (ph_lo_ <= (k) && (k) < ph_hi_)
#ifdef PROBE_SEAM2
#define SEAM_EXTRA xcd_barrier(bar_);
#else
#define SEAM_EXTRA
#endif
#define SEAM(k) do { if (IN(k) && IN((k) + 1)) { const int zz_ = __builtin_amdgcn_readfirstlane((int)*(volatile LAS unsigned*)(lds + LDSCTL_OFF + 32)); XcdBarrier bar_; bar_.bar = (unsigned*)(args.ws + zz_ + WS_CTL) + CW_BAR + (ph_li_ + zz_) * XCD_BAR_WORDS; bar_.x = xb_xcc_id(); bar_.st = (volatile LAS unsigned*)(lds + MISC_OFF) + 8; xcd_barrier(bar_); SEAM_EXTRA } } while (0)

__global__ void __launch_bounds__(NTHR, 2) fwd(Args args) {
    extern __shared__ __attribute__((aligned(16))) unsigned char lds_raw[];
    LAS unsigned char* lds = (LAS unsigned char*)lds_raw;
    const int ph_lo_ = __builtin_amdgcn_readfirstlane(args.ph_lo), ph_hi_ = __builtin_amdgcn_readfirstlane(args.ph_hi), ph_li_ = __builtin_amdgcn_readfirstlane(args.li);
    for (int u = threadIdx.x; u < (LDS_BYTES - LDSCTL_OFF) / 4; u += NTHR) ((LAS unsigned*)(lds + LDSCTL_OFF))[u] = 0u;
    __syncthreads();
    if (ph_hi_ - ph_lo_ > 1) (void)xcd_barrier_post((unsigned*)(args.ws + WS_CTL) + CW_BAR + ph_li_ * XCD_BAR_WORDS, (volatile LAS unsigned*)(lds + MISC_OFF) + 8);

    REP(13) if (PH_EN(13) && IN(0)) { PHASE_BEGIN(); p0_prologue(in, ws, lds, vcu, G, tid, wave, lane); if (!IN(1)) SEAM(0); }

#pragma nounroll
    for (int l = 0; l < 2; ++l) {
        const int pb = 1 + PH_PER_LAYER * l;
        REP(0) if (PH_EN(0) && IN(pb + 0)) { PHASE_BEGIN(); LAYER_VARS();
#ifdef PROBE_NORM2
            if (l == 0) norm_rows<0>(in[0], nullptr, false, nullptr, nullptr, in[1], (bf16*)(ws + A_HN1), nullptr, gw, NGW, lane, (unsigned char*)out + 2048);
            else norm_rows<0, true>(out, nullptr, true, (const bf16*)(ws + A_YE), (const int*)(ws + WS_INV), in[1] + DMODEL, (bf16*)(ws + A_HN1), nullptr, gw, NGW, lane, (unsigned char*)out + 2048);
#endif
            if (l == 0) norm_rows<0>(in[0], nullptr, false, nullptr, nullptr, in[1], (bf16*)(ws + A_HN1), nullptr, gw, NGW, lane, (unsigned char*)out + 2048);
            else norm_rows<0, true>(out, out, true, (const bf16*)(ws + A_YE), (const int*)(ws + WS_INV), in[1] + DMODEL, (bf16*)(ws + A_HN1), nullptr, gw, NGW, lane, (unsigned char*)out + 2048);
            SEAM(pb + 0);
        }
        REP(1) if (PH_EN(1) && IN(pb + 1)) { PHASE_BEGIN(); LAYER_VARS();
            pg8::ProjOrder S{(const char*)(ws + A_HN1), (const char*)(wl + WO_IN), (size_t)((const unsigned char*)out + 2048 - (ws + A_HN1)), (size_t)(WO_QKV8 - WO_IN), 1024, 1024, 1024, M / 256, NPJ / 256, 10, 4096, G, bx};
            pg8::EpiPlainS E{(bf16*)(ws + A_PRJ), NPJ, 10, 1.0f / 32.0f};
#ifdef PROBE_P2_SINK
            if (rep_ == 0) { pg8::EpiSink E0; pg8::gemm_phase<pg8::EpiSink, pg8::ProjOrder, true, true, false, false, true>(lds + RING_OFF, tid, 1024, 2048, 1024, S, E0); } else
#endif
            pg8::gemm_phase<pg8::EpiPlainS, pg8::ProjOrder, true, true, false, false, true>(lds + RING_OFF, tid, 1024, 2048, 1024, S, E);
            SEAM(pb + 1);
        }
        REP(2) if (PH_EN(2) && IN(pb + 2)) { PHASE_BEGIN(); p3_prep(l, in, ws, lds, gw, NGW, tid, lane); SEAM(pb + 2); }
        REP(3) if (PH_EN(3) && IN(pb + 3)) {
#ifndef P4DUP
#define P4DUP 0
#endif
            for (int r4_ = 0; r4_ < 1 + (P4DUP & 1); ++r4_) { PHASE_BEGIN(); LAYER_VARS();
              pg8::LoraOrder S{(const char*)(ws + A_TW), (const char*)(wl + WO_LORA), G, bx};
              pg8::EpiLora E{(bf16*)(ws + A_LW), (bf16*)(ws + A_AA), in[5] + (size_t)l * 1024, in[7] + (size_t)l * 1024};
              pg8::gemm_phase<pg8::EpiLora, pg8::LoraOrder, true>(lds + RING_OFF, tid, 384, 384, 128, S, E); }
            for (int r4_ = 0; r4_ < 1 + ((P4DUP >> 1) & 1); ++r4_) { PHASE_BEGIN(); LAYER_VARS();
              pg8::PlainOrder S{(const char*)(ws + A_TW) + 512, (const char*)(wl + WO_G2), 384, 128, 128, M / 256, 2, G, bx, 0, 1, 0};
              pg8::EpiPlain E{(bf16*)(ws + A_G), 512};
              pg8::gemm_phase<pg8::EpiPlain, pg8::PlainOrder, true>(lds + RING_OFF, tid, 384, 384, 128, S, E); }
            for (int r4_ = 0; r4_ < 1 + ((P4DUP >> 2) & 1); ++r4_) { PHASE_BEGIN(); LAYER_VARS();
              pg8::PlainOrder S{(const char*)(ws + A_PL), (const char*)(wl + WO_PW), 512, 512, 512, M / 256, 2, G, bx, 0, 1, 0};
              pg8::EpiColScale E{(bf16*)(ws + A_YB), 512, in[19] + (size_t)l * 512};
              pg8::gemm_phase<pg8::EpiColScale, pg8::PlainOrder, true>(lds + RING_OFF, tid, 512, 512, 512, S, E); }
            SEAM(pb + 3);
        }
        REP(4) if (PH_EN(4) && IN(pb + 4)) {
            #ifdef SCAN_SEQ
            { PHASE_BEGIN(); if (bx < 128) scan_chain(l, bx, in, ws, lds, tid, wave, lane); }
#else
            #ifdef SCAN_BLOCKSYNC
            { PHASE_BEGIN(); if (bx < 128) scan_chain_chunked(l, bx, in, ws, lds, tid, wave, lane); }
#else
            { PHASE_BEGIN(); if (bx < 128) scan_chain_pipe(l, bx, in, ws, lds, tid, wave, lane); }
#ifdef DUP_SCAN
            { PHASE_BEGIN(); if (bx < 128) scan_chain_pipe(l, bx, in, ws, lds, tid, wave, lane); }
#endif
#endif
#endif
#ifndef NO_ATTN
            { PHASE_BEGIN();
              volatile LAS int* slot = (volatile LAS int*)(lds + LDSCTL_OFF + 16); gu32* qh = (gu32*)(ws + WS_CTL) + CW_ATTQ + 64 * l;
              float negM; { const float gq = fabsf(in[20][(size_t)l * 64 + lane]), gk = fabsf(in[21][(size_t)l * 64 + lane]); float mq = gq, mk = gk;
#pragma unroll
                for (int o_ = 1; o_ < 64; o_ <<= 1) { mq = fmaxf(mq, shx(mq, o_, lane)); mk = fmaxf(mk, shx(mk, o_, lane)); }
                negM = -(64.0f * 0.125f * 1.4426950408889634f * 1.01f) * mq * mk; negM = __builtin_bit_cast(float, __builtin_amdgcn_readfirstlane(__builtin_bit_cast(int, negM))); }
              const unsigned char* Qp = ws + A_Q; const unsigned char* Kp = ws + A_K; const unsigned char* Vp = ws + A_V;
#ifdef ATT_CODE_EXP
              negM = 4.0f * (negM + 13.0f) + 60.0f;
#else
              negM += 13.0f;
#endif
              for (;;) {
                  if (tid == 0) *slot = (int)__hip_atomic_fetch_add(qh, 1u, RLX_AGENT);
                  __syncthreads();
                  const int item = __builtin_amdgcn_readfirstlane(*slot);
                  __syncthreads();
                  if (item >= 2048 + 1024) break;
                  if (item >= 2048) { convert_experts_items(in, l, ws, lds, (item - 2048) * 24, 24, wave, lane);
#ifdef PROBE_CONV2
                      convert_experts_items(in, l, ws, lds, (item - 2048) * 24, 24, wave, lane);
#endif
                      continue; }
                  const int grp = item >> 7, r = item & 127, b = grp >> 1, h = (grp & 1) * 4 + (r >> 5), qb = r & 31;
#ifdef PROBE_ATT_TWICE
                  attn_body::attn_unit(tid, negM, b, h, qb, Qp, Kp, Vp, (unsigned char*)out + 3072, (char*)lds_raw + RING_OFF, false);
#endif
                  attn_body::attn_unit(tid, negM, b, h, qb, Qp, Kp, Vp, (unsigned char*)out + 3072, (char*)lds_raw + RING_OFF);
              } }
#endif
            SEAM(pb + 4);
        }
        REP(5) if (PH_EN(5) && IN(pb + 5)) { PHASE_BEGIN(); LAYER_VARS();
            p6a_rows(l, in, ws, gw, NGW, lane);
            SEAM(pb + 5);
        }
        REP(6) if (PH_EN(6) && IN(pb + 6)) { PHASE_BEGIN(); LAYER_VARS();
            typedef pg8::MergeOrder<A_HN, A_YA, A_YB, WO_BRA8, WO_G, WO_BR> MOrd;
            MOrd S{(const char*)ws, (const char*)wl, G, bx, (size_t)((const unsigned char*)out + 2048 - ws), (size_t)4096};
            pg8::EpiMerge E{(bf16*)(ws + A_TS) + (size_t)bx * 65536, (bf16*)(ws + A_MG), 1.0f / 32.0f, 1.0f / (32.0f * attn_body::OSC)};
#ifdef PROBE_SINK_P6B
            { pg8::EpiSink E0; pg8::gemm_phase<pg8::EpiSink, MOrd, true, true, false, false, true>(lds + RING_OFF, tid, 512, 2048, 512, S, E0); }
#endif
            pg8::gemm_phase<pg8::EpiMerge, MOrd, true, true, false, false, true>(lds + RING_OFF, tid, 512, 2048, 512, S, E);
            SEAM(pb + 6);
        }
        REP(7) if (PH_EN(7) && IN(pb + 7)) { PHASE_BEGIN(); LAYER_VARS();
            pg8::PlainOrder S{(const char*)(ws + A_MG), (const char*)(wl + WO_OUT), 1024, 1024, 1024, M / 256, 4, G, bx, 0, 1, 0};
            pg8::EpiResBf E{(l == 0) ? in[0] : (const float*)nullptr, (pg8::bf16_t*)out, XBP};
#ifdef PROBE_SINK_P7
            { pg8::EpiSink E0; pg8::gemm_phase<pg8::EpiSink, pg8::PlainOrder, true>(lds + RING_OFF, tid, 1024, 1024, 1024, S, E0); }
#endif
            pg8::gemm_phase<pg8::EpiResBf, pg8::PlainOrder, true>(lds + RING_OFF, tid, 1024, 1024, 1024, S, E);
            SEAM(pb + 7);
        }
        REP(8) if (PH_EN(8) && IN(pb + 8)) {
            { PHASE_BEGIN(); p8_router(l, in, out, ws, lds, gw, NGW, tid, lane); }
            SEAM(pb + 8);
        }
        REP(9) if (PH_EN(9) && IN(pb + 9)) { PHASE_BEGIN(); if (bx < BATCH * NEXP) p9_topk(bx, ws, lds, tid, wave, lane); SEAM(pb + 9); }
        REP(11) if (PH_EN(11) && IN(pb + 11)) { PHASE_BEGIN();
            pg8::GatherOrder S{(const char*)(ws + A_HN), (const char*)(ws + A_WGU), (const int*)(ws + WS_IDX), 512, 512, 512, MR / 256, 8, G, bx, 4, NEXP, NEXP * 4, SEQ, (size_t)2048 * 1024};
            pg8::EpiSwiGLU<true> E{(bf16*)(ws + A_HID), 1024, 1.0f / 32.0f, 16.0f};
            pg8::gemm_phase<pg8::EpiSwiGLU<true>, pg8::GatherOrder, true, false, true, true>(lds + RING_OFF, tid, 512, 512, 512, S, E);
            SEAM(pb + 11);
        }
        REP(12) if (PH_EN(12) && IN(pb + 12)) { PHASE_BEGIN();
            pg8::PlainOrder S{(const char*)(ws + A_HID), (const char*)(ws + A_WD), 512, 512, 512, MR / 256, 4, G, bx, 4, NEXP, (size_t)1024 * 1024};
            pg8::EpiRowScale E{(bf16*)(ws + A_YE), 1024, (const float*)(ws + WS_VAL), 1.0f / 512.0f};
#ifdef PROBE_SINK_P12
            { pg8::EpiSink E0; pg8::gemm_phase<pg8::EpiSink, pg8::PlainOrder, true, false, false, true>(lds + RING_OFF, tid, 512, 512, 512, S, E0); }
#endif
            pg8::gemm_phase<pg8::EpiRowScale, pg8::PlainOrder, true, false, false, true>(lds + RING_OFF, tid, 512, 512, 512, S, E);
            SEAM(pb + 12);
        }
    }
#ifdef DBG_DUMP_OFF
#ifndef DBG_DUMP_ELEMS
#define DBG_DUMP_ELEMS ((size_t)M * DMODEL)
#endif
    if (IN(28)) { PHASE_BEGIN(); const bf16* src = (const bf16*)(ws + (size_t)(DBG_DUMP_OFF)); const size_t gt = (size_t)vcu * NTHR + tid, NGT = (size_t)G * NTHR;
        for (size_t i = gt; i < (size_t)M * DMODEL / 8; i += NGT) { float f[8]; unp8(ld16(src + (i % ((size_t)(DBG_DUMP_ELEMS) / 8)) * 8), f); f32x4* o = (f32x4*)(out + i * 8); o[0] = (f32x4){f[0], f[1], f[2], f[3]}; o[1] = (f32x4){f[4], f[5], f[6], f[7]}; } }
#endif
#ifdef PROBE_NORM2
    if (PH_EN(14) && IN(27)) { PHASE_BEGIN(); norm_rows<0, true>(out, nullptr, true, (const bf16*)(ws + A_YE), (const int*)(ws + WS_INV), in[31], (bf16*)(ws + A_HN1), nullptr, gw, NGW, lane); }
#endif
    if (PH_EN(14) && IN(27)) { PHASE_BEGIN(); norm_rows<1, true>(out, nullptr, true, (const bf16*)(ws + A_YE), (const int*)(ws + WS_INV), in[31], nullptr, out, gw, NGW, lane); }
}
#undef IN
#undef SEAM

#ifndef MK_PER_PHASE
#define MK_PER_PHASE 0
#endif
extern "C" void kernel_launch(void* const* d_in, const int* in_sizes, int n_in, void* d_out, int out_size, void* d_ws, size_t ws_size, hipStream_t stream) {
    static int grid = 0;
    if (grid == 0) {
        if (n_in != 32 || in_sizes[0] != M * DMODEL || out_size != M * DMODEL || ws_size < WS_END) { fprintf(stderr, "kernel_launch: unexpected shapes (n_in %d, in0 %d, out %d, ws %zu)\n", n_in, n_in > 0 ? in_sizes[0] : -1, out_size, ws_size); grid = -1; return; }
        int dev = 0, cus = 0, per_cu = 0;
        if (hipGetDevice(&dev) != hipSuccess || hipDeviceGetAttribute(&cus, hipDeviceAttributeMultiprocessorCount, dev) != hipSuccess) { grid = -1; return; }
        if (hipFuncSetAttribute((const void*)fwd, hipFuncAttributeMaxDynamicSharedMemorySize, LDS_BYTES) != hipSuccess) { fprintf(stderr, "kernel_launch: hipFuncSetAttribute failed\n"); grid = -1; return; }
        if (hipOccupancyMaxActiveBlocksPerMultiprocessor(&per_cu, (const void*)fwd, NTHR, LDS_BYTES) != hipSuccess || per_cu < 1) fprintf(stderr, "kernel_launch: occupancy query reports %d\n", per_cu);
        (void)hipGetLastError();
        grid = cus;
        if (grid > 256) grid = 256;
    }
    if (grid < 0) return;
    if (hipMemsetAsync((char*)d_ws + WS_CTL, 0, CTL_ZERO_BYTES, stream) != hipSuccess) return;
    Args a{};
    for (int i = 0; i < 32; ++i) a.in[i] = (const float*)d_in[i];
    a.out = (float*)d_out; a.ws = (unsigned char*)d_ws; a.pad = 0;
#if MK_PER_PHASE
#ifdef DBG_LAST_PHASE
    for (int p = 0; p <= DBG_LAST_PHASE; ++p) { a.ph_lo = p; a.ph_hi = p + 1; a.li = 0; hipLaunchKernelGGL(fwd, dim3(grid), dim3(NTHR), LDS_BYTES, stream, a); }
#ifdef DBG_DUMP_OFF
    a.ph_lo = 28; a.ph_hi = 29; a.li = 0; hipLaunchKernelGGL(fwd, dim3(grid), dim3(NTHR), LDS_BYTES, stream, a);
#endif
#else
    for (int p = 0; p < N_PHASES; ++p) { a.ph_lo = p; a.ph_hi = p + 1; a.li = 0; hipLaunchKernelGGL(fwd, dim3(grid), dim3(NTHR), LDS_BYTES, stream, a); }
#endif
#else
    a.ph_lo = 0; a.ph_hi = N_PHASES; a.li = 0;
    hipLaunchKernelGGL(fwd, dim3(grid), dim3(NTHR), LDS_BYTES, stream, a);
#endif
    const hipError_t le = hipPeekAtLastError();
    if (le != hipSuccess) fprintf(stderr, "kernel_launch: launch failed: %s\n", hipGetErrorName(le));
}
```

```cpp
#include <hip/hip_runtime.h>
#include <cstdio>
#include <cstdint>
namespace pg8 {
#define PG8_LAS __attribute__((address_space(3)))
typedef unsigned short bf16_t;
typedef short bf16x8 __attribute__((ext_vector_type(8)));
typedef float f32x4 __attribute__((ext_vector_type(4)));
typedef unsigned u32x4 __attribute__((ext_vector_type(4)));
constexpr int BM = 256, BK = 64, HALF = 128, HTB = HALF * BK * 2  , STAGE_BYTES = 8 * HTB, NXCD = 8, WGM = 8;

__host__ __device__ __forceinline__ int lds_byte(int r, int c) { const int st = (r >> 4) * 2 + (c >> 5), rr = r & 15, cc = c & 31, ob = rr * 64 + cc * 2; return st * 1024 + (ob ^ (((ob >> 9) & 1) << 5)); }
__host__ __device__ __forceinline__ void stage_rc(int b, int& R, int& C) { const int st = b / 1024, sb = b % 1024, swz = sb ^ (((sb >> 9) & 1) << 5); R = (st >> 1) * 16 + swz / 64; C = (st & 1) * 32 + (swz % 64) / 2; }
__host__ __device__ __forceinline__ int perm32(int rho) { const int n = rho >> 4, i = rho & 15; return 8 * (i >> 2) + 4 * n + (i & 3); }

struct Unit { int pm, pn, sub; };

__device__ __forceinline__ bool tile_of(int i, int G, int c, int nM, int nN, int& pm, int& pn) {
    const long L = (long)i * G + c; const int nwg = nM * nN; if (L >= nwg) return false;
    int wgid = (int)L; { const int q = nwg / NXCD, r = nwg % NXCD, xcd = wgid % NXCD, off = wgid / NXCD; wgid = (xcd < r ? xcd * (q + 1) : r * (q + 1) + (xcd - r) * q) + off; }
    const int nig = WGM * nN, gid = wgid / nig, fm = gid * WGM, gsz = (nM - fm) < WGM ? (nM - fm) : WGM;
    pm = fm + ((wgid % nig) % gsz); pn = (wgid % nig) / gsz; return true;
}
struct PlainOrder {
    const char* A; const char* B; int lda, ldb, K, nM, nN, G, c, grp_panels, ngrp; size_t grp_stride;
    __device__ __forceinline__ int grow(const Unit&, int) const { return 0; }
    __device__ __forceinline__ bool next(int i, Unit& u) const { u.sub = 0; return tile_of(i, G, c, nM, nN, u.pm, u.pn); }
    __device__ __forceinline__ void ops(const Unit& u, const char*& a, const char*& b, int& nt, bool& asel) const {
        nt = K / BK; asel = false;
        a = A + (size_t)u.pm * BM * lda * 2;
        b = B + (size_t)u.pn * BM * ldb * 2 + (grp_panels ? (size_t)((u.pm / grp_panels) % ngrp) * grp_stride : (size_t)0);
    }
};
struct ProjOrder {
    const char* A; const char* B; size_t a8_off, b8_off; int lda, ldb, K, nM, nN, pn8, a8_pitch, G, c;
    __device__ __forceinline__ int grow(const Unit&, int) const { return 0; }
    __device__ __forceinline__ bool next(int i, Unit& u) const { u.sub = 0; return tile_of(i, G, c, nM, nN, u.pm, u.pn); }
    __device__ __forceinline__ void ops(const Unit& u, const char*& a, const char*& b, int& nt, bool& asel) const {
        asel = u.pn >= pn8; nt = asel ? K / (2 * BK) : K / BK;
        a = A + (asel ? a8_off + (size_t)u.pm * BM * a8_pitch : (size_t)u.pm * BM * lda * 2);
        b = B + (asel ? b8_off + (size_t)(u.pn - pn8) * BM * ldb * 2 : (size_t)u.pn * BM * ldb * 2);
    }
};
struct LoraOrder {
    const char* A; const char* B; int G, c;
    __device__ __forceinline__ int grow(const Unit&, int) const { return 0; }
    __device__ __forceinline__ bool next(int i, Unit& u) const { u.sub = 0; return tile_of(i, G, c, 256, 8, u.pm, u.pn); }
    __device__ __forceinline__ void ops(const Unit& u, const char*& a, const char*& b, int& nt, bool& asel) const {
        nt = 2; asel = false; a = A + (size_t)u.pm * BM * 384 * 2 + (u.pn >= 4 ? 256 : 0); b = B + (size_t)u.pn * BM * 128 * 2; }
};
struct GatherOrder {
    const char* A; const char* B; const int* idx; int lda, ldb, K, nM, nN, G, c, grp_panels, ngrp, panels_per_batch, seq; size_t grp_stride;
    __device__ __forceinline__ bool next(int i, Unit& u) const { u.sub = 0; return tile_of(i, G, c, nM, nN, u.pm, u.pn); }
    __device__ __forceinline__ void ops(const Unit& u, const char*& a, const char*& b, int& nt, bool& asel) const {
        nt = K / BK; asel = false; a = A;
        b = B + (size_t)u.pn * BM * ldb * 2 + (size_t)((u.pm / grp_panels) % ngrp) * grp_stride;
    }
    __device__ __forceinline__ int grow(const Unit& u, int row) const { return (u.pm / panels_per_batch) * seq + idx[u.pm * BM + row]; }
};
template <size_t OHN, size_t OYA, size_t OYB, size_t OYC, size_t OWG, size_t OWBR>
struct MergeOrder {
    const char* base; const char* wbase; int G, c; size_t hn_off, hn_pitch;
    __device__ __forceinline__ int grow(const Unit&, int) const { return 0; }
#ifndef MERGE_NSUB
#define MERGE_NSUB 6
#endif
    __device__ __forceinline__ bool next(int i, Unit& u) const { const int ti = i / MERGE_NSUB; u.sub = i - ti * MERGE_NSUB; return tile_of(ti, G, c, 256, 4, u.pm, u.pn); }
    __device__ __forceinline__ void ops(const Unit& u, const char*& a, const char*& b, int& nt, bool& asel) const {
        const int bb = u.sub >> 1; const size_t wrow = (size_t)(bb * 1024 + u.pn * BM) * 1024, arow = (size_t)u.pm * BM * 1024; nt = 8;
        if (!(u.sub & 1)) { a = base + (hn_off + (size_t)u.pm * BM * hn_pitch); b = wbase + OWG + wrow; asel = true; }
        else if (bb == 2) { a = base + (hn_off + 1024 + (size_t)u.pm * BM * hn_pitch); b = wbase + OYC + (size_t)u.pn * BM * 1024; asel = true; nt = 4; }
        else { const size_t yo = (bb == 0) ? OYA : OYB; a = base + yo + arow; b = wbase + OWBR + wrow; asel = false; }
    }
};

typedef float f32x2_t __attribute__((ext_vector_type(2))); typedef __bf16 bf16x2_t __attribute__((ext_vector_type(2)));
__device__ __forceinline__ unsigned cvt_pk_bf16(float lo, float hi) { const f32x2_t v = {lo, hi}; const bf16x2_t b = __builtin_convertvector(v, bf16x2_t); return __builtin_bit_cast(unsigned, b); }
__device__ __forceinline__ u32x4 pack8(const f32x4& v0, const f32x4& v1) { u32x4 w; w.x = cvt_pk_bf16(v0[0], v0[1]); w.y = cvt_pk_bf16(v0[2], v0[3]); w.z = cvt_pk_bf16(v1[0], v1[1]); w.w = cvt_pk_bf16(v1[2], v1[3]); return w; }
__device__ __forceinline__ void unpack8(const u32x4& w, f32x4& v0, f32x4& v1) {
    v0[0] = __uint_as_float(w.x << 16); v0[1] = __uint_as_float(w.x & 0xffff0000u); v0[2] = __uint_as_float(w.y << 16); v0[3] = __uint_as_float(w.y & 0xffff0000u);
    v1[0] = __uint_as_float(w.z << 16); v1[1] = __uint_as_float(w.z & 0xffff0000u); v1[2] = __uint_as_float(w.w << 16); v1[3] = __uint_as_float(w.w & 0xffff0000u); }
__device__ __forceinline__ float sigm(float x) { return __builtin_amdgcn_rcpf(1.0f + __builtin_amdgcn_exp2f(-1.4426950408889634f * x)); }
__device__ __forceinline__ f32x4 sigm4(const f32x4& v) { f32x4 r; r[0] = sigm(v[0]); r[1] = sigm(v[1]); r[2] = sigm(v[2]); r[3] = sigm(v[3]); return r; }

struct EpiPlain {
    static constexpr bool PERM = true;
    bf16_t* O; int ldc;
    __device__ __forceinline__ void operator()(const f32x4 (&acc)[2][2][4][2], const Unit& u, int wr, int wc, int fr, int fq) const {
        const int row0 = u.pm * BM + wr * 64 + fr, col0 = u.pn * BM + wc * 32 + 8 * fq;
#pragma unroll
        for (int ai = 0; ai < 2; ++ai)
#pragma unroll
            for (int m = 0; m < 4; ++m) { bf16_t* rowp = O + (size_t)(row0 + ai * HALF + m * 16) * ldc + col0;
#pragma unroll
                for (int bj = 0; bj < 2; ++bj) *(u32x4*)(rowp + bj * HALF) = pack8(acc[ai][bj][m][0], acc[ai][bj][m][1]); }
    }
};
struct EpiSink {
    static constexpr bool PERM = true;
    __device__ __forceinline__ void operator()(const f32x4 (&acc)[2][2][4][2], const Unit&, int, int, int, int) const {
#pragma unroll
        for (int ai = 0; ai < 2; ++ai)
#pragma unroll
            for (int bj = 0; bj < 2; ++bj)
#pragma unroll
                for (int m = 0; m < 4; ++m) { asm volatile("" :: "v"(acc[ai][bj][m][0]), "v"(acc[ai][bj][m][1])); }
    }
};
struct EpiPlainS {
    static constexpr bool PERM = true;
    bf16_t* O; int ldc, pn8; float s8;
    __device__ __forceinline__ void operator()(const f32x4 (&acc)[2][2][4][2], const Unit& u, int wr, int wc, int fr, int fq) const {
        const int row0 = u.pm * BM + wr * 64 + fr, col0 = u.pn * BM + wc * 32 + 8 * fq; const float sc = (u.pn >= pn8) ? s8 : 1.0f;
#pragma unroll
        for (int ai = 0; ai < 2; ++ai)
#pragma unroll
            for (int m = 0; m < 4; ++m) { bf16_t* rowp = O + (size_t)(row0 + ai * HALF + m * 16) * ldc + col0;
#pragma unroll
                for (int bj = 0; bj < 2; ++bj) *(u32x4*)(rowp + bj * HALF) = pack8(acc[ai][bj][m][0] * sc, acc[ai][bj][m][1] * sc); }
    }
};
struct EpiColScale {
    static constexpr bool PERM = true;
    bf16_t* O; int ldc; const float* scale;
    __device__ __forceinline__ void operator()(const f32x4 (&acc)[2][2][4][2], const Unit& u, int wr, int wc, int fr, int fq) const {
        const int row0 = u.pm * BM + wr * 64 + fr, col0 = u.pn * BM + wc * 32 + 8 * fq;
        f32x4 sv[2][2];
#pragma unroll
        for (int bj = 0; bj < 2; ++bj)
#pragma unroll
            for (int n = 0; n < 2; ++n) sv[bj][n] = *(const f32x4*)(scale + col0 + bj * HALF + 4 * n);
#pragma unroll
        for (int ai = 0; ai < 2; ++ai)
#pragma unroll
            for (int m = 0; m < 4; ++m) { bf16_t* rowp = O + (size_t)(row0 + ai * HALF + m * 16) * ldc + col0;
#pragma unroll
                for (int bj = 0; bj < 2; ++bj) {
#ifdef PROBE_YB8
                    f32x4 a0 = acc[ai][bj][m][0] * sv[bj][0], a1 = acc[ai][bj][m][1] * sv[bj][1];
#pragma unroll
                    for (int e = 0; e < 4; ++e) { a0[e] = __builtin_amdgcn_cvt_f32_fp8(__builtin_amdgcn_cvt_pk_fp8_f32(a0[e], a0[e], 0, false), 0); a1[e] = __builtin_amdgcn_cvt_f32_fp8(__builtin_amdgcn_cvt_pk_fp8_f32(a1[e], a1[e], 0, false), 0); }
                    *(u32x4*)(rowp + bj * HALF) = pack8(a0, a1);
#else
                    *(u32x4*)(rowp + bj * HALF) = pack8(acc[ai][bj][m][0] * sv[bj][0], acc[ai][bj][m][1] * sv[bj][1]);
#endif
                } }
    }
};
struct EpiLora {
    static constexpr bool PERM = true;
    bf16_t* LW; bf16_t* AA; const float* w0; const float* a0;
    __device__ __forceinline__ void operator()(const f32x4 (&acc)[2][2][4][2], const Unit& u, int wr, int wc, int fr, int fq) const {
        const bool isw = u.pn < 4; const int ct = (u.pn & 3) * BM;
        bf16_t* O = isw ? LW : AA; const float* bias = isw ? w0 : a0; const float sc = isw ? -0.6065306597126334f : 1.0f;
        const int row0 = u.pm * BM + wr * 64 + fr, col0 = ct + wc * 32 + 8 * fq;
        f32x4 bv[2][2];
#pragma unroll
        for (int bj = 0; bj < 2; ++bj)
#pragma unroll
            for (int n = 0; n < 2; ++n) bv[bj][n] = *(const f32x4*)(bias + col0 + bj * HALF + 4 * n);
#pragma unroll
        for (int ai = 0; ai < 2; ++ai)
#pragma unroll
            for (int m = 0; m < 4; ++m) { bf16_t* rowp = O + (size_t)(row0 + ai * HALF + m * 16) * 1024 + col0;
#pragma unroll
                for (int bj = 0; bj < 2; ++bj) { const f32x4 v0 = sigm4(acc[ai][bj][m][0] + bv[bj][0]) * sc, v1 = sigm4(acc[ai][bj][m][1] + bv[bj][1]) * sc;
                    *(u32x4*)(rowp + bj * HALF) = pack8(v0, v1); } }
    }
};
__device__ __forceinline__ u32x4 ld16_dev(const void* p) { u32x4 v; asm volatile("global_load_dwordx4 %0, %1, off sc0 sc1\n\ts_waitcnt vmcnt(0)" : "=v"(v) : "v"(p) : "memory"); return v; }
struct EpiMerge {
    static constexpr bool PERM = true;
    bf16_t* TS; bf16_t* MG; float gs, s5;
    __device__ __forceinline__ void operator()(const f32x4 (&acc)[2][2][4][2], const Unit& u, int wr, int wc, int fr, int fq) const {
        const int lr0 = wr * 64 + fr, lc0 = wc * 32 + 8 * fq;
        if (!(u.sub & 1)) {
#pragma unroll
            for (int ai = 0; ai < 2; ++ai)
#pragma unroll
                for (int m = 0; m < 4; ++m) { bf16_t* rowp = TS + (size_t)(lr0 + ai * HALF + m * 16) * 256 + lc0;
#pragma unroll
                    for (int bj = 0; bj < 2; ++bj) *(u32x4*)(rowp + bj * HALF) = pack8(sigm4(acc[ai][bj][m][0] * gs), sigm4(acc[ai][bj][m][1] * gs)); }
        } else {
            const bool first = (u.sub == 1); const float bs = (u.sub == 5) ? s5 : 1.0f;
#pragma unroll
            for (int ai = 0; ai < 2; ++ai)
#pragma unroll
                for (int m = 0; m < 4; ++m) { const bf16_t* trow = TS + (size_t)(lr0 + ai * HALF + m * 16) * 256 + lc0;
                    bf16_t* grow = MG + (size_t)(u.pm * BM + lr0 + ai * HALF + m * 16) * 1024 + u.pn * BM + lc0;
#pragma unroll
                    for (int bj = 0; bj < 2; ++bj) { f32x4 t0, t1; unpack8(*(const u32x4*)(trow + bj * HALF), t0, t1);
                        f32x4 r0 = t0 * (acc[ai][bj][m][0] * bs), r1 = t1 * (acc[ai][bj][m][1] * bs);
                        if (!first) { f32x4 g0, g1; unpack8(*(const u32x4*)(grow + bj * HALF), g0, g1); r0 += g0; r1 += g1; }
                        *(u32x4*)(grow + bj * HALF) = pack8(r0, r1); }
                    asm volatile("" ::: "memory"); }
        }
    }
};
struct EpiResF32 {
    static constexpr bool PERM = false;
    const float* base; float* out; int ldc;
    __device__ __forceinline__ void operator()(const f32x4 (&acc)[2][2][4][2], const Unit& u, int wr, int wc, int fr, int fq) const {
        const int row0 = u.pm * BM + wr * 64 + fr, col0 = u.pn * BM + wc * 32 + 4 * fq;
#pragma unroll
        for (int ai = 0; ai < 2; ++ai)
#pragma unroll
            for (int m = 0; m < 4; ++m) { const size_t off = (size_t)(row0 + ai * HALF + m * 16) * ldc + col0;
#pragma unroll
                for (int bj = 0; bj < 2; ++bj)
#pragma unroll
                    for (int n = 0; n < 2; ++n) { const f32x4 b = *(const f32x4*)(base + off + bj * HALF + n * 16); *(f32x4*)(out + off + bj * HALF + n * 16) = b + acc[ai][bj][m][n]; } }
    }
};
struct EpiResBf {
    static constexpr bool PERM = false;
    const float* srcf; bf16_t* xb; int ldo;
    __device__ __forceinline__ void operator()(const f32x4 (&acc)[2][2][4][2], const Unit& u, int wr, int wc, int fr, int fq) const {
        const int row0 = u.pm * BM + wr * 64 + fr, col0 = u.pn * BM + wc * 32 + 4 * fq;
        typedef unsigned u32x2 __attribute__((ext_vector_type(2)));
#pragma unroll
        for (int ai = 0; ai < 2; ++ai)
#pragma unroll
            for (int m = 0; m < 4; ++m) { const int row = row0 + ai * HALF + m * 16;
#pragma unroll
                for (int bj = 0; bj < 2; ++bj)
#pragma unroll
                    for (int n = 0; n < 2; ++n) { const int col = col0 + bj * HALF + n * 16; bf16_t* xp = xb + (size_t)row * ldo + col; f32x4 b;
                        if (srcf) b = *(const f32x4*)(srcf + (size_t)row * 1024 + col);
                        else { const u32x2 w = *(const u32x2*)xp; b = (f32x4){__uint_as_float(w.x << 16), __uint_as_float(w.x & 0xffff0000u), __uint_as_float(w.y << 16), __uint_as_float(w.y & 0xffff0000u)}; }
                        const f32x4 r = b + acc[ai][bj][m][n]; *(u32x2*)xp = (u32x2){cvt_pk_bf16(r[0], r[1]), cvt_pk_bf16(r[2], r[3])}; } }
    }
};
__device__ __forceinline__ float clamp_e4m3(float v) { return __builtin_amdgcn_fmed3f(v, -448.0f, 448.0f); }
__device__ __forceinline__ unsigned pk4_fp8(float a, float b, float c, float d) { unsigned w = 0u; w = __builtin_amdgcn_cvt_pk_fp8_f32(clamp_e4m3(a), clamp_e4m3(b), w, false); w = __builtin_amdgcn_cvt_pk_fp8_f32(clamp_e4m3(c), clamp_e4m3(d), w, true); return w; }
template <bool OUT8> struct EpiSwiGLU {
    static constexpr bool PERM = true;
    bf16_t* HID; int ldc; float s, so;
    __device__ __forceinline__ void operator()(const f32x4 (&acc)[2][2][4][2], const Unit& u, int wr, int wc, int fr, int fq) const {
        const int row0 = u.pm * BM + wr * 64 + fr, col0 = u.pn * HALF + wc * 32 + 8 * fq;
#pragma unroll
        for (int ai = 0; ai < 2; ++ai)
#pragma unroll
            for (int m = 0; m < 4; ++m) {
                const f32x4 g0 = acc[ai][0][m][0] * s, g1 = acc[ai][0][m][1] * s;
                const f32x4 h0 = g0 * sigm4(g0) * (acc[ai][1][m][0] * (s * so)), h1 = g1 * sigm4(g1) * (acc[ai][1][m][1] * (s * so));
                if constexpr (OUT8) { unsigned char* rowp = (unsigned char*)HID + (size_t)(row0 + ai * HALF + m * 16) * ldc + col0;
                    typedef unsigned u32x2 __attribute__((ext_vector_type(2))); *(u32x2*)rowp = (u32x2){pk4_fp8(h0[0], h0[1], h0[2], h0[3]), pk4_fp8(h1[0], h1[1], h1[2], h1[3])}; }
                else { bf16_t* rowp = HID + (size_t)(row0 + ai * HALF + m * 16) * ldc + col0; *(u32x4*)rowp = pack8(h0, h1); } }
    }
};
struct EpiRowScale {
    static constexpr bool PERM = true;
    bf16_t* O; int ldc; const float* rscale; float cs;
    __device__ __forceinline__ void operator()(const f32x4 (&acc)[2][2][4][2], const Unit& u, int wr, int wc, int fr, int fq) const {
        const int row0 = u.pm * BM + wr * 64 + fr, col0 = u.pn * BM + wc * 32 + 8 * fq;
#pragma unroll
        for (int ai = 0; ai < 2; ++ai)
#pragma unroll
            for (int m = 0; m < 4; ++m) { const int row = row0 + ai * HALF + m * 16; const float s = rscale[row] * cs; bf16_t* rowp = O + (size_t)row * ldc + col0;
#pragma unroll
                for (int bj = 0; bj < 2; ++bj) *(u32x4*)(rowp + bj * HALF) = pack8(acc[ai][bj][m][0] * s, acc[ai][bj][m][1] * s); }
    }
};

typedef int v8i32_t __attribute__((ext_vector_type(8))); typedef int v4i32_t __attribute__((ext_vector_type(4)));
__device__ __forceinline__ v8i32_t cat16(const bf16x8& a, const bf16x8& b) { typedef short s16_t __attribute__((ext_vector_type(16))); const s16_t c = __builtin_shufflevector(a, b, 0, 1, 2, 3, 4, 5, 6, 7, 8, 9, 10, 11, 12, 13, 14, 15); return __builtin_bit_cast(v8i32_t, c); }
template <class Epi, class Sched, bool ALIGN_EPI, bool TWO_LDA = false, bool GATHER = false, bool FP8 = false, bool MIXED = false>
__device__ __forceinline__ void gemm_phase(PG8_LAS unsigned char* lds, const int tid, const int lda0, const int lda1, const int ldb, const Sched& S, const Epi& E) {
    const int wid = __builtin_amdgcn_readfirstlane(tid >> 6), lane = tid & 63, wr = wid >> 2, wc = wid & 3, fr = lane & 15, fq = lane >> 4;
    unsigned voffA0[2], voffA1[2], voffB[2]; int gR[2], gC[2];
#pragma unroll
    for (int i = 0; i < 2; ++i) { int R, C; stage_rc(tid * 16 + i * 8192, R, C); gR[i] = R; gC[i] = C; const int Rb = Epi::PERM ? ((R & ~31) + perm32(R & 31)) : R;
        voffA0[i] = (unsigned)(R * lda0 + C) * 2u; voffA1[i] = TWO_LDA ? (unsigned)(R * lda1 + C) * 2u : 0u; voffB[i] = (unsigned)(Rb * ldb + C) * 2u; }
    const size_t kstep = (size_t)(BK * 2);
    const unsigned hsB = (unsigned)HALF * ldb * 2, hsA0 = (unsigned)HALF * lda0 * 2, hsA1 = (unsigned)HALF * lda1 * 2;
    const unsigned ldsw = (unsigned)wid * 1024u;
    const int aoff = lds_byte(wr * 64 + fr, fq * 8), boff = lds_byte(wc * 32 + fr, fq * 8);
#define PG8_SA(b, h) (((b) * 2 + (h)) * HTB)
#define PG8_SB(b, h) ((4 + (b) * 2 + (h)) * HTB)
#define PG8_STAGE(bufoff, gbase, voff) do { _Pragma("unroll") for (int _i = 0; _i < 2; ++_i) \
        __builtin_amdgcn_global_load_lds((const unsigned*)((const char*)(gbase) + (voff)[_i]), (PG8_LAS unsigned*)(lds + (bufoff) + ldsw + _i * 8192), 16, 0, 0); } while (0)
#define PG8_LDA4(dst, b, h) do { _Pragma("unroll") for (int m = 0; m < 4; ++m) _Pragma("unroll") for (int k = 0; k < 2; ++k) dst[m][k] = *(const PG8_LAS bf16x8*)(lds + PG8_SA(b, h) + aoff + m * 2048 + k * 1024); } while (0)
#define PG8_LDB4(dst, b, h) do { _Pragma("unroll") for (int n = 0; n < 2; ++n) _Pragma("unroll") for (int k = 0; k < 2; ++k) dst[n][k] = *(const PG8_LAS bf16x8*)(lds + PG8_SB(b, h) + boff + n * 2048 + k * 1024); } while (0)
#define PG8_LDA8(dst, b, h) do { _Pragma("unroll") for (int m = 0; m < 4; ++m) { const bf16x8 l0_ = *(const PG8_LAS bf16x8*)(lds + PG8_SA(b, h) + aoff + m * 2048), l1_ = *(const PG8_LAS bf16x8*)(lds + PG8_SA(b, h) + aoff + m * 2048 + 1024); dst##8[m] = cat16(l0_, l1_); } } while (0)
#define PG8_LDB8(dst, b, h) do { _Pragma("unroll") for (int n = 0; n < 2; ++n) { const bf16x8 l0_ = *(const PG8_LAS bf16x8*)(lds + PG8_SB(b, h) + boff + n * 2048), l1_ = *(const PG8_LAS bf16x8*)(lds + PG8_SB(b, h) + boff + n * 2048 + 1024); dst##8[n] = cat16(l0_, l1_); } } while (0)
#define PG8_MMAB(ai, bj, At, Bt) do { __builtin_amdgcn_s_setprio(1); _Pragma("unroll") for (int m = 0; m < 4; ++m) _Pragma("unroll") for (int n = 0; n < 2; ++n) _Pragma("unroll") for (int k = 0; k < 2; ++k) \
        acc[ai][bj][m][n] = __builtin_amdgcn_mfma_f32_16x16x32_bf16(Bt[n][k], At[m][k], acc[ai][bj][m][n], 0, 0, 0); __builtin_amdgcn_s_setprio(0); } while (0)
#define PG8_MMA16A(ai, bj, At, Bt) do { __builtin_amdgcn_s_setprio(1); _Pragma("unroll") for (int m = 0; m < 4; ++m) _Pragma("unroll") for (int n = 0; n < 2; ++n) _Pragma("unroll") for (int k = 0; k < 2; ++k) \
        asm volatile("v_mfma_f32_16x16x32_bf16 %0, %1, %2, %0" : "+v"(acc[ai][bj][m][n]) : "v"(Bt[n][k]), "v"(At[m][k])); __builtin_amdgcn_s_setprio(0); } while (0)
#define PG8_MMA8(ai, bj, At, Bt) do { __builtin_amdgcn_s_setprio(1); _Pragma("unroll") for (int m = 0; m < 4; ++m) _Pragma("unroll") for (int n = 0; n < 2; ++n) \
        asm volatile("v_mfma_scale_f32_16x16x128_f8f6f4 %0, %1, %2, %0, %3, %3 op_sel_hi:[0,0,0]" : "+v"(acc[ai][bj][m][n]) : "v"(Bt##8[n]), "v"(At##8[m]), "v"(sc127)); __builtin_amdgcn_s_setprio(0); } while (0)
#define PG8_WAIT_V(n) asm volatile("s_waitcnt vmcnt(" #n ")" ::: "memory")
#define PG8_WAIT_L(n) asm volatile("s_waitcnt lgkmcnt(" #n ")" ::: "memory")
#define PG8_BAR __builtin_amdgcn_s_barrier()
#define PG8_SCHED __builtin_amdgcn_sched_barrier(0)
#define PG8_KLOOP(LDA_, LDB_, MMA_) \
        for (int t = 0; t < nt; t += 2) { \
            const bool last = (t == nt - 2); \
            const char* a1 = cA + (size_t)(t + 1) * kstep; \
            const char* a2 = last ? nA : cA + (size_t)(t + 2) * kstep; const char* b2 = last ? nB : cB + (size_t)(t + 2) * kstep; \
            const char* a3 = a2 + kstep; const char* b3 = b2 + kstep; \
            LDB_(B0, 0, 0); LDB_(B1, 0, 1); PG8_SCHED; LDA_(At, 0, 0); PG8_STAGE_A(PG8_SA(1, 1), a1, 1, false); \
            PG8_WAIT_V(8); PG8_WAIT_L(0); PG8_BAR; MMA_(0, 0, At, B0); MMA_(0, 1, At, B1); PG8_BAR; PG8_SCHED; \
            LDA_(At, 0, 1); PG8_STAGE(PG8_SB(0, 0), b2, voffB); PG8_STAGE(PG8_SB(0, 1), b2 + hsB, voffB); PG8_STAGE_A(PG8_SA(0, 0), a2, 0, last); \
            PG8_WAIT_V(8); PG8_WAIT_L(0); PG8_BAR; MMA_(1, 0, At, B0); MMA_(1, 1, At, B1); PG8_BAR; PG8_SCHED; \
            LDB_(B0, 1, 0); LDB_(B1, 1, 1); PG8_SCHED; LDA_(At, 1, 0); PG8_STAGE_A(PG8_SA(0, 1), a2, 1, last); \
            PG8_WAIT_V(8); PG8_WAIT_L(0); PG8_BAR; MMA_(0, 0, At, B0); MMA_(0, 1, At, B1); PG8_BAR; PG8_SCHED; \
            LDA_(At, 1, 1); PG8_STAGE(PG8_SB(1, 0), b3, voffB); PG8_STAGE(PG8_SB(1, 1), b3 + hsB, voffB); PG8_STAGE_A(PG8_SA(1, 0), a3, 0, last); \
            PG8_WAIT_V(8); PG8_WAIT_L(0); PG8_BAR; MMA_(1, 0, At, B0); MMA_(1, 1, At, B1); PG8_BAR; PG8_SCHED; \
        }
    Unit cur, nxt; int ui = 0;
    if (!S.next(0, cur)) return;
    f32x4 acc[2][2][4][2];
#pragma unroll
    for (int a = 0; a < 2; ++a)
#pragma unroll
        for (int b = 0; b < 2; ++b)
#pragma unroll
            for (int m = 0; m < 4; ++m)
#pragma unroll
                for (int n = 0; n < 2; ++n) acc[a][b][m][n] = (f32x4){0.f, 0.f, 0.f, 0.f};
    const int sc127 = 127;
    bf16x8 At[4][2], B0[2][2], B1[2][2]; v8i32_t At8[4], B08[2], B18[2];
    const char* cA; const char* cB; int nt; bool selc;
    S.ops(cur, cA, cB, nt, selc); selc = (TWO_LDA || MIXED) && selc;
    nt = __builtin_amdgcn_readfirstlane(nt); asm volatile("" : "+s"(nt));
    unsigned hsAc = selc ? hsA1 : hsA0;
    unsigned vgc0[2] = {0u, 0u}, vgc1[2] = {0u, 0u}, vgn0[2] = {0u, 0u}, vgn1[2] = {0u, 0u};
    if constexpr (GATHER) {
#pragma unroll
        for (int i = 0; i < 2; ++i) { vgc0[i] = (unsigned)(S.grow(cur, gR[i]) * lda0 + gC[i]) * 2u; vgc1[i] = (unsigned)(S.grow(cur, HALF + gR[i]) * lda0 + gC[i]) * 2u; } }
#define PG8_STAGE_A(bufoff, gbase, hf, nx) do { if constexpr (GATHER) { const unsigned v_[2] = { (nx) ? vgn##hf[0] : vgc##hf[0], (nx) ? vgn##hf[1] : vgc##hf[1] }; PG8_STAGE(bufoff, gbase, v_); } \
        else { const unsigned v_[2] = PG8_VA((nx) ? seln : selc); PG8_STAGE(bufoff, (gbase) + ((hf) ? ((nx) ? hsAn : hsAc) : 0u), v_); } } while (0)
#define PG8_VA(sel) { (TWO_LDA && (sel)) ? voffA1[0] : voffA0[0], (TWO_LDA && (sel)) ? voffA1[1] : voffA0[1] }
    { const bool seln = selc; const unsigned hsAn = hsAc;
    PG8_STAGE(PG8_SB(0, 0), cB, voffB); PG8_STAGE(PG8_SB(0, 1), cB + hsB, voffB); PG8_STAGE_A(PG8_SA(0, 0), cA, 0, false); PG8_STAGE_A(PG8_SA(0, 1), cA, 1, false);
    if (wr == 1) PG8_BAR;
    PG8_WAIT_V(2); PG8_BAR;
    PG8_STAGE(PG8_SB(1, 0), cB + kstep, voffB); PG8_STAGE_A(PG8_SA(1, 0), cA + kstep, 0, false); PG8_STAGE(PG8_SB(1, 1), cB + hsB + kstep, voffB); }
    PG8_WAIT_V(6); PG8_BAR;
    for (;;) {
        const bool has_next = S.next(ui + 1, nxt);
        const char* nA = cA; const char* nB = cB; int ntn = nt; bool seln = selc;
        if (has_next) { S.ops(nxt, nA, nB, ntn, seln); seln = (TWO_LDA || MIXED) && seln; }
        const unsigned hsAn = seln ? hsA1 : hsA0;
        if constexpr (GATHER) {
#pragma unroll
            for (int i = 0; i < 2; ++i) { vgn0[i] = has_next ? (unsigned)(S.grow(nxt, gR[i]) * lda0 + gC[i]) * 2u : vgc0[i]; vgn1[i] = has_next ? (unsigned)(S.grow(nxt, HALF + gR[i]) * lda0 + gC[i]) * 2u : vgc1[i]; } }
        if constexpr (MIXED) { if (selc) { PG8_KLOOP(PG8_LDA8, PG8_LDB8, PG8_MMA8) } else { PG8_KLOOP(PG8_LDA4, PG8_LDB4, PG8_MMA16A) } }
        else if constexpr (FP8) { PG8_KLOOP(PG8_LDA8, PG8_LDB8, PG8_MMA8) }
        else { PG8_KLOOP(PG8_LDA4, PG8_LDB4, PG8_MMAB) }
        if constexpr (ALIGN_EPI) { if (wr == 0) PG8_BAR; }
        if constexpr (FP8 || MIXED) asm volatile("s_nop 15\n\ts_nop 15" ::: "memory");
        { int t_ = tid; asm volatile("" : "+v"(t_)); const int fr_ = t_ & 15, fq_ = (t_ >> 4) & 3; E(acc, cur, wr, wc, fr_, fq_); }
        if (!has_next) break;
#pragma unroll
        for (int a = 0; a < 2; ++a)
#pragma unroll
            for (int b = 0; b < 2; ++b)
#pragma unroll
                for (int m = 0; m < 4; ++m)
#pragma unroll
                    for (int n = 0; n < 2; ++n) acc[a][b][m][n] = (f32x4){0.f, 0.f, 0.f, 0.f};
        cur = nxt; cA = nA; cB = nB; selc = seln; hsAc = hsAn; nt = ntn; ++ui;
        if constexpr (GATHER) { vgc0[0] = vgn0[0]; vgc0[1] = vgn0[1]; vgc1[0] = vgn1[0]; vgc1[1] = vgn1[1]; }
        if constexpr (ALIGN_EPI) { if (wr == 1) PG8_BAR; }
    }
    PG8_WAIT_V(0);
    if constexpr (!ALIGN_EPI) { if (wr == 0) PG8_BAR; }
    PG8_BAR;
#undef PG8_VA
#undef PG8_STAGE_A
#undef PG8_SA
#undef PG8_SB
#undef PG8_STAGE
#undef PG8_MMAB
#undef PG8_MMA8
#undef PG8_MMA16A
#undef PG8_KLOOP
#undef PG8_LDA4
#undef PG8_LDB4
#undef PG8_LDA8
#undef PG8_LDB8
#undef PG8_WAIT_V
#undef PG8_WAIT_L
#undef PG8_BAR
#undef PG8_SCHED
}
}

#include <hip/hip_bf16.h>
#include <cmath>
namespace attn_body {
using bf16=__hip_bfloat16;
using i32x8=__attribute__((ext_vector_type(8)))int;
using i32x4=__attribute__((ext_vector_type(4)))int;
using f32x16=__attribute__((ext_vector_type(16)))float;
using u32x4=__attribute__((ext_vector_type(4)))unsigned;
constexpr int BATCH=8,NHEAD=8,SEQ=8192,D=64,DM=NHEAD*D;
constexpr int Q8P=1024,O8P=4096; constexpr float OSC=64.0f;
constexpr int NW=8,QBLK=32,QB=QBLK*NW,KVBLK=64,NQB=SEQ/QB;
__device__ __forceinline__ int crow(int r,int hi){return (r&3)+8*(r>>2)+4*hi;}
#define SBAR() __builtin_amdgcn_sched_barrier(0)
constexpr int NSLOT=3, SLOTB=4096;
constexpr int LDS_K=0, LDS_V=NSLOT*SLOTB, LDS_WS=2*NSLOT*SLOTB, LDS_OST=LDS_WS+NW*64*4, LDS_BYTES=LDS_OST+NW*4096;
__device__ __forceinline__ void glds16(const void*gsrc,unsigned lds_dst){unsigned keep;
  asm volatile("s_mov_b32 %0, m0\n\ts_mov_b32 m0, %2\n\ts_nop 0\n\tglobal_load_lds_dwordx4 %1, off\n\ts_mov_b32 m0, %0":"=&s"(keep):"v"(gsrc),"s"(lds_dst):"memory");}
#define WAIT_BAR(N) asm volatile("s_waitcnt vmcnt(" #N ") lgkmcnt(0)\n\ts_barrier":::"memory")
typedef __attribute__((address_space(3))) const char* lds_cptr;
__device__ __forceinline__ i32x8 frag32(lds_cptr p){ const i32x4 a=*(const __attribute__((address_space(3))) i32x4*)(p), b=*(const __attribute__((address_space(3))) i32x4*)(p+1024); return (i32x8){a[0],a[1],a[2],a[3],b[0],b[1],b[2],b[3]}; }
#define MFMA_QK(D_,A,B,C) asm volatile("v_mfma_scale_f32_32x32x64_f8f6f4 %0, %1, %2, %3, %4, %5 op_sel_hi:[0,0,0]":"=&v"(D_):"v"(A),"v"(B),"v"(C),"v"(scA),"v"(scB))
#define MFMA_PV(D_,A,B) asm volatile("v_mfma_f32_32x32x64_f8f6f4 %0, %1, %2, %0 cbsz:1":"+v"(D_):"v"(A),"v"(B))

#ifndef ATTN_STORE16
#define ATTN_STORE16(p,v) (*(u32x4*)(p)=(v))
#endif
__device__ __forceinline__ void attn_unit(int tid_in,float negM,int b,int h,int qb,const unsigned char*Q8,const unsigned char*__restrict__ K8,const unsigned char*__restrict__ Vt8,unsigned char*O8,char*shm,const bool do_store=true){
  const int tid=tid_in,lane=tid&63,r32=lane&31,hi=lane>>5; const int wid=__builtin_amdgcn_readfirstlane(tid>>6);
  const long rowbase=(long)b*SEQ; const int q0=qb*QB; const int kvh=h>>2;
  const unsigned lds0=(unsigned)(uintptr_t)shm;
  const bool kw=wid<4;
  const int ki=lane&31, kkey=32*((ki>>2)&1)+16*(lane>>5)+(ki&3)+4*(ki>>3);
  const unsigned char*ksrc=K8+((long)(b*2+kvh)*SEQ+kkey)*64+(wid&3)*16;
  const unsigned char*vsrc=Vt8+((long)(b*2+kvh)*64+lane)*SEQ+(wid&3)*16;
  const unsigned char*dsrc=kw?ksrc:vsrc; const int dstep=kw?KVBLK*64:KVBLK;
  const unsigned ddst=lds0+(kw?LDS_K:LDS_V)+(wid&3)*1024;
  const int NT=SEQ/KVBLK;
  #define DMA(tt,slot) do{ int ti_=(tt); ti_=ti_<NT?ti_:NT-1; glds16(dsrc+(long)ti_*dstep,(unsigned)__builtin_amdgcn_readfirstlane(ddst+(slot))); }while(0)
  const lds_cptr shm3=(lds_cptr)shm; const lds_cptr kp0=shm3+LDS_K+hi*2048+r32*16; const lds_cptr vp0=shm3+LDS_V+hi*2048+r32*16;
  const unsigned char*Qw=Q8+(rowbase+q0+wid*QBLK+r32)*Q8P+h*128+hi*32;
  const i32x4 qa=*(const i32x4*)Qw, qb_=*(const i32x4*)(Qw+16);
  const i32x8 qf=(i32x8){qa[0],qa[1],qa[2],qa[3],qb_[0],qb_[1],qb_[2],qb_[3]};
  if(kw){DMA(0,0);DMA(1,SLOTB);DMA(2,2*SLOTB);}
  f32x16 o[2],ol;o[0]=f32x16{};o[1]=f32x16{};ol=f32x16{};f32x16 negm;
  #pragma unroll
  for(int r=0;r<16;++r)negm[r]=negM;
  asm volatile("":"+v"(negm));
  f32x16 pA0,pA1,pB0,pB1; i32x8 kf0,kf1,vf0,vf1,pw0=(i32x8){0,0,0,0,0,0,0,0},pw1=(i32x8){0,0,0,0,0,0,0,0};
  i32x8 ones; _Pragma("unroll") for(int r=0;r<8;++r)ones[r]=0x38383838; asm volatile("":"+v"(ones));
#ifdef ATT_CODE_EXP
  int scA=127,scB=125; asm volatile("":"+v"(scA),"+v"(scB));
#else
  int scA=127,scB=123; asm volatile("":"+v"(scA),"+v"(scB));
#endif
  int sl_cur=0,sl_next=SLOTB;
  #define ROT() do{sl_cur=sl_next;sl_next=(sl_next==(NSLOT-1)*SLOTB)?0:sl_next+SLOTB;}while(0)
  #define EX(v) __builtin_amdgcn_exp2f(v)
  #define PIN(x) asm volatile("":"+v"(x))
#ifdef ATT_CODE_EXP
  #define PACK2(P,PW,J,LO) do{ _Pragma("unroll") for(int j_=0;j_<2;++j_){ unsigned w_=(unsigned)PW[(J)+j_]; _Pragma("unroll") for(int b_=0;b_<4;++b_) w_=__builtin_amdgcn_cvt_pk_u8_f32(P[(LO)+4*j_+b_],b_,w_); PW[(J)+j_]=(int)w_; } }while(0)
  #define PACK(P,PW,J) do{ PACK2(P,PW,J,0); PACK2(P,PW,(J)+2,8); }while(0)
  #define EXPS(P,LO) do{}while(0)
  #define G1(Y0,Y1,PWN) do{ PACK2(Y0,PWN,0,0); PIN(PWN); }while(0)
  #define G2(Y0,Y1,PWN) do{ PACK2(Y0,PWN,2,8); PIN(PWN); }while(0)
  #define G3(Y0,Y1,PWN) do{ PACK2(Y1,PWN,4,0); PIN(PWN); }while(0)
  #define G4(Y0,Y1,PWN) do{ PACK2(Y1,PWN,6,8); PIN(PWN); }while(0)
  #define G5(Y0,Y1,PWN) do{}while(0)
#else
  #define PK2(P,B,OLD,HIW) __builtin_amdgcn_cvt_pk_bf8_f32(P[B],P[B+1],OLD,HIW)
  #define PACK(P,PW,J) do{ _Pragma("unroll") for(int j_=0;j_<4;++j_){ int w_=PK2(P,4*j_,PW[(J)+j_],false); w_=PK2(P,4*j_+2,w_,true); PW[(J)+j_]=w_; } }while(0)
  #define EXPS(P,LO) do{ _Pragma("unroll") for(int r_=(LO);r_<(LO)+8;++r_)P[r_]=EX(P[r_]); PIN(P); }while(0)
  #define G1(Y0,Y1,PWN) EXPS(Y0,0)
  #define G2(Y0,Y1,PWN) EXPS(Y0,8)
  #define G3(Y0,Y1,PWN) EXPS(Y1,0)
  #define G4(Y0,Y1,PWN) EXPS(Y1,8)
  #define G5(Y0,Y1,PWN) do{ PACK(Y0,PWN,0); PACK(Y1,PWN,4); PIN(PWN); }while(0)
#endif
  if(kw){asm volatile("s_waitcnt vmcnt(2)":::"memory");}else{asm volatile("s_waitcnt vmcnt(0)":::"memory");}
  asm volatile("s_barrier":::"memory");
  kf0=frag32(kp0);kf1=frag32(kp0+512);
  MFMA_QK(pA0,kf0,qf,negm);MFMA_QK(pA1,kf1,qf,negm);asm volatile("s_nop 15\n\ts_nop 7":"+v"(pA0),"+v"(pA1));
  WAIT_BAR(1);
  DMA(kw?3:0,0);
  ROT();
  kf0=frag32(kp0+sl_cur);kf1=frag32(kp0+sl_cur+512);
  WAIT_BAR(1);
  MFMA_QK(pB0,kf0,qf,negm); EXPS(pA0,0); EXPS(pA0,8); SBAR();
  MFMA_QK(pB1,kf1,qf,negm); EXPS(pA1,0); EXPS(pA1,8); SBAR();
  DMA(kw?4:1,sl_cur);
  kf0=frag32(kp0+sl_next);kf1=frag32(kp0+sl_next+512);
  PACK(pA0,pw0,0); PACK(pA1,pw0,4); PIN(pw0);
  WAIT_BAR(1); ROT();
  #define STEP(X0,X1,Y0,Y1,PWN,PWO,t) do{ SBAR(); \
    vf0=frag32(vp0+sl_next); vf1=frag32(vp0+sl_next+512); SBAR(); \
    MFMA_QK(X0,kf0,qf,negm); G1(Y0,Y1,PWN); SBAR(); \
    MFMA_QK(X1,kf1,qf,negm); G2(Y0,Y1,PWN); SBAR(); \
    DMA(kw?(t)+3:(t),sl_cur); \
    kf0=frag32(kp0+sl_next); kf1=frag32(kp0+sl_next+512); SBAR(); \
    MFMA_PV(o[0],PWO,vf0); G3(Y0,Y1,PWN); SBAR(); \
    MFMA_PV(o[1],PWO,vf1); G4(Y0,Y1,PWN); SBAR(); \
    MFMA_PV(ol,PWO,ones); G5(Y0,Y1,PWN); SBAR(); \
    }while(0)
  for(int t=2;t<NT;t+=2){
    STEP(pA0,pA1,pB0,pB1,pw1,pw0,t);     WAIT_BAR(1); ROT();
    STEP(pB0,pB1,pA0,pA1,pw0,pw1,t+1);   WAIT_BAR(1); ROT();
  }
  { vf0=frag32(vp0+sl_next); vf1=frag32(vp0+sl_next+512);
    MFMA_PV(o[0],pw0,vf0); EXPS(pB0,0); EXPS(pB0,8); SBAR();
    MFMA_PV(o[1],pw0,vf1); EXPS(pB1,0); EXPS(pB1,8); SBAR();
    DMA(NT,sl_cur);
    MFMA_PV(ol,pw0,ones); PACK(pB0,pw1,0); PACK(pB1,pw1,4); PIN(pw1);
    WAIT_BAR(1); ROT(); }
  { vf0=frag32(vp0+sl_next); vf1=frag32(vp0+sl_next+512);
    MFMA_PV(o[0],pw1,vf0); MFMA_PV(o[1],pw1,vf1); MFMA_PV(ol,pw1,ones); asm volatile("s_nop 15\n\ts_nop 7":"+v"(o[0]),"+v"(o[1]),"+v"(ol)); }
#ifndef ATT_CODE_EXP
  #undef PK2
#else
  #undef PACK2
#endif
  #undef PACK
  #undef G1
  #undef G2
  #undef G3
  #undef G4
  #undef G5
  #undef EXPS
  #undef PIN
  #undef EX
  #undef STEP
  float rli[16];
  #pragma unroll
  for(int r=0;r<16;++r)rli[r]=__builtin_amdgcn_rcpf(ol[r])*OSC;
  unsigned char*Ow=O8+(rowbase+q0+wid*QBLK)*(long)O8P+h*D;
  { unsigned char*stg=(unsigned char*)(shm+LDS_OST)+wid*2048;
    #pragma unroll
    for(int r=0;r<16;++r){const int orow=crow(r,hi);
      #pragma unroll
      for(int d0=0;d0<2;++d0){ const float v_=__builtin_amdgcn_fmed3f(o[d0][r]*rli[r],-448.0f,448.0f); stg[orow*64+d0*32+r32]=(unsigned char)__builtin_amdgcn_cvt_pk_fp8_f32(v_,v_,0,false); } }
    asm volatile("s_waitcnt lgkmcnt(0)":::"memory");
    #pragma unroll
    for(int i=0;i<2;++i){const int idx=i*64+lane,row=idx>>2,ch=idx&3; const u32x4 v=*(const u32x4*)(stg+row*64+ch*16); if(do_store)ATTN_STORE16(Ow+(long)row*O8P+ch*16,v);} }
  asm volatile("s_waitcnt vmcnt(0) lgkmcnt(0)\n\ts_barrier":::"memory");
  #undef DMA
  #undef ROT
}
constexpr int ATTN_LDS_BYTES=LDS_BYTES;
#undef SBAR
#undef WAIT_BAR
#undef MFMA_QK
#undef MFMA_PV
}

constexpr int NWAVES = 8, NTHR = NWAVES * 64;
constexpr int BATCH = 8, SEQ = 8192, DMODEL = 1024, M = BATCH * SEQ;
constexpr int NPJ = 3328;
constexpr int COL_VL = 1920, COL_POOL = 2048, COL_Q = 2560, COL_K = 3072, COL_V = 3200;
constexpr int NEXP = 16, CAP = 1024, MR = BATCH * NEXP * CAP;
constexpr int NPROJ_IN = 6272;
constexpr float C2Q = 0.125f * 1.4426950408889634f;
constexpr int N_PHASES = 28, PH_PER_LAYER = 13;
constexpr int XBP = 2048;

constexpr size_t MiB = 1u << 20;
constexpr size_t WS_CTL = 0, CTL_ZERO_BYTES = 1 * MiB;
constexpr size_t WS_ROPE = 1 * MiB;
constexpr size_t WS_W = 3 * MiB, WL_STRIDE = 23 * MiB;
constexpr size_t WO_IN = 0, WO_G = 6656 * 1024, WO_LORA = WO_G + 6 * MiB, WO_G2 = WO_LORA + 1 * MiB, WO_PW = WO_G2 + 256 * 1024, WO_BR = WO_PW + 512 * 1024, WO_OUT = WO_BR + 6 * MiB;
constexpr size_t WO_BRA8 = WO_BR + 3 * MiB;
constexpr size_t WO_QKV8 = WO_G + 3 * MiB;
static_assert(WO_OUT + 2 * MiB <= WL_STRIDE && WO_QKV8 + 768 * 2048 <= WO_LORA, "weight map");
constexpr size_t WS_VF = 49 * MiB, WS_AFFT = 113 * MiB, WS_IDX = 117 * MiB, WS_VAL = WS_IDX + 512 * 1024, WS_INV = 118 * MiB, WS_CFB = 122 * MiB;
constexpr size_t ACT = 128 * MiB;
constexpr size_t A_PRJ = ACT, A_R = ACT + 416 * MiB, A_KS = ACT + 480 * MiB, A_VS = ACT + 544 * MiB, A_Q = ACT + 608 * MiB, A_K = ACT + 672 * MiB, A_V = ACT + 688 * MiB,
                 A_TW = ACT + 704 * MiB, A_PL = ACT + 752 * MiB, A_HN1 = ACT + 672 * MiB;
constexpr size_t A_LW = ACT, A_AA = ACT + 128 * MiB, A_G = ACT + 256 * MiB, A_YB = ACT + 320 * MiB, A_YSF = ACT + 704 * MiB, A_YSB = ACT + 768 * MiB;
constexpr size_t A_HN = ACT, A_YA = ACT + 128 * MiB, A_TS = ACT + 192 * MiB, A_MG = ACT + 416 * MiB;
constexpr size_t A_WGU = ACT + 832 * MiB, A_WD = ACT + 384 * MiB, A_XG = ACT + 416 * MiB, A_HID = ACT + 128 * MiB, A_YE = ACT + 416 * MiB;
constexpr size_t WS_END = ACT + 896 * MiB;
constexpr int CW_BAR = 4096;
constexpr int CW_ATTQ = 200000;

constexpr int RING_OFF = 0, RING_BYTES = 131072;
constexpr int LDSCTL_OFF = RING_BYTES, MISC_OFF = LDSCTL_OFF + 320;
constexpr int LDS_BYTES = 147456;

#define GAS __attribute__((address_space(1)))
#define LAS __attribute__((address_space(3)))
typedef unsigned short bf16;
typedef unsigned v4u __attribute__((ext_vector_type(4)));
typedef unsigned v2u __attribute__((ext_vector_type(2)));
typedef float f32x4 __attribute__((ext_vector_type(4)));
typedef float f32x2 __attribute__((ext_vector_type(2)));
typedef GAS unsigned gu32;
#define RLX_AGENT __ATOMIC_RELAXED, __HIP_MEMORY_SCOPE_AGENT
#define LDS_WAIT() asm volatile("s_waitcnt lgkmcnt(0)" ::: "memory")
typedef float f32x2c_t __attribute__((ext_vector_type(2))); typedef __bf16 bf16x2c_t __attribute__((ext_vector_type(2)));
__device__ __forceinline__ unsigned pk2(float lo, float hi) { const f32x2c_t v = {lo, hi}; const bf16x2c_t b = __builtin_convertvector(v, bf16x2c_t); return __builtin_bit_cast(unsigned, b); }
__device__ __forceinline__ unsigned f2bf(float f) { return pk2(f, 0.f) & 0xffffu; }
__device__ __forceinline__ void unp8(const v4u& p, float (&f)[8]) {
    f[0] = __uint_as_float(p.x << 16); f[1] = __uint_as_float(p.x & 0xffff0000u); f[2] = __uint_as_float(p.y << 16); f[3] = __uint_as_float(p.y & 0xffff0000u);
    f[4] = __uint_as_float(p.z << 16); f[5] = __uint_as_float(p.z & 0xffff0000u); f[6] = __uint_as_float(p.w << 16); f[7] = __uint_as_float(p.w & 0xffff0000u); }
__device__ __forceinline__ v4u pk8(const float (&f)[8]) { v4u o; o.x = pk2(f[0], f[1]); o.y = pk2(f[2], f[3]); o.z = pk2(f[4], f[5]); o.w = pk2(f[6], f[7]); return o; }
__device__ __forceinline__ v4u ld16(const bf16* p) { return *(const v4u*)p; }
__device__ __forceinline__ void st16(bf16* p, const v4u& v) { *(v4u*)p = v; }
__device__ __forceinline__ void ldf8(const float* p, float (&f)[8]) { const f32x4 a = *(const f32x4*)p, b = *(const f32x4*)(p + 4); f[0] = a[0]; f[1] = a[1]; f[2] = a[2]; f[3] = a[3]; f[4] = b[0]; f[5] = b[1]; f[6] = b[2]; f[7] = b[3]; }
__device__ __forceinline__ float sigmf(float x) { return __builtin_amdgcn_rcpf(1.0f + __builtin_amdgcn_exp2f(-1.4426950408889634f * x)); }
__device__ __forceinline__ float shx(float v, int m, int lane) { return __builtin_bit_cast(float, __builtin_amdgcn_ds_bpermute((lane ^ m) << 2, __builtin_bit_cast(int, v))); }
__device__ __forceinline__ float shx_from(float v, int src, int lane) { (void)lane; return __builtin_bit_cast(float, __builtin_amdgcn_ds_bpermute((src & 63) << 2, __builtin_bit_cast(int, v))); }
__device__ __forceinline__ int shxi(int v, int m, int lane) { return __builtin_amdgcn_ds_bpermute((lane ^ m) << 2, v); }
__device__ __forceinline__ int shupi(int v, int o, int lane) { return __builtin_amdgcn_ds_bpermute((lane >= o ? lane - o : lane) << 2, v); }
template <int CTRL> __device__ __forceinline__ float dppf(float v) { return __builtin_bit_cast(float, __builtin_amdgcn_update_dpp(0, __builtin_bit_cast(int, v), CTRL, 0xf, 0xf, true)); }
__device__ __forceinline__ float sum8(float v, int lane) { (void)lane; v += dppf<0xB1>(v); v += dppf<0x4E>(v); v += dppf<0x141>(v); return v; }
__device__ __forceinline__ float sum16(float v) { v += dppf<0xB1>(v); v += dppf<0x4E>(v); v += dppf<0x141>(v); v += dppf<0x140>(v); return v; }
__device__ __forceinline__ float max16(float v) { v = fmaxf(v, dppf<0xB1>(v)); v = fmaxf(v, dppf<0x4E>(v)); v = fmaxf(v, dppf<0x141>(v)); v = fmaxf(v, dppf<0x140>(v)); return v; }
__device__ __forceinline__ float sum_rows(float v) {
    { const auto r = __builtin_amdgcn_permlane16_swap(__builtin_bit_cast(unsigned, v), __builtin_bit_cast(unsigned, v), false, false); v = __uint_as_float(r[0]) + __uint_as_float(r[1]); }
    { const auto r = __builtin_amdgcn_permlane32_swap(__builtin_bit_cast(unsigned, v), __builtin_bit_cast(unsigned, v), false, false); v = __uint_as_float(r[0]) + __uint_as_float(r[1]); }
    return v; }
__device__ __forceinline__ float wave_sum(float v, int lane) { (void)lane; return sum_rows(sum16(v)); }


#define XB_TMO      128
#define XB_XCNT(j)  (256  + 64 * (j))
#define XB_XSUB(j)  (1280 + 64 * (j))
#define XB_XGEN(j)  (2304 + 64 * (j))
#define XB_TOP      3328
#define XB_TOPGEN   3392
#define XCD_BAR_WORDS 3456
#define XB_SPIN_CAP (1u << 22)

__device__ __forceinline__ unsigned xb_ld(unsigned* p)              { return __hip_atomic_load(p, __ATOMIC_RELAXED, __HIP_MEMORY_SCOPE_AGENT); }
__device__ __forceinline__ unsigned xb_add(unsigned* p, unsigned v) { return __hip_atomic_fetch_add(p, v, __ATOMIC_RELAXED, __HIP_MEMORY_SCOPE_AGENT); }
__device__ __forceinline__ unsigned xb_xcc_id() { return (unsigned)__builtin_amdgcn_s_getreg((3 << 11) | 20) & 0xFu; }
#define XB_SPIN(cond, bar) do { unsigned _sp = 0; while (cond) { __builtin_amdgcn_s_sleep(1); \
    if ((++_sp & 255u) == 0u) { if (xb_ld(&(bar)[XB_TMO])) break; if (_sp > XB_SPIN_CAP) { atomicAdd(&(bar)[XB_TMO], 1u); break; } } } } while (0)

struct XcdBarrier {
    unsigned* bar; unsigned x;
    volatile LAS unsigned* st;
};

__device__ __forceinline__ XcdBarrier xcd_barrier_post(unsigned* bar, volatile LAS unsigned* st) {
    XcdBarrier b; b.bar = bar; b.x = xb_xcc_id(); b.st = st;
    if (threadIdx.x == 0) (void)xb_add(&bar[XB_XCNT(b.x)], 1u);
    return b;
}
__device__ __forceinline__ void xcd_barrier_complete(unsigned* bar, unsigned x, unsigned& nloc, unsigned& nx) {
    const unsigned G = gridDim.x * gridDim.y * gridDim.z;
    unsigned sum, cnt, mine, sp = 0u;
    for (;;) {
        sum = 0u; cnt = 0u; mine = 0u;
#pragma unroll
        for (unsigned j = 0; j < 16; ++j) { const unsigned c = xb_ld(&bar[XB_XCNT(j)]); sum += c; cnt += (c > 0u) ? 1u : 0u; mine = (j == x) ? c : mine; }
        if (sum == G) break;
        __builtin_amdgcn_s_sleep(1);
        if ((++sp & 255u) == 0u) { if (xb_ld(&bar[XB_TMO])) break; if (sp > XB_SPIN_CAP) { atomicAdd(&bar[XB_TMO], 1u); break; } }
    }
    nloc = mine > 0u ? mine : 1u; nx = cnt > 0u ? cnt : 1u;
}

__device__ __forceinline__ void xcd_barrier(const XcdBarrier& b) {
    asm volatile("s_waitcnt vmcnt(0)" ::: "memory");
    __syncthreads();
    if (threadIdx.x == 0) {
        unsigned* bar = b.bar;
        __builtin_amdgcn_s_waitcnt(0);
        unsigned nloc = b.st[0], nx = b.st[1];
        if (nloc == 0u) { xcd_barrier_complete(bar, b.x, nloc, nx); b.st[0] = nloc; b.st[1] = nx; }
        const unsigned old = xb_add(&bar[XB_XSUB(b.x)], 1u);
        const unsigned gen = old / nloc;
        if (old + 1u == (gen + 1u) * nloc) {
            __builtin_amdgcn_fence(__ATOMIC_RELEASE, "agent");
            asm volatile("s_waitcnt vmcnt(0)" ::: "memory");
            const unsigned og = xb_add(&bar[XB_TOP], 1u);
            const unsigned tg = og / nx;
            if (og + 1u == (tg + 1u) * nx) xb_add(&bar[XB_TOPGEN], 1u);
            else XB_SPIN(xb_ld(&bar[XB_TOPGEN]) == tg, bar);
            __builtin_amdgcn_fence(__ATOMIC_ACQUIRE, "agent");
            xb_add(&bar[XB_XGEN(b.x)], 1u);
            asm volatile("s_waitcnt vmcnt(0)" ::: "memory");
        } else {
            XB_SPIN(xb_ld(&bar[XB_XGEN(b.x)]) == gen, bar);
            __builtin_amdgcn_fence(__ATOMIC_ACQUIRE, "agent");
            asm volatile("s_waitcnt vmcnt(0)" ::: "memory");
        }
    }
    __syncthreads();
}

__device__ __forceinline__ void tr_item(const float* W, int src_ld, int k0, int n0, bf16* WT, int dst_ld, int dst_row0, LAS float* scr, int lane, float sc = 1.0f) {
    float t_[32];
#pragma unroll
    for (int i = 0; i < 32; ++i) t_[i] = W[(size_t)(k0 + 2 * i + (lane >> 5)) * src_ld + n0 + (lane & 31)];
#pragma unroll
    for (int i = 0; i < 32; ++i) scr[(2 * i + (lane >> 5)) * 33 + (lane & 31)] = t_[i] * sc;
    LDS_WAIT(); asm volatile("" ::: "memory");
    const int c = lane & 7;
#pragma unroll
    for (int j = 0; j < 4; ++j) { const int n = (lane >> 3) + 8 * j; const LAS float* s = scr + (8 * c) * 33 + n;
        v4u o; o.x = pk2(s[0 * 33], s[1 * 33]); o.y = pk2(s[2 * 33], s[3 * 33]); o.z = pk2(s[4 * 33], s[5 * 33]); o.w = pk2(s[6 * 33], s[7 * 33]);
        *(GAS v4u*)(WT + (size_t)(dst_row0 + n) * dst_ld + k0 + 8 * c) = o; }
    LDS_WAIT(); asm volatile("" ::: "memory");
}
__device__ __forceinline__ void tr_item8(const float* W, int src_ld, int k0, int n0, unsigned char* WT8, int dst_ld, int dst_row0, float sc, LAS float* scr, int lane) {
    float t_[32];
#pragma unroll
    for (int i = 0; i < 32; ++i) t_[i] = W[(size_t)(k0 + 2 * i + (lane >> 5)) * src_ld + n0 + (lane & 31)];
#pragma unroll
    for (int i = 0; i < 32; ++i) scr[(2 * i + (lane >> 5)) * 33 + (lane & 31)] = t_[i] * sc;
    LDS_WAIT(); asm volatile("" ::: "memory");
#pragma unroll
    for (int j = 0; j < 2; ++j) { const int q = lane + 64 * j, n = q >> 2, c = q & 3; const LAS float* s = scr + (16 * c) * 33 + n; v4u o;
        o.x = pg8::pk4_fp8(s[0 * 33], s[1 * 33], s[2 * 33], s[3 * 33]); o.y = pg8::pk4_fp8(s[4 * 33], s[5 * 33], s[6 * 33], s[7 * 33]);
        o.z = pg8::pk4_fp8(s[8 * 33], s[9 * 33], s[10 * 33], s[11 * 33]); o.w = pg8::pk4_fp8(s[12 * 33], s[13 * 33], s[14 * 33], s[15 * 33]);
        *(GAS v4u*)(WT8 + (size_t)(dst_row0 + n) * dst_ld + k0 + 16 * c) = o; }
    LDS_WAIT(); asm volatile("" ::: "memory");
}
__device__ __forceinline__ void tr_job(const float* W, int src_ld, int col0, int K, int ncols, bf16* WT, int dst_ld, int dst_row0, LAS float* scr, int gw, int NGW, int lane, float sc = 1.0f) {
    const int nblk = ncols / 32, nitems = (K / 64) * nblk;
    for (int it = gw; it < nitems; it += NGW) { const int kb = it / nblk, nb = it - kb * nblk; tr_item(W, src_ld, 64 * kb, col0 + 32 * nb, WT, dst_ld, dst_row0 + 32 * nb, scr, lane, sc); }
}
__device__ __forceinline__ void zero_rows(bf16* WT, int row0, int nrows, int ld, int gtid, int NGT) {
    const int per = ld / 8, n = nrows * per;
    for (int i = gtid; i < n; i += NGT) *(GAS v4u*)(WT + (size_t)(row0 + i / per) * ld + (i % per) * 8) = (v4u){0u, 0u, 0u, 0u};
}

__device__ __forceinline__ void p0_prologue(const float* const* in, unsigned char* ws, LAS unsigned char* lds, int vcu, int G, int tid, int wave, int lane) {
    LAS float* scr = (LAS float*)(lds + RING_OFF + wave * 16384);
    const int gw = vcu * NWAVES + wave, NGW = G * NWAVES, gtid = vcu * NTHR + tid, NGT = G * NTHR;
    { f32x2* rope = (f32x2*)(ws + WS_ROPE);
      for (int i = gtid; i < SEQ * 32; i += NGT) { const int s = i >> 5, p = i & 31, fi = p & 15; const float freq = exp2f(-(float)(2 * fi) * (13.287712379549449f / 32.0f));
          const float pos = (p < 16) ? (float)(s >> 6) : (float)(s & 63); float sn, cs; sincosf(pos * freq, &sn, &cs); rope[i] = (f32x2){cs, sn}; } }
    for (int l = 0; l < 2; ++l) {
        unsigned char* wl = ws + WS_W + (size_t)l * WL_STRIDE;
        const float* w_in = in[2] + (size_t)l * DMODEL * NPROJ_IN;
        bf16* Win_t = (bf16*)(wl + WO_IN); bf16* Wg_t = (bf16*)(wl + WO_G); bf16* Wlo_t = (bf16*)(wl + WO_LORA); bf16* Wg2_t = (bf16*)(wl + WO_G2); bf16* PW_t = (bf16*)(wl + WO_PW);
        bf16* Wbr_t = (bf16*)(wl + WO_BR); bf16* Wout_t = (bf16*)(wl + WO_OUT);
        tr_job(w_in, NPROJ_IN, 0, DMODEL, 1920, Win_t, DMODEL, 0, scr, gw, NGW, lane);
        tr_job(w_in, NPROJ_IN, 1920, DMODEL, 512, Win_t, DMODEL, COL_POOL, scr, gw, NGW, lane);
        { const int nblk = 768 / 32, nitems = (DMODEL / 64) * nblk; unsigned char* Wq8 = wl + WO_QKV8;
          for (int it = gw; it < nitems; it += NGW) { const int kb = it / nblk, nb = it - kb * nblk; tr_item8(w_in, NPROJ_IN, 64 * kb, 2432 + 32 * nb, Wq8, 2048, 32 * nb, 32.0f, scr, lane); } }
        { const int nblk = 3072 / 32, nitems = (DMODEL / 64) * nblk;
          for (int it = gw; it < nitems; it += NGW) { const int kb = it / nblk, nb = it - kb * nblk; tr_item8(w_in, NPROJ_IN, 64 * kb, 3200 + 32 * nb, (unsigned char*)Wg_t, DMODEL, 32 * nb, 32.0f, scr, lane); } }
        if (l == 0) zero_rows(Win_t, 1920, 128, DMODEL, gtid, NGT);
        else { tr_job(in[16], 32, 0, DMODEL, 32, Win_t, DMODEL, COL_VL, scr, gw, NGW, lane); zero_rows(Win_t, 1952, 96, DMODEL, gtid, NGT); }
        tr_job(in[22] + (size_t)l * 512 * 1024, 1024, 0, 512, 1024, Wbr_t, 512, 0, scr, gw, NGW, lane);
        tr_job(in[23] + (size_t)l * 512 * 1024, 1024, 0, 512, 1024, Wbr_t, 512, 1024, scr, gw, NGW, lane);
        #ifndef PROBE_ATT_AMP
#define PROBE_ATT_AMP 1.0f
#endif
        { const float* wa = in[24] + (size_t)l * 512 * 1024; unsigned char* Wa8 = wl + WO_BRA8;
          const int nblk = 1024 / 32, nitems = (512 / 64) * nblk;
          for (int it = gw; it < nitems; it += NGW) { const int kb = it / nblk, nb = it - kb * nblk; tr_item8(wa, 1024, 64 * kb, 32 * nb, Wa8, 1024, 32 * nb, 32.0f, scr, lane); } }
        tr_job(in[25] + (size_t)l * 1024 * 1024, 1024, 0, 1024, 1024, Wout_t, 1024, 0, scr, gw, NGW, lane);
        { const float* w2 = in[6] + (size_t)l * 2 * 64 * 512; const float* a2 = in[8] + (size_t)l * 2 * 64 * 512;
          for (int i = gtid; i < 2048 * 16; i += NGT) { const int n = i >> 4, k0 = (i & 15) * 8; const bool isa = n >= 1024; const int nn = n & 1023, dir = nn >> 9, c = nn & 511, kb = 64 * dir;
              float f[8];
#pragma unroll
              for (int j = 0; j < 8; ++j) { const int k = k0 + j; f[j] = (k >= kb && k < kb + 64) ? (isa ? a2 : w2)[((size_t)dir * 64 + (k - kb)) * 512 + c] : 0.f; }
              *(GAS v4u*)(Wlo_t + (size_t)n * 128 + k0) = pk8(f); } }
        { const float* g2 = in[9] + (size_t)l * 128 * 512;
          for (int i = gtid; i < 512 * 16; i += NGT) { const int n = i >> 4, k0 = (i & 15) * 8; float f[8];
#pragma unroll
              for (int j = 0; j < 8; ++j) f[j] = g2[(size_t)(k0 + j) * 512 + n];
              *(GAS v4u*)(Wg2_t + (size_t)n * 128 + k0) = pk8(f); } }
        { const float* pw = in[18] + (size_t)l * 4 * 128 * 128;
          for (int i = gtid; i < 512 * 64; i += NGT) { const int n = i >> 6, k0 = (i & 63) * 8, g = n >> 7, d = n & 127; float f[8];
#pragma unroll
              for (int j = 0; j < 8; ++j) { const int k = k0 + j; f[j] = ((k >> 7) == g) ? pw[((size_t)g * 128 + (k & 127)) * 128 + d] : 0.f; }
              *(GAS v4u*)(PW_t + (size_t)n * 512 + k0) = pk8(f); } }
    }
}
__device__ __forceinline__ void convert_experts_items(const float* const* in, int l, unsigned char* ws, LAS unsigned char* lds, int it0, int nit, int wave, int lane) {
    LAS float* scr = (LAS float*)(lds + RING_OFF + wave * 16384);
    bf16* Wgu = (bf16*)(ws + A_WGU); bf16* Wd = (bf16*)(ws + A_WD);
    const float* eg = in[28] + (size_t)l * NEXP * 1024 * 1024; const float* eu = in[29] + (size_t)l * NEXP * 1024 * 1024; const float* ed = in[30] + (size_t)l * NEXP * 1024 * 1024;
    for (int it = it0 + wave; it < it0 + nit; it += NWAVES) {
        const int mat = it / (NEXP * 512), r = it - mat * (NEXP * 512), e = r >> 9, q = r & 511, kb = q >> 5, nb = q & 31, n0 = 32 * nb;
        if (mat == 0)      tr_item8(eg + (size_t)e * 1024 * 1024, 1024, 64 * kb, n0, (unsigned char*)Wgu, 1024, e * 2048 + (n0 >> 7) * 256 + (n0 & 127), 32.0f, scr, lane);
        else if (mat == 1) tr_item8(eu + (size_t)e * 1024 * 1024, 1024, 64 * kb, n0, (unsigned char*)Wgu, 1024, e * 2048 + (n0 >> 7) * 256 + 128 + (n0 & 127), 32.0f, scr, lane);
        else               tr_item8(ed + (size_t)e * 1024 * 1024, 1024, 64 * kb, n0, (unsigned char*)Wd, 1024, e * 1024 + n0, 32.0f, scr, lane);
    }
}

template <int MODE, bool XB = false, int NR = 2>
__device__ __forceinline__ void norm_rows(const float* xsrc, float* xdst, bool combine, const bf16* YE, const int* INV, const float* gain, bf16* obf, float* of32, int gw, int NGW, int lane, unsigned char* o8 = nullptr) {
    f32x4 g[4];
#pragma unroll
    for (int j = 0; j < 4; ++j) g[j] = *(const f32x4*)(gain + 4 * lane + 256 * j);
    for (int t0 = gw; t0 < M; t0 += NR * NGW) {
        f32x4 v[NR][4]; int inv[NR];
#pragma unroll
        for (int q = 0; q < NR; ++q) { const int t = t0 + q * NGW;
            if (XB) { const v2u* xr = (const v2u*)((const bf16*)xsrc + (size_t)t * XBP) + lane;
#pragma unroll
                for (int j = 0; j < 4; ++j) { const v2u w = xr[64 * j]; v[q][j] = (f32x4){__uint_as_float(w.x << 16), __uint_as_float(w.x & 0xffff0000u), __uint_as_float(w.y << 16), __uint_as_float(w.y & 0xffff0000u)}; } }
            else { const f32x4* xr = (const f32x4*)(xsrc + (size_t)t * DMODEL) + lane;
#pragma unroll
                for (int j = 0; j < 4; ++j) v[q][j] = xr[64 * j]; }
            inv[q] = (combine && lane < NEXP) ? INV[(size_t)t * NEXP + lane] : -1; }
#pragma unroll
        for (int q = 0; q < NR; ++q) { const int t = t0 + q * NGW;
            if (combine) {
                const int b = t / SEQ;
#pragma unroll
                for (int e_unused = 0; e_unused < 1; ++e_unused) {
                    unsigned mk = (unsigned)(__builtin_amdgcn_ballot_w64(inv[q] >= 0) & 0xffffull);
                    while (mk) { int es[4]; v2u w[4][4];
#pragma unroll
                        for (int u = 0; u < 4; ++u) { es[u] = mk ? (int)__builtin_ctz(mk) : -1; mk = mk ? (mk & (mk - 1u)) : 0u; }
#pragma unroll
                        for (int u = 0; u < 4; ++u) if (es[u] >= 0) { const int c = __builtin_amdgcn_readlane(inv[q], es[u]); const bf16* yr = YE + ((size_t)((b * NEXP + es[u]) * CAP + c)) * DMODEL + 4 * lane;
#pragma unroll
                            for (int j = 0; j < 4; ++j) w[u][j] = *(const v2u*)(yr + 256 * j); }
#pragma unroll
                        for (int u = 0; u < 4; ++u) if (es[u] >= 0) {
#pragma unroll
                            for (int j = 0; j < 4; ++j) { v[q][j][0] += __uint_as_float(w[u][j].x << 16); v[q][j][1] += __uint_as_float(w[u][j].x & 0xffff0000u); v[q][j][2] += __uint_as_float(w[u][j].y << 16); v[q][j][3] += __uint_as_float(w[u][j].y & 0xffff0000u); } } } }
                if (xdst) {
                    if (XB) { v2u* xw = (v2u*)((bf16*)xdst + (size_t)t * XBP) + lane;
#pragma unroll
                        for (int j = 0; j < 4; ++j) xw[64 * j] = (v2u){pk2(v[q][j][0], v[q][j][1]), pk2(v[q][j][2], v[q][j][3])}; }
                    else { f32x4* xw = (f32x4*)(xdst + (size_t)t * DMODEL) + lane;
#pragma unroll
                        for (int j = 0; j < 4; ++j) xw[64 * j] = v[q][j]; } }
            }
            float ss = 0.f;
#pragma unroll
            for (int j = 0; j < 4; ++j) ss += (v[q][j][0] * v[q][j][0] + v[q][j][1] * v[q][j][1]) + (v[q][j][2] * v[q][j][2] + v[q][j][3] * v[q][j][3]);
            const float rstd = __builtin_amdgcn_rsqf(wave_sum(ss, lane) * (1.0f / DMODEL) + 1e-6f);
            if (MODE == 2) { unsigned* o4 = (unsigned*)((unsigned char*)obf + (size_t)t * DMODEL) + lane;
#pragma unroll
                for (int j = 0; j < 4; ++j) { const f32x4 o = v[q][j] * rstd * g[j]; o4[64 * j] = pg8::pk4_fp8(o[0], o[1], o[2], o[3]); } }
            else if (MODE == 0) { v2u* ob_ = (v2u*)(obf + (size_t)t * DMODEL) + lane;
#pragma unroll
                for (int j = 0; j < 4; ++j) { const f32x4 o = v[q][j] * rstd * g[j]; ob_[64 * j] = (v2u){pk2(o[0], o[1]), pk2(o[2], o[3])}; }
                if (o8) { unsigned* e4 = (unsigned*)(o8 + (size_t)t * 4096) + lane;
#pragma unroll
                    for (int j = 0; j < 4; ++j) { const f32x4 o = v[q][j] * rstd * g[j]; e4[64 * j] = pg8::pk4_fp8(o[0], o[1], o[2], o[3]); } } }
            else { f32x4* o4 = (f32x4*)(of32 + (size_t)t * DMODEL) + lane;
#pragma unroll
                for (int j = 0; j < 4; ++j) o4[64 * j] = v[q][j] * rstd * g[j]; }
        }
    }
}

__device__ __forceinline__ v2u pk8_e4m3(const float (&f)[8]) { v2u o; o.x = pg8::pk4_fp8(f[0], f[1], f[2], f[3]); o.y = pg8::pk4_fp8(f[4], f[5], f[6], f[7]); return o; }
__device__ __forceinline__ void p3_prep(int l, const float* const* in, unsigned char* ws, LAS unsigned char* lds, int gw, int NGW, int tid, int lane) {
    const bf16* PRJ = (const bf16*)(ws + A_PRJ);
    bf16* R = (bf16*)(ws + A_R); bf16* KS = (bf16*)(ws + A_KS); bf16* VS = (bf16*)(ws + A_VS); bf16* VF = (bf16*)(ws + WS_VF); bf16* TW = (bf16*)(ws + A_TW); bf16* PL = (bf16*)(ws + A_PL);
    unsigned char* Q8 = ws + A_Q; unsigned char* K8 = ws + A_K; unsigned char* Vt8 = ws + A_V;
    const f32x2* rope = (const f32x2*)(ws + WS_ROPE);
    LAS float* v2L = (LAS float*)(lds + RING_OFF);
    LAS float* mpL = (LAS float*)(lds + RING_OFF + 65536); LAS float* mnL = mpL + 1920;
    if (l == 1) { for (int i = tid; i < 32 * 512; i += NTHR) v2L[i] = in[17][i]; }
    LAS float* gqL = mnL + 1920; LAS float* gkL = gqL + 64; LAS float* v0L = gkL + 64;
    for (int i = tid; i < 1920; i += NTHR) { mpL[i] = in[3][(size_t)l * 1920 + i]; mnL[i] = in[4][(size_t)l * 1920 + i]; }
    if (tid < 64) { gqL[tid] = in[20][(size_t)l * 64 + tid]; gkL[tid] = in[21][(size_t)l * 64 + tid]; }
    v0L[tid] = in[15][tid];
    __syncthreads();
    const int gi = lane >> 4, lo = 1 << gi, hi = lo - 1, pcol = COL_POOL + lane * 8;
    const float tw_k = (lane < 16) ? -2.0f * 1.4426950408889634f : -1.4426950408889634f, tw_m = (lane < 16) ? 2.0f : 1.0f, tw_c = (lane < 16) ? -1.0f : 0.0f; const bool tw_id = (lane >= 16 && lane < 32);
    for (int run = gw; run < M / 32; run += NGW) {
        const int t0 = run * 32, s0 = t0 & (SEQ - 1);
        const bf16* row0 = PRJ + (size_t)t0 * NPJ;
        { unsigned char* vrow = Vt8 + ((size_t)((t0 >> 13) * 2 + (lane >> 5)) * 64 + 2 * (lane & 31)) * SEQ + s0;
#pragma unroll
          for (int hf = 0; hf < 2; ++hf) { unsigned w[16];
#pragma unroll
              for (int i = 0; i < 16; ++i) w[i] = *(const unsigned*)(row0 + (size_t)(hf * 16 + i) * NPJ + COL_V + 2 * lane);
              v4u a, b_;
#pragma unroll
              for (int j = 0; j < 4; ++j) {
                  a[j] = pg8::pk4_fp8(__uint_as_float(w[4 * j] << 16), __uint_as_float(w[4 * j + 1] << 16), __uint_as_float(w[4 * j + 2] << 16), __uint_as_float(w[4 * j + 3] << 16));
                  b_[j] = pg8::pk4_fp8(__uint_as_float(w[4 * j] & 0xffff0000u), __uint_as_float(w[4 * j + 1] & 0xffff0000u), __uint_as_float(w[4 * j + 2] & 0xffff0000u), __uint_as_float(w[4 * j + 3] & 0xffff0000u)); }
              *(v4u*)(vrow + hf * 16) = a; *(v4u*)(vrow + SEQ + hf * 16) = b_; } }
        v4u prv[4], cur[4];
#pragma unroll
        for (int j = 0; j < 4; ++j) { const int c8 = lane + 64 * j, col = (c8 < 240 ? c8 : 0) * 8;
            prv[j] = (s0 > 0) ? ld16(row0 - NPJ + col) : (v4u){0u, 0u, 0u, 0u}; cur[j] = ld16(row0 + col); }
        float psum[8]; int pcnt = 0;
#pragma unroll
        for (int i = 0; i < 8; ++i) psum[i] = 0.f;
#pragma unroll
        for (int hf = 0; hf < 2; ++hf) { v4u pw_[8];
#pragma unroll
            for (int q = 0; q < 8; ++q) { const int dd = hf * 8 + q - 8; const bool ok = (dd >= -lo && dd <= hi && s0 + dd >= 0); pw_[q] = ld16(row0 + (long)(ok ? dd : 0) * NPJ + pcol); }
#pragma unroll
            for (int q = 0; q < 8; ++q) asm volatile("" : "+v"(pw_[q]));
#pragma unroll
            for (int q = 0; q < 8; ++q) { const int dd = hf * 8 + q - 8; const bool ok = (dd >= -lo && dd <= hi && s0 + dd >= 0); float x[8]; unp8(pw_[q], x); const float m_ = ok ? 1.0f : 0.0f; pcnt += ok ? 1 : 0;
#pragma unroll
                for (int i = 0; i < 8; ++i) psum[i] += m_ * x[i]; } }
        for (int ti = 0; ti < 32; ++ti) {
            const int t = t0 + ti, s = s0 + ti; const bf16* rowp = row0 + (size_t)ti * NPJ;
            v4u nxt[4];
#pragma unroll
            for (int j = 0; j < 4; ++j) { const int c8 = lane + 64 * j, col = (c8 < 240 ? c8 : 0) * 8; nxt[j] = (s + 1 < SEQ) ? ld16(rowp + NPJ + col) : (v4u){0u, 0u, 0u, 0u}; }
            const v4u pself = ld16(rowp + pcol);
            const bool padd = (s + 1 + hi < SEQ), psub = (s - lo >= 0);
            const v4u pin = padd ? ld16(rowp + (long)(1 + hi) * NPJ + pcol) : (v4u){0u, 0u, 0u, 0u};
            const v4u pout = psub ? ld16(rowp - (long)lo * NPJ + pcol) : (v4u){0u, 0u, 0u, 0u};
            const v4u qraw = ld16(rowp + COL_Q + lane * 8), kraw = ld16(rowp + COL_K + (lane & 15) * 8);
            const f32x4 rp0 = *(const f32x4*)(rope + (size_t)s * 32 + (lane & 7) * 4), rp1 = *(const f32x4*)(rope + (size_t)s * 32 + (lane & 7) * 4 + 2);
            { float self[8], o[8]; unp8(pself, self); const float ic = __builtin_amdgcn_rcpf((float)pcnt);
#pragma unroll
              for (int i = 0; i < 8; ++i) o[i] = psum[i] * ic - self[i];
              st16(PL + (size_t)t * 512 + lane * 8, pk8(o));
              float xin[8], xout[8]; unp8(pin, xin); unp8(pout, xout);
#pragma unroll
              for (int i = 0; i < 8; ++i) psum[i] += xin[i] - xout[i];
              pcnt += (padd ? 1 : 0) - (psub ? 1 : 0); }
            { float x[8], o[8]; const float cs[8] = {rp0[0], rp0[1], rp0[2], rp0[3], rp1[0], rp1[1], rp1[2], rp1[3]};
              unp8(qraw, x);
              float ss = 0.f;
#pragma unroll
              for (int i = 0; i < 8; ++i) ss += x[i] * x[i];
              ss = sum8(ss, lane); const float rms = __builtin_amdgcn_rsqf(ss * (1.0f / 64.0f) + 1e-6f);
#pragma unroll
              for (int i = 0; i < 8; ++i) x[i] = x[i] * rms * gqL[(lane & 7) * 8 + i];
#pragma unroll
              for (int ii = 0; ii < 4; ++ii) { o[2 * ii] = (x[2 * ii] * cs[2 * ii] - x[2 * ii + 1] * cs[2 * ii + 1]) * (C2Q * 16.0f); o[2 * ii + 1] = (x[2 * ii] * cs[2 * ii + 1] + x[2 * ii + 1] * cs[2 * ii]) * (C2Q * 16.0f); }
              *(v2u*)(Q8 + (size_t)t * 1024 + (lane >> 3) * 128 + (lane & 7) * 8) = pk8_e4m3(o);
              unp8(kraw, x);
              ss = 0.f;
#pragma unroll
              for (int i = 0; i < 8; ++i) ss += x[i] * x[i];
              ss = sum8(ss, lane); const float rmk = __builtin_amdgcn_rsqf(ss * (1.0f / 64.0f) + 1e-6f);
#pragma unroll
              for (int i = 0; i < 8; ++i) x[i] = x[i] * rmk * gkL[(lane & 7) * 8 + i];
#pragma unroll
              for (int ii = 0; ii < 4; ++ii) { o[2 * ii] = x[2 * ii] * cs[2 * ii] - x[2 * ii + 1] * cs[2 * ii + 1]; o[2 * ii + 1] = x[2 * ii] * cs[2 * ii + 1] + x[2 * ii + 1] * cs[2 * ii]; }
              if (lane < 16) *(v2u*)(K8 + ((size_t)((t >> 13) * 2 + (lane >> 3)) * SEQ + s) * 64 + (lane & 7) * 8) = pk8_e4m3(o); }
            asm volatile("" ::: "memory");
#pragma unroll
            for (int j = 0; j < 4; ++j) {
                const int c8 = lane + 64 * j, col = c8 * 8;
                if (c8 < 240) {
                    float cu[8], pv[8], nx[8], ps[8];
                    unp8(cur[j], cu); unp8(prv[j], pv); unp8(nxt[j], nx);
                    float a_[8], b_[8]; { const f32x4 m0 = *(const LAS f32x4*)(mpL + col), m1 = *(const LAS f32x4*)(mpL + col + 4), n0 = *(const LAS f32x4*)(mnL + col), n1 = *(const LAS f32x4*)(mnL + col + 4);
                        a_[0] = m0[0]; a_[1] = m0[1]; a_[2] = m0[2]; a_[3] = m0[3]; a_[4] = m1[0]; a_[5] = m1[1]; a_[6] = m1[2]; a_[7] = m1[3]; b_[0] = n0[0]; b_[1] = n0[1]; b_[2] = n0[2]; b_[3] = n0[3]; b_[4] = n1[0]; b_[5] = n1[1]; b_[6] = n1[2]; b_[7] = n1[3]; }
#pragma unroll
                    for (int i = 0; i < 8; ++i) ps[i] = cu[i] + a_[i] * (pv[i] - cu[i]) + b_[i] * (nx[i] - cu[i]);
                    if (j == 0) st16(R + (size_t)t * 512 + col, pk8(ps));
                    else if (j == 1) st16(KS + (size_t)t * 512 + (col - 512), pk8(ps));
                    else if (j == 2) { const int cc = col - 1024;
                        if (l == 0) { const v4u o = pk8(ps); st16(VS + (size_t)t * 512 + cc, o); st16(VF + (size_t)t * 512 + cc, o); }
                        else { float vl[32], mx[8], vf[8];
                            { float t8[8]; unp8(ld16(rowp + COL_VL), t8);
#pragma unroll
                              for (int i = 0; i < 8; ++i) vl[i] = t8[i];
                              unp8(ld16(rowp + COL_VL + 8), t8);
#pragma unroll
                              for (int i = 0; i < 8; ++i) vl[8 + i] = t8[i];
                              unp8(ld16(rowp + COL_VL + 16), t8);
#pragma unroll
                              for (int i = 0; i < 8; ++i) vl[16 + i] = t8[i];
                              unp8(ld16(rowp + COL_VL + 24), t8);
#pragma unroll
                              for (int i = 0; i < 8; ++i) vl[24 + i] = t8[i]; }
                            { const f32x4 z0 = *(const LAS f32x4*)(v0L + cc), z1 = *(const LAS f32x4*)(v0L + cc + 4); mx[0] = z0[0]; mx[1] = z0[1]; mx[2] = z0[2]; mx[3] = z0[3]; mx[4] = z1[0]; mx[5] = z1[1]; mx[6] = z1[2]; mx[7] = z1[3]; }
#pragma unroll
                            for (int k = 0; k < 32; ++k) { const f32x4 w0 = *(const LAS f32x4*)(v2L + k * 512 + cc), w1 = *(const LAS f32x4*)(v2L + k * 512 + cc + 4);
                                mx[0] += vl[k] * w0[0]; mx[1] += vl[k] * w0[1]; mx[2] += vl[k] * w0[2]; mx[3] += vl[k] * w0[3]; mx[4] += vl[k] * w1[0]; mx[5] += vl[k] * w1[1]; mx[6] += vl[k] * w1[2]; mx[7] += vl[k] * w1[3]; }
                            unp8(ld16(VF + (size_t)t * 512 + cc), vf);
#pragma unroll
                            for (int i = 0; i < 8; ++i) ps[i] = ps[i] + (vf[i] - ps[i]) * sigmf(mx[i]);
                            st16(VS + (size_t)t * 512 + cc, pk8(ps)); } }
                    else { float o[8];
#pragma unroll
                        for (int i = 0; i < 8; ++i) { const float x = ps[i];
                            const float sg = __builtin_amdgcn_rcpf(1.0f + __builtin_amdgcn_exp2f(tw_k * __builtin_amdgcn_fmed3f(x, -15.f, 15.f)));
                            const float y = tw_m * sg + tw_c; o[i] = tw_id ? x : y; }
                        st16(TW + (size_t)t * 384 + lane * 8, pk8(o)); }
                }
                prv[j] = cur[j]; cur[j] = nxt[j];
            }
        }
    }
}

__device__ __forceinline__ float dpp_add(float x, float y) { return x + y; }
template <int CTRL> __device__ __forceinline__ float dppx(float x) { return __builtin_bit_cast(float, __builtin_amdgcn_update_dpp(0, __builtin_bit_cast(int, x), CTRL, 0xF, 0xF, true)); }
__device__ __forceinline__ float red16(float x) {
    x += dppx<0xB1>(x);
    x += dppx<0x4E>(x);
    x += dppx<0x141>(x);
    x += dppx<0x140>(x);
    return x;
}
__device__ __forceinline__ void scan_chain(int l, int chain, const float* const* in, unsigned char* ws, LAS unsigned char* lds, int tid, int wave, int lane) {
    const int d = chain >> 6, b = (chain >> 3) & 7, h = chain & 7;
    const bf16* R = (const bf16*)(ws + A_R); const bf16* KS = (const bf16*)(ws + A_KS); const bf16* VS = (const bf16*)(ws + A_VS);
    const bf16* LW = (const bf16*)(ws + A_LW); const bf16* AA = (const bf16*)(ws + A_AA);
    bf16* YS = (bf16*)(ws + (d ? A_YSB : A_YSF)); float* CFB = (float*)(ws + WS_CFB) + (size_t)d * M * 8;
    LAS float* kkL = (LAS float*)(lds + RING_OFF); LAS float* wL = kkL + 4096; LAS float* nbL = wL + 4096; LAS float* kdL = nbL + 4096; LAS float* rL = kdL + 4096; LAS float* vL = rL + 4096; LAS float* yL = vL + 4096;
    const int ps = tid >> 3, pc = tid & 7;
    const int pl = lane >> 4, jg = lane & 15, i0 = 2 * (4 * wave + pl);
    float kkc[8], kac[8], rkc[8];
    ldf8(in[10] + (size_t)l * 512 + h * 64 + pc * 8, kkc); ldf8(in[11] + (size_t)l * 512 + h * 64 + pc * 8, kac); ldf8(in[12] + (size_t)l * 512 + h * 64 + pc * 8, rkc);
    float st[2][4];
#pragma unroll
    for (int r = 0; r < 2; ++r)
#pragma unroll
        for (int j = 0; j < 4; ++j) st[r][j] = 0.f;
    v4u rr, kr, vr, lwr, ar;
    { const int tok = d ? (SEQ - 1 - ps) : ps; const size_t t = (size_t)b * SEQ + tok;
      rr = ld16(R + t * 512 + h * 64 + pc * 8); kr = ld16(KS + t * 512 + h * 64 + pc * 8); vr = ld16(VS + t * 512 + h * 64 + pc * 8);
      lwr = ld16(LW + t * 1024 + d * 512 + h * 64 + pc * 8); ar = ld16(AA + t * 1024 + d * 512 + h * 64 + pc * 8); }
    for (int blk = 0; blk < SEQ / 64; ++blk) {
        const int tokp = d ? (SEQ - 1 - (blk * 64 + ps)) : (blk * 64 + ps); const size_t tp = (size_t)b * SEQ + tokp;
        { float r8[8], k8[8], v8[8], lw8[8], a8[8], kk8[8], o[8];
          unp8(rr, r8); unp8(kr, k8); unp8(vr, v8); unp8(lwr, lw8); unp8(ar, a8);
          float ss = 0.f;
#pragma unroll
          for (int i = 0; i < 8; ++i) { kk8[i] = k8[i] * kkc[i]; ss += kk8[i] * kk8[i]; }
          ss = sum8(ss, lane); const float inv = 1.0f / fmaxf(sqrtf(ss), 1e-12f);
          float cf = 0.f;
#pragma unroll
          for (int i = 0; i < 8; ++i) { kk8[i] *= inv; const float kd = k8[i] * (1.0f + (a8[i] - 1.0f) * kac[i]); cf += r8[i] * kd * rkc[i]; o[i] = kd; }
          cf = sum8(cf, lane); if (pc == 0) CFB[tp * 8 + h] = cf;
          LAS float* p;
          p = kkL + ps * 64 + pc * 8; *(LAS f32x4*)p = (f32x4){kk8[0], kk8[1], kk8[2], kk8[3]}; *(LAS f32x4*)(p + 4) = (f32x4){kk8[4], kk8[5], kk8[6], kk8[7]};
          p = kdL + ps * 64 + pc * 8; *(LAS f32x4*)p = (f32x4){o[0], o[1], o[2], o[3]}; *(LAS f32x4*)(p + 4) = (f32x4){o[4], o[5], o[6], o[7]};
          p = wL + ps * 64 + pc * 8; *(LAS f32x4*)p = (f32x4){__expf(lw8[0]), __expf(lw8[1]), __expf(lw8[2]), __expf(lw8[3])}; *(LAS f32x4*)(p + 4) = (f32x4){__expf(lw8[4]), __expf(lw8[5]), __expf(lw8[6]), __expf(lw8[7])};
          p = nbL + ps * 64 + pc * 8; *(LAS f32x4*)p = (f32x4){-kk8[0] * a8[0], -kk8[1] * a8[1], -kk8[2] * a8[2], -kk8[3] * a8[3]}; *(LAS f32x4*)(p + 4) = (f32x4){-kk8[4] * a8[4], -kk8[5] * a8[5], -kk8[6] * a8[6], -kk8[7] * a8[7]};
          p = rL + ps * 64 + pc * 8; *(LAS f32x4*)p = (f32x4){r8[0], r8[1], r8[2], r8[3]}; *(LAS f32x4*)(p + 4) = (f32x4){r8[4], r8[5], r8[6], r8[7]};
          p = vL + ps * 64 + pc * 8; *(LAS f32x4*)p = (f32x4){v8[0], v8[1], v8[2], v8[3]}; *(LAS f32x4*)(p + 4) = (f32x4){v8[4], v8[5], v8[6], v8[7]}; }
        __syncthreads();
        if (blk + 1 < SEQ / 64) { const int tok = d ? (SEQ - 1 - ((blk + 1) * 64 + ps)) : ((blk + 1) * 64 + ps); const size_t t = (size_t)b * SEQ + tok;
            rr = ld16(R + t * 512 + h * 64 + pc * 8); kr = ld16(KS + t * 512 + h * 64 + pc * 8); vr = ld16(VS + t * 512 + h * 64 + pc * 8);
            lwr = ld16(LW + t * 1024 + d * 512 + h * 64 + pc * 8); ar = ld16(AA + t * 1024 + d * 512 + h * 64 + pc * 8); }
#pragma unroll 2
        for (int s = 0; s < 64; ++s) {
            const f32x4 kk4 = *(const LAS f32x4*)(kkL + s * 64 + jg * 4), w4 = *(const LAS f32x4*)(wL + s * 64 + jg * 4), nb4 = *(const LAS f32x4*)(nbL + s * 64 + jg * 4);
            const f32x4 kd4 = *(const LAS f32x4*)(kdL + s * 64 + jg * 4), r4 = *(const LAS f32x4*)(rL + s * 64 + jg * 4);
            const f32x2 v2 = *(const LAS f32x2*)(vL + s * 64 + i0);
            float y[2];
#pragma unroll
            for (int r = 0; r < 2; ++r) {
                float dq = (st[r][0] * kk4[0] + st[r][1] * kk4[1]) + (st[r][2] * kk4[2] + st[r][3] * kk4[3]);
                dq = red16(dq);
                const float vv = v2[r];
#pragma unroll
                for (int j = 0; j < 4; ++j) st[r][j] = st[r][j] * w4[j] + dq * nb4[j] + vv * kd4[j];
                float yq = (st[r][0] * r4[0] + st[r][1] * r4[1]) + (st[r][2] * r4[2] + st[r][3] * r4[3]);
                y[r] = red16(yq);
            }
            if (jg == 0) *(LAS f32x2*)(yL + s * 64 + i0) = (f32x2){y[0], y[1]};
        }
        __syncthreads();
        { const LAS float* p = yL + ps * 64 + pc * 8; const f32x4 a = *(const LAS f32x4*)p, c = *(const LAS f32x4*)(p + 4);
          v4u o; o.x = pk2(a[0], a[1]); o.y = pk2(a[2], a[3]); o.z = pk2(c[0], c[1]); o.w = pk2(c[2], c[3]);
          st16(YS + tp * 512 + h * 64 + pc * 8, o); }
    }
    __syncthreads();
}

__device__ __forceinline__ void p6a_rows(int l, const float* const* in, unsigned char* ws, int gw, int NGW, int lane) {
    const bf16* YSF = (const bf16*)(ws + A_YSF); const bf16* YSB = (const bf16*)(ws + A_YSB); const bf16* VS = (const bf16*)(ws + A_VS); const bf16* Gb = (const bf16*)(ws + A_G);
    const float* CFB = (const float*)(ws + WS_CFB); bf16* YA = (bf16*)(ws + A_YA);
    float lw[8], lb[8]; ldf8(in[13] + (size_t)l * 512 + lane * 8, lw); ldf8(in[14] + (size_t)l * 512 + lane * 8, lb);
    const int head = lane >> 3;
    for (int t0 = gw; t0 < M; t0 += 4 * NGW) {
        v4u ra[4], rb_[4], rv[4], rg[4]; float cfa[4], cfb[4];
#pragma unroll
        for (int q = 0; q < 4; ++q) { const size_t t = (size_t)(t0 + q * NGW);
            ra[q] = ld16(YSF + t * 512 + lane * 8); rb_[q] = ld16(YSB + t * 512 + lane * 8); rv[q] = ld16(VS + t * 512 + lane * 8); rg[q] = ld16(Gb + t * 512 + lane * 8);
            cfa[q] = CFB[t * 8 + head]; cfb[q] = CFB[((size_t)M + t) * 8 + head]; }
#pragma unroll
        for (int q = 0; q < 4; ++q) { const size_t t = (size_t)(t0 + q * NGW);
            float yf[8], yb[8], v[8], g[8], o[8];
            unp8(ra[q], yf); unp8(rb_[q], yb); unp8(rv[q], v); unp8(rg[q], g);
            const float cf = cfa[q] + cfb[q];
            float sm = 0.f;
#pragma unroll
            for (int i = 0; i < 8; ++i) { yf[i] += yb[i]; sm += yf[i]; }
            const float mu = sum8(sm, lane) * (1.0f / 64.0f); float sq = 0.f;
#pragma unroll
            for (int i = 0; i < 8; ++i) { yf[i] -= mu; sq += yf[i] * yf[i]; }
            const float rs = __builtin_amdgcn_rsqf(sum8(sq, lane) * (1.0f / 64.0f) + 64e-5f);
#pragma unroll
            for (int i = 0; i < 8; ++i) o[i] = (yf[i] * rs * lw[i] + lb[i] + cf * v[i]) * g[i];
            st16(YA + t * 512 + lane * 8, pk8(o)); }
    }
}

__device__ __forceinline__ void p8_router(int l, const float* const* in, const float* X, unsigned char* ws, LAS unsigned char* lds, int gw, int NGW, int tid, int lane) {
    LAS bf16* Bh = (LAS bf16*)(lds + RING_OFF); LAS bf16* Bl = Bh + 32 * 64 * 8;
    LAS float* gL = (LAS float*)(lds + RING_OFF + 65536);
    const float* rw = in[27] + (size_t)l * DMODEL * NEXP; const float* gain = in[26] + (size_t)l * DMODEL;
    for (int i = tid; i < 32 * 64; i += NTHR) { const int kk = i >> 6, ln = i & 63, e = ln & 15, kg_ = ln >> 4; float hi8[8], lo8[8];
#pragma unroll
        for (int j = 0; j < 8; ++j) { const int k = 32 * kk + 8 * kg_ + j; const float w = rw[(size_t)k * NEXP + e] * gain[k]; const float wh = __uint_as_float(f2bf(w) << 16); hi8[j] = wh; lo8[j] = w - wh; }
        *(LAS v4u*)(Bh + i * 8) = pk8(hi8); *(LAS v4u*)(Bl + i * 8) = pk8(lo8); }
    for (int i = tid; i < DMODEL; i += NTHR) gL[i] = gain[i];
    __syncthreads();
    unsigned char* HN2 = ws + A_HN; float* AFFT = (float*)(ws + WS_AFFT);
    typedef short bf16x8_t __attribute__((ext_vector_type(8)));
    const int m = lane & 15, kg = lane >> 4;
    for (int tr = gw; tr < M / 16; tr += NGW) {
        const int t0 = tr * 16; const bf16* xrow = (const bf16*)X + (size_t)(t0 + m) * XBP + 8 * kg;
        f32x4 D = {0.f, 0.f, 0.f, 0.f}; float ss = 0.f;
#define P8_LD(XB_, c_) do { _Pragma("unroll") for (int q = 0; q < 8; ++q) XB_[q] = ld16(xrow + 32 * (8 * (c_) + q)); } while (0)
#define P8_MM(XB_, c_) do { _Pragma("unroll") for (int q = 0; q < 8; ++q) { const int kk = 8 * (c_) + q; const bf16x8_t a = __builtin_bit_cast(bf16x8_t, XB_[q]); \
                const bf16x8_t bh = *(const LAS bf16x8_t*)(Bh + (kk * 64 + lane) * 8), bl = *(const LAS bf16x8_t*)(Bl + (kk * 64 + lane) * 8); \
                D = __builtin_amdgcn_mfma_f32_16x16x32_bf16(a, bh, D, 0, 0, 0); D = __builtin_amdgcn_mfma_f32_16x16x32_bf16(a, bl, D, 0, 0, 0); \
                float x[8]; unp8(XB_[q], x); _Pragma("unroll") for (int j = 0; j < 8; ++j) ss += x[j] * x[j]; } } while (0)
#define P8_HN(XB_, c_) do { _Pragma("unroll") for (int q = 0; q < 8; ++q) { const int kk = 8 * (c_) + q; float x[8]; unp8(XB_[q], x); const f32x4 g0 = *(const LAS f32x4*)(gL + 32 * kk + 8 * kg), g1 = *(const LAS f32x4*)(gL + 32 * kk + 8 * kg + 4); \
                x[0] *= rstd * g0[0]; x[1] *= rstd * g0[1]; x[2] *= rstd * g0[2]; x[3] *= rstd * g0[3]; x[4] *= rstd * g1[0]; x[5] *= rstd * g1[1]; x[6] *= rstd * g1[2]; x[7] *= rstd * g1[3]; \
                *(v2u*)(hrow + 32 * kk) = pk8_e4m3(x); } } while (0)
        v4u xa[8], xb[8];
        P8_LD(xa, 0);
#pragma nounroll
        for (int c = 0; c < 4; c += 2) { P8_LD(xb, c + 1); P8_MM(xa, c); if (c + 2 < 4) P8_LD(xa, c + 2); else P8_LD(xa, 0); P8_MM(xb, c + 1); }
        ss = sum_rows(ss);
        const float rstd = __builtin_amdgcn_rsqf(ss * (1.0f / DMODEL) + 1e-6f);
        unsigned char* hrow = HN2 + (size_t)(t0 + m) * DMODEL + 8 * kg;
#pragma nounroll
        for (int c = 0; c < 4; c += 2) { P8_LD(xb, c + 1); P8_HN(xa, c); if (c + 2 < 4) P8_LD(xa, c + 2); P8_HN(xb, c + 1); }
#undef P8_LD
#undef P8_MM
#undef P8_HN
        f32x4 aff;
#pragma unroll
        for (int r = 0; r < 4; ++r) { const float rs = shx_from(rstd, 4 * kg + r, lane); const float lg = D[r] * rs; float mx = lg;
#pragma unroll
            for (int o = 0; o < 1; ++o) mx = max16(mx);
            const float ex = __expf(lg - mx); float se = ex;
#pragma unroll
            for (int o = 0; o < 1; ++o) se = sum16(se);
            aff[r] = ex * __builtin_amdgcn_rcpf(se); }
        const int b = t0 / SEQ, s0 = t0 & (SEQ - 1);
        *(f32x4*)(AFFT + ((size_t)(b * NEXP + m)) * SEQ + s0 + 4 * kg) = aff;
    }
    __syncthreads();
}

__device__ __forceinline__ int block_sum_i(int v, LAS int* tmp, int wave, int lane) {
#pragma unroll
    for (int o = 1; o < 64; o <<= 1) v += shxi(v, o, lane);
    if (lane == 0) tmp[wave] = v;
    __syncthreads();
    int tot = 0;
#pragma unroll
    for (int i = 0; i < NWAVES; ++i) tot += tmp[i];
    __syncthreads();
    return tot;
}
__device__ __forceinline__ int block_excl_scan_i(int v, LAS int* tmp, int wave, int lane) {
    int inc = v;
#pragma unroll
    for (int o = 1; o < 64; o <<= 1) { const int t = shupi(inc, o, lane); if (lane >= o) inc += t; }
    if (lane == 63) tmp[wave] = inc;
    __syncthreads();
    int base = 0;
#pragma unroll
    for (int i = 0; i < NWAVES; ++i) { const int x = tmp[i]; if (i < wave) base += x; }
    __syncthreads();
    return base + inc - v;
}
__device__ __forceinline__ void p9_topk(int be, unsigned char* ws, LAS unsigned char* lds, int tid, int wave, int lane) {
    const float* AFFT = (const float*)(ws + WS_AFFT) + (size_t)be * SEQ; int* IDX = (int*)(ws + WS_IDX) + (size_t)be * CAP; float* VAL = (float*)(ws + WS_VAL) + (size_t)be * CAP;
    int* INV = (int*)(ws + WS_INV); const int b = be / NEXP, e = be - b * NEXP;
    LAS int* tmp = (LAS int*)(lds + RING_OFF);
    unsigned key[16];
#pragma unroll
    for (int q = 0; q < 4; ++q) { const v4u w = *(const v4u*)(AFFT + tid * 16 + q * 4); key[4 * q] = w.x; key[4 * q + 1] = w.y; key[4 * q + 2] = w.z; key[4 * q + 3] = w.w; }
    unsigned T = 0u;
#pragma nounroll
    for (int bit = 30; bit >= 0; --bit) { const unsigned cand = T | (1u << bit); int c = 0;
#pragma unroll
        for (int i = 0; i < 16; ++i) c += (key[i] >= cand) ? 1 : 0;
        if (block_sum_i(c, tmp, wave, lane) >= CAP) T = cand; }
    int ngt = 0, neq = 0;
#pragma unroll
    for (int i = 0; i < 16; ++i) { ngt += (key[i] > T) ? 1 : 0; neq += (key[i] == T) ? 1 : 0; }
    const int need = CAP - block_sum_i(ngt, tmp, wave, lane);
    const int eqb = block_excl_scan_i(neq, tmp, wave, lane);
    int take = need - eqb; take = take < 0 ? 0 : (take > neq ? neq : take);
    int pos = block_excl_scan_i(ngt + take, tmp, wave, lane);
    int er = eqb;
#pragma unroll
    for (int i = 0; i < 16; ++i) { const int s = tid * 16 + i; bool sel = key[i] > T; if (key[i] == T) { sel = er < need; ++er; }
        int w = -1; if (sel) { IDX[pos] = s; VAL[pos] = __uint_as_float(key[i]); w = pos; ++pos; }
        INV[((size_t)b * SEQ + s) * NEXP + e] = w; }
}

__device__ __forceinline__ void p10_gather(unsigned char* ws, int gw, int NGW, int lane) {
    const bf16* HN2 = (const bf16*)(ws + A_HN); bf16* XG = (bf16*)(ws + A_XG); const int* IDX = (const int*)(ws + WS_IDX);
    for (int r = gw; r < MR; r += NGW) { const int b = r / (NEXP * CAP); const int tok = IDX[r];
        const v4u* src = (const v4u*)(HN2 + ((size_t)b * SEQ + tok) * DMODEL); v4u* dst = (v4u*)(XG + (size_t)r * DMODEL);
        const v4u a = src[lane], c = src[lane + 64]; dst[lane] = a; dst[lane + 64] = c; }
}

namespace cs {
typedef short bf16x8 __attribute__((ext_vector_type(8)));
typedef short s16x4 __attribute__((ext_vector_type(4)));
typedef float f32x16 __attribute__((ext_vector_type(16)));
constexpr int LWL = 0;
constexpr int CH0 = 16384, CH_STRIDE = 20992;
constexpr int O_QR = 0, O_BK = 4608, O_BH = 9216, O_KH = 11520, O_V = 13824, O_QH = 16128, O_XX = 18432, O_BNK = 19584, O_GC = 20736;
constexpr int P144 = 72, P72 = 36;
constexpr int YL0 = CH0 + 4 * CH_STRIDE;
static_assert(YL0 + 64 * 144 <= RING_BYTES, "chunk-scan LDS map");
__device__ __forceinline__ int crow(int reg, int h) { return (reg & 3) + 8 * (reg >> 2) + 4 * h; }
__device__ __forceinline__ bf16x8 ld8(const LAS bf16* p) { const s16x4 lo = *(const LAS s16x4*)p, hi = *(const LAS s16x4*)(p + 8); return __builtin_shufflevector(lo, hi, 0, 1, 2, 3, 4, 5, 6, 7); }
__device__ __forceinline__ bf16x8 ld8c(const LAS bf16* p) { const s16x4 lo = *(const LAS s16x4*)p, hi = *(const LAS s16x4*)(p + 4); return __builtin_shufflevector(lo, hi, 0, 1, 2, 3, 4, 5, 6, 7); }
template <bool PERM> __device__ __forceinline__ bf16x8 ldcol(const LAS bf16* p, int h) {
    const LAS bf16* q = p + (PERM ? 4 * h : 8 * h) * P144;
    unsigned e[8];
#pragma unroll
    for (int jj = 0; jj < 8; ++jj) e[jj] = q[((PERM && jj >= 4) ? jj + 4 : jj) * P144];
    v4u w; w.x = e[0] | (e[1] << 16); w.y = e[2] | (e[3] << 16); w.z = e[4] | (e[5] << 16); w.w = e[6] | (e[7] << 16);
    return __builtin_bit_cast(bf16x8, w); }
typedef short v4i16_tr_t __attribute__((ext_vector_type(4)));
template <bool PERM> __device__ __forceinline__ bf16x8 ldcol_tr(const LAS bf16* p0, int r, int h) {
    const int i = r & 15, q = i >> 2, pp = i & 3;
    const LAS bf16* a = p0 + ((PERM ? 4 * h : 8 * h) + q) * P144 + (r & 16) + 4 * pp;
    const s16x4 lo = __builtin_bit_cast(s16x4, __builtin_amdgcn_ds_read_tr16_b64_v4i16((LAS v4i16_tr_t*)a));
    const s16x4 hi = __builtin_bit_cast(s16x4, __builtin_amdgcn_ds_read_tr16_b64_v4i16((LAS v4i16_tr_t*)(a + (PERM ? 8 : 4) * P144)));
    return __builtin_shufflevector(lo, hi, 0, 1, 2, 3, 4, 5, 6, 7); }
__device__ __forceinline__ bf16x8 pack8r(const f32x16& x, int s) {
    v4u p; p.x = pg8::cvt_pk_bf16(x[8 * s], x[8 * s + 1]); p.y = pg8::cvt_pk_bf16(x[8 * s + 2], x[8 * s + 3]); p.z = pg8::cvt_pk_bf16(x[8 * s + 4], x[8 * s + 5]); p.w = pg8::cvt_pk_bf16(x[8 * s + 6], x[8 * s + 7]);
    return __builtin_bit_cast(bf16x8, p); }
#define CS_SYNC() do { asm volatile("s_waitcnt lgkmcnt(0)" ::: "memory"); __builtin_amdgcn_s_barrier(); asm volatile("" ::: "memory"); } while (0)
#define CS_MFMA(a, b, c) __builtin_amdgcn_mfma_f32_32x32x16_bf16((a), (b), (c), 0, 0, 0)
}
__device__ __forceinline__ void scan_chain_chunked(int l, int chain, const float* const* in, unsigned char* ws, LAS unsigned char* lds, int tid, int wave, int lane) {
    using namespace cs;
    const int d = chain >> 6, b = (chain >> 3) & 7, hd = chain & 7;
    const bf16* R = (const bf16*)(ws + A_R); const bf16* KS = (const bf16*)(ws + A_KS); const bf16* VS = (const bf16*)(ws + A_VS);
    const bf16* LW = (const bf16*)(ws + A_LW); const bf16* AA = (const bf16*)(ws + A_AA);
    bf16* YS = (bf16*)(ws + (d ? A_YSB : A_YSF)); float* CFB = (float*)(ws + WS_CFB) + (size_t)d * M * 8;
    LAS float* lwL = (LAS float*)(lds + RING_OFF + LWL);
    const int ps0 = tid >> 3, pc0 = tid & 7;
    const int r0 = lane & 31, h0 = lane >> 5;
    const float* kkcp = in[10] + (size_t)l * 512 + hd * 64; const float* kacp = in[11] + (size_t)l * 512 + hd * 64; const float* rkcp = in[12] + (size_t)l * 512 + hd * 64;
    f32x16 st0, st1;
#pragma unroll
    for (int i = 0; i < 16; ++i) { st0[i] = 0.f; st1[i] = 0.f; }
    v4u rr, kr, vr, lwr, ar;
    { const int tok = d ? (SEQ - 1 - ps0) : ps0; const size_t t = (size_t)b * SEQ + tok;
      rr = ld16(R + t * 512 + hd * 64 + pc0 * 8); kr = ld16(KS + t * 512 + hd * 64 + pc0 * 8); vr = ld16(VS + t * 512 + hd * 64 + pc0 * 8);
      lwr = ld16(LW + t * 1024 + d * 512 + hd * 64 + pc0 * 8); ar = ld16(AA + t * 1024 + d * 512 + hd * 64 + pc0 * 8); }
    for (int blk = 0; blk < SEQ / 64; ++blk) {
        int ps = ps0, pc = pc0, r = r0, h = h0; asm volatile("" : "+v"(ps), "+v"(pc), "+v"(r), "+v"(h));
        const int ch = ps >> 4, sl = ps & 15;

        const int tokp = d ? (SEQ - 1 - (blk * 64 + ps)) : (blk * 64 + ps); const size_t tp = (size_t)b * SEQ + tokp;
        LAS unsigned char* cbase = lds + RING_OFF + CH0 + ch * CH_STRIDE;
        if (blk > 0) { const int tl = (blk - 1) * 64 + ps; const int tok = d ? (SEQ - 1 - tl) : tl;
            const v4u yv = *(const LAS v4u*)((const LAS bf16*)(lds + RING_OFF + YL0) + ps * P144 + pc * 8); st16(YS + ((size_t)b * SEQ + tok) * 512 + hd * 64 + pc * 8, yv); }
        float r8[8], k8[8], v8[8], lw8[8], a8[8], kk8[8], kd8[8], nb8[8], kkc[8], kac[8], rkc[8];
        ldf8(kkcp + pc * 8, kkc); ldf8(kacp + pc * 8, kac); ldf8(rkcp + pc * 8, rkc);
        unp8(rr, r8); unp8(kr, k8); unp8(vr, v8); unp8(lwr, lw8); unp8(ar, a8); const v4u vraw_ = vr; (void)v8;
        { float ss = 0.f;
#pragma unroll
          for (int i = 0; i < 8; ++i) { kk8[i] = k8[i] * kkc[i]; ss += kk8[i] * kk8[i]; }
          ss = sum8(ss, lane); const float inv = 1.0f / fmaxf(sqrtf(ss), 1e-12f);
          float cf = 0.f;
#pragma unroll
          for (int i = 0; i < 8; ++i) { kk8[i] *= inv; kd8[i] = k8[i] * (1.0f + (a8[i] - 1.0f) * kac[i]); cf += r8[i] * kd8[i] * rkc[i]; nb8[i] = -kk8[i] * a8[i]; }
          cf = sum8(cf, lane); if (pc == 0) CFB[tp * 8 + hd] = cf; }
        { LAS float* p = lwL + ps * 64 + pc * 8; *(LAS f32x4*)p = (f32x4){lw8[0], lw8[1], lw8[2], lw8[3]}; *(LAS f32x4*)(p + 4) = (f32x4){lw8[4], lw8[5], lw8[6], lw8[7]}; }
        CS_SYNC();
        if (blk + 1 < SEQ / 64) { const int tok = d ? (SEQ - 1 - ((blk + 1) * 64 + ps)) : ((blk + 1) * 64 + ps); const size_t t = (size_t)b * SEQ + tok;
            rr = ld16(R + t * 512 + hd * 64 + pc * 8); kr = ld16(KS + t * 512 + hd * 64 + pc * 8); vr = ld16(VS + t * 512 + hd * 64 + pc * 8);
            lwr = ld16(LW + t * 1024 + d * 512 + hd * 64 + pc * 8); ar = ld16(AA + t * 1024 + d * 512 + hd * 64 + pc * 8); }
        { float Lex[8], Lt[8];
#pragma unroll
          for (int i = 0; i < 8; ++i) { Lex[i] = 0.f; Lt[i] = 0.f; }
#pragma unroll 4
          for (int u = 0; u < 16; ++u) { const LAS float* p = lwL + (ch * 16 + u) * 64 + pc * 8; const f32x4 x0 = *(const LAS f32x4*)p, x1 = *(const LAS f32x4*)(p + 4);
              const float m = (u < sl) ? 1.0f : 0.0f;
#pragma unroll
              for (int i = 0; i < 4; ++i) { Lt[i] += x0[i]; Lt[4 + i] += x1[i]; Lex[i] += m * x0[i]; Lex[4 + i] += m * x1[i]; } }
          LAS bf16* QRp = (LAS bf16*)(cbase + O_QR); LAS bf16* BKp = (LAS bf16*)(cbase + O_BK);
          float Lin[8], tmp[8], tm2[8];
#pragma unroll
          for (int i = 0; i < 8; ++i) { Lin[i] = Lex[i] + lw8[i]; tmp[i] = kk8[i] * __expf(Lex[i]); }
          *(LAS v4u*)(QRp + sl * P144 + pc * 8) = pk8(tmp);
          asm volatile("" ::: "memory");
#pragma unroll
          for (int i = 0; i < 8; ++i) tmp[i] = r8[i] * __expf(Lin[i]);
          *(LAS v4u*)(QRp + (16 + sl) * P144 + pc * 8) = pk8(tmp);
          asm volatile("" ::: "memory");
#pragma unroll
          for (int i = 0; i < 8; ++i) { const float ig = __expf(-Lin[i]); tmp[i] = nb8[i] * ig; tm2[i] = kd8[i] * ig; }
          *(LAS v4u*)(BKp + sl * P144 + pc * 8) = pk8(tmp); *(LAS v4u*)(BKp + (16 + sl) * P144 + pc * 8) = pk8(tm2);
          asm volatile("" ::: "memory");
#pragma unroll
          for (int i = 0; i < 8; ++i) { const float igc = __expf(Lt[i] - Lin[i]); tmp[i] = nb8[i] * igc; tm2[i] = kd8[i] * igc; }
          *(LAS v4u*)((LAS bf16*)(cbase + O_BH) + sl * P144 + pc * 8) = pk8(tmp); *(LAS v4u*)((LAS bf16*)(cbase + O_KH) + sl * P144 + pc * 8) = pk8(tm2);
          *(LAS v4u*)((LAS bf16*)(cbase + O_V) + sl * P144 + pc * 8) = vraw_;
          if (sl == 15) { LAS float* gp = (LAS float*)(cbase + O_GC) + pc * 8; *(LAS f32x4*)gp = (f32x4){__expf(Lt[0]), __expf(Lt[1]), __expf(Lt[2]), __expf(Lt[3])}; *(LAS f32x4*)(gp + 4) = (f32x4){__expf(Lt[4]), __expf(Lt[5]), __expf(Lt[6]), __expf(Lt[7])}; } }
        CS_SYNC();
#ifndef CS_NO_A
#ifndef CS_REP_A
#define CS_REP_A 1
#endif
        for (int repa_ = 0; repa_ < CS_REP_A; ++repa_) if (wave < 4) {
            LAS unsigned char* cb = lds + RING_OFF + CH0 + wave * CH_STRIDE;
            const LAS bf16* QRp = (const LAS bf16*)(cb + O_QR); const LAS bf16* BKp = (const LAS bf16*)(cb + O_BK); LAS float* AD = (LAS float*)(cb + O_BK);
            f32x16 D;
#pragma unroll
            for (int i = 0; i < 16; ++i) D[i] = 0.f;
#pragma unroll
            for (int ks = 0; ks < 4; ++ks) { const bf16x8 A = *(const LAS bf16x8*)(QRp + r * P144 + ks * 16 + h * 8), B = *(const LAS bf16x8*)(BKp + r * P144 + ks * 16 + h * 8); D = CS_MFMA(A, B, D); }
            asm volatile("s_waitcnt lgkmcnt(0)" ::: "memory");
            LAS float* AnT = (LAS float*)(cb + O_QH);
#pragma unroll
            for (int i = 0; i < 16; ++i) { const int row = crow(i, h), s_ = row & 15, u_ = r & 15; const bool keep = (i < 8) ? (u_ < s_) : (u_ <= s_); const float v = keep ? D[i] : 0.f;
                AD[row * 32 + r] = v; if (i < 8) AnT[r * 16 + row] = v; }
            asm volatile("s_waitcnt lgkmcnt(0)" ::: "memory");
            float x[16];
#pragma unroll
            for (int t = 0; t < 16; ++t) { const float ldv = AD[t * 32 + r]; x[t] = (r < 16) ? ((t == r) ? 1.0f : 0.0f) : ldv; }
#pragma unroll
            for (int s = 0; s < 15; ++s) { const f32x4 a0 = *(const LAS f32x4*)(AnT + s * 16), a1 = *(const LAS f32x4*)(AnT + s * 16 + 4), a2 = *(const LAS f32x4*)(AnT + s * 16 + 8), a3 = *(const LAS f32x4*)(AnT + s * 16 + 12);
                const float an[16] = {a0[0], a0[1], a0[2], a0[3], a1[0], a1[1], a1[2], a1[3], a2[0], a2[1], a2[2], a2[3], a3[0], a3[1], a3[2], a3[3]};
                const float xs = x[s];
#pragma unroll
                for (int t = 0; t < 16; ++t) if (t > s) x[t] += an[t] * xs; }
            LAS bf16* XXp = (LAS bf16*)(cb + O_XX);
            if (h == 0) {
#pragma unroll
                for (int s = 0; s < 16; ++s) XXp[s * P72 + r] = (bf16)f2bf(x[s]); }
            { const int s = lane >> 2, c8 = (lane & 3) * 8; const LAS float* ap = AD + (16 + s) * 32 + c8; const f32x4 y0 = *(const LAS f32x4*)ap, y1 = *(const LAS f32x4*)(ap + 4);
              LAS v2u* bp = (LAS v2u*)((LAS bf16*)(cb + O_BNK) + s * P72 + c8); bp[0] = (v2u){pk2(y0[0], y0[1]), pk2(y0[2], y0[3])}; bp[1] = (v2u){pk2(y1[0], y1[1]), pk2(y1[2], y1[3])}; }
            asm volatile("s_waitcnt lgkmcnt(0)" ::: "memory");
            { LAS bf16* QHp = (LAS bf16*)(cb + O_QH);
              const bf16x8 A = ld8c(XXp + (r & 15) * P72 + 8 * h);
#pragma unroll
              for (int ct = 0; ct < 2; ++ct) { const bf16x8 B = ldcol<false>(QRp + 32 * ct + r, h); f32x16 z;
#pragma unroll
                  for (int i = 0; i < 16; ++i) z[i] = 0.f;
                  z = CS_MFMA(A, B, z);
#pragma unroll
                  for (int i = 0; i < 8; ++i) QHp[crow(i, h) * P144 + 32 * ct + r] = (bf16)f2bf(z[i]); } }
        }
#endif
        CS_SYNC();
#ifndef CS_NO_B
        if (wave < 2) {
            const int c0 = 32 * wave;
#pragma unroll 1
            for (int cc = 0; cc < 4; ++cc) {
                LAS unsigned char* cb = lds + RING_OFF + CH0 + cc * CH_STRIDE;
                const LAS bf16* QRp = (const LAS bf16*)(cb + O_QR); const LAS bf16* QHp = (const LAS bf16*)(cb + O_QH); const LAS bf16* XXp = (const LAS bf16*)(cb + O_XX); const LAS bf16* BNp = (const LAS bf16*)(cb + O_BNK);
                const LAS bf16* Vp = (const LAS bf16*)(cb + O_V); const LAS bf16* BHp = (const LAS bf16*)(cb + O_BH); const LAS bf16* KHp = (const LAS bf16*)(cb + O_KH); const LAS float* GCp = (const LAS float*)(cb + O_GC);
                const int ra = (r & 15) * P144 + 4 * h, rb = (16 + (r & 15)) * P144 + 4 * h, rx = (r & 15) * P72 + 4 * h;
                const bf16x8 qh0 = ld8(QHp + ra), qh1 = ld8(QHp + ra + 16), qh2 = ld8(QHp + ra + 32), qh3 = ld8(QHp + ra + 48);
                const bf16x8 taf = ld8(XXp + rx + 16), vf = ldcol<true>(Vp + c0 + r, h);
                const bf16x8 sb00 = pack8r(st0, 0), sb01 = pack8r(st0, 1), sb10 = pack8r(st1, 0), sb11 = pack8r(st1, 1);
                f32x16 dq;
#pragma unroll
                for (int i = 0; i < 16; ++i) dq[i] = 0.f;
                dq = CS_MFMA(qh0, sb00, dq); dq = CS_MFMA(qh1, sb01, dq); dq = CS_MFMA(qh2, sb10, dq); dq = CS_MFMA(qh3, sb11, dq); dq = CS_MFMA(taf, vf, dq);
                const bf16x8 kh0 = ldcol<true>(KHp + r, h), kh1 = ldcol<true>(KHp + 32 + r, h), bh0 = ldcol<true>(BHp + r, h), bh1 = ldcol<true>(BHp + 32 + r, h);
                { f32x16 acc0, acc1;
#pragma unroll
                  for (int g = 0; g < 4; ++g) { const f32x4 ga = *(const LAS f32x4*)(GCp + 8 * g + 4 * h), gb = *(const LAS f32x4*)(GCp + 32 + 8 * g + 4 * h);
                      acc0[4 * g] = st0[4 * g] * ga[0]; acc0[4 * g + 1] = st0[4 * g + 1] * ga[1]; acc0[4 * g + 2] = st0[4 * g + 2] * ga[2]; acc0[4 * g + 3] = st0[4 * g + 3] * ga[3];
                      acc1[4 * g] = st1[4 * g] * gb[0]; acc1[4 * g + 1] = st1[4 * g + 1] * gb[1]; acc1[4 * g + 2] = st1[4 * g + 2] * gb[2]; acc1[4 * g + 3] = st1[4 * g + 3] * gb[3]; }
                  acc0 = CS_MFMA(kh0, vf, acc0); acc1 = CS_MFMA(kh1, vf, acc1);
                  const bf16x8 dqb = pack8r(dq, 0);
                  acc0 = CS_MFMA(bh0, dqb, acc0); acc1 = CS_MFMA(bh1, dqb, acc1);
                  st0 = acc0; st1 = acc1;
                  f32x16 y;
#pragma unroll
                  for (int i = 0; i < 16; ++i) y[i] = 0.f;
                  y = CS_MFMA(ld8(QRp + rb), sb00, y); y = CS_MFMA(ld8(QRp + rb + 16), sb01, y); y = CS_MFMA(ld8(QRp + rb + 32), sb10, y); y = CS_MFMA(ld8(QRp + rb + 48), sb11, y);
                  y = CS_MFMA(ld8(BNp + rx + 16), vf, y); y = CS_MFMA(ld8(BNp + rx), dqb, y);
                  { LAS bf16* YLp = (LAS bf16*)(lds + RING_OFF + YL0) + (cc * 16) * P144 + c0 + r;
#pragma unroll
                    for (int i = 0; i < 8; i += 2) { const unsigned w = pg8::cvt_pk_bf16(y[i], y[i + 1]); YLp[crow(i, h) * P144] = (bf16)(w & 0xffffu); YLp[crow(i + 1, h) * P144] = (bf16)(w >> 16); } } }
            }
        }
#endif
        CS_SYNC();
    }
    { const int tl = (SEQ / 64 - 1) * 64 + ps0; const int tok = d ? (SEQ - 1 - tl) : tl;
      const v4u yv = *(const LAS v4u*)((const LAS bf16*)(lds + RING_OFF + YL0) + ps0 * P144 + pc0 * 8); st16(YS + ((size_t)b * SEQ + tok) * 512 + hd * 64 + pc0 * 8, yv); }
    CS_SYNC();
}

namespace cp {
constexpr int REG = 16384;
constexpr int O_QR = 0, O_BK = 4608, O_V = 9216, O_QH = 11520, O_XX = 13824, O_BNK = 14976, O_GC = 16128;
constexpr int AD0 = 6 * REG, LW0 = AD0 + 8192, YL0 = LW0 + 16384;
static_assert(YL0 + 8192 <= RING_BYTES, "pipelined chunk-scan LDS map");
}
__device__ __forceinline__ void scan_chain_pipe(int l, int chain, const float* const* in, unsigned char* ws, LAS unsigned char* lds, int tid, int wave, int lane) {
    using namespace cs;
    const int d = chain >> 6, b = (chain >> 3) & 7, hd = chain & 7;
    const bf16* R = (const bf16*)(ws + A_R); const bf16* KS = (const bf16*)(ws + A_KS); const bf16* VS = (const bf16*)(ws + A_VS);
    const bf16* LW = (const bf16*)(ws + A_LW); const bf16* AA = (const bf16*)(ws + A_AA);
    bf16* YS = (bf16*)(ws + (d ? A_YSB : A_YSF)); float* CFB = (float*)(ws + WS_CFB) + (size_t)d * M * 8;
    LAS unsigned char* ring = lds + RING_OFF;
    constexpr int NB = SEQ / 32;
    const bool isprep = wave >= 4;
    const int ps0 = (tid & 255) >> 3, pc0 = tid & 7, r0 = lane & 31, h0 = lane >> 5;
    const float* kkcp = in[10] + (size_t)l * 512 + hd * 64; const float* kacp = in[11] + (size_t)l * 512 + hd * 64; const float* rkcp = in[12] + (size_t)l * 512 + hd * 64;
    f32x16 st0, st1;
#pragma unroll
    for (int i = 0; i < 16; ++i) { st0[i] = 0.f; st1[i] = 0.f; }
#define kk8(i) st0[(i)]
#define r8(i) st0[8 + (i)]
#define nb8(i) st1[(i)]
#define kd8(i) st1[8 + (i)]
    float lw8[8], inc8[8]; v4u vkeep = {0u, 0u, 0u, 0u};
#pragma unroll
    for (int i = 0; i < 8; ++i) { lw8[i] = 0.f; inc8[i] = 0.f; }
    v4u rr = {0u, 0u, 0u, 0u}, kr = rr, vr = rr, lwr = rr, ar = rr;
#define CP_LOADRAW(j) do { const int tok_ = d ? (SEQ - 1 - ((j) * 32 + ps)) : ((j) * 32 + ps); const size_t t_ = (size_t)b * SEQ + tok_; \
        rr = ld16(R + t_ * 512 + hd * 64 + pc * 8); kr = ld16(KS + t_ * 512 + hd * 64 + pc * 8); vr = ld16(VS + t_ * 512 + hd * 64 + pc * 8); \
        lwr = ld16(LW + t_ * 1024 + d * 512 + hd * 64 + pc * 8); ar = ld16(AA + t_ * 1024 + d * 512 + hd * 64 + pc * 8); } while (0)
#define CP_PREP1(j) do { float k8_[8], a8_[8], kkc_[8], kac_[8], rkc_[8]; \
        { const LAS float* c_ = cstL + pc * 8; const f32x4 a0_ = *(const LAS f32x4*)c_, a1_ = *(const LAS f32x4*)(c_ + 4), b0_ = *(const LAS f32x4*)(c_ + 64), b1_ = *(const LAS f32x4*)(c_ + 68), c0_ = *(const LAS f32x4*)(c_ + 128), c1_ = *(const LAS f32x4*)(c_ + 132); \
          _Pragma("unroll") for (int i = 0; i < 4; ++i) { kkc_[i] = a0_[i]; kkc_[4 + i] = a1_[i]; kac_[i] = b0_[i]; kac_[4 + i] = b1_[i]; rkc_[i] = c0_[i]; rkc_[4 + i] = c1_[i]; } } \
        { float r_[8]; unp8(rr, r_); _Pragma("unroll") for (int i = 0; i < 8; ++i) r8(i) = r_[i]; } unp8(kr, k8_); unp8(lwr, lw8); unp8(ar, a8_); vkeep = vr; \
        float ss_ = 0.f, cf_ = 0.f; _Pragma("unroll") for (int i = 0; i < 8; ++i) { kk8(i) = k8_[i] * kkc_[i]; ss_ += kk8(i) * kk8(i); kd8(i) = k8_[i] * (1.0f + (a8_[i] - 1.0f) * kac_[i]); cf_ += r8(i) * kd8(i) * rkc_[i]; } \
        ss_ = sum8(ss_, lane); cf_ = sum8(cf_, lane); \
        const float inv_ = fminf(__builtin_amdgcn_rsqf(ss_), 1e12f); \
        _Pragma("unroll") for (int i = 0; i < 8; ++i) { kk8(i) *= inv_; nb8(i) = -kk8(i) * a8_[i]; } \
        { const int tok_ = d ? (SEQ - 1 - ((j) * 32 + ps)) : ((j) * 32 + ps); if (pc == 0) CFB[((size_t)b * SEQ + tok_) * 8 + hd] = cf_; } \
        _Pragma("unroll") for (int i = 0; i < 8; ++i) inc8[i] = lw8[i]; \
        _Pragma("unroll") for (int off_ = 8; off_ < 64; off_ <<= 1) { float t8_[8]; _Pragma("unroll") for (int i = 0; i < 8; ++i) t8_[i] = shx_from(inc8[i], lane - off_, lane); \
            __builtin_amdgcn_sched_barrier(0);     \
            _Pragma("unroll") for (int i = 0; i < 8; ++i) inc8[i] += (lane >= off_) ? t8_[i] : 0.f; } \
        if ((lane >> 3) == 7) { LAS float* p_ = (LAS float*)(ring + cp::LW0) + ((j) & 1) * 256 + (wave & 3) * 64 + pc * 8; *(LAS f32x4*)p_ = (f32x4){inc8[0], inc8[1], inc8[2], inc8[3]}; *(LAS f32x4*)(p_ + 4) = (f32x4){inc8[4], inc8[5], inc8[6], inc8[7]}; } \
        if ((j) + 1 < NB) CP_LOADRAW((j) + 1); } while (0)
    LAS float* cstL = (LAS float*)(lds + MISC_OFF + 1024);
    if (tid < 192) cstL[tid] = (tid < 64 ? kkcp : (tid < 128 ? kacp : rkcp))[tid & 63];
    CS_SYNC();
    if (isprep) { const int ps = ps0, pc = pc0; CP_LOADRAW(0); CP_PREP1(0); }
    CS_SYNC();
    for (int k = 0; k < NB + 3; ++k) {
        int ps = ps0, pc = pc0, r = r0, h = h0; asm volatile("" : "+v"(ps), "+v"(pc), "+v"(r), "+v"(h));
        if (isprep) {
            const int ch = ps >> 4, sl = ps & 15;
            if (k >= 3) { const int j = k - 3; const int tl = j * 32 + ps; const int tok = d ? (SEQ - 1 - tl) : tl;
                const v4u yv = *(const LAS v4u*)((const LAS bf16*)(ring + cp::YL0) + (j & 1) * 2048 + ps * 64 + pc * 8); st16(YS + ((size_t)b * SEQ + tok) * 512 + hd * 64 + pc * 8, yv); }
#ifndef CP_REP_P
#define CP_REP_P 1
#endif
            for (int repp_ = 0; repp_ < CP_REP_P; ++repp_) if (k < NB) {
                LAS unsigned char* cbase = ring + ((k % 3) * 2 + ch) * cp::REG;
                const LAS float* WT = (const LAS float*)(ring + cp::LW0) + (k & 1) * 256 + (ch * 2) * 64 + pc * 8;
                float Lex[8], Lt[8];
                { const f32x4 a0 = *(const LAS f32x4*)WT, a1 = *(const LAS f32x4*)(WT + 4), b0 = *(const LAS f32x4*)(WT + 64), b1 = *(const LAS f32x4*)(WT + 68);
                  const float w0[8] = {a0[0], a0[1], a0[2], a0[3], a1[0], a1[1], a1[2], a1[3]}, w1[8] = {b0[0], b0[1], b0[2], b0[3], b1[0], b1[1], b1[2], b1[3]};
                  const float m = (sl >= 8) ? 1.0f : 0.0f;
#pragma unroll
                  for (int i = 0; i < 8; ++i) { Lt[i] = w0[i] + w1[i]; Lex[i] = inc8[i] + m * w0[i] - lw8[i]; } }
                LAS bf16* QRp = (LAS bf16*)(cbase + cp::O_QR); LAS bf16* BKp = (LAS bf16*)(cbase + cp::O_BK);
                float Lin[8], tmp[8], tm2[8];
#pragma unroll
                for (int i = 0; i < 8; ++i) { Lin[i] = Lex[i] + lw8[i]; tmp[i] = kk8(i) * __expf(Lex[i]); }
                *(LAS v4u*)(QRp + sl * P144 + pc * 8) = pk8(tmp);
#pragma unroll
                for (int i = 0; i < 8; ++i) tmp[i] = r8(i) * __expf(Lin[i]);
                *(LAS v4u*)(QRp + (16 + sl) * P144 + pc * 8) = pk8(tmp);
#pragma unroll
                for (int i = 0; i < 8; ++i) { const float ig = __expf(-Lin[i]); tmp[i] = nb8(i) * ig; tm2[i] = kd8(i) * ig; }
                *(LAS v4u*)(BKp + sl * P144 + pc * 8) = pk8(tmp); *(LAS v4u*)(BKp + (16 + sl) * P144 + pc * 8) = pk8(tm2);
                *(LAS v4u*)((LAS bf16*)(cbase + cp::O_V) + sl * P144 + pc * 8) = vkeep;
                if (sl == 15) { LAS float* gp = (LAS float*)(cbase + cp::O_GC) + pc * 8; *(LAS f32x4*)gp = (f32x4){__expf(Lt[0]), __expf(Lt[1]), __expf(Lt[2]), __expf(Lt[3])}; *(LAS f32x4*)(gp + 4) = (f32x4){__expf(Lt[4]), __expf(Lt[5]), __expf(Lt[6]), __expf(Lt[7])}; }
            }
            if (k + 1 < NB) CP_PREP1(k + 1);
        }
        if (wave == 2 || wave == 3) {
#ifndef CP_REP_A
#define CP_REP_A 1
#endif
            for (int repa_ = 0; repa_ < CP_REP_A; ++repa_) if (k >= 1 && k <= NB) {
                const int j = k - 1, ca = wave - 2;
                LAS unsigned char* cb = ring + ((j % 3) * 2 + ca) * cp::REG;
                const LAS bf16* QRp = (const LAS bf16*)(cb + cp::O_QR); const LAS bf16* BKp = (const LAS bf16*)(cb + cp::O_BK); LAS float* AD = (LAS float*)(ring + cp::AD0 + ca * 4096);
                f32x16 D;
#pragma unroll
                for (int i = 0; i < 16; ++i) D[i] = 0.f;
#pragma unroll
                for (int ks = 0; ks < 4; ++ks) { const bf16x8 A = *(const LAS bf16x8*)(QRp + r * P144 + ks * 16 + h * 8), B = *(const LAS bf16x8*)(BKp + r * P144 + ks * 16 + h * 8); D = CS_MFMA(A, B, D); }
                LAS float* AnT = (LAS float*)(cb + cp::O_QH);
#pragma unroll
                for (int i = 0; i < 16; ++i) { const int row = crow(i, h), s_ = row & 15, u_ = r & 15; const bool keep = (i < 8) ? (u_ < s_) : (u_ <= s_); const float v = keep ? D[i] : 0.f;
                    AD[row * 32 + r] = v; if (i < 8) AnT[r * 16 + row] = v; }
                asm volatile("s_waitcnt lgkmcnt(0)" ::: "memory");
                float x[16];
#pragma unroll
                for (int t = 0; t < 16; ++t) x[t] = AD[t * 32 + r];
#pragma unroll
                for (int t = 0; t < 16; ++t) asm volatile("" : "+v"(x[t]));
#pragma unroll
                for (int t = 0; t < 16; ++t) x[t] = (r < 16) ? ((t == r) ? 1.0f : 0.0f) : x[t];
#pragma unroll
                for (int s = 0; s < 15; ++s) { const f32x4 a0 = *(const LAS f32x4*)(AnT + s * 16), a1 = *(const LAS f32x4*)(AnT + s * 16 + 4), a2 = *(const LAS f32x4*)(AnT + s * 16 + 8), a3 = *(const LAS f32x4*)(AnT + s * 16 + 12);
                    const float an[16] = {a0[0], a0[1], a0[2], a0[3], a1[0], a1[1], a1[2], a1[3], a2[0], a2[1], a2[2], a2[3], a3[0], a3[1], a3[2], a3[3]};
                    const float xs = x[s];
#pragma unroll
                    for (int t = 0; t < 16; ++t) if (t > s) x[t] += an[t] * xs; }
                LAS bf16* XXp = (LAS bf16*)(cb + cp::O_XX);
                if (h == 0) {
#pragma unroll
                    for (int s = 0; s < 16; ++s) XXp[s * P72 + r] = (bf16)f2bf(x[s]); }
                { const int s = lane >> 2, c8 = (lane & 3) * 8; const LAS float* ap = AD + (16 + s) * 32 + c8; const f32x4 y0 = *(const LAS f32x4*)ap, y1 = *(const LAS f32x4*)(ap + 4);
                  LAS v2u* bp = (LAS v2u*)((LAS bf16*)(cb + cp::O_BNK) + s * P72 + c8); bp[0] = (v2u){pk2(y0[0], y0[1]), pk2(y0[2], y0[3])}; bp[1] = (v2u){pk2(y1[0], y1[1]), pk2(y1[2], y1[3])}; }
                asm volatile("s_waitcnt lgkmcnt(0)" ::: "memory");
                { LAS bf16* QHp = (LAS bf16*)(cb + cp::O_QH);
                  const bf16x8 A = ld8c(XXp + (r & 15) * P72 + 8 * h);
                  f32x16 z0, z1;
#pragma unroll
                  for (int i = 0; i < 16; ++i) { z0[i] = 0.f; z1[i] = 0.f; }
                  z0 = CS_MFMA(A, ldcol_tr<false>(QRp, r, h), z0); z1 = CS_MFMA(A, ldcol_tr<false>(QRp + 32, r, h), z1);
#pragma unroll
                  for (int i = 0; i < 8; ++i) { QHp[crow(i, h) * P144 + r] = (bf16)f2bf(z0[i]); QHp[crow(i, h) * P144 + 32 + r] = (bf16)f2bf(z1[i]); } }
            }
        }
        if (wave < 2) {
            if (k >= 2 && k <= NB + 1) {
                const int j = k - 2, c0 = 32 * wave;
                const int ra = (r & 15) * P144 + 4 * h, rb = (16 + (r & 15)) * P144 + 4 * h, rx = (r & 15) * P72 + 4 * h;
                LAS unsigned char* cb0 = ring + ((j % 3) * 2 + 0) * cp::REG; LAS unsigned char* cb1 = cb0 + cp::REG;
#define CP_P(cb, off) ((const LAS bf16*)((cb) + (off)))
#define CP_GC(cb, GA, GB) do { _Pragma("unroll") for (int g = 0; g < 4; ++g) { GA[g] = *(const LAS f32x4*)((const LAS float*)((cb) + cp::O_GC) + 8 * g + 4 * h); GB[g] = *(const LAS f32x4*)((const LAS float*)((cb) + cp::O_GC) + 32 + 8 * g + 4 * h); } } while (0)
#define CP_SCALE(GA, GB) do { _Pragma("unroll") for (int g = 0; g < 4; ++g) { \
                    st0[4 * g] = acc0[4 * g] * GA[g][0]; st0[4 * g + 1] = acc0[4 * g + 1] * GA[g][1]; st0[4 * g + 2] = acc0[4 * g + 2] * GA[g][2]; st0[4 * g + 3] = acc0[4 * g + 3] * GA[g][3]; \
                    st1[4 * g] = acc1[4 * g] * GB[g][0]; st1[4 * g + 1] = acc1[4 * g + 1] * GB[g][1]; st1[4 * g + 2] = acc1[4 * g + 2] * GB[g][2]; st1[4 * g + 3] = acc1[4 * g + 3] * GB[g][3]; } } while (0)
                const bf16x8 qh00 = ld8(CP_P(cb0, cp::O_QH) + ra), qh01 = ld8(CP_P(cb0, cp::O_QH) + ra + 16), qh02 = ld8(CP_P(cb0, cp::O_QH) + ra + 32), qh03 = ld8(CP_P(cb0, cp::O_QH) + ra + 48), ta0 = ld8(CP_P(cb0, cp::O_XX) + rx + 16);
                const bf16x8 vf0 = ldcol_tr<true>(CP_P(cb0, cp::O_V) + c0, r, h);
                const bf16x8 kt00 = ldcol_tr<true>(CP_P(cb0, cp::O_BK) + 16 * P144, r, h), kt01 = ldcol_tr<true>(CP_P(cb0, cp::O_BK) + 16 * P144 + 32, r, h), bt00 = ldcol_tr<true>(CP_P(cb0, cp::O_BK), r, h), bt01 = ldcol_tr<true>(CP_P(cb0, cp::O_BK) + 32, r, h);
                f32x4 ga[4], gb[4]; CP_GC(cb0, ga, gb);
                __builtin_amdgcn_sched_barrier(0);
                const bf16x8 s00 = pack8r(st0, 0), s01 = pack8r(st0, 1), s10 = pack8r(st1, 0), s11 = pack8r(st1, 1);
                f32x16 dq;
#pragma unroll
                for (int i = 0; i < 16; ++i) dq[i] = 0.f;
                dq = CS_MFMA(qh00, s00, dq); dq = CS_MFMA(qh01, s01, dq); dq = CS_MFMA(qh02, s10, dq); dq = CS_MFMA(qh03, s11, dq); dq = CS_MFMA(ta0, vf0, dq);
                f32x16 acc0 = st0, acc1 = st1;
                acc0 = CS_MFMA(kt00, vf0, acc0); acc1 = CS_MFMA(kt01, vf0, acc1);
                __builtin_amdgcn_sched_barrier(0);
                const bf16x8 qh10 = ld8(CP_P(cb1, cp::O_QH) + ra), qh11 = ld8(CP_P(cb1, cp::O_QH) + ra + 16), qh12 = ld8(CP_P(cb1, cp::O_QH) + ra + 32), qh13 = ld8(CP_P(cb1, cp::O_QH) + ra + 48), ta1 = ld8(CP_P(cb1, cp::O_XX) + rx + 16);
                const bf16x8 vf1 = ldcol_tr<true>(CP_P(cb1, cp::O_V) + c0, r, h);
                const bf16x8 kt10 = ldcol_tr<true>(CP_P(cb1, cp::O_BK) + 16 * P144, r, h), kt11 = ldcol_tr<true>(CP_P(cb1, cp::O_BK) + 16 * P144 + 32, r, h), bt10 = ldcol_tr<true>(CP_P(cb1, cp::O_BK), r, h), bt11 = ldcol_tr<true>(CP_P(cb1, cp::O_BK) + 32, r, h);
                __builtin_amdgcn_sched_barrier(0);
                const bf16x8 dqb0 = pack8r(dq, 0);
                acc0 = CS_MFMA(bt00, dqb0, acc0); acc1 = CS_MFMA(bt01, dqb0, acc1);
                CP_SCALE(ga, gb);
                __builtin_amdgcn_sched_barrier(0);
                const bf16x8 rt00 = ld8(CP_P(cb0, cp::O_QR) + rb), rt01 = ld8(CP_P(cb0, cp::O_QR) + rb + 16), rt02 = ld8(CP_P(cb0, cp::O_QR) + rb + 32), rt03 = ld8(CP_P(cb0, cp::O_QR) + rb + 48);
                const bf16x8 bn0v = ld8(CP_P(cb0, cp::O_BNK) + rx + 16), bn0d = ld8(CP_P(cb0, cp::O_BNK) + rx);
                __builtin_amdgcn_sched_barrier(0);
                const bf16x8 t00 = pack8r(st0, 0), t01 = pack8r(st0, 1), t10 = pack8r(st1, 0), t11 = pack8r(st1, 1);
                f32x16 dq1, y0;
#pragma unroll
                for (int i = 0; i < 16; ++i) { dq1[i] = 0.f; y0[i] = 0.f; }
                dq1 = CS_MFMA(qh10, t00, dq1);     y0 = CS_MFMA(rt00, s00, y0);
                dq1 = CS_MFMA(qh11, t01, dq1);     y0 = CS_MFMA(rt01, s01, y0);
                dq1 = CS_MFMA(qh12, t10, dq1);     y0 = CS_MFMA(rt02, s10, y0);
                dq1 = CS_MFMA(qh13, t11, dq1);     y0 = CS_MFMA(rt03, s11, y0);
                dq1 = CS_MFMA(ta1, vf1, dq1);      y0 = CS_MFMA(bn0v, vf0, y0);
                acc0 = st0; acc1 = st1;
                acc0 = CS_MFMA(kt10, vf1, acc0); acc1 = CS_MFMA(kt11, vf1, acc1);
                y0 = CS_MFMA(bn0d, dqb0, y0);
                __builtin_amdgcn_sched_barrier(0);
                CP_GC(cb1, ga, gb);
                const bf16x8 rt10 = ld8(CP_P(cb1, cp::O_QR) + rb), rt11 = ld8(CP_P(cb1, cp::O_QR) + rb + 16), rt12 = ld8(CP_P(cb1, cp::O_QR) + rb + 32), rt13 = ld8(CP_P(cb1, cp::O_QR) + rb + 48);
                const bf16x8 bn1v = ld8(CP_P(cb1, cp::O_BNK) + rx + 16), bn1d = ld8(CP_P(cb1, cp::O_BNK) + rx);
                __builtin_amdgcn_sched_barrier(0);
                const bf16x8 dqb1 = pack8r(dq1, 0);
                acc0 = CS_MFMA(bt10, dqb1, acc0); acc1 = CS_MFMA(bt11, dqb1, acc1);
                f32x16 y1;
#pragma unroll
                for (int i = 0; i < 16; ++i) y1[i] = 0.f;
                y1 = CS_MFMA(rt10, t00, y1); y1 = CS_MFMA(rt11, t01, y1); y1 = CS_MFMA(rt12, t10, y1); y1 = CS_MFMA(rt13, t11, y1);
                y1 = CS_MFMA(bn1v, vf1, y1); y1 = CS_MFMA(bn1d, dqb1, y1);
                CP_SCALE(ga, gb);
#undef CP_GC
#undef CP_SCALE
                { LAS bf16* YLp = (LAS bf16*)(ring + cp::YL0) + (j & 1) * 2048 + c0 + r;
#pragma unroll
                  for (int i = 0; i < 8; i += 2) { const unsigned w0 = pg8::cvt_pk_bf16(y0[i], y0[i + 1]), w1 = pg8::cvt_pk_bf16(y1[i], y1[i + 1]);
                      YLp[crow(i, h) * 64] = (bf16)(w0 & 0xffffu); YLp[crow(i + 1, h) * 64] = (bf16)(w0 >> 16); YLp[(16 + crow(i, h)) * 64] = (bf16)(w1 & 0xffffu); YLp[(16 + crow(i + 1, h)) * 64] = (bf16)(w1 >> 16); } }
#undef CP_P
            }
        }
        CS_SYNC();
    }
#undef CP_LOADRAW
#undef kk8
#undef r8
#undef nb8
#undef kd8
#undef CP_PREP1
}

struct Args { const float* in[32]; float* out; unsigned char* ws; int ph_lo, ph_hi, li, pad; };
#ifndef PHMASK
#define PHMASK 0xFFFF
#endif
#define PH_EN(i) (((PHMASK) >> (i)) & 1)
#ifndef DUPMASK
#define DUPMASK 0
#endif
#define REP(i) for (int rep_ = 0; rep_ < ((((DUPMASK) >> (i)) & 1) + 1); ++rep_)
#define PHASE_BEGIN() \
    const int z_ = __builtin_amdgcn_readfirstlane((int)*(volatile LAS unsigned*)(lds + LDSCTL_OFF + 32)); \
    unsigned char* const ws = args.ws + z_; const float* const* const in = args.in + z_; float* const out = args.out + z_; \
    const int tid = (int)threadIdx.x + z_, lane = tid & 63, wave = __builtin_amdgcn_readfirstlane(tid >> 6); \
    const int G = (int)gridDim.x + z_, bx = (int)blockIdx.x + z_, vcu = (G % 8 == 0) ? (bx % 8) * (G / 8) + bx / 8 : bx; \
    const int gw = vcu * NWAVES + wave, NGW = G * NWAVES; (void)ws; (void)in; (void)out; (void)lane; (void)gw; (void)NGW; (void)vcu
#define LAYER_VARS() const float* const xcur = (l == 0) ? in[0] : (const float*)out; unsigned char* const wl = ws + WS_W + (size_t)l * WL_STRIDE; (void)xcur; (void)wl
#define IN(k) (ph_lo_ <= (k) && (k) < ph_hi_)
#ifdef PROBE_SEAM2
#define SEAM_EXTRA xcd_barrier(bar_);
#else
#define SEAM_EXTRA
#endif
#define SEAM(k) do { if (IN(k) && IN((k) + 1)) { const int zz_ = __builtin_amdgcn_readfirstlane((int)*(volatile LAS unsigned*)(lds + LDSCTL_OFF + 32)); XcdBarrier bar_; bar_.bar = (unsigned*)(args.ws + zz_ + WS_CTL) + CW_BAR + (ph_li_ + zz_) * XCD_BAR_WORDS; bar_.x = xb_xcc_id(); bar_.st = (volatile LAS unsigned*)(lds + MISC_OFF) + 8; xcd_barrier(bar_); SEAM_EXTRA } } while (0)

__global__ void __launch_bounds__(NTHR, 2) fwd(Args args) {
    extern __shared__ __attribute__((aligned(16))) unsigned char lds_raw[];
    LAS unsigned char* lds = (LAS unsigned char*)lds_raw;
    const int ph_lo_ = __builtin_amdgcn_readfirstlane(args.ph_lo), ph_hi_ = __builtin_amdgcn_readfirstlane(args.ph_hi), ph_li_ = __builtin_amdgcn_readfirstlane(args.li);
    for (int u = threadIdx.x; u < (LDS_BYTES - LDSCTL_OFF) / 4; u += NTHR) ((LAS unsigned*)(lds + LDSCTL_OFF))[u] = 0u;
    __syncthreads();
    if (ph_hi_ - ph_lo_ > 1) (void)xcd_barrier_post((unsigned*)(args.ws + WS_CTL) + CW_BAR + ph_li_ * XCD_BAR_WORDS, (volatile LAS unsigned*)(lds + MISC_OFF) + 8);

    REP(13) if (PH_EN(13) && IN(0)) { PHASE_BEGIN(); p0_prologue(in, ws, lds, vcu, G, tid, wave, lane); if (!IN(1)) SEAM(0); }

#pragma nounroll
    for (int l = 0; l < 2; ++l) {
        const int pb = 1 + PH_PER_LAYER * l;
        REP(0) if (PH_EN(0) && IN(pb + 0)) { PHASE_BEGIN(); LAYER_VARS();
#ifdef PROBE_NORM2
            if (l == 0) norm_rows<0>(in[0], nullptr, false, nullptr, nullptr, in[1], (bf16*)(ws + A_HN1), nullptr, gw, NGW, lane, (unsigned char*)out + 2048);
            else norm_rows<0, true>(out, nullptr, true, (const bf16*)(ws + A_YE), (const int*)(ws + WS_INV), in[1] + DMODEL, (bf16*)(ws + A_HN1), nullptr, gw, NGW, lane, (unsigned char*)out + 2048);
#endif
            if (l == 0) norm_rows<0>(in[0], nullptr, false, nullptr, nullptr, in[1], (bf16*)(ws + A_HN1), nullptr, gw, NGW, lane, (unsigned char*)out + 2048);
            else norm_rows<0, true>(out, out, true, (const bf16*)(ws + A_YE), (const int*)(ws + WS_INV), in[1] + DMODEL, (bf16*)(ws + A_HN1), nullptr, gw, NGW, lane, (unsigned char*)out + 2048);
            SEAM(pb + 0);
        }
        REP(1) if (PH_EN(1) && IN(pb + 1)) { PHASE_BEGIN(); LAYER_VARS();
            pg8::ProjOrder S{(const char*)(ws + A_HN1), (const char*)(wl + WO_IN), (size_t)((const unsigned char*)out + 2048 - (ws + A_HN1)), (size_t)(WO_QKV8 - WO_IN), 1024, 1024, 1024, M / 256, NPJ / 256, 10, 4096, G, bx};
            pg8::EpiPlainS E{(bf16*)(ws + A_PRJ), NPJ, 10, 1.0f / 32.0f};
#ifdef PROBE_P2_SINK
            if (rep_ == 0) { pg8::EpiSink E0; pg8::gemm_phase<pg8::EpiSink, pg8::ProjOrder, true, true, false, false, true>(lds + RING_OFF, tid, 1024, 2048, 1024, S, E0); } else
#endif
            pg8::gemm_phase<pg8::EpiPlainS, pg8::ProjOrder, true, true, false, false, true>(lds + RING_OFF, tid, 1024, 2048, 1024, S, E);
            SEAM(pb + 1);
        }
        REP(2) if (PH_EN(2) && IN(pb + 2)) { PHASE_BEGIN(); p3_prep(l, in, ws, lds, gw, NGW, tid, lane); SEAM(pb + 2); }
        REP(3) if (PH_EN(3) && IN(pb + 3)) {
#ifndef P4DUP
#define P4DUP 0
#endif
            for (int r4_ = 0; r4_ < 1 + (P4DUP & 1); ++r4_) { PHASE_BEGIN(); LAYER_VARS();
              pg8::LoraOrder S{(const char*)(ws + A_TW), (const char*)(wl + WO_LORA), G, bx};
              pg8::EpiLora E{(bf16*)(ws + A_LW), (bf16*)(ws + A_AA), in[5] + (size_t)l * 1024, in[7] + (size_t)l * 1024};
              pg8::gemm_phase<pg8::EpiLora, pg8::LoraOrder, true>(lds + RING_OFF, tid, 384, 384, 128, S, E); }
            for (int r4_ = 0; r4_ < 1 + ((P4DUP >> 1) & 1); ++r4_) { PHASE_BEGIN(); LAYER_VARS();
              pg8::PlainOrder S{(const char*)(ws + A_TW) + 512, (const char*)(wl + WO_G2), 384, 128, 128, M / 256, 2, G, bx, 0, 1, 0};
              pg8::EpiPlain E{(bf16*)(ws + A_G), 512};
              pg8::gemm_phase<pg8::EpiPlain, pg8::PlainOrder, true>(lds + RING_OFF, tid, 384, 384, 128, S, E); }
            for (int r4_ = 0; r4_ < 1 + ((P4DUP >> 2) & 1); ++r4_) { PHASE_BEGIN(); LAYER_VARS();
              pg8::PlainOrder S{(const char*)(ws + A_PL), (const char*)(wl + WO_PW), 512, 512, 512, M / 256, 2, G, bx, 0, 1, 0};
              pg8::EpiColScale E{(bf16*)(ws + A_YB), 512, in[19] + (size_t)l * 512};
              pg8::gemm_phase<pg8::EpiColScale, pg8::PlainOrder, true>(lds + RING_OFF, tid, 512, 512, 512, S, E); }
            SEAM(pb + 3);
        }
        REP(4) if (PH_EN(4) && IN(pb + 4)) {
            #ifdef SCAN_SEQ
            { PHASE_BEGIN(); if (bx < 128) scan_chain(l, bx, in, ws, lds, tid, wave, lane); }
#else
            #ifdef SCAN_BLOCKSYNC
            { PHASE_BEGIN(); if (bx < 128) scan_chain_chunked(l, bx, in, ws, lds, tid, wave, lane); }
#else
            { PHASE_BEGIN(); if (bx < 128) scan_chain_pipe(l, bx, in, ws, lds, tid, wave, lane); }
#ifdef DUP_SCAN
            { PHASE_BEGIN(); if (bx < 128) scan_chain_pipe(l, bx, in, ws, lds, tid, wave, lane); }
#endif
#endif
#endif
#ifndef NO_ATTN
            { PHASE_BEGIN();
              volatile LAS int* slot = (volatile LAS int*)(lds + LDSCTL_OFF + 16); gu32* qh = (gu32*)(ws + WS_CTL) + CW_ATTQ + 64 * l;
              float negM; { const float gq = fabsf(in[20][(size_t)l * 64 + lane]), gk = fabsf(in[21][(size_t)l * 64 + lane]); float mq = gq, mk = gk;
#pragma unroll
                for (int o_ = 1; o_ < 64; o_ <<= 1) { mq = fmaxf(mq, shx(mq, o_, lane)); mk = fmaxf(mk, shx(mk, o_, lane)); }
                negM = -(64.0f * 0.125f * 1.4426950408889634f * 1.01f) * mq * mk; negM = __builtin_bit_cast(float, __builtin_amdgcn_readfirstlane(__builtin_bit_cast(int, negM))); }
              const unsigned char* Qp = ws + A_Q; const unsigned char* Kp = ws + A_K; const unsigned char* Vp = ws + A_V;
#ifdef ATT_CODE_EXP
              negM = 4.0f * (negM + 13.0f) + 60.0f;
#else
              negM += 13.0f;
#endif
              for (;;) {
                  if (tid == 0) *slot = (int)__hip_atomic_fetch_add(qh, 1u, RLX_AGENT);
                  __syncthreads();
                  const int item = __builtin_amdgcn_readfirstlane(*slot);
                  __syncthreads();
                  if (item >= 2048 + 1024) break;
                  if (item >= 2048) { convert_experts_items(in, l, ws, lds, (item - 2048) * 24, 24, wave, lane);
#ifdef PROBE_CONV2
                      convert_experts_items(in, l, ws, lds, (item - 2048) * 24, 24, wave, lane);
#endif
                      continue; }
                  const int grp = item >> 7, r = item & 127, b = grp >> 1, h = (grp & 1) * 4 + (r >> 5), qb = r & 31;
#ifdef PROBE_ATT_TWICE
                  attn_body::attn_unit(tid, negM, b, h, qb, Qp, Kp, Vp, (unsigned char*)out + 3072, (char*)lds_raw + RING_OFF, false);
#endif
                  attn_body::attn_unit(tid, negM, b, h, qb, Qp, Kp, Vp, (unsigned char*)out + 3072, (char*)lds_raw + RING_OFF);
              } }
#endif
            SEAM(pb + 4);
        }
        REP(5) if (PH_EN(5) && IN(pb + 5)) { PHASE_BEGIN(); LAYER_VARS();
            p6a_rows(l, in, ws, gw, NGW, lane);
            SEAM(pb + 5);
        }
        REP(6) if (PH_EN(6) && IN(pb + 6)) { PHASE_BEGIN(); LAYER_VARS();
            typedef pg8::MergeOrder<A_HN, A_YA, A_YB, WO_BRA8, WO_G, WO_BR> MOrd;
            MOrd S{(const char*)ws, (const char*)wl, G, bx, (size_t)((const unsigned char*)out + 2048 - ws), (size_t)4096};
            pg8::EpiMerge E{(bf16*)(ws + A_TS) + (size_t)bx * 65536, (bf16*)(ws + A_MG), 1.0f / 32.0f, 1.0f / (32.0f * attn_body::OSC)};
#ifdef PROBE_SINK_P6B
            { pg8::EpiSink E0; pg8::gemm_phase<pg8::EpiSink, MOrd, true, true, false, false, true>(lds + RING_OFF, tid, 512, 2048, 512, S, E0); }
#endif
            pg8::gemm_phase<pg8::EpiMerge, MOrd, true, true, false, false, true>(lds + RING_OFF, tid, 512, 2048, 512, S, E);
            SEAM(pb + 6);
        }
        REP(7) if (PH_EN(7) && IN(pb + 7)) { PHASE_BEGIN(); LAYER_VARS();
            pg8::PlainOrder S{(const char*)(ws + A_MG), (const char*)(wl + WO_OUT), 1024, 1024, 1024, M / 256, 4, G, bx, 0, 1, 0};
            pg8::EpiResBf E{(l == 0) ? in[0] : (const float*)nullptr, (pg8::bf16_t*)out, XBP};
#ifdef PROBE_SINK_P7
            { pg8::EpiSink E0; pg8::gemm_phase<pg8::EpiSink, pg8::PlainOrder, true>(lds + RING_OFF, tid, 1024, 1024, 1024, S, E0); }
#endif
            pg8::gemm_phase<pg8::EpiResBf, pg8::PlainOrder, true>(lds + RING_OFF, tid, 1024, 1024, 1024, S, E);
            SEAM(pb + 7);
        }
        REP(8) if (PH_EN(8) && IN(pb + 8)) {
            { PHASE_BEGIN(); p8_router(l, in, out, ws, lds, gw, NGW, tid, lane); }
            SEAM(pb + 8);
        }
        REP(9) if (PH_EN(9) && IN(pb + 9)) { PHASE_BEGIN(); if (bx < BATCH * NEXP) p9_topk(bx, ws, lds, tid, wave, lane); SEAM(pb + 9); }
        REP(11) if (PH_EN(11) && IN(pb + 11)) { PHASE_BEGIN();
            pg8::GatherOrder S{(const char*)(ws + A_HN), (const char*)(ws + A_WGU), (const int*)(ws + WS_IDX), 512, 512, 512, MR / 256, 8, G, bx, 4, NEXP, NEXP * 4, SEQ, (size_t)2048 * 1024};
            pg8::EpiSwiGLU<true> E{(bf16*)(ws + A_HID), 1024, 1.0f / 32.0f, 16.0f};
            pg8::gemm_phase<pg8::EpiSwiGLU<true>, pg8::GatherOrder, true, false, true, true>(lds + RING_OFF, tid, 512, 512, 512, S, E);
            SEAM(pb + 11);
        }
        REP(12) if (PH_EN(12) && IN(pb + 12)) { PHASE_BEGIN();
            pg8::PlainOrder S{(const char*)(ws + A_HID), (const char*)(ws + A_WD), 512, 512, 512, MR / 256, 4, G, bx, 4, NEXP, (size_t)1024 * 1024};
            pg8::EpiRowScale E{(bf16*)(ws + A_YE), 1024, (const float*)(ws + WS_VAL), 1.0f / 512.0f};
#ifdef PROBE_SINK_P12
            { pg8::EpiSink E0; pg8::gemm_phase<pg8::EpiSink, pg8::PlainOrder, true, false, false, true>(lds + RING_OFF, tid, 512, 512, 512, S, E0); }
#endif
            pg8::gemm_phase<pg8::EpiRowScale, pg8::PlainOrder, true, false, false, true>(lds + RING_OFF, tid, 512, 512, 512, S, E);
            SEAM(pb + 12);
        }
    }
#ifdef DBG_DUMP_OFF
#ifndef DBG_DUMP_ELEMS
#define DBG_DUMP_ELEMS ((size_t)M * DMODEL)
#endif
    if (IN(28)) { PHASE_BEGIN(); const bf16* src = (const bf16*)(ws + (size_t)(DBG_DUMP_OFF)); const size_t gt = (size_t)vcu * NTHR + tid, NGT = (size_t)G * NTHR;
        for (size_t i = gt; i < (size_t)M * DMODEL / 8; i += NGT) { float f[8]; unp8(ld16(src + (i % ((size_t)(DBG_DUMP_ELEMS) / 8)) * 8), f); f32x4* o = (f32x4*)(out + i * 8); o[0] = (f32x4){f[0], f[1], f[2], f[3]}; o[1] = (f32x4){f[4], f[5], f[6], f[7]}; } }
#endif
#ifdef PROBE_NORM2
    if (PH_EN(14) && IN(27)) { PHASE_BEGIN(); norm_rows<0, true>(out, nullptr, true, (const bf16*)(ws + A_YE), (const int*)(ws + WS_INV), in[31], (bf16*)(ws + A_HN1), nullptr, gw, NGW, lane); }
#endif
    if (PH_EN(14) && IN(27)) { PHASE_BEGIN(); norm_rows<1, true>(out, nullptr, true, (const bf16*)(ws + A_YE), (const int*)(ws + WS_INV), in[31], nullptr, out, gw, NGW, lane); }
}
#undef IN
#undef SEAM

#ifndef MK_PER_PHASE
#define MK_PER_PHASE 0
#endif
extern "C" void kernel_launch(void* const* d_in, const int* in_sizes, int n_in, void* d_out, int out_size, void* d_ws, size_t ws_size, hipStream_t stream) {
    static int grid = 0;
    if (grid == 0) {
        if (n_in != 32 || in_sizes[0] != M * DMODEL || out_size != M * DMODEL || ws_size < WS_END) { fprintf(stderr, "kernel_launch: unexpected shapes (n_in %d, in0 %d, out %d, ws %zu)\n", n_in, n_in > 0 ? in_sizes[0] : -1, out_size, ws_size); grid = -1; return; }
        int dev = 0, cus = 0, per_cu = 0;
        if (hipGetDevice(&dev) != hipSuccess || hipDeviceGetAttribute(&cus, hipDeviceAttributeMultiprocessorCount, dev) != hipSuccess) { grid = -1; return; }
        if (hipFuncSetAttribute((const void*)fwd, hipFuncAttributeMaxDynamicSharedMemorySize, LDS_BYTES) != hipSuccess) { fprintf(stderr, "kernel_launch: hipFuncSetAttribute failed\n"); grid = -1; return; }
        if (hipOccupancyMaxActiveBlocksPerMultiprocessor(&per_cu, (const void*)fwd, NTHR, LDS_BYTES) != hipSuccess || per_cu < 1) fprintf(stderr, "kernel_launch: occupancy query reports %d\n", per_cu);
        (void)hipGetLastError();
        grid = cus;
        if (grid > 256) grid = 256;
    }
    if (grid < 0) return;
    if (hipMemsetAsync((char*)d_ws + WS_CTL, 0, CTL_ZERO_BYTES, stream) != hipSuccess) return;
    Args a{};
    for (int i = 0; i < 32; ++i) a.in[i] = (const float*)d_in[i];
    a.out = (float*)d_out; a.ws = (unsigned char*)d_ws; a.pad = 0;
#if MK_PER_PHASE
#ifdef DBG_LAST_PHASE
    for (int p = 0; p <= DBG_LAST_PHASE; ++p) { a.ph_lo = p; a.ph_hi = p + 1; a.li = 0; hipLaunchKernelGGL(fwd, dim3(grid), dim3(NTHR), LDS_BYTES, stream, a); }
#ifdef DBG_DUMP_OFF
    a.ph_lo = 28; a.ph_hi = 29; a.li = 0; hipLaunchKernelGGL(fwd, dim3(grid), dim3(NTHR), LDS_BYTES, stream, a);
#endif
#else
    for (int p = 0; p < N_PHASES; ++p) { a.ph_lo = p; a.ph_hi = p + 1; a.li = 0; hipLaunchKernelGGL(fwd, dim3(grid), dim3(NTHR), LDS_BYTES, stream, a); }
#endif
#else
    a.ph_lo = 0; a.ph_hi = N_PHASES; a.li = 0;
    hipLaunchKernelGGL(fwd, dim3(grid), dim3(NTHR), LDS_BYTES, stream, a);
#endif
    const hipError_t le = hipPeekAtLastError();
    if (le != hipSuccess) fprintf(stderr, "kernel_launch: launch failed: %s\n", hipGetErrorName(le));
}
```

```cpp
#include <hip/hip_runtime.h>
#include <cstdio>
#include <cstdint>
namespace pg8 {
#define PG8_LAS __attribute__((address_space(3)))
typedef unsigned short bf16_t;
typedef short bf16x8 __attribute__((ext_vector_type(8)));
typedef float f32x4 __attribute__((ext_vector_type(4)));
typedef unsigned u32x4 __attribute__((ext_vector_type(4)));
constexpr int BM = 256, BK = 64, HALF = 128, HTB = HALF * BK * 2  , STAGE_BYTES = 8 * HTB, NXCD = 8, WGM = 8;

__host__ __device__ __forceinline__ int lds_byte(int r, int c) { const int st = (r >> 4) * 2 + (c >> 5), rr = r & 15, cc = c & 31, ob = rr * 64 + cc * 2; return st * 1024 + (ob ^ (((ob >> 9) & 1) << 5)); }
__host__ __device__ __forceinline__ void stage_rc(int b, int& R, int& C) { const int st = b / 1024, sb = b % 1024, swz = sb ^ (((sb >> 9) & 1) << 5); R = (st >> 1) * 16 + swz / 64; C = (st & 1) * 32 + (swz % 64) / 2; }
__host__ __device__ __forceinline__ int perm32(int rho) { const int n = rho >> 4, i = rho & 15; return 8 * (i >> 2) + 4 * n + (i & 3); }

struct Unit { int pm, pn, sub; };

__device__ __forceinline__ bool tile_of(int i, int G, int c, int nM, int nN, int& pm, int& pn) {
    const long L = (long)i * G + c; const int nwg = nM * nN; if (L >= nwg) return false;
    int wgid = (int)L; { const int q = nwg / NXCD, r = nwg % NXCD, xcd = wgid % NXCD, off = wgid / NXCD; wgid = (xcd < r ? xcd * (q + 1) : r * (q + 1) + (xcd - r) * q) + off; }
    const int nig = WGM * nN, gid = wgid / nig, fm = gid * WGM, gsz = (nM - fm) < WGM ? (nM - fm) : WGM;
    pm = fm + ((wgid % nig) % gsz); pn = (wgid % nig) / gsz; return true;
}
struct PlainOrder {
    const char* A; const char* B; int lda, ldb, K, nM, nN, G, c, grp_panels, ngrp; size_t grp_stride;
    __device__ __forceinline__ int grow(const Unit&, int) const { return 0; }
    __device__ __forceinline__ bool next(int i, Unit& u) const { u.sub = 0; return tile_of(i, G, c, nM, nN, u.pm, u.pn); }
    __device__ __forceinline__ void ops(const Unit& u, const char*& a, const char*& b, int& nt, bool& asel) const {
        nt = K / BK; asel = false;
        a = A + (size_t)u.pm * BM * lda * 2;
        b = B + (size_t)u.pn * BM * ldb * 2 + (grp_panels ? (size_t)((u.pm / grp_panels) % ngrp) * grp_stride : (size_t)0);
    }
};
struct ProjOrder {
    const char* A; const char* B; size_t a8_off, b8_off; int lda, ldb, K, nM, nN, pn8, a8_pitch, G, c;
    __device__ __forceinline__ int grow(const Unit&, int) const { return 0; }
    __device__ __forceinline__ bool next(int i, Unit& u) const { u.sub = 0; return tile_of(i, G, c, nM, nN, u.pm, u.pn); }
    __device__ __forceinline__ void ops(const Unit& u, const char*& a, const char*& b, int& nt, bool& asel) const {
        asel = u.pn >= pn8; nt = asel ? K / (2 * BK) : K / BK;
        a = A + (asel ? a8_off + (size_t)u.pm * BM * a8_pitch : (size_t)u.pm * BM * lda * 2);
        b = B + (asel ? b8_off + (size_t)(u.pn - pn8) * BM * ldb * 2 : (size_t)u.pn * BM * ldb * 2);
    }
};
struct LoraOrder {
    const char* A; const char* B; int G, c;
    __device__ __forceinline__ int grow(const Unit&, int) const { return 0; }
    __device__ __forceinline__ bool next(int i, Unit& u) const { u.sub = 0; return tile_of(i, G, c, 256, 8, u.pm, u.pn); }
    __device__ __forceinline__ void ops(const Unit& u, const char*& a, const char*& b, int& nt, bool& asel) const {
        nt = 2; asel = false; a = A + (size_t)u.pm * BM * 384 * 2 + (u.pn >= 4 ? 256 : 0); b = B + (size_t)u.pn * BM * 128 * 2; }
};
struct GatherOrder {
    const char* A; const char* B; const int* idx; int lda, ldb, K, nM, nN, G, c, grp_panels, ngrp, panels_per_batch, seq; size_t grp_stride;
    __device__ __forceinline__ bool next(int i, Unit& u) const { u.sub = 0; return tile_of(i, G, c, nM, nN, u.pm, u.pn); }
    __device__ __forceinline__ void ops(const Unit& u, const char*& a, const char*& b, int& nt, bool& asel) const {
        nt = K / BK; asel = false; a = A;
        b = B + (size_t)u.pn * BM * ldb * 2 + (size_t)((u.pm / grp_panels) % ngrp) * grp_stride;
    }
    __device__ __forceinline__ int grow(const Unit& u, int row) const { return (u.pm / panels_per_batch) * seq + idx[u.pm * BM + row]; }
};
template <size_t OHN, size_t OYA, size_t OYB, size_t OYC, size_t OWG, size_t OWBR>
struct MergeOrder {
    const char* base; const char* wbase; int G, c; size_t hn_off, hn_pitch;
    __device__ __forceinline__ int grow(const Unit&, int) const { return 0; }
#ifndef MERGE_NSUB
#define MERGE_NSUB 6
#endif
    __device__ __forceinline__ bool next(int i, Unit& u) const { const int ti = i / MERGE_NSUB; u.sub = i - ti * MERGE_NSUB; return tile_of(ti, G, c, 256, 4, u.pm, u.pn); }
    __device__ __forceinline__ void ops(const Unit& u, const char*& a, const char*& b, int& nt, bool& asel) const {
        const int bb = u.sub >> 1; const size_t wrow = (size_t)(bb * 1024 + u.pn * BM) * 1024, arow = (size_t)u.pm * BM * 1024; nt = 8;
        if (!(u.sub & 1)) { a = base + (hn_off + (size_t)u.pm * BM * hn_pitch); b = wbase + OWG + wrow; asel = true; }
        else if (bb == 2) { a = base + (hn_off + 1024 + (size_t)u.pm * BM * hn_pitch); b = wbase + OYC + (size_t)u.pn * BM * 1024; asel = true; nt = 4; }
        else { const size_t yo = (bb == 0) ? OYA : OYB; a = base + yo + arow; b = wbase + OWBR + wrow; asel = false; }
    }
};

typedef float f32x2_t __attribute__((ext_vector_type(2))); typedef __bf16 bf16x2_t __attribute__((ext_vector_type(2)));
__device__ __forceinline__ unsigned cvt_pk_bf16(float lo, float hi) { const f32x2_t v = {lo, hi}; const bf16x2_t b = __builtin_convertvector(v, bf16x2_t); return __builtin_bit_cast(unsigned, b); }
__device__ __forceinline__ u32x4 pack8(const f32x4& v0, const f32x4& v1) { u32x4 w; w.x = cvt_pk_bf16(v0[0], v0[1]); w.y = cvt_pk_bf16(v0[2], v0[3]); w.z = cvt_pk_bf16(v1[0], v1[1]); w.w = cvt_pk_bf16(v1[2], v1[3]); return w; }
__device__ __forceinline__ void unpack8(const u32x4& w, f32x4& v0, f32x4& v1) {
    v0[0] = __uint_as_float(w.x << 16); v0[1] = __uint_as_float(w.x & 0xffff0000u); v0[2] = __uint_as_float(w.y << 16); v0[3] = __uint_as_float(w.y & 0xffff0000u);
    v1[0] = __uint_as_float(w.z << 16); v1[1] = __uint_as_float(w.z & 0xffff0000u); v1[2] = __uint_as_float(w.w << 16); v1[3] = __uint_as_float(w.w & 0xffff0000u); }
__device__ __forceinline__ float sigm(float x) { return __builtin_amdgcn_rcpf(1.0f + __builtin_amdgcn_exp2f(-1.4426950408889634f * x)); }
__device__ __forceinline__ f32x4 sigm4(const f32x4& v) { f32x4 r; r[0] = sigm(v[0]); r[1] = sigm(v[1]); r[2] = sigm(v[2]); r[3] = sigm(v[3]); return r; }

struct EpiPlain {
    static constexpr bool PERM = true;
    bf16_t* O; int ldc;
    __device__ __forceinline__ void operator()(const f32x4 (&acc)[2][2][4][2], const Unit& u, int wr, int wc, int fr, int fq) const {
        const int row0 = u.pm * BM + wr * 64 + fr, col0 = u.pn * BM + wc * 32 + 8 * fq;
#pragma unroll
        for (int ai = 0; ai < 2; ++ai)
#pragma unroll
            for (int m = 0; m < 4; ++m) { bf16_t* rowp = O + (size_t)(row0 + ai * HALF + m * 16) * ldc + col0;
#pragma unroll
                for (int bj = 0; bj < 2; ++bj) *(u32x4*)(rowp + bj * HALF) = pack8(acc[ai][bj][m][0], acc[ai][bj][m][1]); }
    }
};
struct EpiSink {
    static constexpr bool PERM = true;
    __device__ __forceinline__ void operator()(const f32x4 (&acc)[2][2][4][2], const Unit&, int, int, int, int) const {
#pragma unroll
        for (int ai = 0; ai < 2; ++ai)
#pragma unroll
            for (int bj = 0; bj < 2; ++bj)
#pragma unroll
                for (int m = 0; m < 4; ++m) { asm volatile("" :: "v"(acc[ai][bj][m][0]), "v"(acc[ai][bj][m][1])); }
    }
};
struct EpiPlainS {
    static constexpr bool PERM = true;
    bf16_t* O; int ldc, pn8; float s8;
    __device__ __forceinline__ void operator()(const f32x4 (&acc)[2][2][4][2], const Unit& u, int wr, int wc, int fr, int fq) const {
        const int row0 = u.pm * BM + wr * 64 + fr, col0 = u.pn * BM + wc * 32 + 8 * fq; const float sc = (u.pn >= pn8) ? s8 : 1.0f;
#pragma unroll
        for (int ai = 0; ai < 2; ++ai)
#pragma unroll
            for (int m = 0; m < 4; ++m) { bf16_t* rowp = O + (size_t)(row0 + ai * HALF + m * 16) * ldc + col0;
#pragma unroll
                for (int bj = 0; bj < 2; ++bj) *(u32x4*)(rowp + bj * HALF) = pack8(acc[ai][bj][m][0] * sc, acc[ai][bj][m][1] * sc); }
    }
};
struct EpiColScale {
    static constexpr bool PERM = true;
    bf16_t* O; int ldc; const float* scale;
    __device__ __forceinline__ void operator()(const f32x4 (&acc)[2][2][4][2], const Unit& u, int wr, int wc, int fr, int fq) const {
        const int row0 = u.pm * BM + wr * 64 + fr, col0 = u.pn * BM + wc * 32 + 8 * fq;
        f32x4 sv[2][2];
#pragma unroll
        for (int bj = 0; bj < 2; ++bj)
#pragma unroll
            for (int n = 0; n < 2; ++n) sv[bj][n] = *(const f32x4*)(scale + col0 + bj * HALF + 4 * n);
#pragma unroll
        for (int ai = 0; ai < 2; ++ai)
#pragma unroll
            for (int m = 0; m < 4; ++m) { bf16_t* rowp = O + (size_t)(row0 + ai * HALF + m * 16) * ldc + col0;
#pragma unroll
                for (int bj = 0; bj < 2; ++bj) {
#ifdef PROBE_YB8
                    f32x4 a0 = acc[ai][bj][m][0] * sv[bj][0], a1 = acc[ai][bj][m][1] * sv[bj][1];
#pragma unroll
                    for (int e = 0; e < 4; ++e) { a0[e] = __builtin_amdgcn_cvt_f32_fp8(__builtin_amdgcn_cvt_pk_fp8_f32(a0[e], a0[e], 0, false), 0); a1[e] = __builtin_amdgcn_cvt_f32_fp8(__builtin_amdgcn_cvt_pk_fp8_f32(a1[e], a1[e], 0, false), 0); }
                    *(u32x4*)(rowp + bj * HALF) = pack8(a0, a1);
#else
                    *(u32x4*)(rowp + bj * HALF) = pack8(acc[ai][bj][m][0] * sv[bj][0], acc[ai][bj][m][1] * sv[bj][1]);
#endif
                } }
    }
};
struct EpiLora {
    static constexpr bool PERM = true;
    bf16_t* LW; bf16_t* AA; const float* w0; const float* a0;
    __device__ __forceinline__ void operator()(const f32x4 (&acc)[2][2][4][2], const Unit& u, int wr, int wc, int fr, int fq) const {
        const bool isw = u.pn < 4; const int ct = (u.pn & 3) * BM;
        bf16_t* O = isw ? LW : AA; const float* bias = isw ? w0 : a0; const float sc = isw ? -0.6065306597126334f * 1.4426950408889634f : 1.0f;
        const int row0 = u.pm * BM + wr * 64 + fr, col0 = ct + wc * 32 + 8 * fq;
        f32x4 bv[2][2];
#pragma unroll
        for (int bj = 0; bj < 2; ++bj)
#pragma unroll
            for (int n = 0; n < 2; ++n) bv[bj][n] = *(const f32x4*)(bias + col0 + bj * HALF + 4 * n);
#pragma unroll
        for (int ai = 0; ai < 2; ++ai)
#pragma unroll
            for (int m = 0; m < 4; ++m) { bf16_t* rowp = O + (size_t)(row0 + ai * HALF + m * 16) * 1024 + col0;
#pragma unroll
                for (int bj = 0; bj < 2; ++bj) { const f32x4 v0 = sigm4(acc[ai][bj][m][0] + bv[bj][0]) * sc, v1 = sigm4(acc[ai][bj][m][1] + bv[bj][1]) * sc;
                    *(u32x4*)(rowp + bj * HALF) = pack8(v0, v1); } }
    }
};
__device__ __forceinline__ u32x4 ld16_dev(const void* p) { u32x4 v; asm volatile("global_load_dwordx4 %0, %1, off sc0 sc1\n\ts_waitcnt vmcnt(0)" : "=v"(v) : "v"(p) : "memory"); return v; }
struct EpiMerge {
    static constexpr bool PERM = true;
    bf16_t* TS; bf16_t* MG; float gs, s5;
    __device__ __forceinline__ void operator()(const f32x4 (&acc)[2][2][4][2], const Unit& u, int wr, int wc, int fr, int fq) const {
        const int lr0 = wr * 64 + fr, lc0 = wc * 32 + 8 * fq;
        if (!(u.sub & 1)) {
#pragma unroll
            for (int ai = 0; ai < 2; ++ai)
#pragma unroll
                for (int m = 0; m < 4; ++m) { bf16_t* rowp = TS + (size_t)(lr0 + ai * HALF + m * 16) * 256 + lc0;
#pragma unroll
                    for (int bj = 0; bj < 2; ++bj) *(u32x4*)(rowp + bj * HALF) = pack8(sigm4(acc[ai][bj][m][0] * gs), sigm4(acc[ai][bj][m][1] * gs)); }
        } else {
            const bool first = (u.sub == 1); const float bs = (u.sub == 5) ? s5 : 1.0f;
#pragma unroll
            for (int ai = 0; ai < 2; ++ai)
#pragma unroll
                for (int m = 0; m < 4; ++m) { const bf16_t* trow = TS + (size_t)(lr0 + ai * HALF + m * 16) * 256 + lc0;
                    bf16_t* grow = MG + (size_t)(u.pm * BM + lr0 + ai * HALF + m * 16) * 1024 + u.pn * BM + lc0;
#pragma unroll
                    for (int bj = 0; bj < 2; ++bj) { f32x4 t0, t1; unpack8(*(const u32x4*)(trow + bj * HALF), t0, t1);
                        f32x4 r0 = t0 * (acc[ai][bj][m][0] * bs), r1 = t1 * (acc[ai][bj][m][1] * bs);
                        if (!first) { f32x4 g0, g1; unpack8(*(const u32x4*)(grow + bj * HALF), g0, g1); r0 += g0; r1 += g1; }
                        *(u32x4*)(grow + bj * HALF) = pack8(r0, r1); }
                    asm volatile("" ::: "memory"); }
        }
    }
};
struct EpiResF32 {
    static constexpr bool PERM = false;
    const float* base; float* out; int ldc;
    __device__ __forceinline__ void operator()(const f32x4 (&acc)[2][2][4][2], const Unit& u, int wr, int wc, int fr, int fq) const {
        const int row0 = u.pm * BM + wr * 64 + fr, col0 = u.pn * BM + wc * 32 + 4 * fq;
#pragma unroll
        for (int ai = 0; ai < 2; ++ai)
#pragma unroll
            for (int m = 0; m < 4; ++m) { const size_t off = (size_t)(row0 + ai * HALF + m * 16) * ldc + col0;
#pragma unroll
                for (int bj = 0; bj < 2; ++bj)
#pragma unroll
                    for (int n = 0; n < 2; ++n) { const f32x4 b = *(const f32x4*)(base + off + bj * HALF + n * 16); *(f32x4*)(out + off + bj * HALF + n * 16) = b + acc[ai][bj][m][n]; } }
    }
};
struct EpiResBf {
    static constexpr bool PERM = false;
    const float* srcf; bf16_t* xb; int ldo;
    __device__ __forceinline__ void operator()(const f32x4 (&acc)[2][2][4][2], const Unit& u, int wr, int wc, int fr, int fq) const {
        const int row0 = u.pm * BM + wr * 64 + fr, col0 = u.pn * BM + wc * 32 + 4 * fq;
        typedef unsigned u32x2 __attribute__((ext_vector_type(2)));
#pragma unroll
        for (int ai = 0; ai < 2; ++ai)
#pragma unroll
            for (int m = 0; m < 4; ++m) { const int row = row0 + ai * HALF + m * 16;
#pragma unroll
                for (int bj = 0; bj < 2; ++bj)
#pragma unroll
                    for (int n = 0; n < 2; ++n) { const int col = col0 + bj * HALF + n * 16; bf16_t* xp = xb + (size_t)row * ldo + col; f32x4 b;
                        if (srcf) b = *(const f32x4*)(srcf + (size_t)row * 1024 + col);
                        else { const u32x2 w = *(const u32x2*)xp; b = (f32x4){__uint_as_float(w.x << 16), __uint_as_float(w.x & 0xffff0000u), __uint_as_float(w.y << 16), __uint_as_float(w.y & 0xffff0000u)}; }
                        const f32x4 r = b + acc[ai][bj][m][n]; *(u32x2*)xp = (u32x2){cvt_pk_bf16(r[0], r[1]), cvt_pk_bf16(r[2], r[3])}; } }
    }
};
__device__ __forceinline__ float clamp_e4m3(float v) { return v; }
__device__ __forceinline__ unsigned pk4_fp8(float a, float b, float c, float d) { unsigned w = 0u; w = __builtin_amdgcn_cvt_pk_fp8_f32(clamp_e4m3(a), clamp_e4m3(b), w, false); w = __builtin_amdgcn_cvt_pk_fp8_f32(clamp_e4m3(c), clamp_e4m3(d), w, true); return w; }
template <bool OUT8> struct EpiSwiGLU {
    static constexpr bool PERM = true;
    bf16_t* HID; int ldc; float s, so;
    __device__ __forceinline__ void operator()(const f32x4 (&acc)[2][2][4][2], const Unit& u, int wr, int wc, int fr, int fq) const {
        const int row0 = u.pm * BM + wr * 64 + fr, col0 = u.pn * HALF + wc * 32 + 8 * fq;
#pragma unroll
        for (int ai = 0; ai < 2; ++ai)
#pragma unroll
            for (int m = 0; m < 4; ++m) {
                const f32x4 g0 = acc[ai][0][m][0] * s, g1 = acc[ai][0][m][1] * s;
                const f32x4 h0 = g0 * sigm4(g0) * (acc[ai][1][m][0] * (s * so)), h1 = g1 * sigm4(g1) * (acc[ai][1][m][1] * (s * so));
                if constexpr (OUT8) { unsigned char* rowp = (unsigned char*)HID + (size_t)(row0 + ai * HALF + m * 16) * ldc + col0;
                    typedef unsigned u32x2 __attribute__((ext_vector_type(2))); *(u32x2*)rowp = (u32x2){pk4_fp8(h0[0], h0[1], h0[2], h0[3]), pk4_fp8(h1[0], h1[1], h1[2], h1[3])}; }
                else { bf16_t* rowp = HID + (size_t)(row0 + ai * HALF + m * 16) * ldc + col0; *(u32x4*)rowp = pack8(h0, h1); } }
    }
};
struct EpiRowScale {
    static constexpr bool PERM = true;
    bf16_t* O; int ldc; const float* rscale; float cs;
    __device__ __forceinline__ void operator()(const f32x4 (&acc)[2][2][4][2], const Unit& u, int wr, int wc, int fr, int fq) const {
        const int row0 = u.pm * BM + wr * 64 + fr, col0 = u.pn * BM + wc * 32 + 8 * fq;
#pragma unroll
        for (int ai = 0; ai < 2; ++ai)
#pragma unroll
            for (int m = 0; m < 4; ++m) { const int row = row0 + ai * HALF + m * 16; const float s = rscale[row] * cs; bf16_t* rowp = O + (size_t)row * ldc + col0;
#pragma unroll
                for (int bj = 0; bj < 2; ++bj) *(u32x4*)(rowp + bj * HALF) = pack8(acc[ai][bj][m][0] * s, acc[ai][bj][m][1] * s); }
    }
};

typedef int v8i32_t __attribute__((ext_vector_type(8))); typedef int v4i32_t __attribute__((ext_vector_type(4)));
__device__ __forceinline__ v8i32_t cat16(const bf16x8& a, const bf16x8& b) { typedef short s16_t __attribute__((ext_vector_type(16))); const s16_t c = __builtin_shufflevector(a, b, 0, 1, 2, 3, 4, 5, 6, 7, 8, 9, 10, 11, 12, 13, 14, 15); return __builtin_bit_cast(v8i32_t, c); }
template <class Epi, class Sched, bool ALIGN_EPI, bool TWO_LDA = false, bool GATHER = false, bool FP8 = false, bool MIXED = false>
__device__ __forceinline__ void gemm_phase(PG8_LAS unsigned char* lds, const int tid, const int lda0, const int lda1, const int ldb, const Sched& S, const Epi& E) {
    const int wid = __builtin_amdgcn_readfirstlane(tid >> 6), lane = tid & 63, wr = wid >> 2, wc = wid & 3, fr = lane & 15, fq = lane >> 4;
    unsigned voffA0[2], voffA1[2], voffB[2]; int gR[2], gC[2];
#pragma unroll
    for (int i = 0; i < 2; ++i) { int R, C; stage_rc(tid * 16 + i * 8192, R, C); gR[i] = R; gC[i] = C; const int Rb = Epi::PERM ? ((R & ~31) + perm32(R & 31)) : R;
        voffA0[i] = (unsigned)(R * lda0 + C) * 2u; voffA1[i] = TWO_LDA ? (unsigned)(R * lda1 + C) * 2u : 0u; voffB[i] = (unsigned)(Rb * ldb + C) * 2u; }
    const size_t kstep = (size_t)(BK * 2);
    const unsigned hsB = (unsigned)HALF * ldb * 2, hsA0 = (unsigned)HALF * lda0 * 2, hsA1 = (unsigned)HALF * lda1 * 2;
    const unsigned ldsw = (unsigned)wid * 1024u;
    const int aoff = lds_byte(wr * 64 + fr, fq * 8), boff = lds_byte(wc * 32 + fr, fq * 8);
#define PG8_SA(b, h) (((b) * 2 + (h)) * HTB)
#define PG8_SB(b, h) ((4 + (b) * 2 + (h)) * HTB)
#define PG8_STAGE(bufoff, gbase, voff) do { _Pragma("unroll") for (int _i = 0; _i < 2; ++_i) \
        __builtin_amdgcn_global_load_lds((const unsigned*)((const char*)(gbase) + (voff)[_i]), (PG8_LAS unsigned*)(lds + (bufoff) + ldsw + _i * 8192), 16, 0, 0); } while (0)
#define PG8_LDA4(dst, b, h) do { _Pragma("unroll") for (int m = 0; m < 4; ++m) _Pragma("unroll") for (int k = 0; k < 2; ++k) dst[m][k] = *(const PG8_LAS bf16x8*)(lds + PG8_SA(b, h) + aoff + m * 2048 + k * 1024); } while (0)
#define PG8_LDB4(dst, b, h) do { _Pragma("unroll") for (int n = 0; n < 2; ++n) _Pragma("unroll") for (int k = 0; k < 2; ++k) dst[n][k] = *(const PG8_LAS bf16x8*)(lds + PG8_SB(b, h) + boff + n * 2048 + k * 1024); } while (0)
#define PG8_LDA8(dst, b, h) do { _Pragma("unroll") for (int m = 0; m < 4; ++m) { const bf16x8 l0_ = *(const PG8_LAS bf16x8*)(lds + PG8_SA(b, h) + aoff + m * 2048), l1_ = *(const PG8_LAS bf16x8*)(lds + PG8_SA(b, h) + aoff + m * 2048 + 1024); dst##8[m] = cat16(l0_, l1_); } } while (0)
#define PG8_LDB8(dst, b, h) do { _Pragma("unroll") for (int n = 0; n < 2; ++n) { const bf16x8 l0_ = *(const PG8_LAS bf16x8*)(lds + PG8_SB(b, h) + boff + n * 2048), l1_ = *(const PG8_LAS bf16x8*)(lds + PG8_SB(b, h) + boff + n * 2048 + 1024); dst##8[n] = cat16(l0_, l1_); } } while (0)
#define PG8_MMAB(ai, bj, At, Bt) do { __builtin_amdgcn_s_setprio(1); _Pragma("unroll") for (int m = 0; m < 4; ++m) _Pragma("unroll") for (int n = 0; n < 2; ++n) _Pragma("unroll") for (int k = 0; k < 2; ++k) \
        acc[ai][bj][m][n] = __builtin_amdgcn_mfma_f32_16x16x32_bf16(Bt[n][k], At[m][k], acc[ai][bj][m][n], 0, 0, 0); __builtin_amdgcn_s_setprio(0); } while (0)
#define PG8_MMA16A(ai, bj, At, Bt) do { __builtin_amdgcn_s_setprio(1); _Pragma("unroll") for (int k = 0; k < 2; ++k) _Pragma("unroll") for (int m = 0; m < 4; ++m) _Pragma("unroll") for (int n = 0; n < 2; ++n)     \
        asm volatile("v_mfma_f32_16x16x32_bf16 %0, %1, %2, %0" : "+v"(acc[ai][bj][m][n]) : "v"(Bt[n][k]), "v"(At[m][k])); __builtin_amdgcn_s_setprio(0); } while (0)
#define PG8_MMA8(ai, bj, At, Bt) do { __builtin_amdgcn_s_setprio(1); _Pragma("unroll") for (int m = 0; m < 4; ++m) _Pragma("unroll") for (int n = 0; n < 2; ++n) \
        asm volatile("v_mfma_scale_f32_16x16x128_f8f6f4 %0, %1, %2, %0, %3, %3 op_sel_hi:[0,0,0]" : "+v"(acc[ai][bj][m][n]) : "v"(Bt##8[n]), "v"(At##8[m]), "v"(sc127)); __builtin_amdgcn_s_setprio(0); } while (0)
#define PG8_WAIT_V(n) asm volatile("s_waitcnt vmcnt(" #n ")" ::: "memory")
#define PG8_WAIT_L(n) asm volatile("s_waitcnt lgkmcnt(" #n ")" ::: "memory")
#define PG8_BAR __builtin_amdgcn_s_barrier()
#define PG8_SCHED __builtin_amdgcn_sched_barrier(0)
#define PG8_KLOOP(LDA_, LDB_, MMA_) \
        for (int t = 0; t < nt; t += 2) { \
            const bool last = (t == nt - 2); \
            const char* a1 = cA + (size_t)(t + 1) * kstep; \
            const char* a2 = last ? nA : cA + (size_t)(t + 2) * kstep; const char* b2 = last ? nB : cB + (size_t)(t + 2) * kstep; \
            const char* a3 = a2 + kstep; const char* b3 = b2 + kstep; \
            LDB_(B0, 0, 0); LDB_(B1, 0, 1); PG8_SCHED; LDA_(At, 0, 0); PG8_STAGE_A(PG8_SA(1, 1), a1, 1, false); \
            PG8_WAIT_V(8); PG8_WAIT_L(0); PG8_BAR; MMA_(0, 0, At, B0); MMA_(0, 1, At, B1); PG8_BAR; PG8_SCHED; \
            LDA_(At, 0, 1); PG8_STAGE(PG8_SB(0, 0), b2, voffB); PG8_STAGE(PG8_SB(0, 1), b2 + hsB, voffB); PG8_STAGE_A(PG8_SA(0, 0), a2, 0, last); \
            PG8_WAIT_V(8); PG8_WAIT_L(0); PG8_BAR; MMA_(1, 0, At, B0); MMA_(1, 1, At, B1); PG8_BAR; PG8_SCHED; \
            LDB_(B0, 1, 0); LDB_(B1, 1, 1); PG8_SCHED; LDA_(At, 1, 0); PG8_STAGE_A(PG8_SA(0, 1), a2, 1, last); \
            PG8_WAIT_V(8); PG8_WAIT_L(0); PG8_BAR; MMA_(0, 0, At, B0); MMA_(0, 1, At, B1); PG8_BAR; PG8_SCHED; \
            LDA_(At, 1, 1); PG8_STAGE(PG8_SB(1, 0), b3, voffB); PG8_STAGE(PG8_SB(1, 1), b3 + hsB, voffB); PG8_STAGE_A(PG8_SA(1, 0), a3, 0, last); \
            PG8_WAIT_V(8); PG8_WAIT_L(0); PG8_BAR; MMA_(1, 0, At, B0); MMA_(1, 1, At, B1); PG8_BAR; PG8_SCHED; \
        }
    Unit cur, nxt; int ui = 0;
    if (!S.next(0, cur)) return;
    f32x4 acc[2][2][4][2];
#pragma unroll
    for (int a = 0; a < 2; ++a)
#pragma unroll
        for (int b = 0; b < 2; ++b)
#pragma unroll
            for (int m = 0; m < 4; ++m)
#pragma unroll
                for (int n = 0; n < 2; ++n) acc[a][b][m][n] = (f32x4){0.f, 0.f, 0.f, 0.f};
    const int sc127 = 127;
    bf16x8 At[4][2], B0[2][2], B1[2][2]; v8i32_t At8[4], B08[2], B18[2];
    const char* cA; const char* cB; int nt; bool selc;
    S.ops(cur, cA, cB, nt, selc); selc = (TWO_LDA || MIXED) && selc;
    nt = __builtin_amdgcn_readfirstlane(nt); asm volatile("" : "+s"(nt));
    unsigned hsAc = selc ? hsA1 : hsA0;
    unsigned vgc0[2] = {0u, 0u}, vgc1[2] = {0u, 0u}, vgn0[2] = {0u, 0u}, vgn1[2] = {0u, 0u};
    if constexpr (GATHER) {
#pragma unroll
        for (int i = 0; i < 2; ++i) { vgc0[i] = (unsigned)(S.grow(cur, gR[i]) * lda0 + gC[i]) * 2u; vgc1[i] = (unsigned)(S.grow(cur, HALF + gR[i]) * lda0 + gC[i]) * 2u; } }
#define PG8_STAGE_A(bufoff, gbase, hf, nx) do { if constexpr (GATHER) { const unsigned v_[2] = { (nx) ? vgn##hf[0] : vgc##hf[0], (nx) ? vgn##hf[1] : vgc##hf[1] }; PG8_STAGE(bufoff, gbase, v_); } \
        else { const unsigned v_[2] = PG8_VA((nx) ? seln : selc); PG8_STAGE(bufoff, (gbase) + ((hf) ? ((nx) ? hsAn : hsAc) : 0u), v_); } } while (0)
#define PG8_VA(sel) { (TWO_LDA && (sel)) ? voffA1[0] : voffA0[0], (TWO_LDA && (sel)) ? voffA1[1] : voffA0[1] }
    { const bool seln = selc; const unsigned hsAn = hsAc;
    PG8_STAGE(PG8_SB(0, 0), cB, voffB); PG8_STAGE(PG8_SB(0, 1), cB + hsB, voffB); PG8_STAGE_A(PG8_SA(0, 0), cA, 0, false); PG8_STAGE_A(PG8_SA(0, 1), cA, 1, false);
    if (wr == 1) PG8_BAR;
    PG8_WAIT_V(2); PG8_BAR;
    PG8_STAGE(PG8_SB(1, 0), cB + kstep, voffB); PG8_STAGE_A(PG8_SA(1, 0), cA + kstep, 0, false); PG8_STAGE(PG8_SB(1, 1), cB + hsB + kstep, voffB); }
    PG8_WAIT_V(6); PG8_BAR;
    for (;;) {
        const bool has_next = S.next(ui + 1, nxt);
        const char* nA = cA; const char* nB = cB; int ntn = nt; bool seln = selc;
        if (has_next) { S.ops(nxt, nA, nB, ntn, seln); seln = (TWO_LDA || MIXED) && seln; }
        const unsigned hsAn = seln ? hsA1 : hsA0;
        if constexpr (GATHER) {
#pragma unroll
            for (int i = 0; i < 2; ++i) { vgn0[i] = has_next ? (unsigned)(S.grow(nxt, gR[i]) * lda0 + gC[i]) * 2u : vgc0[i]; vgn1[i] = has_next ? (unsigned)(S.grow(nxt, HALF + gR[i]) * lda0 + gC[i]) * 2u : vgc1[i]; } }
        if constexpr (MIXED) { if (selc) { PG8_KLOOP(PG8_LDA8, PG8_LDB8, PG8_MMA8) } else { PG8_KLOOP(PG8_LDA4, PG8_LDB4, PG8_MMA16A) } }
        else if constexpr (FP8) { PG8_KLOOP(PG8_LDA8, PG8_LDB8, PG8_MMA8) }
        else { PG8_KLOOP(PG8_LDA4, PG8_LDB4, PG8_MMAB) }
        if constexpr (ALIGN_EPI) { if (wr == 0) PG8_BAR; }
        if constexpr (FP8 || MIXED) asm volatile("s_nop 15\n\ts_nop 15" ::: "memory");
        { int t_ = tid; asm volatile("" : "+v"(t_)); const int fr_ = t_ & 15, fq_ = (t_ >> 4) & 3; E(acc, cur, wr, wc, fr_, fq_); }
        if (!has_next) break;
#pragma unroll
        for (int a = 0; a < 2; ++a)
#pragma unroll
            for (int b = 0; b < 2; ++b)
#pragma unroll
                for (int m = 0; m < 4; ++m)
#pragma unroll
                    for (int n = 0; n < 2; ++n) acc[a][b][m][n] = (f32x4){0.f, 0.f, 0.f, 0.f};
        cur = nxt; cA = nA; cB = nB; selc = seln; hsAc = hsAn; nt = ntn; ++ui;
        if constexpr (GATHER) { vgc0[0] = vgn0[0]; vgc0[1] = vgn0[1]; vgc1[0] = vgn1[0]; vgc1[1] = vgn1[1]; }
        if constexpr (ALIGN_EPI) { if (wr == 1) PG8_BAR; }
    }
    PG8_WAIT_V(0);
    if constexpr (!ALIGN_EPI) { if (wr == 0) PG8_BAR; }
    PG8_BAR;
#undef PG8_VA
#undef PG8_STAGE_A
#undef PG8_SA
#undef PG8_SB
#undef PG8_STAGE
#undef PG8_MMAB
#undef PG8_MMA8
#undef PG8_MMA16A
#undef PG8_KLOOP
#undef PG8_LDA4
#undef PG8_LDB4
#undef PG8_LDA8
#undef PG8_LDB8
#undef PG8_WAIT_V
#undef PG8_WAIT_L
#undef PG8_BAR
#undef PG8_SCHED
}
}

#include <hip/hip_bf16.h>
#include <cmath>
namespace attn_body {
using bf16=__hip_bfloat16;
using i32x8=__attribute__((ext_vector_type(8)))int;
using i32x4=__attribute__((ext_vector_type(4)))int;
using f32x16=__attribute__((ext_vector_type(16)))float;
using u32x4=__attribute__((ext_vector_type(4)))unsigned;
constexpr int BATCH=8,NHEAD=8,SEQ=8192,D=64,DM=NHEAD*D;
constexpr int Q8P=1024,O8P=4096; constexpr float OSC=64.0f;
constexpr int NW=8,QBLK=32,QB=QBLK*NW,KVBLK=64,NQB=SEQ/QB;
__device__ __forceinline__ int crow(int r,int hi){return (r&3)+8*(r>>2)+4*hi;}
#define SBAR() __builtin_amdgcn_sched_barrier(0)
constexpr int NSLOT=3, SLOTB=4096;
constexpr int LDS_K=0, LDS_V=NSLOT*SLOTB, LDS_WS=2*NSLOT*SLOTB, LDS_OST=LDS_WS+NW*64*4, LDS_BYTES=LDS_OST+NW*4096;
__device__ __forceinline__ void glds16(const void*gsrc,unsigned lds_dst){unsigned keep;
  asm volatile("s_mov_b32 %0, m0\n\ts_mov_b32 m0, %2\n\ts_nop 0\n\tglobal_load_lds_dwordx4 %1, off\n\ts_mov_b32 m0, %0":"=&s"(keep):"v"(gsrc),"s"(lds_dst):"memory");}
#define WAIT_BAR(N) asm volatile("s_waitcnt vmcnt(" #N ") lgkmcnt(0)\n\ts_barrier":::"memory")
typedef __attribute__((address_space(3))) const char* lds_cptr;
__device__ __forceinline__ i32x8 frag32(lds_cptr p){ const i32x4 a=*(const __attribute__((address_space(3))) i32x4*)(p), b=*(const __attribute__((address_space(3))) i32x4*)(p+1024); return (i32x8){a[0],a[1],a[2],a[3],b[0],b[1],b[2],b[3]}; }
#define MFMA_QK(D_,A,B,C) asm volatile("v_mfma_scale_f32_32x32x64_f8f6f4 %0, %1, %2, %3, %4, %5 op_sel_hi:[0,0,0]":"=&v"(D_):"v"(A),"v"(B),"v"(C),"v"(scA),"v"(scB))
#define MFMA_PV(D_,A,B) asm volatile("v_mfma_f32_32x32x64_f8f6f4 %0, %1, %2, %0 cbsz:1":"+v"(D_):"v"(A),"v"(B))

#ifndef ATTN_STORE16
#define ATTN_STORE16(p,v) (*(u32x4*)(p)=(v))
#endif
__device__ __forceinline__ void attn_unit(int tid_in,float negM,int b,int h,int qb,const unsigned char*Q8,const unsigned char*__restrict__ K8,const unsigned char*__restrict__ Vt8,unsigned char*O8,char*shm,const bool do_store=true){
  const int tid=tid_in,lane=tid&63,r32=lane&31,hi=lane>>5; const int wid=__builtin_amdgcn_readfirstlane(tid>>6);
  const long rowbase=(long)b*SEQ; const int q0=qb*QB; const int kvh=h>>2;
  const unsigned lds0=(unsigned)(uintptr_t)shm;
  const bool kw=wid<4;
  const int ki=lane&31, kkey=32*((ki>>2)&1)+16*(lane>>5)+(ki&3)+4*(ki>>3);
  const unsigned char*ksrc=K8+((long)(b*2+kvh)*SEQ+kkey)*64+(wid&3)*16;
  const unsigned char*vsrc=Vt8+((long)(b*2+kvh)*64+lane)*SEQ+(wid&3)*16;
  const unsigned char*dsrc=kw?ksrc:vsrc; const int dstep=kw?KVBLK*64:KVBLK;
  const unsigned ddst=lds0+(kw?LDS_K:LDS_V)+(wid&3)*1024;
  const int NT=SEQ/KVBLK;
  #define DMA(tt,slot) do{ int ti_=(tt); ti_=ti_<NT?ti_:NT-1; glds16(dsrc+(long)ti_*dstep,(unsigned)__builtin_amdgcn_readfirstlane(ddst+(slot))); }while(0)
  const lds_cptr shm3=(lds_cptr)shm; const lds_cptr kp0=shm3+LDS_K+hi*2048+r32*16; const lds_cptr vp0=shm3+LDS_V+hi*2048+r32*16;
  const unsigned char*Qw=Q8+(rowbase+q0+wid*QBLK+r32)*Q8P+h*128+hi*32;
  const i32x4 qa=*(const i32x4*)Qw, qb_=*(const i32x4*)(Qw+16);
  const i32x8 qf=(i32x8){qa[0],qa[1],qa[2],qa[3],qb_[0],qb_[1],qb_[2],qb_[3]};
  if(kw){DMA(0,0);DMA(1,SLOTB);DMA(2,2*SLOTB);}
  f32x16 o[2],ol;o[0]=f32x16{};o[1]=f32x16{};ol=f32x16{};f32x16 negm;
  #pragma unroll
  for(int r=0;r<16;++r)negm[r]=negM;
  asm volatile("":"+v"(negm));
  f32x16 pA0,pA1,pB0,pB1; i32x8 kf0,kf1,vf0,vf1,pw0=(i32x8){0,0,0,0,0,0,0,0},pw1=(i32x8){0,0,0,0,0,0,0,0};
  i32x8 ones; _Pragma("unroll") for(int r=0;r<8;++r)ones[r]=0x38383838; asm volatile("":"+v"(ones));
#ifdef ATT_CODE_EXP
  int scA=127,scB=125; asm volatile("":"+v"(scA),"+v"(scB));
#else
  int scA=127,scB=123; asm volatile("":"+v"(scA),"+v"(scB));
#endif
  int sl_cur=0,sl_next=SLOTB;
  #define ROT() do{sl_cur=sl_next;sl_next=(sl_next==(NSLOT-1)*SLOTB)?0:sl_next+SLOTB;}while(0)
  #define EX(v) __builtin_amdgcn_exp2f(v)
  #define PIN(x) asm volatile("":"+v"(x))
#ifdef ATT_CODE_EXP
  #define PACK2(P,PW,J,LO) do{ _Pragma("unroll") for(int j_=0;j_<2;++j_){ unsigned w_=(unsigned)PW[(J)+j_]; _Pragma("unroll") for(int b_=0;b_<4;++b_) w_=__builtin_amdgcn_cvt_pk_u8_f32(P[(LO)+4*j_+b_],b_,w_); PW[(J)+j_]=(int)w_; } }while(0)
  #define PACK(P,PW,J) do{ PACK2(P,PW,J,0); PACK2(P,PW,(J)+2,8); }while(0)
  #define EXPS(P,LO) do{}while(0)
  #define G1(Y0,Y1,PWN) do{ PACK2(Y0,PWN,0,0); PIN(PWN); }while(0)
  #define G2(Y0,Y1,PWN) do{ PACK2(Y0,PWN,2,8); PIN(PWN); }while(0)
  #define G3(Y0,Y1,PWN) do{ PACK2(Y1,PWN,4,0); PIN(PWN); }while(0)
  #define G4(Y0,Y1,PWN) do{ PACK2(Y1,PWN,6,8); PIN(PWN); }while(0)
  #define G5(Y0,Y1,PWN) do{}while(0)
#else
  #define PK2(P,B,OLD,HIW) __builtin_amdgcn_cvt_pk_bf8_f32(P[B],P[B+1],OLD,HIW)
  #define PACK(P,PW,J) do{ _Pragma("unroll") for(int j_=0;j_<4;++j_){ int w_=PK2(P,4*j_,PW[(J)+j_],false); w_=PK2(P,4*j_+2,w_,true); PW[(J)+j_]=w_; } }while(0)
  #define EXPS(P,LO) do{ _Pragma("unroll") for(int r_=(LO);r_<(LO)+8;++r_)P[r_]=EX(P[r_]); PIN(P); }while(0)
  #define G1(Y0,Y1,PWN) EXPS(Y0,0)
  #define G2(Y0,Y1,PWN) EXPS(Y0,8)
  #define G3(Y0,Y1,PWN) EXPS(Y1,0)
  #define G4(Y0,Y1,PWN) EXPS(Y1,8)
  #define G5(Y0,Y1,PWN) do{ PACK(Y0,PWN,0); PACK(Y1,PWN,4); PIN(PWN); }while(0)
#endif
  if(kw){asm volatile("s_waitcnt vmcnt(2)":::"memory");}else{asm volatile("s_waitcnt vmcnt(0)":::"memory");}
  asm volatile("s_barrier":::"memory");
  kf0=frag32(kp0);kf1=frag32(kp0+512);
  MFMA_QK(pA0,kf0,qf,negm);MFMA_QK(pA1,kf1,qf,negm);asm volatile("s_nop 15\n\ts_nop 7":"+v"(pA0),"+v"(pA1));
  WAIT_BAR(1);
  DMA(kw?3:0,0);
  ROT();
  kf0=frag32(kp0+sl_cur);kf1=frag32(kp0+sl_cur+512);
  WAIT_BAR(1);
  MFMA_QK(pB0,kf0,qf,negm); EXPS(pA0,0); EXPS(pA0,8); SBAR();
  MFMA_QK(pB1,kf1,qf,negm); EXPS(pA1,0); EXPS(pA1,8); SBAR();
  DMA(kw?4:1,sl_cur);
  kf0=frag32(kp0+sl_next);kf1=frag32(kp0+sl_next+512);
  PACK(pA0,pw0,0); PACK(pA1,pw0,4); PIN(pw0);
  WAIT_BAR(1); ROT();
  #define STEP(X0,X1,Y0,Y1,PWN,PWO,t) do{ SBAR(); \
    vf0=frag32(vp0+sl_next); vf1=frag32(vp0+sl_next+512); SBAR(); \
    MFMA_QK(X0,kf0,qf,negm); G1(Y0,Y1,PWN); SBAR(); \
    MFMA_QK(X1,kf1,qf,negm); G2(Y0,Y1,PWN); SBAR(); \
    DMA(kw?(t)+3:(t),sl_cur); \
    kf0=frag32(kp0+sl_next); kf1=frag32(kp0+sl_next+512); SBAR(); \
    MFMA_PV(o[0],PWO,vf0); G3(Y0,Y1,PWN); SBAR(); \
    MFMA_PV(o[1],PWO,vf1); G4(Y0,Y1,PWN); SBAR(); \
    MFMA_PV(ol,PWO,ones); G5(Y0,Y1,PWN); SBAR(); \
    }while(0)
  for(int t=2;t<NT;t+=2){
    STEP(pA0,pA1,pB0,pB1,pw1,pw0,t);     WAIT_BAR(1); ROT();
    STEP(pB0,pB1,pA0,pA1,pw0,pw1,t+1);   WAIT_BAR(1); ROT();
  }
  { vf0=frag32(vp0+sl_next); vf1=frag32(vp0+sl_next+512);
    MFMA_PV(o[0],pw0,vf0); EXPS(pB0,0); EXPS(pB0,8); SBAR();
    MFMA_PV(o[1],pw0,vf1); EXPS(pB1,0); EXPS(pB1,8); SBAR();
    DMA(NT,sl_cur);
    MFMA_PV(ol,pw0,ones); PACK(pB0,pw1,0); PACK(pB1,pw1,4); PIN(pw1);
    WAIT_BAR(1); ROT(); }
  { vf0=frag32(vp0+sl_next); vf1=frag32(vp0+sl_next+512);
    MFMA_PV(o[0],pw1,vf0); MFMA_PV(o[1],pw1,vf1); MFMA_PV(ol,pw1,ones); asm volatile("s_nop 15\n\ts_nop 7":"+v"(o[0]),"+v"(o[1]),"+v"(ol)); }
#ifndef ATT_CODE_EXP
  #undef PK2
#else
  #undef PACK2
#endif
  #undef PACK
  #undef G1
  #undef G2
  #undef G3
  #undef G4
  #undef G5
  #undef EXPS
  #undef PIN
  #undef EX
  #undef STEP
  float rli[16];
  #pragma unroll
  for(int r=0;r<16;++r)rli[r]=__builtin_amdgcn_rcpf(ol[r])*OSC;
  unsigned char*Ow=O8+(rowbase+q0+wid*QBLK)*(long)O8P+h*D;
  { unsigned char*stg=(unsigned char*)(shm+LDS_OST)+wid*2048;
    #pragma unroll
    for(int r=0;r<16;++r){const int orow=crow(r,hi);
      #pragma unroll
      for(int d0=0;d0<2;++d0){ const float v_=o[d0][r]*rli[r]; stg[orow*64+d0*32+r32]=(unsigned char)__builtin_amdgcn_cvt_pk_fp8_f32(v_,v_,0,false); } }
    asm volatile("s_waitcnt lgkmcnt(0)":::"memory");
    #pragma unroll
    for(int i=0;i<2;++i){const int idx=i*64+lane,row=idx>>2,ch=idx&3; const u32x4 v=*(const u32x4*)(stg+row*64+ch*16); if(do_store)ATTN_STORE16(Ow+(long)row*O8P+ch*16,v);} }
  asm volatile("s_waitcnt vmcnt(0) lgkmcnt(0)\n\ts_barrier":::"memory");
  #undef DMA
  #undef ROT
}
constexpr int ATTN_LDS_BYTES=LDS_BYTES;
#undef SBAR
#undef WAIT_BAR
#undef MFMA_QK
#undef MFMA_PV
}

constexpr int NWAVES = 8, NTHR = NWAVES * 64;
constexpr int BATCH = 8, SEQ = 8192, DMODEL = 1024, M = BATCH * SEQ;
constexpr int NPJ = 3328;
constexpr int COL_VL = 1920, COL_POOL = 2048, COL_Q = 2560, COL_K = 3072, COL_V = 3200;
constexpr int NEXP = 16, CAP = 1024, MR = BATCH * NEXP * CAP;
constexpr int NPROJ_IN = 6272;
constexpr float C2Q = 0.125f * 1.4426950408889634f;
constexpr int N_PHASES = 28, PH_PER_LAYER = 13;
constexpr int XBP = 2048;

constexpr size_t MiB = 1u << 20;
constexpr size_t WS_CTL = 0, CTL_ZERO_BYTES = 1 * MiB;
constexpr size_t WS_ROPE = 1 * MiB;
constexpr size_t WS_W = 3 * MiB, WL_STRIDE = 23 * MiB;
constexpr size_t WO_IN = 0, WO_G = 6656 * 1024, WO_LORA = WO_G + 6 * MiB, WO_G2 = WO_LORA + 1 * MiB, WO_PW = WO_G2 + 256 * 1024, WO_BR = WO_PW + 512 * 1024, WO_OUT = WO_BR + 6 * MiB;
constexpr size_t WO_BRA8 = WO_BR + 3 * MiB;
constexpr size_t WO_QKV8 = WO_G + 3 * MiB;
static_assert(WO_OUT + 2 * MiB <= WL_STRIDE && WO_QKV8 + 768 * 2048 <= WO_LORA, "weight map");
constexpr size_t WS_VF = 49 * MiB, WS_AFFT = 113 * MiB, WS_IDX = 117 * MiB, WS_VAL = WS_IDX + 512 * 1024, WS_INV = 118 * MiB, WS_CFB = 122 * MiB;
constexpr size_t ACT = 128 * MiB;
constexpr size_t A_PRJ = ACT, A_R = ACT + 416 * MiB, A_KS = ACT + 480 * MiB, A_VS = ACT + 544 * MiB, A_Q = ACT + 608 * MiB, A_K = ACT + 672 * MiB, A_V = ACT + 688 * MiB,
                 A_TW = ACT + 704 * MiB, A_PL = ACT + 752 * MiB, A_HN1 = ACT + 672 * MiB;
constexpr size_t A_LW = ACT, A_AA = ACT + 128 * MiB, A_G = ACT + 256 * MiB, A_YB = ACT + 320 * MiB, A_YSF = ACT + 704 * MiB, A_YSB = ACT + 768 * MiB;
constexpr size_t A_HN = ACT, A_YA = ACT + 128 * MiB, A_TS = ACT + 192 * MiB, A_MG = ACT + 416 * MiB;
constexpr size_t A_WGU = ACT + 832 * MiB, A_WD = ACT + 384 * MiB, A_XG = ACT + 416 * MiB, A_HID = ACT + 128 * MiB, A_YE = ACT + 416 * MiB;
constexpr size_t WS_END = ACT + 896 * MiB;
constexpr int CW_BAR = 4096;
constexpr int CW_ATTQ = 200000;

constexpr int RING_OFF = 0, RING_BYTES = 131072;
constexpr int LDSCTL_OFF = RING_BYTES, MISC_OFF = LDSCTL_OFF + 320;
constexpr int LDS_BYTES = 147456;

#define GAS __attribute__((address_space(1)))
#define LAS __attribute__((address_space(3)))
typedef unsigned short bf16;
typedef unsigned v4u __attribute__((ext_vector_type(4)));
typedef unsigned v2u __attribute__((ext_vector_type(2)));
typedef float f32x4 __attribute__((ext_vector_type(4)));
typedef float f32x2 __attribute__((ext_vector_type(2)));
typedef GAS unsigned gu32;
#define RLX_AGENT __ATOMIC_RELAXED, __HIP_MEMORY_SCOPE_AGENT
#define LDS_WAIT() asm volatile("s_waitcnt lgkmcnt(0)" ::: "memory")
typedef float f32x2c_t __attribute__((ext_vector_type(2))); typedef __bf16 bf16x2c_t __attribute__((ext_vector_type(2)));
__device__ __forceinline__ unsigned pk2(float lo, float hi) { const f32x2c_t v = {lo, hi}; const bf16x2c_t b = __builtin_convertvector(v, bf16x2c_t); return __builtin_bit_cast(unsigned, b); }
__device__ __forceinline__ unsigned f2bf(float f) { return pk2(f, 0.f) & 0xffffu; }
__device__ __forceinline__ void unp8(const v4u& p, float (&f)[8]) {
    f[0] = __uint_as_float(p.x << 16); f[1] = __uint_as_float(p.x & 0xffff0000u); f[2] = __uint_as_float(p.y << 16); f[3] = __uint_as_float(p.y & 0xffff0000u);
    f[4] = __uint_as_float(p.z << 16); f[5] = __uint_as_float(p.z & 0xffff0000u); f[6] = __uint_as_float(p.w << 16); f[7] = __uint_as_float(p.w & 0xffff0000u); }
__device__ __forceinline__ v4u pk8(const float (&f)[8]) { v4u o; o.x = pk2(f[0], f[1]); o.y = pk2(f[2], f[3]); o.z = pk2(f[4], f[5]); o.w = pk2(f[6], f[7]); return o; }
__device__ __forceinline__ v4u ld16(const bf16* p) { return *(const v4u*)p; }
__device__ __forceinline__ void st16(bf16* p, const v4u& v) { *(v4u*)p = v; }
__device__ __forceinline__ void ldf8(const float* p, float (&f)[8]) { const f32x4 a = *(const f32x4*)p, b = *(const f32x4*)(p + 4); f[0] = a[0]; f[1] = a[1]; f[2] = a[2]; f[3] = a[3]; f[4] = b[0]; f[5] = b[1]; f[6] = b[2]; f[7] = b[3]; }
__device__ __forceinline__ float sigmf(float x) { return __builtin_amdgcn_rcpf(1.0f + __builtin_amdgcn_exp2f(-1.4426950408889634f * x)); }
__device__ __forceinline__ float shx(float v, int m, int lane) { return __builtin_bit_cast(float, __builtin_amdgcn_ds_bpermute((lane ^ m) << 2, __builtin_bit_cast(int, v))); }
__device__ __forceinline__ float shx_from(float v, int src, int lane) { (void)lane; return __builtin_bit_cast(float, __builtin_amdgcn_ds_bpermute((src & 63) << 2, __builtin_bit_cast(int, v))); }
__device__ __forceinline__ int shxi(int v, int m, int lane) { return __builtin_amdgcn_ds_bpermute((lane ^ m) << 2, v); }
__device__ __forceinline__ int shupi(int v, int o, int lane) { return __builtin_amdgcn_ds_bpermute((lane >= o ? lane - o : lane) << 2, v); }
template <int CTRL> __device__ __forceinline__ float dppf(float v) { return __builtin_bit_cast(float, __builtin_amdgcn_update_dpp(0, __builtin_bit_cast(int, v), CTRL, 0xf, 0xf, true)); }
__device__ __forceinline__ float sum8(float v, int lane) { (void)lane; v += dppf<0xB1>(v); v += dppf<0x4E>(v); v += dppf<0x141>(v); return v; }
__device__ __forceinline__ float sum16(float v) { v += dppf<0xB1>(v); v += dppf<0x4E>(v); v += dppf<0x141>(v); v += dppf<0x140>(v); return v; }
__device__ __forceinline__ float max16(float v) { v = fmaxf(v, dppf<0xB1>(v)); v = fmaxf(v, dppf<0x4E>(v)); v = fmaxf(v, dppf<0x141>(v)); v = fmaxf(v, dppf<0x140>(v)); return v; }
__device__ __forceinline__ float sum_rows(float v) {
    { const auto r = __builtin_amdgcn_permlane16_swap(__builtin_bit_cast(unsigned, v), __builtin_bit_cast(unsigned, v), false, false); v = __uint_as_float(r[0]) + __uint_as_float(r[1]); }
    { const auto r = __builtin_amdgcn_permlane32_swap(__builtin_bit_cast(unsigned, v), __builtin_bit_cast(unsigned, v), false, false); v = __uint_as_float(r[0]) + __uint_as_float(r[1]); }
    return v; }
__device__ __forceinline__ float wave_sum(float v, int lane) { (void)lane; return sum_rows(sum16(v)); }


#define XB_TMO      128
#define XB_XCNT(j)  (256  + 64 * (j))
#define XB_XSUB(j)  (1280 + 64 * (j))
#define XB_XGEN(j)  (2304 + 64 * (j))
#define XB_TOP      3328
#define XB_TOPGEN   3392
#define XCD_BAR_WORDS 3456
#define XB_SPIN_CAP (1u << 22)

__device__ __forceinline__ unsigned xb_ld(unsigned* p)              { return __hip_atomic_load(p, __ATOMIC_RELAXED, __HIP_MEMORY_SCOPE_AGENT); }
__device__ __forceinline__ unsigned xb_add(unsigned* p, unsigned v) { return __hip_atomic_fetch_add(p, v, __ATOMIC_RELAXED, __HIP_MEMORY_SCOPE_AGENT); }
__device__ __forceinline__ unsigned xb_xcc_id() { return (unsigned)__builtin_amdgcn_s_getreg((3 << 11) | 20) & 0xFu; }
#define XB_SPIN(cond, bar) do { unsigned _sp = 0; while (cond) { __builtin_amdgcn_s_sleep(1); \
    if ((++_sp & 255u) == 0u) { if (xb_ld(&(bar)[XB_TMO])) break; if (_sp > XB_SPIN_CAP) { atomicAdd(&(bar)[XB_TMO], 1u); break; } } } } while (0)

struct XcdBarrier {
    unsigned* bar; unsigned x;
    volatile LAS unsigned* st;
};

__device__ __forceinline__ XcdBarrier xcd_barrier_post(unsigned* bar, volatile LAS unsigned* st) {
    XcdBarrier b; b.bar = bar; b.x = xb_xcc_id(); b.st = st;
    if (threadIdx.x == 0) (void)xb_add(&bar[XB_XCNT(b.x)], 1u);
    return b;
}
__device__ __forceinline__ void xcd_barrier_complete(unsigned* bar, unsigned x, unsigned& nloc, unsigned& nx) {
    const unsigned G = gridDim.x * gridDim.y * gridDim.z;
    unsigned sum, cnt, mine, sp = 0u;
    for (;;) {
        sum = 0u; cnt = 0u; mine = 0u;
#pragma unroll
        for (unsigned j = 0; j < 16; ++j) { const unsigned c = xb_ld(&bar[XB_XCNT(j)]); sum += c; cnt += (c > 0u) ? 1u : 0u; mine = (j == x) ? c : mine; }
        if (sum == G) break;
        __builtin_amdgcn_s_sleep(1);
        if ((++sp & 255u) == 0u) { if (xb_ld(&bar[XB_TMO])) break; if (sp > XB_SPIN_CAP) { atomicAdd(&bar[XB_TMO], 1u); break; } }
    }
    nloc = mine > 0u ? mine : 1u; nx = cnt > 0u ? cnt : 1u;
}

__device__ __forceinline__ void xcd_barrier(const XcdBarrier& b) {
    asm volatile("s_waitcnt vmcnt(0)" ::: "memory");
    __syncthreads();
    if (threadIdx.x == 0) {
        unsigned* bar = b.bar;
        __builtin_amdgcn_s_waitcnt(0);
        unsigned nloc = b.st[0], nx = b.st[1];
        if (nloc == 0u) { xcd_barrier_complete(bar, b.x, nloc, nx); b.st[0] = nloc; b.st[1] = nx; }
        const unsigned old = xb_add(&bar[XB_XSUB(b.x)], 1u);
        const unsigned gen = old / nloc;
        if (old + 1u == (gen + 1u) * nloc) {
            __builtin_amdgcn_fence(__ATOMIC_RELEASE, "agent");
            asm volatile("s_waitcnt vmcnt(0)" ::: "memory");
            const unsigned og = xb_add(&bar[XB_TOP], 1u);
            const unsigned tg = og / nx;
            if (og + 1u == (tg + 1u) * nx) xb_add(&bar[XB_TOPGEN], 1u);
            else XB_SPIN(xb_ld(&bar[XB_TOPGEN]) == tg, bar);
            __builtin_amdgcn_fence(__ATOMIC_ACQUIRE, "agent");
            xb_add(&bar[XB_XGEN(b.x)], 1u);
            asm volatile("s_waitcnt vmcnt(0)" ::: "memory");
        } else {
            XB_SPIN(xb_ld(&bar[XB_XGEN(b.x)]) == gen, bar);
            __builtin_amdgcn_fence(__ATOMIC_ACQUIRE, "agent");
            asm volatile("s_waitcnt vmcnt(0)" ::: "memory");
        }
    }
    __syncthreads();
}

__device__ __forceinline__ void tr_item(const float* W, int src_ld, int k0, int n0, bf16* WT, int dst_ld, int dst_row0, LAS float* scr, int lane, float sc = 1.0f) {
    float t_[32];
#pragma unroll
    for (int i = 0; i < 32; ++i) t_[i] = W[(size_t)(k0 + 2 * i + (lane >> 5)) * src_ld + n0 + (lane & 31)];
#pragma unroll
    for (int i = 0; i < 32; ++i) scr[(2 * i + (lane >> 5)) * 33 + (lane & 31)] = t_[i] * sc;
    LDS_WAIT(); asm volatile("" ::: "memory");
    const int c = lane & 7;
#pragma unroll
    for (int j = 0; j < 4; ++j) { const int n = (lane >> 3) + 8 * j; const LAS float* s = scr + (8 * c) * 33 + n;
        v4u o; o.x = pk2(s[0 * 33], s[1 * 33]); o.y = pk2(s[2 * 33], s[3 * 33]); o.z = pk2(s[4 * 33], s[5 * 33]); o.w = pk2(s[6 * 33], s[7 * 33]);
        *(GAS v4u*)(WT + (size_t)(dst_row0 + n) * dst_ld + k0 + 8 * c) = o; }
    LDS_WAIT(); asm volatile("" ::: "memory");
}
__device__ __forceinline__ void tr_item8(const float* W, int src_ld, int k0, int n0, unsigned char* WT8, int dst_ld, int dst_row0, float sc, LAS float* scr, int lane) {
    float t_[32];
#pragma unroll
    for (int i = 0; i < 32; ++i) t_[i] = W[(size_t)(k0 + 2 * i + (lane >> 5)) * src_ld + n0 + (lane & 31)];
#pragma unroll
    for (int i = 0; i < 32; ++i) scr[(2 * i + (lane >> 5)) * 33 + (lane & 31)] = t_[i] * sc;
    LDS_WAIT(); asm volatile("" ::: "memory");
#pragma unroll
    for (int j = 0; j < 2; ++j) { const int q = lane + 64 * j, n = q >> 2, c = q & 3; const LAS float* s = scr + (16 * c) * 33 + n; v4u o;
        o.x = pg8::pk4_fp8(s[0 * 33], s[1 * 33], s[2 * 33], s[3 * 33]); o.y = pg8::pk4_fp8(s[4 * 33], s[5 * 33], s[6 * 33], s[7 * 33]);
        o.z = pg8::pk4_fp8(s[8 * 33], s[9 * 33], s[10 * 33], s[11 * 33]); o.w = pg8::pk4_fp8(s[12 * 33], s[13 * 33], s[14 * 33], s[15 * 33]);
        *(GAS v4u*)(WT8 + (size_t)(dst_row0 + n) * dst_ld + k0 + 16 * c) = o; }
    LDS_WAIT(); asm volatile("" ::: "memory");
}
__device__ __forceinline__ void tr_job(const float* W, int src_ld, int col0, int K, int ncols, bf16* WT, int dst_ld, int dst_row0, LAS float* scr, int gw, int NGW, int lane, float sc = 1.0f) {
    const int nblk = ncols / 32, nitems = (K / 64) * nblk;
    for (int it = gw; it < nitems; it += NGW) { const int kb = it / nblk, nb = it - kb * nblk; tr_item(W, src_ld, 64 * kb, col0 + 32 * nb, WT, dst_ld, dst_row0 + 32 * nb, scr, lane, sc); }
}
__device__ __forceinline__ void zero_rows(bf16* WT, int row0, int nrows, int ld, int gtid, int NGT) {
    const int per = ld / 8, n = nrows * per;
    for (int i = gtid; i < n; i += NGT) *(GAS v4u*)(WT + (size_t)(row0 + i / per) * ld + (i % per) * 8) = (v4u){0u, 0u, 0u, 0u};
}

__device__ __forceinline__ void p0_prologue(const float* const* in, unsigned char* ws, LAS unsigned char* lds, int vcu, int G, int tid, int wave, int lane) {
    LAS float* scr = (LAS float*)(lds + RING_OFF + wave * 16384);
    const int gw = vcu * NWAVES + wave, NGW = G * NWAVES, gtid = vcu * NTHR + tid, NGT = G * NTHR;
    { f32x2* rope = (f32x2*)(ws + WS_ROPE);
      for (int i = gtid; i < SEQ * 32; i += NGT) { const int s = i >> 5, p = i & 31, fi = p & 15; const float freq = exp2f(-(float)(2 * fi) * (13.287712379549449f / 32.0f));
          const float pos = (p < 16) ? (float)(s >> 6) : (float)(s & 63); float sn, cs; sincosf(pos * freq, &sn, &cs); rope[i] = (f32x2){cs, sn}; } }
    for (int l = 0; l < 2; ++l) {
        unsigned char* wl = ws + WS_W + (size_t)l * WL_STRIDE;
        const float* w_in = in[2] + (size_t)l * DMODEL * NPROJ_IN;
        bf16* Win_t = (bf16*)(wl + WO_IN); bf16* Wg_t = (bf16*)(wl + WO_G); bf16* Wlo_t = (bf16*)(wl + WO_LORA); bf16* Wg2_t = (bf16*)(wl + WO_G2); bf16* PW_t = (bf16*)(wl + WO_PW);
        bf16* Wbr_t = (bf16*)(wl + WO_BR); bf16* Wout_t = (bf16*)(wl + WO_OUT);
        tr_job(w_in, NPROJ_IN, 0, DMODEL, 1920, Win_t, DMODEL, 0, scr, gw, NGW, lane);
        tr_job(w_in, NPROJ_IN, 1920, DMODEL, 512, Win_t, DMODEL, COL_POOL, scr, gw, NGW, lane);
        { const int nblk = 768 / 32, nitems = (DMODEL / 64) * nblk; unsigned char* Wq8 = wl + WO_QKV8;
          for (int it = gw; it < nitems; it += NGW) { const int kb = it / nblk, nb = it - kb * nblk; tr_item8(w_in, NPROJ_IN, 64 * kb, 2432 + 32 * nb, Wq8, 2048, 32 * nb, 32.0f, scr, lane); } }
        { const int nblk = 3072 / 32, nitems = (DMODEL / 64) * nblk;
          for (int it = gw; it < nitems; it += NGW) { const int kb = it / nblk, nb = it - kb * nblk; tr_item8(w_in, NPROJ_IN, 64 * kb, 3200 + 32 * nb, (unsigned char*)Wg_t, DMODEL, 32 * nb, 32.0f, scr, lane); } }
        if (l == 0) zero_rows(Win_t, 1920, 128, DMODEL, gtid, NGT);
        else { tr_job(in[16], 32, 0, DMODEL, 32, Win_t, DMODEL, COL_VL, scr, gw, NGW, lane); zero_rows(Win_t, 1952, 96, DMODEL, gtid, NGT); }
        tr_job(in[22] + (size_t)l * 512 * 1024, 1024, 0, 512, 1024, Wbr_t, 512, 0, scr, gw, NGW, lane);
        tr_job(in[23] + (size_t)l * 512 * 1024, 1024, 0, 512, 1024, Wbr_t, 512, 1024, scr, gw, NGW, lane);
        #ifndef PROBE_ATT_AMP
#define PROBE_ATT_AMP 1.0f
#endif
        { const float* wa = in[24] + (size_t)l * 512 * 1024; unsigned char* Wa8 = wl + WO_BRA8;
          const int nblk = 1024 / 32, nitems = (512 / 64) * nblk;
          for (int it = gw; it < nitems; it += NGW) { const int kb = it / nblk, nb = it - kb * nblk; tr_item8(wa, 1024, 64 * kb, 32 * nb, Wa8, 1024, 32 * nb, 32.0f, scr, lane); } }
        tr_job(in[25] + (size_t)l * 1024 * 1024, 1024, 0, 1024, 1024, Wout_t, 1024, 0, scr, gw, NGW, lane);
        { const float* w2 = in[6] + (size_t)l * 2 * 64 * 512; const float* a2 = in[8] + (size_t)l * 2 * 64 * 512;
          for (int i = gtid; i < 2048 * 16; i += NGT) { const int n = i >> 4, k0 = (i & 15) * 8; const bool isa = n >= 1024; const int nn = n & 1023, dir = nn >> 9, c = nn & 511, kb = 64 * dir;
              float f[8];
#pragma unroll
              for (int j = 0; j < 8; ++j) { const int k = k0 + j; f[j] = (k >= kb && k < kb + 64) ? (isa ? a2 : w2)[((size_t)dir * 64 + (k - kb)) * 512 + c] : 0.f; }
              *(GAS v4u*)(Wlo_t + (size_t)n * 128 + k0) = pk8(f); } }
        { const float* g2 = in[9] + (size_t)l * 128 * 512;
          for (int i = gtid; i < 512 * 16; i += NGT) { const int n = i >> 4, k0 = (i & 15) * 8; float f[8];
#pragma unroll
              for (int j = 0; j < 8; ++j) f[j] = g2[(size_t)(k0 + j) * 512 + n];
              *(GAS v4u*)(Wg2_t + (size_t)n * 128 + k0) = pk8(f); } }
        { const float* pw = in[18] + (size_t)l * 4 * 128 * 128;
          for (int i = gtid; i < 512 * 64; i += NGT) { const int n = i >> 6, k0 = (i & 63) * 8, g = n >> 7, d = n & 127; float f[8];
#pragma unroll
              for (int j = 0; j < 8; ++j) { const int k = k0 + j; f[j] = ((k >> 7) == g) ? pw[((size_t)g * 128 + (k & 127)) * 128 + d] : 0.f; }
              *(GAS v4u*)(PW_t + (size_t)n * 512 + k0) = pk8(f); } }
    }
}
__device__ __forceinline__ void convert_experts_items(const float* const* in, int l, unsigned char* ws, LAS unsigned char* lds, int it0, int nit, int wave, int lane) {
    LAS float* scr = (LAS float*)(lds + RING_OFF + wave * 16384);
    bf16* Wgu = (bf16*)(ws + A_WGU); bf16* Wd = (bf16*)(ws + A_WD);
    const float* eg = in[28] + (size_t)l * NEXP * 1024 * 1024; const float* eu = in[29] + (size_t)l * NEXP * 1024 * 1024; const float* ed = in[30] + (size_t)l * NEXP * 1024 * 1024;
    for (int it = it0 + wave; it < it0 + nit; it += NWAVES) {
        const int mat = it / (NEXP * 512), r = it - mat * (NEXP * 512), e = r >> 9, q = r & 511, kb = q >> 5, nb = q & 31, n0 = 32 * nb;
        if (mat == 0)      tr_item8(eg + (size_t)e * 1024 * 1024, 1024, 64 * kb, n0, (unsigned char*)Wgu, 1024, e * 2048 + (n0 >> 7) * 256 + (n0 & 127), 32.0f, scr, lane);
        else if (mat == 1) tr_item8(eu + (size_t)e * 1024 * 1024, 1024, 64 * kb, n0, (unsigned char*)Wgu, 1024, e * 2048 + (n0 >> 7) * 256 + 128 + (n0 & 127), 32.0f, scr, lane);
        else               tr_item8(ed + (size_t)e * 1024 * 1024, 1024, 64 * kb, n0, (unsigned char*)Wd, 1024, e * 1024 + n0, 32.0f, scr, lane);
    }
}

template <int MODE, bool XB = false, int NR = 2>
__device__ __forceinline__ void norm_rows(const float* xsrc, float* xdst, bool combine, const bf16* YE, const int* INV, const float* gain, bf16* obf, float* of32, int gw, int NGW, int lane, unsigned char* o8 = nullptr) {
    f32x4 g[4];
#pragma unroll
    for (int j = 0; j < 4; ++j) g[j] = *(const f32x4*)(gain + 4 * lane + 256 * j);
    for (int t0 = gw; t0 < M; t0 += NR * NGW) {
        f32x4 v[NR][4]; int inv[NR];
#pragma unroll
        for (int q = 0; q < NR; ++q) { const int t = t0 + q * NGW;
            if (XB) { const v2u* xr = (const v2u*)((const bf16*)xsrc + (size_t)t * XBP) + lane;
#pragma unroll
                for (int j = 0; j < 4; ++j) { const v2u w = xr[64 * j]; v[q][j] = (f32x4){__uint_as_float(w.x << 16), __uint_as_float(w.x & 0xffff0000u), __uint_as_float(w.y << 16), __uint_as_float(w.y & 0xffff0000u)}; } }
            else { const f32x4* xr = (const f32x4*)(xsrc + (size_t)t * DMODEL) + lane;
#pragma unroll
                for (int j = 0; j < 4; ++j) v[q][j] = xr[64 * j]; }
            inv[q] = (combine && lane < NEXP) ? INV[(size_t)t * NEXP + lane] : -1; }
#pragma unroll
        for (int q = 0; q < NR; ++q) { const int t = t0 + q * NGW;
            if (combine) {
                const int b = t / SEQ;
#pragma unroll
                for (int e_unused = 0; e_unused < 1; ++e_unused) {
                    unsigned mk = (unsigned)(__builtin_amdgcn_ballot_w64(inv[q] >= 0) & 0xffffull);
                    while (mk) { int es[4]; v2u w[4][4];
#pragma unroll
                        for (int u = 0; u < 4; ++u) { es[u] = mk ? (int)__builtin_ctz(mk) : -1; mk = mk ? (mk & (mk - 1u)) : 0u; }
#pragma unroll
                        for (int u = 0; u < 4; ++u) if (es[u] >= 0) { const int c = __builtin_amdgcn_readlane(inv[q], es[u]); const bf16* yr = YE + ((size_t)((b * NEXP + es[u]) * CAP + c)) * DMODEL + 4 * lane;
#pragma unroll
                            for (int j = 0; j < 4; ++j) w[u][j] = *(const v2u*)(yr + 256 * j); }
#pragma unroll
                        for (int u = 0; u < 4; ++u) if (es[u] >= 0) {
#pragma unroll
                            for (int j = 0; j < 4; ++j) { v[q][j][0] += __uint_as_float(w[u][j].x << 16); v[q][j][1] += __uint_as_float(w[u][j].x & 0xffff0000u); v[q][j][2] += __uint_as_float(w[u][j].y << 16); v[q][j][3] += __uint_as_float(w[u][j].y & 0xffff0000u); } } } }
                if (xdst) {
                    if (XB) { v2u* xw = (v2u*)((bf16*)xdst + (size_t)t * XBP) + lane;
#pragma unroll
                        for (int j = 0; j < 4; ++j) xw[64 * j] = (v2u){pk2(v[q][j][0], v[q][j][1]), pk2(v[q][j][2], v[q][j][3])}; }
                    else { f32x4* xw = (f32x4*)(xdst + (size_t)t * DMODEL) + lane;
#pragma unroll
                        for (int j = 0; j < 4; ++j) xw[64 * j] = v[q][j]; } }
            }
            float ss = 0.f;
#pragma unroll
            for (int j = 0; j < 4; ++j) ss += (v[q][j][0] * v[q][j][0] + v[q][j][1] * v[q][j][1]) + (v[q][j][2] * v[q][j][2] + v[q][j][3] * v[q][j][3]);
            const float rstd = __builtin_amdgcn_rsqf(wave_sum(ss, lane) * (1.0f / DMODEL) + 1e-6f);
            if (MODE == 2) { unsigned* o4 = (unsigned*)((unsigned char*)obf + (size_t)t * DMODEL) + lane;
#pragma unroll
                for (int j = 0; j < 4; ++j) { const f32x4 o = v[q][j] * rstd * g[j]; o4[64 * j] = pg8::pk4_fp8(o[0], o[1], o[2], o[3]); } }
            else if (MODE == 0) { v2u* ob_ = (v2u*)(obf + (size_t)t * DMODEL) + lane;
#pragma unroll
                for (int j = 0; j < 4; ++j) { const f32x4 o = v[q][j] * rstd * g[j]; ob_[64 * j] = (v2u){pk2(o[0], o[1]), pk2(o[2], o[3])}; }
                if (o8) { unsigned* e4 = (unsigned*)(o8 + (size_t)t * 4096) + lane;
#pragma unroll
                    for (int j = 0; j < 4; ++j) { const f32x4 o = v[q][j] * rstd * g[j]; e4[64 * j] = pg8::pk4_fp8(o[0], o[1], o[2], o[3]); } } }
            else { f32x4* o4 = (f32x4*)(of32 + (size_t)t * DMODEL) + lane;
#pragma unroll
                for (int j = 0; j < 4; ++j) o4[64 * j] = v[q][j] * rstd * g[j]; }
        }
    }
}

__device__ __forceinline__ v2u pk8_e4m3(const float (&f)[8]) { v2u o; o.x = pg8::pk4_fp8(f[0], f[1], f[2], f[3]); o.y = pg8::pk4_fp8(f[4], f[5], f[6], f[7]); return o; }
__device__ __forceinline__ void p3_prep(int l, const float* const* in, unsigned char* ws, LAS unsigned char* lds, int gw, int NGW, int tid, int lane) {
    const bf16* PRJ = (const bf16*)(ws + A_PRJ);
    bf16* R = (bf16*)(ws + A_R); bf16* KS = (bf16*)(ws + A_KS); bf16* VS = (bf16*)(ws + A_VS); bf16* VF = (bf16*)(ws + WS_VF); bf16* TW = (bf16*)(ws + A_TW); bf16* PL = (bf16*)(ws + A_PL);
    unsigned char* Q8 = ws + A_Q; unsigned char* K8 = ws + A_K; unsigned char* Vt8 = ws + A_V;
    const f32x2* rope = (const f32x2*)(ws + WS_ROPE);
    LAS float* v2L = (LAS float*)(lds + RING_OFF);
    LAS float* mpL = (LAS float*)(lds + RING_OFF + 65536); LAS float* mnL = mpL + 1920;
    if (l == 1) { for (int i = tid; i < 32 * 512; i += NTHR) v2L[i] = in[17][i]; }
    LAS float* gqL = mnL + 1920; LAS float* gkL = gqL + 64; LAS float* v0L = gkL + 64;
    for (int i = tid; i < 1920; i += NTHR) { mpL[i] = in[3][(size_t)l * 1920 + i]; mnL[i] = in[4][(size_t)l * 1920 + i]; }
    if (tid < 64) { gqL[tid] = in[20][(size_t)l * 64 + tid]; gkL[tid] = in[21][(size_t)l * 64 + tid]; }
    v0L[tid] = in[15][tid];
    __syncthreads();
    const int gi = lane >> 4, lo = 1 << gi, hi = lo - 1, pcol = COL_POOL + lane * 8;
    const float tw_k = (lane < 16) ? -2.0f * 1.4426950408889634f : -1.4426950408889634f, tw_m = (lane < 16) ? 2.0f : 1.0f, tw_c = (lane < 16) ? -1.0f : 0.0f; const bool tw_id = (lane >= 16 && lane < 32);
#define P3_LD(base, boff) (*(const v4u*)((const unsigned char*)(base) + (boff)))
#define P3_ST(base, boff, val) (*(v4u*)((unsigned char*)(base) + (boff)) = (val))
    const unsigned ob_nxt0 = (unsigned)((17 * NPJ + lane * 8) * 2), ob_nxt3 = (unsigned)((17 * NPJ + (lane < 48 ? (lane + 192) * 8 : 0)) * 2);
    const unsigned ob_self = (unsigned)((16 * NPJ + pcol) * 2), ob_in = (unsigned)(((17 + hi) * NPJ + pcol) * 2), ob_out = (unsigned)(((16 - lo) * NPJ + pcol) * 2);
    const unsigned ob_q = (unsigned)((16 * NPJ + COL_Q + lane * 8) * 2), ob_k = (unsigned)((16 * NPJ + COL_K + (lane & 15) * 8) * 2), ob_rope = (unsigned)((lane & 7) * 32), ob_l16 = (unsigned)(lane * 16);
    const unsigned ob_q8 = (unsigned)((lane >> 3) * 128 + (lane & 7) * 8), ob_k8 = (unsigned)(((lane >> 3) & 1) * SEQ * 64 + (lane & 7) * 8);
    for (int run = gw; run < M / 32; run += NGW) {
        const int t0 = run * 32, s0 = t0 & (SEQ - 1);
        const bf16* row0 = PRJ + (size_t)t0 * NPJ;
        { unsigned char* vrow = Vt8 + ((size_t)((t0 >> 13) * 2 + (lane >> 5)) * 64 + 2 * (lane & 31)) * SEQ + s0;
#pragma unroll
          for (int hf = 0; hf < 2; ++hf) { unsigned w[16];
#pragma unroll
              for (int i = 0; i < 16; ++i) w[i] = *(const unsigned*)(row0 + (size_t)(hf * 16 + i) * NPJ + COL_V + 2 * lane);
              v4u a, b_;
#pragma unroll
              for (int j = 0; j < 4; ++j) {
                  a[j] = pg8::pk4_fp8(__uint_as_float(w[4 * j] << 16), __uint_as_float(w[4 * j + 1] << 16), __uint_as_float(w[4 * j + 2] << 16), __uint_as_float(w[4 * j + 3] << 16));
                  b_[j] = pg8::pk4_fp8(__uint_as_float(w[4 * j] & 0xffff0000u), __uint_as_float(w[4 * j + 1] & 0xffff0000u), __uint_as_float(w[4 * j + 2] & 0xffff0000u), __uint_as_float(w[4 * j + 3] & 0xffff0000u)); }
              *(v4u*)(vrow + hf * 16) = a; *(v4u*)(vrow + SEQ + hf * 16) = b_; } }
        v4u prv[4], cur[4];
#pragma unroll
        for (int j = 0; j < 4; ++j) { const int c8 = lane + 64 * j, col = (c8 < 240 ? c8 : 0) * 8;
            prv[j] = (s0 > 0) ? ld16(row0 - NPJ + col) : (v4u){0u, 0u, 0u, 0u}; cur[j] = ld16(row0 + col); }
        float psum[8]; int pcnt = 0;
#pragma unroll
        for (int i = 0; i < 8; ++i) psum[i] = 0.f;
#pragma unroll
        for (int hf = 0; hf < 2; ++hf) { v4u pw_[8];
#pragma unroll
            for (int q = 0; q < 8; ++q) { const int dd = hf * 8 + q - 8; const bool ok = (dd >= -lo && dd <= hi && s0 + dd >= 0); pw_[q] = ld16(row0 + (long)(ok ? dd : 0) * NPJ + pcol); }
#pragma unroll
            for (int q = 0; q < 8; ++q) asm volatile("" : "+v"(pw_[q]));
#pragma unroll
            for (int q = 0; q < 8; ++q) { const int dd = hf * 8 + q - 8; const bool ok = (dd >= -lo && dd <= hi && s0 + dd >= 0); float x[8]; unp8(pw_[q], x); const float m_ = ok ? 1.0f : 0.0f; pcnt += ok ? 1 : 0;
#pragma unroll
                for (int i = 0; i < 8; ++i) psum[i] += m_ * x[i]; } }
        for (int ti = 0; ti < 32; ++ti) {
            const int t = t0 + ti, s = s0 + ti; const bf16* rowp = row0 + (size_t)ti * NPJ;
            v4u nxt[4];
            const bf16* rowq = rowp - 16 * NPJ;
#pragma unroll
            for (int j = 0; j < 4; ++j) nxt[j] = (s + 1 < SEQ) ? (j < 3 ? P3_LD(rowq + 512 * j, ob_nxt0) : P3_LD(rowq, ob_nxt3)) : (v4u){0u, 0u, 0u, 0u};
            const v4u pself = P3_LD(rowq, ob_self);
            const bool padd = (s + 1 + hi < SEQ), psub = (s - lo >= 0);
            const v4u pin = padd ? P3_LD(rowq, ob_in) : (v4u){0u, 0u, 0u, 0u};
            const v4u pout = psub ? P3_LD(rowq, ob_out) : (v4u){0u, 0u, 0u, 0u};
            const v4u qraw = P3_LD(rowq, ob_q), kraw = P3_LD(rowq, ob_k);
            const unsigned char* ropes = (const unsigned char*)(rope + (size_t)s * 32); const f32x4 rp0 = *(const f32x4*)(ropes + ob_rope), rp1 = *(const f32x4*)(ropes + ob_rope + 16);
            { float self[8], o[8]; unp8(pself, self); const float ic = __builtin_amdgcn_rcpf((float)pcnt);
#pragma unroll
              for (int i = 0; i < 8; ++i) o[i] = psum[i] * ic - self[i];
              P3_ST(PL + (size_t)t * 512, ob_l16, pk8(o));
              float xin[8], xout[8]; unp8(pin, xin); unp8(pout, xout);
#pragma unroll
              for (int i = 0; i < 8; ++i) psum[i] += xin[i] - xout[i];
              pcnt += (padd ? 1 : 0) - (psub ? 1 : 0); }
            { float x[8], o[8]; const float cs[8] = {rp0[0], rp0[1], rp0[2], rp0[3], rp1[0], rp1[1], rp1[2], rp1[3]};
              unp8(qraw, x);
              float ss = 0.f;
#pragma unroll
              for (int i = 0; i < 8; ++i) ss += x[i] * x[i];
              ss = sum8(ss, lane); const float rms = __builtin_amdgcn_rsqf(ss * (1.0f / 64.0f) + 1e-6f);
#pragma unroll
              for (int i = 0; i < 8; ++i) x[i] = x[i] * rms * gqL[(lane & 7) * 8 + i];
#pragma unroll
              for (int ii = 0; ii < 4; ++ii) { o[2 * ii] = (x[2 * ii] * cs[2 * ii] - x[2 * ii + 1] * cs[2 * ii + 1]) * (C2Q * 16.0f); o[2 * ii + 1] = (x[2 * ii] * cs[2 * ii + 1] + x[2 * ii + 1] * cs[2 * ii]) * (C2Q * 16.0f); }
              *(v2u*)(Q8 + (size_t)t * 1024 + ob_q8) = pk8_e4m3(o);
              unp8(kraw, x);
              ss = 0.f;
#pragma unroll
              for (int i = 0; i < 8; ++i) ss += x[i] * x[i];
              ss = sum8(ss, lane); const float rmk = __builtin_amdgcn_rsqf(ss * (1.0f / 64.0f) + 1e-6f);
#pragma unroll
              for (int i = 0; i < 8; ++i) x[i] = x[i] * rmk * gkL[(lane & 7) * 8 + i];
#pragma unroll
              for (int ii = 0; ii < 4; ++ii) { o[2 * ii] = x[2 * ii] * cs[2 * ii] - x[2 * ii + 1] * cs[2 * ii + 1]; o[2 * ii + 1] = x[2 * ii] * cs[2 * ii + 1] + x[2 * ii + 1] * cs[2 * ii]; }
              if (lane < 16) *(v2u*)(K8 + ((size_t)((t >> 13) * 2) * SEQ + s) * 64 + ob_k8) = pk8_e4m3(o); }
            asm volatile("" ::: "memory");
#pragma unroll
            for (int j = 0; j < 4; ++j) {
                const int c8 = lane + 64 * j, col = c8 * 8;
                if (c8 < 240) {
                    float cu[8], pv[8], nx[8], ps[8];
                    unp8(cur[j], cu); unp8(prv[j], pv); unp8(nxt[j], nx);
                    float a_[8], b_[8]; { const f32x4 m0 = *(const LAS f32x4*)(mpL + col), m1 = *(const LAS f32x4*)(mpL + col + 4), n0 = *(const LAS f32x4*)(mnL + col), n1 = *(const LAS f32x4*)(mnL + col + 4);
                        a_[0] = m0[0]; a_[1] = m0[1]; a_[2] = m0[2]; a_[3] = m0[3]; a_[4] = m1[0]; a_[5] = m1[1]; a_[6] = m1[2]; a_[7] = m1[3]; b_[0] = n0[0]; b_[1] = n0[1]; b_[2] = n0[2]; b_[3] = n0[3]; b_[4] = n1[0]; b_[5] = n1[1]; b_[6] = n1[2]; b_[7] = n1[3]; }
#pragma unroll
                    for (int i = 0; i < 8; ++i) ps[i] = cu[i] + a_[i] * (pv[i] - cu[i]) + b_[i] * (nx[i] - cu[i]);
                    if (j == 0) P3_ST(R + (size_t)t * 512, ob_l16, pk8(ps));
                    else if (j == 1) P3_ST(KS + (size_t)t * 512, ob_l16, pk8(ps));
                    else if (j == 2) { const int cc = col - 1024;
                        if (l == 0) { const v4u o = pk8(ps); P3_ST(VS + (size_t)t * 512, ob_l16, o); P3_ST(VF + (size_t)t * 512, ob_l16, o); }
                        else { float vl[32], mx[8], vf[8];
                            { float t8[8]; unp8(ld16(rowp + COL_VL), t8);
#pragma unroll
                              for (int i = 0; i < 8; ++i) vl[i] = t8[i];
                              unp8(ld16(rowp + COL_VL + 8), t8);
#pragma unroll
                              for (int i = 0; i < 8; ++i) vl[8 + i] = t8[i];
                              unp8(ld16(rowp + COL_VL + 16), t8);
#pragma unroll
                              for (int i = 0; i < 8; ++i) vl[16 + i] = t8[i];
                              unp8(ld16(rowp + COL_VL + 24), t8);
#pragma unroll
                              for (int i = 0; i < 8; ++i) vl[24 + i] = t8[i]; }
                            { const f32x4 z0 = *(const LAS f32x4*)(v0L + cc), z1 = *(const LAS f32x4*)(v0L + cc + 4); mx[0] = z0[0]; mx[1] = z0[1]; mx[2] = z0[2]; mx[3] = z0[3]; mx[4] = z1[0]; mx[5] = z1[1]; mx[6] = z1[2]; mx[7] = z1[3]; }
#pragma unroll
                            for (int k = 0; k < 32; ++k) { const f32x4 w0 = *(const LAS f32x4*)(v2L + k * 512 + cc), w1 = *(const LAS f32x4*)(v2L + k * 512 + cc + 4);
                                mx[0] += vl[k] * w0[0]; mx[1] += vl[k] * w0[1]; mx[2] += vl[k] * w0[2]; mx[3] += vl[k] * w0[3]; mx[4] += vl[k] * w1[0]; mx[5] += vl[k] * w1[1]; mx[6] += vl[k] * w1[2]; mx[7] += vl[k] * w1[3]; }
                            unp8(P3_LD(VF + (size_t)t * 512, ob_l16), vf);
#pragma unroll
                            for (int i = 0; i < 8; ++i) ps[i] = ps[i] + (vf[i] - ps[i]) * sigmf(mx[i]);
                            P3_ST(VS + (size_t)t * 512, ob_l16, pk8(ps)); } }
                    else { float o[8];
#pragma unroll
                        for (int i = 0; i < 8; ++i) { const float x = ps[i];
                            const float sg = __builtin_amdgcn_rcpf(1.0f + __builtin_amdgcn_exp2f(tw_k * __builtin_amdgcn_fmed3f(x, -15.f, 15.f)));
                            const float y = tw_m * sg + tw_c; o[i] = tw_id ? x : y; }
                        P3_ST(TW + (size_t)t * 384, ob_l16, pk8(o)); }
                }
                prv[j] = cur[j]; cur[j] = nxt[j];
            }
        }
    }
#undef P3_LD
#undef P3_ST
}

__device__ __forceinline__ float dpp_add(float x, float y) { return x + y; }
template <int CTRL> __device__ __forceinline__ float dppx(float x) { return __builtin_bit_cast(float, __builtin_amdgcn_update_dpp(0, __builtin_bit_cast(int, x), CTRL, 0xF, 0xF, true)); }
__device__ __forceinline__ float red16(float x) {
    x += dppx<0xB1>(x);
    x += dppx<0x4E>(x);
    x += dppx<0x141>(x);
    x += dppx<0x140>(x);
    return x;
}
__device__ __forceinline__ void scan_chain(int l, int chain, const float* const* in, unsigned char* ws, LAS unsigned char* lds, int tid, int wave, int lane) {
    const int d = chain >> 6, b = (chain >> 3) & 7, h = chain & 7;
    const bf16* R = (const bf16*)(ws + A_R); const bf16* KS = (const bf16*)(ws + A_KS); const bf16* VS = (const bf16*)(ws + A_VS);
    const bf16* LW = (const bf16*)(ws + A_LW); const bf16* AA = (const bf16*)(ws + A_AA);
    bf16* YS = (bf16*)(ws + (d ? A_YSB : A_YSF)); float* CFB = (float*)(ws + WS_CFB) + (size_t)d * M * 8;
    LAS float* kkL = (LAS float*)(lds + RING_OFF); LAS float* wL = kkL + 4096; LAS float* nbL = wL + 4096; LAS float* kdL = nbL + 4096; LAS float* rL = kdL + 4096; LAS float* vL = rL + 4096; LAS float* yL = vL + 4096;
    const int ps = tid >> 3, pc = tid & 7;
    const int pl = lane >> 4, jg = lane & 15, i0 = 2 * (4 * wave + pl);
    float kkc[8], kac[8], rkc[8];
    ldf8(in[10] + (size_t)l * 512 + h * 64 + pc * 8, kkc); ldf8(in[11] + (size_t)l * 512 + h * 64 + pc * 8, kac); ldf8(in[12] + (size_t)l * 512 + h * 64 + pc * 8, rkc);
    float st[2][4];
#pragma unroll
    for (int r = 0; r < 2; ++r)
#pragma unroll
        for (int j = 0; j < 4; ++j) st[r][j] = 0.f;
    v4u rr, kr, vr, lwr, ar;
    { const int tok = d ? (SEQ - 1 - ps) : ps; const size_t t = (size_t)b * SEQ + tok;
      rr = ld16(R + t * 512 + h * 64 + pc * 8); kr = ld16(KS + t * 512 + h * 64 + pc * 8); vr = ld16(VS + t * 512 + h * 64 + pc * 8);
      lwr = ld16(LW + t * 1024 + d * 512 + h * 64 + pc * 8); ar = ld16(AA + t * 1024 + d * 512 + h * 64 + pc * 8); }
    for (int blk = 0; blk < SEQ / 64; ++blk) {
        const int tokp = d ? (SEQ - 1 - (blk * 64 + ps)) : (blk * 64 + ps); const size_t tp = (size_t)b * SEQ + tokp;
        { float r8[8], k8[8], v8[8], lw8[8], a8[8], kk8[8], o[8];
          unp8(rr, r8); unp8(kr, k8); unp8(vr, v8); unp8(lwr, lw8); unp8(ar, a8);
          float ss = 0.f;
#pragma unroll
          for (int i = 0; i < 8; ++i) { kk8[i] = k8[i] * kkc[i]; ss += kk8[i] * kk8[i]; }
          ss = sum8(ss, lane); const float inv = 1.0f / fmaxf(sqrtf(ss), 1e-12f);
          float cf = 0.f;
#pragma unroll
          for (int i = 0; i < 8; ++i) { kk8[i] *= inv; const float kd = k8[i] * (1.0f + (a8[i] - 1.0f) * kac[i]); cf += r8[i] * kd * rkc[i]; o[i] = kd; }
          cf = sum8(cf, lane); if (pc == 0) CFB[tp * 8 + h] = cf;
          LAS float* p;
          p = kkL + ps * 64 + pc * 8; *(LAS f32x4*)p = (f32x4){kk8[0], kk8[1], kk8[2], kk8[3]}; *(LAS f32x4*)(p + 4) = (f32x4){kk8[4], kk8[5], kk8[6], kk8[7]};
          p = kdL + ps * 64 + pc * 8; *(LAS f32x4*)p = (f32x4){o[0], o[1], o[2], o[3]}; *(LAS f32x4*)(p + 4) = (f32x4){o[4], o[5], o[6], o[7]};
          p = wL + ps * 64 + pc * 8; *(LAS f32x4*)p = (f32x4){__expf(lw8[0]), __expf(lw8[1]), __expf(lw8[2]), __expf(lw8[3])}; *(LAS f32x4*)(p + 4) = (f32x4){__expf(lw8[4]), __expf(lw8[5]), __expf(lw8[6]), __expf(lw8[7])};
          p = nbL + ps * 64 + pc * 8; *(LAS f32x4*)p = (f32x4){-kk8[0] * a8[0], -kk8[1] * a8[1], -kk8[2] * a8[2], -kk8[3] * a8[3]}; *(LAS f32x4*)(p + 4) = (f32x4){-kk8[4] * a8[4], -kk8[5] * a8[5], -kk8[6] * a8[6], -kk8[7] * a8[7]};
          p = rL + ps * 64 + pc * 8; *(LAS f32x4*)p = (f32x4){r8[0], r8[1], r8[2], r8[3]}; *(LAS f32x4*)(p + 4) = (f32x4){r8[4], r8[5], r8[6], r8[7]};
          p = vL + ps * 64 + pc * 8; *(LAS f32x4*)p = (f32x4){v8[0], v8[1], v8[2], v8[3]}; *(LAS f32x4*)(p + 4) = (f32x4){v8[4], v8[5], v8[6], v8[7]}; }
        __syncthreads();
        if (blk + 1 < SEQ / 64) { const int tok = d ? (SEQ - 1 - ((blk + 1) * 64 + ps)) : ((blk + 1) * 64 + ps); const size_t t = (size_t)b * SEQ + tok;
            rr = ld16(R + t * 512 + h * 64 + pc * 8); kr = ld16(KS + t * 512 + h * 64 + pc * 8); vr = ld16(VS + t * 512 + h * 64 + pc * 8);
            lwr = ld16(LW + t * 1024 + d * 512 + h * 64 + pc * 8); ar = ld16(AA + t * 1024 + d * 512 + h * 64 + pc * 8); }
#pragma unroll 2
        for (int s = 0; s < 64; ++s) {
            const f32x4 kk4 = *(const LAS f32x4*)(kkL + s * 64 + jg * 4), w4 = *(const LAS f32x4*)(wL + s * 64 + jg * 4), nb4 = *(const LAS f32x4*)(nbL + s * 64 + jg * 4);
            const f32x4 kd4 = *(const LAS f32x4*)(kdL + s * 64 + jg * 4), r4 = *(const LAS f32x4*)(rL + s * 64 + jg * 4);
            const f32x2 v2 = *(const LAS f32x2*)(vL + s * 64 + i0);
            float y[2];
#pragma unroll
            for (int r = 0; r < 2; ++r) {
                float dq = (st[r][0] * kk4[0] + st[r][1] * kk4[1]) + (st[r][2] * kk4[2] + st[r][3] * kk4[3]);
                dq = red16(dq);
                const float vv = v2[r];
#pragma unroll
                for (int j = 0; j < 4; ++j) st[r][j] = st[r][j] * w4[j] + dq * nb4[j] + vv * kd4[j];
                float yq = (st[r][0] * r4[0] + st[r][1] * r4[1]) + (st[r][2] * r4[2] + st[r][3] * r4[3]);
                y[r] = red16(yq);
            }
            if (jg == 0) *(LAS f32x2*)(yL + s * 64 + i0) = (f32x2){y[0], y[1]};
        }
        __syncthreads();
        { const LAS float* p = yL + ps * 64 + pc * 8; const f32x4 a = *(const LAS f32x4*)p, c = *(const LAS f32x4*)(p + 4);
          v4u o; o.x = pk2(a[0], a[1]); o.y = pk2(a[2], a[3]); o.z = pk2(c[0], c[1]); o.w = pk2(c[2], c[3]);
          st16(YS + tp * 512 + h * 64 + pc * 8, o); }
    }
    __syncthreads();
}

__device__ __forceinline__ void p6a_rows(int l, const float* const* in, unsigned char* ws, int gw, int NGW, int lane) {
    const bf16* YSF = (const bf16*)(ws + A_YSF); const bf16* YSB = (const bf16*)(ws + A_YSB); const bf16* VS = (const bf16*)(ws + A_VS); const bf16* Gb = (const bf16*)(ws + A_G);
    const float* CFB = (const float*)(ws + WS_CFB); bf16* YA = (bf16*)(ws + A_YA);
    float lw[8], lb[8]; ldf8(in[13] + (size_t)l * 512 + lane * 8, lw); ldf8(in[14] + (size_t)l * 512 + lane * 8, lb);
    const int head = lane >> 3;
    for (int t0 = gw; t0 < M; t0 += 4 * NGW) {
        v4u ra[4], rb_[4], rv[4], rg[4]; float cfa[4], cfb[4];
#pragma unroll
        for (int q = 0; q < 4; ++q) { const size_t t = (size_t)(t0 + q * NGW);
            ra[q] = ld16(YSF + t * 512 + lane * 8); rb_[q] = ld16(YSB + t * 512 + lane * 8); rv[q] = ld16(VS + t * 512 + lane * 8); rg[q] = ld16(Gb + t * 512 + lane * 8);
            cfa[q] = CFB[t * 8 + head]; cfb[q] = CFB[((size_t)M + t) * 8 + head]; }
#pragma unroll
        for (int q = 0; q < 4; ++q) { const size_t t = (size_t)(t0 + q * NGW);
            float yf[8], yb[8], v[8], g[8], o[8];
            unp8(ra[q], yf); unp8(rb_[q], yb); unp8(rv[q], v); unp8(rg[q], g);
            const float cf = cfa[q] + cfb[q];
            float sm = 0.f;
#pragma unroll
            for (int i = 0; i < 8; ++i) { yf[i] += yb[i]; sm += yf[i]; }
            const float mu = sum8(sm, lane) * (1.0f / 64.0f); float sq = 0.f;
#pragma unroll
            for (int i = 0; i < 8; ++i) { yf[i] -= mu; sq += yf[i] * yf[i]; }
            const float rs = __builtin_amdgcn_rsqf(sum8(sq, lane) * (1.0f / 64.0f) + 64e-5f);
#pragma unroll
            for (int i = 0; i < 8; ++i) o[i] = (yf[i] * rs * lw[i] + lb[i] + cf * v[i]) * g[i];
            st16(YA + t * 512 + lane * 8, pk8(o)); }
    }
}

__device__ __forceinline__ void p8_router(int l, const float* const* in, const float* X, unsigned char* ws, LAS unsigned char* lds, int gw, int NGW, int tid, int lane) {
    LAS bf16* Bh = (LAS bf16*)(lds + RING_OFF); LAS bf16* Bl = Bh + 32 * 64 * 8;
    LAS float* gL = (LAS float*)(lds + RING_OFF + 65536);
    const float* rw = in[27] + (size_t)l * DMODEL * NEXP; const float* gain = in[26] + (size_t)l * DMODEL;
    for (int i = tid; i < 32 * 64; i += NTHR) { const int kk = i >> 6, ln = i & 63, e = ln & 15, kg_ = ln >> 4; float hi8[8], lo8[8];
#pragma unroll
        for (int j = 0; j < 8; ++j) { const int k = 32 * kk + 8 * kg_ + j; const float w = rw[(size_t)k * NEXP + e] * gain[k]; const float wh = __uint_as_float(f2bf(w) << 16); hi8[j] = wh; lo8[j] = w - wh; }
        *(LAS v4u*)(Bh + i * 8) = pk8(hi8); *(LAS v4u*)(Bl + i * 8) = pk8(lo8); }
    for (int i = tid; i < DMODEL; i += NTHR) gL[i] = gain[i];
    __syncthreads();
    unsigned char* HN2 = ws + A_HN; float* AFFT = (float*)(ws + WS_AFFT);
    typedef short bf16x8_t __attribute__((ext_vector_type(8)));
    const int m = lane & 15, kg = lane >> 4;
    for (int tr = gw; tr < M / 16; tr += NGW) {
        const int t0 = tr * 16; const bf16* xrow = (const bf16*)X + (size_t)(t0 + m) * XBP + 8 * kg;
        f32x4 D = {0.f, 0.f, 0.f, 0.f}, D2 = {0.f, 0.f, 0.f, 0.f}; float ss = 0.f;
#define P8_LD(XB_, c_) do { _Pragma("unroll") for (int q = 0; q < 8; ++q) XB_[q] = ld16(xrow + 32 * (8 * (c_) + q)); } while (0)
#define P8_MM(XB_, c_) do { _Pragma("unroll") for (int q = 0; q < 8; ++q) { const int kk = 8 * (c_) + q; const bf16x8_t a = __builtin_bit_cast(bf16x8_t, XB_[q]); \
                const bf16x8_t bh = *(const LAS bf16x8_t*)(Bh + (kk * 64 + lane) * 8), bl = *(const LAS bf16x8_t*)(Bl + (kk * 64 + lane) * 8); \
                D = __builtin_amdgcn_mfma_f32_16x16x32_bf16(a, bh, D, 0, 0, 0); D2 = __builtin_amdgcn_mfma_f32_16x16x32_bf16(a, bl, D2, 0, 0, 0);     \
                float x[8]; unp8(XB_[q], x); _Pragma("unroll") for (int j = 0; j < 8; ++j) ss += x[j] * x[j]; } } while (0)
#define P8_HN(XB_, c_) do { _Pragma("unroll") for (int q = 0; q < 8; ++q) { const int kk = 8 * (c_) + q; float x[8]; unp8(XB_[q], x); const f32x4 g0 = *(const LAS f32x4*)(gL + 32 * kk + 8 * kg), g1 = *(const LAS f32x4*)(gL + 32 * kk + 8 * kg + 4); \
                x[0] *= rstd * g0[0]; x[1] *= rstd * g0[1]; x[2] *= rstd * g0[2]; x[3] *= rstd * g0[3]; x[4] *= rstd * g1[0]; x[5] *= rstd * g1[1]; x[6] *= rstd * g1[2]; x[7] *= rstd * g1[3]; \
                *(v2u*)(hrow + 32 * kk) = pk8_e4m3(x); } } while (0)
        v4u xa[8], xb[8];
        P8_LD(xa, 0);
#pragma nounroll
        for (int c = 0; c < 4; c += 2) { P8_LD(xb, c + 1); P8_MM(xa, c); if (c + 2 < 4) P8_LD(xa, c + 2); else P8_LD(xa, 0); P8_MM(xb, c + 1); }
        D += D2;
        ss = sum_rows(ss);
        const float rstd = __builtin_amdgcn_rsqf(ss * (1.0f / DMODEL) + 1e-6f);
        unsigned char* hrow = HN2 + (size_t)(t0 + m) * DMODEL + 8 * kg;
#pragma nounroll
        for (int c = 0; c < 4; c += 2) { P8_LD(xb, c + 1); P8_HN(xa, c); if (c + 2 < 4) P8_LD(xa, c + 2); P8_HN(xb, c + 1); }
#undef P8_LD
#undef P8_MM
#undef P8_HN
        f32x4 aff;
#pragma unroll
        for (int r = 0; r < 4; ++r) { const float rs = shx_from(rstd, 4 * kg + r, lane); const float lg = D[r] * rs; float mx = lg;
#pragma unroll
            for (int o = 0; o < 1; ++o) mx = max16(mx);
            const float ex = __expf(lg - mx); float se = ex;
#pragma unroll
            for (int o = 0; o < 1; ++o) se = sum16(se);
            aff[r] = ex * __builtin_amdgcn_rcpf(se); }
        const int b = t0 / SEQ, s0 = t0 & (SEQ - 1);
        *(f32x4*)(AFFT + ((size_t)(b * NEXP + m)) * SEQ + s0 + 4 * kg) = aff;
    }
    __syncthreads();
}

__device__ __forceinline__ int block_sum_i(int v, LAS int* tmp, int wave, int lane) {
#pragma unroll
    for (int o = 1; o < 64; o <<= 1) v += shxi(v, o, lane);
    if (lane == 0) tmp[wave] = v;
    __syncthreads();
    int tot = 0;
#pragma unroll
    for (int i = 0; i < NWAVES; ++i) tot += tmp[i];
    __syncthreads();
    return tot;
}
__device__ __forceinline__ int block_excl_scan_i(int v, LAS int* tmp, int wave, int lane) {
    int inc = v;
#pragma unroll
    for (int o = 1; o < 64; o <<= 1) { const int t = shupi(inc, o, lane); if (lane >= o) inc += t; }
    if (lane == 63) tmp[wave] = inc;
    __syncthreads();
    int base = 0;
#pragma unroll
    for (int i = 0; i < NWAVES; ++i) { const int x = tmp[i]; if (i < wave) base += x; }
    __syncthreads();
    return base + inc - v;
}
__device__ __forceinline__ void p9_topk(int be, unsigned char* ws, LAS unsigned char* lds, int tid, int wave, int lane) {
    const float* AFFT = (const float*)(ws + WS_AFFT) + (size_t)be * SEQ; int* IDX = (int*)(ws + WS_IDX) + (size_t)be * CAP; float* VAL = (float*)(ws + WS_VAL) + (size_t)be * CAP;
    int* INV = (int*)(ws + WS_INV); const int b = be / NEXP, e = be - b * NEXP;
    LAS int* tmp = (LAS int*)(lds + RING_OFF);
    unsigned key[16];
#pragma unroll
    for (int q = 0; q < 4; ++q) { const v4u w = *(const v4u*)(AFFT + tid * 16 + q * 4); key[4 * q] = w.x; key[4 * q + 1] = w.y; key[4 * q + 2] = w.z; key[4 * q + 3] = w.w; }
    unsigned T = 0u;
#pragma nounroll
    for (int bit = 30; bit >= 0; --bit) { const unsigned cand = T | (1u << bit); int c = 0;
#pragma unroll
        for (int i = 0; i < 16; ++i) c += (key[i] >= cand) ? 1 : 0;
        if (block_sum_i(c, tmp, wave, lane) >= CAP) T = cand; }
    int ngt = 0, neq = 0;
#pragma unroll
    for (int i = 0; i < 16; ++i) { ngt += (key[i] > T) ? 1 : 0; neq += (key[i] == T) ? 1 : 0; }
    const int need = CAP - block_sum_i(ngt, tmp, wave, lane);
    const int eqb = block_excl_scan_i(neq, tmp, wave, lane);
    int take = need - eqb; take = take < 0 ? 0 : (take > neq ? neq : take);
    int pos = block_excl_scan_i(ngt + take, tmp, wave, lane);
    int er = eqb;
#pragma unroll
    for (int i = 0; i < 16; ++i) { const int s = tid * 16 + i; bool sel = key[i] > T; if (key[i] == T) { sel = er < need; ++er; }
        int w = -1; if (sel) { IDX[pos] = s; VAL[pos] = __uint_as_float(key[i]); w = pos; ++pos; }
        INV[((size_t)b * SEQ + s) * NEXP + e] = w; }
}

__device__ __forceinline__ void p10_gather(unsigned char* ws, int gw, int NGW, int lane) {
    const bf16* HN2 = (const bf16*)(ws + A_HN); bf16* XG = (bf16*)(ws + A_XG); const int* IDX = (const int*)(ws + WS_IDX);
    for (int r = gw; r < MR; r += NGW) { const int b = r / (NEXP * CAP); const int tok = IDX[r];
        const v4u* src = (const v4u*)(HN2 + ((size_t)b * SEQ + tok) * DMODEL); v4u* dst = (v4u*)(XG + (size_t)r * DMODEL);
        const v4u a = src[lane], c = src[lane + 64]; dst[lane] = a; dst[lane + 64] = c; }
}

namespace cs {
typedef short bf16x8 __attribute__((ext_vector_type(8)));
typedef short s16x4 __attribute__((ext_vector_type(4)));
typedef float f32x16 __attribute__((ext_vector_type(16)));
constexpr int LWL = 0;
constexpr int CH0 = 16384, CH_STRIDE = 20992;
constexpr int O_QR = 0, O_BK = 4608, O_BH = 9216, O_KH = 11520, O_V = 13824, O_QH = 16128, O_XX = 18432, O_BNK = 19584, O_GC = 20736;
constexpr int P144 = 72, P72 = 36;
constexpr int YL0 = CH0 + 4 * CH_STRIDE;
static_assert(YL0 + 64 * 144 <= RING_BYTES, "chunk-scan LDS map");
__device__ __forceinline__ int crow(int reg, int h) { return (reg & 3) + 8 * (reg >> 2) + 4 * h; }
__device__ __forceinline__ bf16x8 ld8(const LAS bf16* p) { const s16x4 lo = *(const LAS s16x4*)p, hi = *(const LAS s16x4*)(p + 8); return __builtin_shufflevector(lo, hi, 0, 1, 2, 3, 4, 5, 6, 7); }
__device__ __forceinline__ bf16x8 ld8c(const LAS bf16* p) { const s16x4 lo = *(const LAS s16x4*)p, hi = *(const LAS s16x4*)(p + 4); return __builtin_shufflevector(lo, hi, 0, 1, 2, 3, 4, 5, 6, 7); }
template <bool PERM> __device__ __forceinline__ bf16x8 ldcol(const LAS bf16* p, int h) {
    const LAS bf16* q = p + (PERM ? 4 * h : 8 * h) * P144;
    unsigned e[8];
#pragma unroll
    for (int jj = 0; jj < 8; ++jj) e[jj] = q[((PERM && jj >= 4) ? jj + 4 : jj) * P144];
    v4u w; w.x = e[0] | (e[1] << 16); w.y = e[2] | (e[3] << 16); w.z = e[4] | (e[5] << 16); w.w = e[6] | (e[7] << 16);
    return __builtin_bit_cast(bf16x8, w); }
typedef short v4i16_tr_t __attribute__((ext_vector_type(4)));
template <bool PERM> __device__ __forceinline__ bf16x8 ldcol_tr(const LAS bf16* p0, int r, int h) {
    const int i = r & 15, q = i >> 2, pp = i & 3;
    const LAS bf16* a = p0 + ((PERM ? 4 * h : 8 * h) + q) * P144 + (r & 16) + 4 * pp;
    const s16x4 lo = __builtin_bit_cast(s16x4, __builtin_amdgcn_ds_read_tr16_b64_v4i16((LAS v4i16_tr_t*)a));
    const s16x4 hi = __builtin_bit_cast(s16x4, __builtin_amdgcn_ds_read_tr16_b64_v4i16((LAS v4i16_tr_t*)(a + (PERM ? 8 : 4) * P144)));
    return __builtin_shufflevector(lo, hi, 0, 1, 2, 3, 4, 5, 6, 7); }
__device__ __forceinline__ bf16x8 pack8r(const f32x16& x, int s) {
    v4u p; p.x = pg8::cvt_pk_bf16(x[8 * s], x[8 * s + 1]); p.y = pg8::cvt_pk_bf16(x[8 * s + 2], x[8 * s + 3]); p.z = pg8::cvt_pk_bf16(x[8 * s + 4], x[8 * s + 5]); p.w = pg8::cvt_pk_bf16(x[8 * s + 6], x[8 * s + 7]);
    return __builtin_bit_cast(bf16x8, p); }
#define CS_SYNC() do { asm volatile("s_waitcnt lgkmcnt(0)" ::: "memory"); __builtin_amdgcn_s_barrier(); asm volatile("" ::: "memory"); } while (0)
#define CS_MFMA(a, b, c) __builtin_amdgcn_mfma_f32_32x32x16_bf16((a), (b), (c), 0, 0, 0)
}
__device__ __forceinline__ void scan_chain_chunked(int l, int chain, const float* const* in, unsigned char* ws, LAS unsigned char* lds, int tid, int wave, int lane) {
    using namespace cs;
    const int d = chain >> 6, b = (chain >> 3) & 7, hd = chain & 7;
    const bf16* R = (const bf16*)(ws + A_R); const bf16* KS = (const bf16*)(ws + A_KS); const bf16* VS = (const bf16*)(ws + A_VS);
    const bf16* LW = (const bf16*)(ws + A_LW); const bf16* AA = (const bf16*)(ws + A_AA);
    bf16* YS = (bf16*)(ws + (d ? A_YSB : A_YSF)); float* CFB = (float*)(ws + WS_CFB) + (size_t)d * M * 8;
    LAS float* lwL = (LAS float*)(lds + RING_OFF + LWL);
    const int ps0 = tid >> 3, pc0 = tid & 7;
    const int r0 = lane & 31, h0 = lane >> 5;
    const float* kkcp = in[10] + (size_t)l * 512 + hd * 64; const float* kacp = in[11] + (size_t)l * 512 + hd * 64; const float* rkcp = in[12] + (size_t)l * 512 + hd * 64;
    f32x16 st0, st1;
#pragma unroll
    for (int i = 0; i < 16; ++i) { st0[i] = 0.f; st1[i] = 0.f; }
    v4u rr, kr, vr, lwr, ar;
    { const int tok = d ? (SEQ - 1 - ps0) : ps0; const size_t t = (size_t)b * SEQ + tok;
      rr = ld16(R + t * 512 + hd * 64 + pc0 * 8); kr = ld16(KS + t * 512 + hd * 64 + pc0 * 8); vr = ld16(VS + t * 512 + hd * 64 + pc0 * 8);
      lwr = ld16(LW + t * 1024 + d * 512 + hd * 64 + pc0 * 8); ar = ld16(AA + t * 1024 + d * 512 + hd * 64 + pc0 * 8); }
    for (int blk = 0; blk < SEQ / 64; ++blk) {
        int ps = ps0, pc = pc0, r = r0, h = h0; asm volatile("" : "+v"(ps), "+v"(pc), "+v"(r), "+v"(h));
        const int ch = ps >> 4, sl = ps & 15;

        const int tokp = d ? (SEQ - 1 - (blk * 64 + ps)) : (blk * 64 + ps); const size_t tp = (size_t)b * SEQ + tokp;
        LAS unsigned char* cbase = lds + RING_OFF + CH0 + ch * CH_STRIDE;
        if (blk > 0) { const int tl = (blk - 1) * 64 + ps; const int tok = d ? (SEQ - 1 - tl) : tl;
            const v4u yv = *(const LAS v4u*)((const LAS bf16*)(lds + RING_OFF + YL0) + ps * P144 + pc * 8); st16(YS + ((size_t)b * SEQ + tok) * 512 + hd * 64 + pc * 8, yv); }
        float r8[8], k8[8], v8[8], lw8[8], a8[8], kk8[8], kd8[8], nb8[8], kkc[8], kac[8], rkc[8];
        ldf8(kkcp + pc * 8, kkc); ldf8(kacp + pc * 8, kac); ldf8(rkcp + pc * 8, rkc);
        unp8(rr, r8); unp8(kr, k8); unp8(vr, v8); unp8(lwr, lw8); unp8(ar, a8); const v4u vraw_ = vr; (void)v8;
        { float ss = 0.f;
#pragma unroll
          for (int i = 0; i < 8; ++i) { kk8[i] = k8[i] * kkc[i]; ss += kk8[i] * kk8[i]; }
          ss = sum8(ss, lane); const float inv = 1.0f / fmaxf(sqrtf(ss), 1e-12f);
          float cf = 0.f;
#pragma unroll
          for (int i = 0; i < 8; ++i) { kk8[i] *= inv; kd8[i] = k8[i] * (1.0f + (a8[i] - 1.0f) * kac[i]); cf += r8[i] * kd8[i] * rkc[i]; nb8[i] = -kk8[i] * a8[i]; }
          cf = sum8(cf, lane); if (pc == 0) CFB[tp * 8 + hd] = cf; }
        { LAS float* p = lwL + ps * 64 + pc * 8; *(LAS f32x4*)p = (f32x4){lw8[0], lw8[1], lw8[2], lw8[3]}; *(LAS f32x4*)(p + 4) = (f32x4){lw8[4], lw8[5], lw8[6], lw8[7]}; }
        CS_SYNC();
        if (blk + 1 < SEQ / 64) { const int tok = d ? (SEQ - 1 - ((blk + 1) * 64 + ps)) : ((blk + 1) * 64 + ps); const size_t t = (size_t)b * SEQ + tok;
            rr = ld16(R + t * 512 + hd * 64 + pc * 8); kr = ld16(KS + t * 512 + hd * 64 + pc * 8); vr = ld16(VS + t * 512 + hd * 64 + pc * 8);
            lwr = ld16(LW + t * 1024 + d * 512 + hd * 64 + pc * 8); ar = ld16(AA + t * 1024 + d * 512 + hd * 64 + pc * 8); }
        { float Lex[8], Lt[8];
#pragma unroll
          for (int i = 0; i < 8; ++i) { Lex[i] = 0.f; Lt[i] = 0.f; }
#pragma unroll 4
          for (int u = 0; u < 16; ++u) { const LAS float* p = lwL + (ch * 16 + u) * 64 + pc * 8; const f32x4 x0 = *(const LAS f32x4*)p, x1 = *(const LAS f32x4*)(p + 4);
              const float m = (u < sl) ? 1.0f : 0.0f;
#pragma unroll
              for (int i = 0; i < 4; ++i) { Lt[i] += x0[i]; Lt[4 + i] += x1[i]; Lex[i] += m * x0[i]; Lex[4 + i] += m * x1[i]; } }
          LAS bf16* QRp = (LAS bf16*)(cbase + O_QR); LAS bf16* BKp = (LAS bf16*)(cbase + O_BK);
          float Lin[8], tmp[8], tm2[8];
#pragma unroll
          for (int i = 0; i < 8; ++i) { Lin[i] = Lex[i] + lw8[i]; tmp[i] = kk8[i] * __expf(Lex[i]); }
          *(LAS v4u*)(QRp + sl * P144 + pc * 8) = pk8(tmp);
          asm volatile("" ::: "memory");
#pragma unroll
          for (int i = 0; i < 8; ++i) tmp[i] = r8[i] * __expf(Lin[i]);
          *(LAS v4u*)(QRp + (16 + sl) * P144 + pc * 8) = pk8(tmp);
          asm volatile("" ::: "memory");
#pragma unroll
          for (int i = 0; i < 8; ++i) { const float ig = __expf(-Lin[i]); tmp[i] = nb8[i] * ig; tm2[i] = kd8[i] * ig; }
          *(LAS v4u*)(BKp + sl * P144 + pc * 8) = pk8(tmp); *(LAS v4u*)(BKp + (16 + sl) * P144 + pc * 8) = pk8(tm2);
          asm volatile("" ::: "memory");
#pragma unroll
          for (int i = 0; i < 8; ++i) { const float igc = __expf(Lt[i] - Lin[i]); tmp[i] = nb8[i] * igc; tm2[i] = kd8[i] * igc; }
          *(LAS v4u*)((LAS bf16*)(cbase + O_BH) + sl * P144 + pc * 8) = pk8(tmp); *(LAS v4u*)((LAS bf16*)(cbase + O_KH) + sl * P144 + pc * 8) = pk8(tm2);
          *(LAS v4u*)((LAS bf16*)(cbase + O_V) + sl * P144 + pc * 8) = vraw_;
          if (sl == 15) { LAS float* gp = (LAS float*)(cbase + O_GC) + pc * 8; *(LAS f32x4*)gp = (f32x4){__expf(Lt[0]), __expf(Lt[1]), __expf(Lt[2]), __expf(Lt[3])}; *(LAS f32x4*)(gp + 4) = (f32x4){__expf(Lt[4]), __expf(Lt[5]), __expf(Lt[6]), __expf(Lt[7])}; } }
        CS_SYNC();
#ifndef CS_NO_A
#ifndef CS_REP_A
#define CS_REP_A 1
#endif
        for (int repa_ = 0; repa_ < CS_REP_A; ++repa_) if (wave < 4) {
            LAS unsigned char* cb = lds + RING_OFF + CH0 + wave * CH_STRIDE;
            const LAS bf16* QRp = (const LAS bf16*)(cb + O_QR); const LAS bf16* BKp = (const LAS bf16*)(cb + O_BK); LAS float* AD = (LAS float*)(cb + O_BK);
            f32x16 D;
#pragma unroll
            for (int i = 0; i < 16; ++i) D[i] = 0.f;
#pragma unroll
            for (int ks = 0; ks < 4; ++ks) { const bf16x8 A = *(const LAS bf16x8*)(QRp + r * P144 + ks * 16 + h * 8), B = *(const LAS bf16x8*)(BKp + r * P144 + ks * 16 + h * 8); D = CS_MFMA(A, B, D); }
            asm volatile("s_waitcnt lgkmcnt(0)" ::: "memory");
            LAS float* AnT = (LAS float*)(cb + O_QH);
#pragma unroll
            for (int i = 0; i < 16; ++i) { const int row = crow(i, h), s_ = row & 15, u_ = r & 15; const bool keep = (i < 8) ? (u_ < s_) : (u_ <= s_); const float v = keep ? D[i] : 0.f;
                AD[row * 32 + r] = v; if (i < 8) AnT[r * 16 + row] = v; }
            asm volatile("s_waitcnt lgkmcnt(0)" ::: "memory");
            float x[16];
#pragma unroll
            for (int t = 0; t < 16; ++t) { const float ldv = AD[t * 32 + r]; x[t] = (r < 16) ? ((t == r) ? 1.0f : 0.0f) : ldv; }
#pragma unroll
            for (int s = 0; s < 15; ++s) { const f32x4 a0 = *(const LAS f32x4*)(AnT + s * 16), a1 = *(const LAS f32x4*)(AnT + s * 16 + 4), a2 = *(const LAS f32x4*)(AnT + s * 16 + 8), a3 = *(const LAS f32x4*)(AnT + s * 16 + 12);
                const float an[16] = {a0[0], a0[1], a0[2], a0[3], a1[0], a1[1], a1[2], a1[3], a2[0], a2[1], a2[2], a2[3], a3[0], a3[1], a3[2], a3[3]};
                const float xs = x[s];
#pragma unroll
                for (int t = 0; t < 16; ++t) if (t > s) x[t] += an[t] * xs; }
            LAS bf16* XXp = (LAS bf16*)(cb + O_XX);
            if (h == 0) {
#pragma unroll
                for (int s = 0; s < 16; ++s) XXp[s * P72 + r] = (bf16)f2bf(x[s]); }
            { const int s = lane >> 2, c8 = (lane & 3) * 8; const LAS float* ap = AD + (16 + s) * 32 + c8; const f32x4 y0 = *(const LAS f32x4*)ap, y1 = *(const LAS f32x4*)(ap + 4);
              LAS v2u* bp = (LAS v2u*)((LAS bf16*)(cb + O_BNK) + s * P72 + c8); bp[0] = (v2u){pk2(y0[0], y0[1]), pk2(y0[2], y0[3])}; bp[1] = (v2u){pk2(y1[0], y1[1]), pk2(y1[2], y1[3])}; }
            asm volatile("s_waitcnt lgkmcnt(0)" ::: "memory");
            { LAS bf16* QHp = (LAS bf16*)(cb + O_QH);
              const bf16x8 A = ld8c(XXp + (r & 15) * P72 + 8 * h);
#pragma unroll
              for (int ct = 0; ct < 2; ++ct) { const bf16x8 B = ldcol<false>(QRp + 32 * ct + r, h); f32x16 z;
#pragma unroll
                  for (int i = 0; i < 16; ++i) z[i] = 0.f;
                  z = CS_MFMA(A, B, z);
#pragma unroll
                  for (int i = 0; i < 8; ++i) QHp[crow(i, h) * P144 + 32 * ct + r] = (bf16)f2bf(z[i]); } }
        }
#endif
        CS_SYNC();
#ifndef CS_NO_B
        if (wave < 2) {
            const int c0 = 32 * wave;
#pragma unroll 1
            for (int cc = 0; cc < 4; ++cc) {
                LAS unsigned char* cb = lds + RING_OFF + CH0 + cc * CH_STRIDE;
                const LAS bf16* QRp = (const LAS bf16*)(cb + O_QR); const LAS bf16* QHp = (const LAS bf16*)(cb + O_QH); const LAS bf16* XXp = (const LAS bf16*)(cb + O_XX); const LAS bf16* BNp = (const LAS bf16*)(cb + O_BNK);
                const LAS bf16* Vp = (const LAS bf16*)(cb + O_V); const LAS bf16* BHp = (const LAS bf16*)(cb + O_BH); const LAS bf16* KHp = (const LAS bf16*)(cb + O_KH); const LAS float* GCp = (const LAS float*)(cb + O_GC);
                const int ra = (r & 15) * P144 + 4 * h, rb = (16 + (r & 15)) * P144 + 4 * h, rx = (r & 15) * P72 + 4 * h;
                const bf16x8 qh0 = ld8(QHp + ra), qh1 = ld8(QHp + ra + 16), qh2 = ld8(QHp + ra + 32), qh3 = ld8(QHp + ra + 48);
                const bf16x8 taf = ld8(XXp + rx + 16), vf = ldcol<true>(Vp + c0 + r, h);
                const bf16x8 sb00 = pack8r(st0, 0), sb01 = pack8r(st0, 1), sb10 = pack8r(st1, 0), sb11 = pack8r(st1, 1);
                f32x16 dq;
#pragma unroll
                for (int i = 0; i < 16; ++i) dq[i] = 0.f;
                dq = CS_MFMA(qh0, sb00, dq); dq = CS_MFMA(qh1, sb01, dq); dq = CS_MFMA(qh2, sb10, dq); dq = CS_MFMA(qh3, sb11, dq); dq = CS_MFMA(taf, vf, dq);
                const bf16x8 kh0 = ldcol<true>(KHp + r, h), kh1 = ldcol<true>(KHp + 32 + r, h), bh0 = ldcol<true>(BHp + r, h), bh1 = ldcol<true>(BHp + 32 + r, h);
                { f32x16 acc0, acc1;
#pragma unroll
                  for (int g = 0; g < 4; ++g) { const f32x4 ga = *(const LAS f32x4*)(GCp + 8 * g + 4 * h), gb = *(const LAS f32x4*)(GCp + 32 + 8 * g + 4 * h);
                      acc0[4 * g] = st0[4 * g] * ga[0]; acc0[4 * g + 1] = st0[4 * g + 1] * ga[1]; acc0[4 * g + 2] = st0[4 * g + 2] * ga[2]; acc0[4 * g + 3] = st0[4 * g + 3] * ga[3];
                      acc1[4 * g] = st1[4 * g] * gb[0]; acc1[4 * g + 1] = st1[4 * g + 1] * gb[1]; acc1[4 * g + 2] = st1[4 * g + 2] * gb[2]; acc1[4 * g + 3] = st1[4 * g + 3] * gb[3]; }
                  acc0 = CS_MFMA(kh0, vf, acc0); acc1 = CS_MFMA(kh1, vf, acc1);
                  const bf16x8 dqb = pack8r(dq, 0);
                  acc0 = CS_MFMA(bh0, dqb, acc0); acc1 = CS_MFMA(bh1, dqb, acc1);
                  st0 = acc0; st1 = acc1;
                  f32x16 y;
#pragma unroll
                  for (int i = 0; i < 16; ++i) y[i] = 0.f;
                  y = CS_MFMA(ld8(QRp + rb), sb00, y); y = CS_MFMA(ld8(QRp + rb + 16), sb01, y); y = CS_MFMA(ld8(QRp + rb + 32), sb10, y); y = CS_MFMA(ld8(QRp + rb + 48), sb11, y);
                  y = CS_MFMA(ld8(BNp + rx + 16), vf, y); y = CS_MFMA(ld8(BNp + rx), dqb, y);
                  { LAS bf16* YLp = (LAS bf16*)(lds + RING_OFF + YL0) + (cc * 16) * P144 + c0 + r;
#pragma unroll
                    for (int i = 0; i < 8; i += 2) { const unsigned w = pg8::cvt_pk_bf16(y[i], y[i + 1]); YLp[crow(i, h) * P144] = (bf16)(w & 0xffffu); YLp[crow(i + 1, h) * P144] = (bf16)(w >> 16); } } }
            }
        }
#endif
        CS_SYNC();
    }
    { const int tl = (SEQ / 64 - 1) * 64 + ps0; const int tok = d ? (SEQ - 1 - tl) : tl;
      const v4u yv = *(const LAS v4u*)((const LAS bf16*)(lds + RING_OFF + YL0) + ps0 * P144 + pc0 * 8); st16(YS + ((size_t)b * SEQ + tok) * 512 + hd * 64 + pc0 * 8, yv); }
    CS_SYNC();
}

namespace cp {
constexpr int REG = 16384;
constexpr int O_QR = 0, O_BK = 4608, O_V = 9216, O_QH = 11520, O_XX = 13824, O_BNK = 14976, O_GC = 16128;
constexpr int AD0 = 6 * REG, LW0 = AD0 + 8192, YL0 = LW0 + 16384;
static_assert(YL0 + 8192 <= RING_BYTES, "pipelined chunk-scan LDS map");
}
__device__ __forceinline__ void scan_chain_pipe(int l, int chain, const float* const* in, unsigned char* ws, LAS unsigned char* lds, int tid, int wave, int lane) {
    using namespace cs;
    const int d = chain >> 6, b = (chain >> 3) & 7, hd = chain & 7;
    const bf16* R = (const bf16*)(ws + A_R); const bf16* KS = (const bf16*)(ws + A_KS); const bf16* VS = (const bf16*)(ws + A_VS);
    const bf16* LW = (const bf16*)(ws + A_LW); const bf16* AA = (const bf16*)(ws + A_AA);
    bf16* YS = (bf16*)(ws + (d ? A_YSB : A_YSF)); float* CFB = (float*)(ws + WS_CFB) + (size_t)d * M * 8;
    LAS unsigned char* ring = lds + RING_OFF;
    constexpr int NB = SEQ / 32;
    const bool isprep = wave >= 4;
    const int ps0 = (tid & 255) >> 3, pc0 = tid & 7, r0 = lane & 31, h0 = lane >> 5;
    const float* kkcp = in[10] + (size_t)l * 512 + hd * 64; const float* kacp = in[11] + (size_t)l * 512 + hd * 64; const float* rkcp = in[12] + (size_t)l * 512 + hd * 64;
    f32x16 st0, st1;
#pragma unroll
    for (int i = 0; i < 16; ++i) { st0[i] = 0.f; st1[i] = 0.f; }
#define kk8(i) st0[(i)]
#define r8(i) st0[8 + (i)]
#define nb8(i) st1[(i)]
#define kd8(i) st1[8 + (i)]
    float lw8[8], inc8[8]; v4u vkeep = {0u, 0u, 0u, 0u};
#pragma unroll
    for (int i = 0; i < 8; ++i) { lw8[i] = 0.f; inc8[i] = 0.f; }
    v4u rr = {0u, 0u, 0u, 0u}, kr = rr, vr = rr, lwr = rr, ar = rr;
#define CP_LOADRAW(j) do { const int tok_ = d ? (SEQ - 1 - ((j) * 32 + ps)) : ((j) * 32 + ps); const unsigned t_ = (unsigned)(b * SEQ + tok_); \
        const unsigned o5_ = t_ * 512u + (unsigned)(hd * 64 + pc * 8), o10_ = t_ * 1024u + (unsigned)(d * 512 + hd * 64 + pc * 8);     \
        rr = ld16(R + o5_); kr = ld16(KS + o5_); vr = ld16(VS + o5_); lwr = ld16(LW + o10_); ar = ld16(AA + o10_); } while (0)
#define CP_PREP1(j) do { float k8_[8], a8_[8], kkc_[8], kac_[8], rkc_[8]; \
        { const LAS float* c_ = cstL + pc * 8; const f32x4 a0_ = *(const LAS f32x4*)c_, a1_ = *(const LAS f32x4*)(c_ + 4), b0_ = *(const LAS f32x4*)(c_ + 64), b1_ = *(const LAS f32x4*)(c_ + 68), c0_ = *(const LAS f32x4*)(c_ + 128), c1_ = *(const LAS f32x4*)(c_ + 132); \
          _Pragma("unroll") for (int i = 0; i < 4; ++i) { kkc_[i] = a0_[i]; kkc_[4 + i] = a1_[i]; kac_[i] = b0_[i]; kac_[4 + i] = b1_[i]; rkc_[i] = c0_[i]; rkc_[4 + i] = c1_[i]; } } \
        { float r_[8]; unp8(rr, r_); _Pragma("unroll") for (int i = 0; i < 8; ++i) r8(i) = r_[i]; } unp8(kr, k8_); unp8(lwr, lw8); unp8(ar, a8_); vkeep = vr; \
        float ss_ = 0.f, cf_ = 0.f; _Pragma("unroll") for (int i = 0; i < 8; ++i) { kk8(i) = k8_[i] * kkc_[i]; ss_ += kk8(i) * kk8(i); kd8(i) = k8_[i] * (1.0f + (a8_[i] - 1.0f) * kac_[i]); cf_ += r8(i) * kd8(i) * rkc_[i]; } \
        ss_ = sum8(ss_, lane); cf_ = sum8(cf_, lane); \
        const float inv_ = fminf(__builtin_amdgcn_rsqf(ss_), 1e12f); \
        _Pragma("unroll") for (int i = 0; i < 8; ++i) { kk8(i) *= inv_; nb8(i) = -kk8(i) * a8_[i]; } \
        { const int tok_ = d ? (SEQ - 1 - ((j) * 32 + ps)) : ((j) * 32 + ps); if (pc == 0) CFB[(unsigned)(b * SEQ + tok_) * 8u + (unsigned)hd] = cf_; } \
        _Pragma("unroll") for (int i = 0; i < 8; ++i) inc8[i] = lw8[i]; \
        _Pragma("unroll") for (int off_ = 8; off_ < 64; off_ <<= 1) { float t8_[8]; _Pragma("unroll") for (int i = 0; i < 8; ++i) t8_[i] = shx_from(inc8[i], lane - off_, lane); \
            __builtin_amdgcn_sched_barrier(0);     \
            _Pragma("unroll") for (int i = 0; i < 8; ++i) inc8[i] += (lane >= off_) ? t8_[i] : 0.f; } \
        if ((lane >> 3) == 7) { LAS float* p_ = (LAS float*)(ring + cp::LW0) + ((j) & 1) * 256 + (wave & 3) * 64 + pc * 8; *(LAS f32x4*)p_ = (f32x4){inc8[0], inc8[1], inc8[2], inc8[3]}; *(LAS f32x4*)(p_ + 4) = (f32x4){inc8[4], inc8[5], inc8[6], inc8[7]}; } \
        if ((j) + 1 < NB) CP_LOADRAW((j) + 1); } while (0)
    LAS float* cstL = (LAS float*)(lds + MISC_OFF + 1024);
    if (tid < 192) cstL[tid] = (tid < 64 ? kkcp : (tid < 128 ? kacp : rkcp))[tid & 63];
    CS_SYNC();
    if (isprep) { const int ps = ps0, pc = pc0; CP_LOADRAW(0); CP_PREP1(0); }
    CS_SYNC();
    for (int k = 0; k < NB + 3; ++k) {
        int ps = ps0, pc = pc0, r = r0, h = h0; asm volatile("" : "+v"(ps), "+v"(pc), "+v"(r), "+v"(h));
        if (isprep) {
            const int ch = ps >> 4, sl = ps & 15;
            if (k >= 3) { const int j = k - 3; const int tl = j * 32 + ps; const int tok = d ? (SEQ - 1 - tl) : tl;
                const v4u yv = *(const LAS v4u*)((const LAS bf16*)(ring + cp::YL0) + (j & 1) * 2048 + ps * 64 + pc * 8); st16(YS + ((unsigned)(b * SEQ + tok) * 512u + (unsigned)(hd * 64 + pc * 8)), yv); }
#ifndef CP_REP_P
#define CP_REP_P 1
#endif
            for (int repp_ = 0; repp_ < CP_REP_P; ++repp_) if (k < NB) {
                LAS unsigned char* cbase = ring + ((k % 3) * 2 + ch) * cp::REG;
                const LAS float* WT = (const LAS float*)(ring + cp::LW0) + (k & 1) * 256 + (ch * 2) * 64 + pc * 8;
                float Lex[8], Lt[8];
                { const f32x4 a0 = *(const LAS f32x4*)WT, a1 = *(const LAS f32x4*)(WT + 4), b0 = *(const LAS f32x4*)(WT + 64), b1 = *(const LAS f32x4*)(WT + 68);
                  const float w0[8] = {a0[0], a0[1], a0[2], a0[3], a1[0], a1[1], a1[2], a1[3]}, w1[8] = {b0[0], b0[1], b0[2], b0[3], b1[0], b1[1], b1[2], b1[3]};
                  const float m = (sl >= 8) ? 1.0f : 0.0f;
#pragma unroll
                  for (int i = 0; i < 8; ++i) { Lt[i] = w0[i] + w1[i]; Lex[i] = inc8[i] + m * w0[i] - lw8[i]; } }
                LAS bf16* QRp = (LAS bf16*)(cbase + cp::O_QR); LAS bf16* BKp = (LAS bf16*)(cbase + cp::O_BK);
                float Lin[8], tmp[8], tm2[8];
#pragma unroll
                for (int i = 0; i < 8; ++i) { Lin[i] = Lex[i] + lw8[i]; tmp[i] = kk8(i) * __builtin_amdgcn_exp2f(Lex[i]); }
                *(LAS v4u*)(QRp + sl * P144 + pc * 8) = pk8(tmp);
#pragma unroll
                for (int i = 0; i < 8; ++i) tmp[i] = r8(i) * __builtin_amdgcn_exp2f(Lin[i]);
                *(LAS v4u*)(QRp + (16 + sl) * P144 + pc * 8) = pk8(tmp);
#pragma unroll
                for (int i = 0; i < 8; ++i) { const float ig = __builtin_amdgcn_exp2f(-Lin[i]); tmp[i] = nb8(i) * ig; tm2[i] = kd8(i) * ig; }
                *(LAS v4u*)(BKp + sl * P144 + pc * 8) = pk8(tmp); *(LAS v4u*)(BKp + (16 + sl) * P144 + pc * 8) = pk8(tm2);
                *(LAS v4u*)((LAS bf16*)(cbase + cp::O_V) + sl * P144 + pc * 8) = vkeep;
                if (sl == 15) { LAS float* gp = (LAS float*)(cbase + cp::O_GC) + pc * 8; *(LAS f32x4*)gp = (f32x4){__builtin_amdgcn_exp2f(Lt[0]), __builtin_amdgcn_exp2f(Lt[1]), __builtin_amdgcn_exp2f(Lt[2]), __builtin_amdgcn_exp2f(Lt[3])}; *(LAS f32x4*)(gp + 4) = (f32x4){__builtin_amdgcn_exp2f(Lt[4]), __builtin_amdgcn_exp2f(Lt[5]), __builtin_amdgcn_exp2f(Lt[6]), __builtin_amdgcn_exp2f(Lt[7])}; }
            }
            if (k + 1 < NB) CP_PREP1(k + 1);
        }
        if (wave == 2 || wave == 3) {
#ifndef CP_REP_A
#define CP_REP_A 1
#endif
            for (int repa_ = 0; repa_ < CP_REP_A; ++repa_) if (k >= 1 && k <= NB) {
                const int j = k - 1, ca = wave - 2;
                LAS unsigned char* cb = ring + ((j % 3) * 2 + ca) * cp::REG;
                const LAS bf16* QRp = (const LAS bf16*)(cb + cp::O_QR); const LAS bf16* BKp = (const LAS bf16*)(cb + cp::O_BK); LAS float* AD = (LAS float*)(ring + cp::AD0 + ca * 4096);
                f32x16 D;
#pragma unroll
                for (int i = 0; i < 16; ++i) D[i] = 0.f;
#pragma unroll
                for (int ks = 0; ks < 4; ++ks) { const bf16x8 A = *(const LAS bf16x8*)(QRp + r * P144 + ks * 16 + h * 8), B = *(const LAS bf16x8*)(BKp + r * P144 + ks * 16 + h * 8); D = CS_MFMA(A, B, D); }
                LAS float* AnT = (LAS float*)(cb + cp::O_QH);
#pragma unroll
                for (int i = 0; i < 16; ++i) { const int row = crow(i, h), s_ = row & 15, u_ = r & 15; const bool keep = (i < 8) ? (u_ < s_) : (u_ <= s_); const float v = keep ? D[i] : 0.f;
                    AD[row * 32 + r] = v; if (i < 8) AnT[r * 16 + row] = v; }
                asm volatile("s_waitcnt lgkmcnt(0)" ::: "memory");
                float x[16];
#pragma unroll
                for (int t = 0; t < 16; ++t) x[t] = AD[t * 32 + r];
#pragma unroll
                for (int t = 0; t < 16; ++t) asm volatile("" : "+v"(x[t]));
#pragma unroll
                for (int t = 0; t < 16; ++t) x[t] = (r < 16) ? ((t == r) ? 1.0f : 0.0f) : x[t];
#pragma unroll
                for (int s = 0; s < 15; ++s) { const f32x4 a0 = *(const LAS f32x4*)(AnT + s * 16), a1 = *(const LAS f32x4*)(AnT + s * 16 + 4), a2 = *(const LAS f32x4*)(AnT + s * 16 + 8), a3 = *(const LAS f32x4*)(AnT + s * 16 + 12);
                    const float an[16] = {a0[0], a0[1], a0[2], a0[3], a1[0], a1[1], a1[2], a1[3], a2[0], a2[1], a2[2], a2[3], a3[0], a3[1], a3[2], a3[3]};
                    const float xs = x[s];
#pragma unroll
                    for (int t = 0; t < 16; ++t) if (t > s) x[t] += an[t] * xs; }
                LAS bf16* XXp = (LAS bf16*)(cb + cp::O_XX);
                if (h == 0) {
#pragma unroll
                    for (int s = 0; s < 16; ++s) XXp[s * P72 + r] = (bf16)f2bf(x[s]); }
                { const int s = lane >> 2, c8 = (lane & 3) * 8; const LAS float* ap = AD + (16 + s) * 32 + c8; const f32x4 y0 = *(const LAS f32x4*)ap, y1 = *(const LAS f32x4*)(ap + 4);
                  LAS v2u* bp = (LAS v2u*)((LAS bf16*)(cb + cp::O_BNK) + s * P72 + c8); bp[0] = (v2u){pk2(y0[0], y0[1]), pk2(y0[2], y0[3])}; bp[1] = (v2u){pk2(y1[0], y1[1]), pk2(y1[2], y1[3])}; }
                asm volatile("s_waitcnt lgkmcnt(0)" ::: "memory");
                { LAS bf16* QHp = (LAS bf16*)(cb + cp::O_QH);
                  const bf16x8 A = ld8c(XXp + (r & 15) * P72 + 8 * h);
                  f32x16 z0, z1;
#pragma unroll
                  for (int i = 0; i < 16; ++i) { z0[i] = 0.f; z1[i] = 0.f; }
                  z0 = CS_MFMA(A, ldcol_tr<false>(QRp, r, h), z0); z1 = CS_MFMA(A, ldcol_tr<false>(QRp + 32, r, h), z1);
#pragma unroll
                  for (int i = 0; i < 8; ++i) { QHp[crow(i, h) * P144 + r] = (bf16)f2bf(z0[i]); QHp[crow(i, h) * P144 + 32 + r] = (bf16)f2bf(z1[i]); } }
            }
        }
        if (wave < 2) {
            if (k >= 2 && k <= NB + 1) {
                const int j = k - 2, c0 = 32 * wave;
                const int ra = (r & 15) * P144 + 4 * h, rb = (16 + (r & 15)) * P144 + 4 * h, rx = (r & 15) * P72 + 4 * h;
                LAS unsigned char* cb0 = ring + ((j % 3) * 2 + 0) * cp::REG; LAS unsigned char* cb1 = cb0 + cp::REG;
#define CP_P(cb, off) ((const LAS bf16*)((cb) + (off)))
#define CP_GC(cb, GA, GB) do { _Pragma("unroll") for (int g = 0; g < 4; ++g) { GA[g] = *(const LAS f32x4*)((const LAS float*)((cb) + cp::O_GC) + 8 * g + 4 * h); GB[g] = *(const LAS f32x4*)((const LAS float*)((cb) + cp::O_GC) + 32 + 8 * g + 4 * h); } } while (0)
#define CP_SCALE(GA, GB) do { _Pragma("unroll") for (int g = 0; g < 4; ++g) { \
                    st0[4 * g] = acc0[4 * g] * GA[g][0]; st0[4 * g + 1] = acc0[4 * g + 1] * GA[g][1]; st0[4 * g + 2] = acc0[4 * g + 2] * GA[g][2]; st0[4 * g + 3] = acc0[4 * g + 3] * GA[g][3]; \
                    st1[4 * g] = acc1[4 * g] * GB[g][0]; st1[4 * g + 1] = acc1[4 * g + 1] * GB[g][1]; st1[4 * g + 2] = acc1[4 * g + 2] * GB[g][2]; st1[4 * g + 3] = acc1[4 * g + 3] * GB[g][3]; } } while (0)
                const bf16x8 qh00 = ld8(CP_P(cb0, cp::O_QH) + ra), qh01 = ld8(CP_P(cb0, cp::O_QH) + ra + 16), qh02 = ld8(CP_P(cb0, cp::O_QH) + ra + 32), qh03 = ld8(CP_P(cb0, cp::O_QH) + ra + 48), ta0 = ld8(CP_P(cb0, cp::O_XX) + rx + 16);
                const bf16x8 vf0 = ldcol_tr<true>(CP_P(cb0, cp::O_V) + c0, r, h);
                const bf16x8 kt00 = ldcol_tr<true>(CP_P(cb0, cp::O_BK) + 16 * P144, r, h), kt01 = ldcol_tr<true>(CP_P(cb0, cp::O_BK) + 16 * P144 + 32, r, h), bt00 = ldcol_tr<true>(CP_P(cb0, cp::O_BK), r, h), bt01 = ldcol_tr<true>(CP_P(cb0, cp::O_BK) + 32, r, h);
                f32x4 ga[4], gb[4]; CP_GC(cb0, ga, gb);
                __builtin_amdgcn_sched_barrier(0);
                const bf16x8 s00 = pack8r(st0, 0), s01 = pack8r(st0, 1), s10 = pack8r(st1, 0), s11 = pack8r(st1, 1);
                f32x16 dq;
#pragma unroll
                for (int i = 0; i < 16; ++i) dq[i] = 0.f;
                dq = CS_MFMA(qh00, s00, dq); dq = CS_MFMA(qh01, s01, dq); dq = CS_MFMA(qh02, s10, dq); dq = CS_MFMA(qh03, s11, dq); dq = CS_MFMA(ta0, vf0, dq);
                f32x16 acc0 = st0, acc1 = st1;
                acc0 = CS_MFMA(kt00, vf0, acc0); acc1 = CS_MFMA(kt01, vf0, acc1);
                __builtin_amdgcn_sched_barrier(0);
                const bf16x8 qh10 = ld8(CP_P(cb1, cp::O_QH) + ra), qh11 = ld8(CP_P(cb1, cp::O_QH) + ra + 16), qh12 = ld8(CP_P(cb1, cp::O_QH) + ra + 32), qh13 = ld8(CP_P(cb1, cp::O_QH) + ra + 48), ta1 = ld8(CP_P(cb1, cp::O_XX) + rx + 16);
                const bf16x8 vf1 = ldcol_tr<true>(CP_P(cb1, cp::O_V) + c0, r, h);
                const bf16x8 kt10 = ldcol_tr<true>(CP_P(cb1, cp::O_BK) + 16 * P144, r, h), kt11 = ldcol_tr<true>(CP_P(cb1, cp::O_BK) + 16 * P144 + 32, r, h), bt10 = ldcol_tr<true>(CP_P(cb1, cp::O_BK), r, h), bt11 = ldcol_tr<true>(CP_P(cb1, cp::O_BK) + 32, r, h);
                __builtin_amdgcn_sched_barrier(0);
                const bf16x8 dqb0 = pack8r(dq, 0);
                acc0 = CS_MFMA(bt00, dqb0, acc0); acc1 = CS_MFMA(bt01, dqb0, acc1);
                CP_SCALE(ga, gb);
                __builtin_amdgcn_sched_barrier(0);
                const bf16x8 rt00 = ld8(CP_P(cb0, cp::O_QR) + rb), rt01 = ld8(CP_P(cb0, cp::O_QR) + rb + 16), rt02 = ld8(CP_P(cb0, cp::O_QR) + rb + 32), rt03 = ld8(CP_P(cb0, cp::O_QR) + rb + 48);
                const bf16x8 bn0v = ld8(CP_P(cb0, cp::O_BNK) + rx + 16), bn0d = ld8(CP_P(cb0, cp::O_BNK) + rx);
                __builtin_amdgcn_sched_barrier(0);
                const bf16x8 t00 = pack8r(st0, 0), t01 = pack8r(st0, 1), t10 = pack8r(st1, 0), t11 = pack8r(st1, 1);
                f32x16 dq1, y0;
#pragma unroll
                for (int i = 0; i < 16; ++i) { dq1[i] = 0.f; y0[i] = 0.f; }
                dq1 = CS_MFMA(qh10, t00, dq1);     y0 = CS_MFMA(rt00, s00, y0);
                dq1 = CS_MFMA(qh11, t01, dq1);     y0 = CS_MFMA(rt01, s01, y0);
                dq1 = CS_MFMA(qh12, t10, dq1);     y0 = CS_MFMA(rt02, s10, y0);
                dq1 = CS_MFMA(qh13, t11, dq1);     y0 = CS_MFMA(rt03, s11, y0);
                dq1 = CS_MFMA(ta1, vf1, dq1);      y0 = CS_MFMA(bn0v, vf0, y0);
                acc0 = st0; acc1 = st1;
                acc0 = CS_MFMA(kt10, vf1, acc0); acc1 = CS_MFMA(kt11, vf1, acc1);
                y0 = CS_MFMA(bn0d, dqb0, y0);
                __builtin_amdgcn_sched_barrier(0);
                CP_GC(cb1, ga, gb);
                const bf16x8 rt10 = ld8(CP_P(cb1, cp::O_QR) + rb), rt11 = ld8(CP_P(cb1, cp::O_QR) + rb + 16), rt12 = ld8(CP_P(cb1, cp::O_QR) + rb + 32), rt13 = ld8(CP_P(cb1, cp::O_QR) + rb + 48);
                const bf16x8 bn1v = ld8(CP_P(cb1, cp::O_BNK) + rx + 16), bn1d = ld8(CP_P(cb1, cp::O_BNK) + rx);
                __builtin_amdgcn_sched_barrier(0);
                const bf16x8 dqb1 = pack8r(dq1, 0);
                acc0 = CS_MFMA(bt10, dqb1, acc0); acc1 = CS_MFMA(bt11, dqb1, acc1);
                f32x16 y1;
#pragma unroll
                for (int i = 0; i < 16; ++i) y1[i] = 0.f;
                y1 = CS_MFMA(rt10, t00, y1); y1 = CS_MFMA(rt11, t01, y1); y1 = CS_MFMA(rt12, t10, y1); y1 = CS_MFMA(rt13, t11, y1);
                y1 = CS_MFMA(bn1v, vf1, y1); y1 = CS_MFMA(bn1d, dqb1, y1);
                CP_SCALE(ga, gb);
#undef CP_GC
#undef CP_SCALE
                { LAS bf16* YLp = (LAS bf16*)(ring + cp::YL0) + (j & 1) * 2048 + c0 + r;
#pragma unroll
                  for (int i = 0; i < 8; i += 2) { const unsigned w0 = pg8::cvt_pk_bf16(y0[i], y0[i + 1]), w1 = pg8::cvt_pk_bf16(y1[i], y1[i + 1]);
                      YLp[crow(i, h) * 64] = (bf16)(w0 & 0xffffu); YLp[crow(i + 1, h) * 64] = (bf16)(w0 >> 16); YLp[(16 + crow(i, h)) * 64] = (bf16)(w1 & 0xffffu); YLp[(16 + crow(i + 1, h)) * 64] = (bf16)(w1 >> 16); } }
#undef CP_P
            }
        }
        CS_SYNC();
    }
#undef CP_LOADRAW
#undef kk8
#undef r8
#undef nb8
#undef kd8
#undef CP_PREP1
}

struct Args { const float* in[32]; float* out; unsigned char* ws; int ph_lo, ph_hi, li, pad; };
#ifndef PHMASK
#define PHMASK 0xFFFF
#endif
#define PH_EN(i) (((PHMASK) >> (i)) & 1)
#ifndef DUPMASK
#define DUPMASK 0
#endif
#define REP(i) for (int rep_ = 0; rep_ < ((((DUPMASK) >> (i)) & 1) + 1); ++rep_)
#define PHASE_BEGIN() \
    const int z_ = __builtin_amdgcn_readfirstlane((int)*(volatile LAS unsigned*)(lds + LDSCTL_OFF + 32)); \
    unsigned char* const ws = args.ws + z_; const float* const* const in = args.in + z_; float* const out = args.out + z_; \
    const int tid = (int)threadIdx.x + z_, lane = tid & 63, wave = __builtin_amdgcn_readfirstlane(tid >> 6); \
    const int G = (int)gridDim.x + z_, bx = (int)blockIdx.x + z_, vcu = (G % 8 == 0) ? (bx % 8) * (G / 8) + bx / 8 : bx; \
    const int gw = vcu * NWAVES + wave, NGW = G * NWAVES; (void)ws; (void)in; (void)out; (void)lane; (void)gw; (void)NGW; (void)vcu
#define LAYER_VARS() const float* const xcur = (l == 0) ? in[0] : (const float*)out; unsigned char* const wl = ws + WS_W + (size_t)l * WL_STRIDE; (void)xcur; (void)wl
#define IN(k) (ph_lo_ <= (k) && (k) < ph_hi_)
#ifdef PROBE_SEAM2
#define SEAM_EXTRA xcd_barrier(bar_);
#else
#define SEAM_EXTRA
#endif
#define SEAM(k) do { if (IN(k) && IN((k) + 1)) { const int zz_ = __builtin_amdgcn_readfirstlane((int)*(volatile LAS unsigned*)(lds + LDSCTL_OFF + 32)); XcdBarrier bar_; bar_.bar = (unsigned*)(args.ws + zz_ + WS_CTL) + CW_BAR + (ph_li_ + zz_) * XCD_BAR_WORDS; bar_.x = xb_xcc_id(); bar_.st = (volatile LAS unsigned*)(lds + MISC_OFF) + 8; xcd_barrier(bar_); SEAM_EXTRA } } while (0)

__global__ void __launch_bounds__(NTHR, 2) fwd(Args args) {
    extern __shared__ __attribute__((aligned(16))) unsigned char lds_raw[];
    LAS unsigned char* lds = (LAS unsigned char*)lds_raw;
    const int ph_lo_ = __builtin_amdgcn_readfirstlane(args.ph_lo), ph_hi_ = __builtin_amdgcn_readfirstlane(args.ph_hi), ph_li_ = __builtin_amdgcn_readfirstlane(args.li);
    for (int u = threadIdx.x; u < (LDS_BYTES - LDSCTL_OFF) / 4; u += NTHR) ((LAS unsigned*)(lds + LDSCTL_OFF))[u] = 0u;
    __syncthreads();
    if (ph_hi_ - ph_lo_ > 1) (void)xcd_barrier_post((unsigned*)(args.ws + WS_CTL) + CW_BAR + ph_li_ * XCD_BAR_WORDS, (volatile LAS unsigned*)(lds + MISC_OFF) + 8);

    REP(13) if (PH_EN(13) && IN(0)) { PHASE_BEGIN(); p0_prologue(in, ws, lds, vcu, G, tid, wave, lane); if (!IN(1)) SEAM(0); }

#pragma nounroll
    for (int l = 0; l < 2; ++l) {
        const int pb = 1 + PH_PER_LAYER * l;
        REP(0) if (PH_EN(0) && IN(pb + 0)) { PHASE_BEGIN(); LAYER_VARS();
#ifdef PROBE_NORM2
            if (l == 0) norm_rows<0>(in[0], nullptr, false, nullptr, nullptr, in[1], (bf16*)(ws + A_HN1), nullptr, gw, NGW, lane, (unsigned char*)out + 2048);
            else norm_rows<0, true>(out, nullptr, true, (const bf16*)(ws + A_YE), (const int*)(ws + WS_INV), in[1] + DMODEL, (bf16*)(ws + A_HN1), nullptr, gw, NGW, lane, (unsigned char*)out + 2048);
#endif
            if (l == 0) norm_rows<0>(in[0], nullptr, false, nullptr, nullptr, in[1], (bf16*)(ws + A_HN1), nullptr, gw, NGW, lane, (unsigned char*)out + 2048);
            else norm_rows<0, true>(out, out, true, (const bf16*)(ws + A_YE), (const int*)(ws + WS_INV), in[1] + DMODEL, (bf16*)(ws + A_HN1), nullptr, gw, NGW, lane, (unsigned char*)out + 2048);
            SEAM(pb + 0);
        }
        REP(1) if (PH_EN(1) && IN(pb + 1)) { PHASE_BEGIN(); LAYER_VARS();
            pg8::ProjOrder S{(const char*)(ws + A_HN1), (const char*)(wl + WO_IN), (size_t)((const unsigned char*)out + 2048 - (ws + A_HN1)), (size_t)(WO_QKV8 - WO_IN), 1024, 1024, 1024, M / 256, NPJ / 256, 10, 4096, G, bx};
            pg8::EpiPlainS E{(bf16*)(ws + A_PRJ), NPJ, 10, 1.0f / 32.0f};
#ifdef PROBE_P2_SINK
            if (rep_ == 0) { pg8::EpiSink E0; pg8::gemm_phase<pg8::EpiSink, pg8::ProjOrder, true, true, false, false, true>(lds + RING_OFF, tid, 1024, 2048, 1024, S, E0); } else
#endif
            pg8::gemm_phase<pg8::EpiPlainS, pg8::ProjOrder, true, true, false, false, true>(lds + RING_OFF, tid, 1024, 2048, 1024, S, E);
            SEAM(pb + 1);
        }
        REP(2) if (PH_EN(2) && IN(pb + 2)) { PHASE_BEGIN(); p3_prep(l, in, ws, lds, gw, NGW, tid, lane); SEAM(pb + 2); }
        REP(3) if (PH_EN(3) && IN(pb + 3)) {
#ifndef P4DUP
#define P4DUP 0
#endif
            for (int r4_ = 0; r4_ < 1 + (P4DUP & 1); ++r4_) { PHASE_BEGIN(); LAYER_VARS();
              pg8::LoraOrder S{(const char*)(ws + A_TW), (const char*)(wl + WO_LORA), G, bx};
              pg8::EpiLora E{(bf16*)(ws + A_LW), (bf16*)(ws + A_AA), in[5] + (size_t)l * 1024, in[7] + (size_t)l * 1024};
              pg8::gemm_phase<pg8::EpiLora, pg8::LoraOrder, true, false, false, false, true>(lds + RING_OFF, tid, 384, 384, 128, S, E); }
            for (int r4_ = 0; r4_ < 1 + ((P4DUP >> 1) & 1); ++r4_) { PHASE_BEGIN(); LAYER_VARS();
              pg8::PlainOrder S{(const char*)(ws + A_TW) + 512, (const char*)(wl + WO_G2), 384, 128, 128, M / 256, 2, G, bx, 0, 1, 0};
              pg8::EpiPlain E{(bf16*)(ws + A_G), 512};
              pg8::gemm_phase<pg8::EpiPlain, pg8::PlainOrder, true, false, false, false, true>(lds + RING_OFF, tid, 384, 384, 128, S, E); }
            for (int r4_ = 0; r4_ < 1 + ((P4DUP >> 2) & 1); ++r4_) { PHASE_BEGIN(); LAYER_VARS();
              pg8::PlainOrder S{(const char*)(ws + A_PL), (const char*)(wl + WO_PW), 512, 512, 512, M / 256, 2, G, bx, 0, 1, 0};
              pg8::EpiColScale E{(bf16*)(ws + A_YB), 512, in[19] + (size_t)l * 512};
              pg8::gemm_phase<pg8::EpiColScale, pg8::PlainOrder, true, false, false, false, true>(lds + RING_OFF, tid, 512, 512, 512, S, E); }
            SEAM(pb + 3);
        }
#if defined(SCAN_SEQ) || defined(SCAN_BLOCKSYNC)
#error "the log-decay rows are in log2 units now: only the pipelined scan reads them that way"
#endif
        REP(4) if (PH_EN(4) && IN(pb + 4)) {
            #ifdef SCAN_SEQ
            { PHASE_BEGIN(); if (bx < 128) scan_chain(l, bx, in, ws, lds, tid, wave, lane); }
#else
            #ifdef SCAN_BLOCKSYNC
            { PHASE_BEGIN(); if (bx < 128) scan_chain_chunked(l, bx, in, ws, lds, tid, wave, lane); }
#else
            { PHASE_BEGIN(); if (bx < 128) scan_chain_pipe(l, bx, in, ws, lds, tid, wave, lane); }
#ifdef DUP_SCAN
            { PHASE_BEGIN(); if (bx < 128) scan_chain_pipe(l, bx, in, ws, lds, tid, wave, lane); }
#endif
#endif
#endif
#ifndef NO_ATTN
            { PHASE_BEGIN();
              volatile LAS int* slot = (volatile LAS int*)(lds + LDSCTL_OFF + 16); gu32* qh = (gu32*)(ws + WS_CTL) + CW_ATTQ + 64 * l;
              float negM; { const float gq = fabsf(in[20][(size_t)l * 64 + lane]), gk = fabsf(in[21][(size_t)l * 64 + lane]); float mq = gq, mk = gk;
#pragma unroll
                for (int o_ = 1; o_ < 64; o_ <<= 1) { mq = fmaxf(mq, shx(mq, o_, lane)); mk = fmaxf(mk, shx(mk, o_, lane)); }
                negM = -(64.0f * 0.125f * 1.4426950408889634f * 1.01f) * mq * mk; negM = __builtin_bit_cast(float, __builtin_amdgcn_readfirstlane(__builtin_bit_cast(int, negM))); }
              const unsigned char* Qp = ws + A_Q; const unsigned char* Kp = ws + A_K; const unsigned char* Vp = ws + A_V;
#ifdef ATT_CODE_EXP
              negM = 4.0f * (negM + 13.0f) + 60.0f;
#else
              negM += 13.0f;
#endif
              for (;;) {
                  if (tid == 0) *slot = (int)__hip_atomic_fetch_add(qh, 1u, RLX_AGENT);
                  __syncthreads();
                  const int item = __builtin_amdgcn_readfirstlane(*slot);
                  __syncthreads();
                  if (item >= 2048 + 1024) break;
                  if (item >= 2048) { convert_experts_items(in, l, ws, lds, (item - 2048) * 24, 24, wave, lane);
#ifdef PROBE_CONV2
                      convert_experts_items(in, l, ws, lds, (item - 2048) * 24, 24, wave, lane);
#endif
                      continue; }
                  const int grp = item >> 7, r = item & 127, b = grp >> 1, h = (grp & 1) * 4 + (r >> 5), qb = r & 31;
#ifdef PROBE_ATT_TWICE
                  attn_body::attn_unit(tid, negM, b, h, qb, Qp, Kp, Vp, (unsigned char*)out + 3072, (char*)lds_raw + RING_OFF, false);
#endif
                  attn_body::attn_unit(tid, negM, b, h, qb, Qp, Kp, Vp, (unsigned char*)out + 3072, (char*)lds_raw + RING_OFF);
              } }
#endif
            SEAM(pb + 4);
        }
        REP(5) if (PH_EN(5) && IN(pb + 5)) { PHASE_BEGIN(); LAYER_VARS();
            p6a_rows(l, in, ws, gw, NGW, lane);
            SEAM(pb + 5);
        }
        REP(6) if (PH_EN(6) && IN(pb + 6)) { PHASE_BEGIN(); LAYER_VARS();
            typedef pg8::MergeOrder<A_HN, A_YA, A_YB, WO_BRA8, WO_G, WO_BR> MOrd;
            MOrd S{(const char*)ws, (const char*)wl, G, bx, (size_t)((const unsigned char*)out + 2048 - ws), (size_t)4096};
            pg8::EpiMerge E{(bf16*)(ws + A_TS) + (size_t)bx * 65536, (bf16*)(ws + A_MG), 1.0f / 32.0f, 1.0f / (32.0f * attn_body::OSC)};
#ifdef PROBE_SINK_P6B
            { pg8::EpiSink E0; pg8::gemm_phase<pg8::EpiSink, MOrd, true, true, false, false, true>(lds + RING_OFF, tid, 512, 2048, 512, S, E0); }
#endif
            pg8::gemm_phase<pg8::EpiMerge, MOrd, true, true, false, false, true>(lds + RING_OFF, tid, 512, 2048, 512, S, E);
            SEAM(pb + 6);
        }
        REP(7) if (PH_EN(7) && IN(pb + 7)) { PHASE_BEGIN(); LAYER_VARS();
            pg8::PlainOrder S{(const char*)(ws + A_MG), (const char*)(wl + WO_OUT), 1024, 1024, 1024, M / 256, 4, G, bx, 0, 1, 0};
            pg8::EpiResBf E{(l == 0) ? in[0] : (const float*)nullptr, (pg8::bf16_t*)out, XBP};
#ifdef PROBE_SINK_P7
            { pg8::EpiSink E0; pg8::gemm_phase<pg8::EpiSink, pg8::PlainOrder, true>(lds + RING_OFF, tid, 1024, 1024, 1024, S, E0); }
#endif
            pg8::gemm_phase<pg8::EpiResBf, pg8::PlainOrder, true, false, false, false, true>(lds + RING_OFF, tid, 1024, 1024, 1024, S, E);
            SEAM(pb + 7);
        }
        REP(8) if (PH_EN(8) && IN(pb + 8)) {
            { PHASE_BEGIN(); p8_router(l, in, out, ws, lds, gw, NGW, tid, lane); }
            SEAM(pb + 8);
        }
        REP(9) if (PH_EN(9) && IN(pb + 9)) { PHASE_BEGIN(); if (bx < BATCH * NEXP) p9_topk(bx, ws, lds, tid, wave, lane); SEAM(pb + 9); }
        REP(11) if (PH_EN(11) && IN(pb + 11)) { PHASE_BEGIN();
            pg8::GatherOrder S{(const char*)(ws + A_HN), (const char*)(ws + A_WGU), (const int*)(ws + WS_IDX), 512, 512, 512, MR / 256, 8, G, bx, 4, NEXP, NEXP * 4, SEQ, (size_t)2048 * 1024};
            pg8::EpiSwiGLU<true> E{(bf16*)(ws + A_HID), 1024, 1.0f / 32.0f, 16.0f};
            pg8::gemm_phase<pg8::EpiSwiGLU<true>, pg8::GatherOrder, true, false, true, true>(lds + RING_OFF, tid, 512, 512, 512, S, E);
            SEAM(pb + 11);
        }
        REP(12) if (PH_EN(12) && IN(pb + 12)) { PHASE_BEGIN();
            pg8::PlainOrder S{(const char*)(ws + A_HID), (const char*)(ws + A_WD), 512, 512, 512, MR / 256, 4, G, bx, 4, NEXP, (size_t)1024 * 1024};
            pg8::EpiRowScale E{(bf16*)(ws + A_YE), 1024, (const float*)(ws + WS_VAL), 1.0f / 512.0f};
#ifdef PROBE_SINK_P12
            { pg8::EpiSink E0; pg8::gemm_phase<pg8::EpiSink, pg8::PlainOrder, true, false, false, true>(lds + RING_OFF, tid, 512, 512, 512, S, E0); }
#endif
            pg8::gemm_phase<pg8::EpiRowScale, pg8::PlainOrder, true, false, false, true>(lds + RING_OFF, tid, 512, 512, 512, S, E);
            SEAM(pb + 12);
        }
    }
#ifdef DBG_DUMP_OFF
#ifndef DBG_DUMP_ELEMS
#define DBG_DUMP_ELEMS ((size_t)M * DMODEL)
#endif
    if (IN(28)) { PHASE_BEGIN(); const bf16* src = (const bf16*)(ws + (size_t)(DBG_DUMP_OFF)); const size_t gt = (size_t)vcu * NTHR + tid, NGT = (size_t)G * NTHR;
        for (size_t i = gt; i < (size_t)M * DMODEL / 8; i += NGT) { float f[8]; unp8(ld16(src + (i % ((size_t)(DBG_DUMP_ELEMS) / 8)) * 8), f); f32x4* o = (f32x4*)(out + i * 8); o[0] = (f32x4){f[0], f[1], f[2], f[3]}; o[1] = (f32x4){f[4], f[5], f[6], f[7]}; } }
#endif
#ifdef PROBE_NORM2
    if (PH_EN(14) && IN(27)) { PHASE_BEGIN(); norm_rows<0, true>(out, nullptr, true, (const bf16*)(ws + A_YE), (const int*)(ws + WS_INV), in[31], (bf16*)(ws + A_HN1), nullptr, gw, NGW, lane); }
#endif
    if (PH_EN(14) && IN(27)) { PHASE_BEGIN(); norm_rows<1, true>(out, nullptr, true, (const bf16*)(ws + A_YE), (const int*)(ws + WS_INV), in[31], nullptr, out, gw, NGW, lane); }
}
#undef IN
#undef SEAM

#ifndef MK_PER_PHASE
#define MK_PER_PHASE 0
#endif
extern "C" void kernel_launch(void* const* d_in, const int* in_sizes, int n_in, void* d_out, int out_size, void* d_ws, size_t ws_size, hipStream_t stream) {
    static int grid = 0;
    if (grid == 0) {
        if (n_in != 32 || in_sizes[0] != M * DMODEL || out_size != M * DMODEL || ws_size < WS_END) { fprintf(stderr, "kernel_launch: unexpected shapes (n_in %d, in0 %d, out %d, ws %zu)\n", n_in, n_in > 0 ? in_sizes[0] : -1, out_size, ws_size); grid = -1; return; }
        int dev = 0, cus = 0, per_cu = 0;
        if (hipGetDevice(&dev) != hipSuccess || hipDeviceGetAttribute(&cus, hipDeviceAttributeMultiprocessorCount, dev) != hipSuccess) { grid = -1; return; }
        if (hipFuncSetAttribute((const void*)fwd, hipFuncAttributeMaxDynamicSharedMemorySize, LDS_BYTES) != hipSuccess) { fprintf(stderr, "kernel_launch: hipFuncSetAttribute failed\n"); grid = -1; return; }
        if (hipOccupancyMaxActiveBlocksPerMultiprocessor(&per_cu, (const void*)fwd, NTHR, LDS_BYTES) != hipSuccess || per_cu < 1) fprintf(stderr, "kernel_launch: occupancy query reports %d\n", per_cu);
        (void)hipGetLastError();
        grid = cus;
        if (grid > 256) grid = 256;
    }
    if (grid < 0) return;
    if (hipMemsetAsync((char*)d_ws + WS_CTL, 0, CTL_ZERO_BYTES, stream) != hipSuccess) return;
    Args a{};
    for (int i = 0; i < 32; ++i) a.in[i] = (const float*)d_in[i];
    a.out = (float*)d_out; a.ws = (unsigned char*)d_ws; a.pad = 0;
#if MK_PER_PHASE
#ifdef DBG_LAST_PHASE
    for (int p = 0; p <= DBG_LAST_PHASE; ++p) { a.ph_lo = p; a.ph_hi = p + 1; a.li = 0; hipLaunchKernelGGL(fwd, dim3(grid), dim3(NTHR), LDS_BYTES, stream, a); }
#ifdef DBG_DUMP_OFF
    a.ph_lo = 28; a.ph_hi = 29; a.li = 0; hipLaunchKernelGGL(fwd, dim3(grid), dim3(NTHR), LDS_BYTES, stream, a);
#endif
#else
    for (int p = 0; p < N_PHASES; ++p) { a.ph_lo = p; a.ph_hi = p + 1; a.li = 0; hipLaunchKernelGGL(fwd, dim3(grid), dim3(NTHR), LDS_BYTES, stream, a); }
#endif
#else
    a.ph_lo = 0; a.ph_hi = N_PHASES; a.li = 0;
    hipLaunchKernelGGL(fwd, dim3(grid), dim3(NTHR), LDS_BYTES, stream, a);
#endif
    const hipError_t le = hipPeekAtLastError();
    if (le != hipSuccess) fprintf(stderr, "kernel_launch: launch failed: %s\n", hipGetErrorName(le));
}
```

```cpp
#include <hip/hip_runtime.h>
#include <cstdio>
#include <cstdint>
namespace pg8 {
#define PG8_LAS __attribute__((address_space(3)))
typedef unsigned short bf16_t;
typedef short bf16x8 __attribute__((ext_vector_type(8)));
typedef float f32x4 __attribute__((ext_vector_type(4)));
typedef unsigned u32x4 __attribute__((ext_vector_type(4)));
constexpr int BM = 256, BK = 64, HALF = 128, HTB = HALF * BK * 2  , STAGE_BYTES = 8 * HTB, NXCD = 8, WGM = 8;

__host__ __device__ __forceinline__ int lds_byte(int r, int c) { const int st = (r >> 4) * 2 + (c >> 5), rr = r & 15, cc = c & 31, ob = rr * 64 + cc * 2; return st * 1024 + (ob ^ (((ob >> 9) & 1) << 5)); }
__host__ __device__ __forceinline__ void stage_rc(int b, int& R, int& C) { const int st = b / 1024, sb = b % 1024, swz = sb ^ (((sb >> 9) & 1) << 5); R = (st >> 1) * 16 + swz / 64; C = (st & 1) * 32 + (swz % 64) / 2; }
__host__ __device__ __forceinline__ int perm32(int rho) { const int n = rho >> 4, i = rho & 15; return 8 * (i >> 2) + 4 * n + (i & 3); }

struct Unit { int pm, pn, sub; };

__device__ __forceinline__ bool tile_of(int i, int G, int c, int nM, int nN, int& pm, int& pn) {
    const long L = (long)i * G + c; const int nwg = nM * nN; if (L >= nwg) return false;
    int wgid = (int)L; { const int q = nwg / NXCD, r = nwg % NXCD, xcd = wgid % NXCD, off = wgid / NXCD; wgid = (xcd < r ? xcd * (q + 1) : r * (q + 1) + (xcd - r) * q) + off; }
    const int nig = WGM * nN, gid = wgid / nig, fm = gid * WGM, gsz = (nM - fm) < WGM ? (nM - fm) : WGM;
    pm = fm + ((wgid % nig) % gsz); pn = (wgid % nig) / gsz; return true;
}
struct PlainOrder {
    const char* A; const char* B; int lda, ldb, K, nM, nN, G, c, grp_panels, ngrp; size_t grp_stride;
    __device__ __forceinline__ int grow(const Unit&, int) const { return 0; }
    __device__ __forceinline__ bool next(int i, Unit& u) const { u.sub = 0; return tile_of(i, G, c, nM, nN, u.pm, u.pn); }
    __device__ __forceinline__ void ops(const Unit& u, const char*& a, const char*& b, int& nt, bool& asel) const {
        nt = K / BK; asel = false;
        a = A + (size_t)u.pm * BM * lda * 2;
        b = B + (size_t)u.pn * BM * ldb * 2 + (grp_panels ? (size_t)((u.pm / grp_panels) % ngrp) * grp_stride : (size_t)0);
    }
};
struct PoolOrder {
    const char* A; const char* B; int G, c;
    __device__ __forceinline__ int grow(const Unit&, int) const { return 0; }
    __device__ __forceinline__ bool next(int i, Unit& u) const { u.sub = 0; return tile_of(i, G, c, 65536 / BM, 2, u.pm, u.pn); }
    __device__ __forceinline__ void ops(const Unit& u, const char*& a, const char*& b, int& nt, bool& asel) const {
        nt = 4; asel = false; a = A + (size_t)u.pm * BM * 512 * 2 + (size_t)u.pn * 256 * 2; b = B + (size_t)u.pn * BM * 512 * 2 + (size_t)u.pn * 256 * 2; }
};
struct ProjOrder {
    const char* A; const char* B; size_t a8_off, b8_off; int lda, ldb, K, nM, nN, pn8, a8_pitch, G, c;
    __device__ __forceinline__ int grow(const Unit&, int) const { return 0; }
    __device__ __forceinline__ bool next(int i, Unit& u) const { u.sub = 0; return tile_of(i, G, c, nM, nN, u.pm, u.pn); }
    __device__ __forceinline__ void ops(const Unit& u, const char*& a, const char*& b, int& nt, bool& asel) const {
        asel = u.pn >= pn8; nt = asel ? K / (2 * BK) : K / BK;
        a = A + (asel ? a8_off + (size_t)u.pm * BM * a8_pitch : (size_t)u.pm * BM * lda * 2);
        b = B + (asel ? b8_off + (size_t)(u.pn - pn8) * BM * ldb * 2 : (size_t)u.pn * BM * ldb * 2);
    }
};
struct LoraOrder {
    const char* A; const char* B; int G, c;
    __device__ __forceinline__ int grow(const Unit&, int) const { return 0; }
    __device__ __forceinline__ bool next(int i, Unit& u) const { u.sub = 0; return tile_of(i, G, c, 256, 8, u.pm, u.pn); }
    __device__ __forceinline__ void ops(const Unit& u, const char*& a, const char*& b, int& nt, bool& asel) const {
        nt = 2; asel = false; a = A + (size_t)u.pm * BM * 384 * 2 + (u.pn >= 4 ? 256 : 0); b = B + (size_t)u.pn * BM * 128 * 2; }
};
struct GatherOrder {
    const char* A; const char* B; const int* idx; int lda, ldb, K, nM, nN, G, c, grp_panels, ngrp, panels_per_batch, seq; size_t grp_stride;
    __device__ __forceinline__ bool next(int i, Unit& u) const { u.sub = 0; return tile_of(i, G, c, nM, nN, u.pm, u.pn); }
    __device__ __forceinline__ void ops(const Unit& u, const char*& a, const char*& b, int& nt, bool& asel) const {
        nt = K / BK; asel = false; a = A;
        b = B + (size_t)u.pn * BM * ldb * 2 + (size_t)((u.pm / grp_panels) % ngrp) * grp_stride;
    }
    __device__ __forceinline__ int grow(const Unit& u, int row) const { return (u.pm / panels_per_batch) * seq + idx[u.pm * BM + row]; }
};
template <size_t OHN, size_t OYA, size_t OYB, size_t OYC, size_t OWG, size_t OWBR>
struct MergeOrder {
    const char* base; const char* wbase; int G, c; size_t hn_off, hn_pitch;
    __device__ __forceinline__ int grow(const Unit&, int) const { return 0; }
#ifndef MERGE_NSUB
#define MERGE_NSUB 6
#endif
    __device__ __forceinline__ bool next(int i, Unit& u) const { const int ti = i / MERGE_NSUB; u.sub = i - ti * MERGE_NSUB; return tile_of(ti, G, c, 256, 4, u.pm, u.pn); }
    __device__ __forceinline__ void ops(const Unit& u, const char*& a, const char*& b, int& nt, bool& asel) const {
        const int bb = u.sub >> 1; const size_t wrow = (size_t)(bb * 1024 + u.pn * BM) * 1024, arow = (size_t)u.pm * BM * 1024; nt = 8;
        if (!(u.sub & 1)) { a = base + (hn_off + (size_t)u.pm * BM * hn_pitch); b = wbase + OWG + wrow; asel = true; }
        else if (bb == 2) { a = base + (hn_off + 1024 + (size_t)u.pm * BM * hn_pitch); b = wbase + OYC + (size_t)u.pn * BM * 1024; asel = true; nt = 4; }
        else { const size_t yo = (bb == 0) ? OYA : OYB; a = base + yo + arow; b = wbase + OWBR + wrow; asel = false; }
    }
};

typedef float f32x2_t __attribute__((ext_vector_type(2))); typedef __bf16 bf16x2_t __attribute__((ext_vector_type(2)));
__device__ __forceinline__ unsigned cvt_pk_bf16(float lo, float hi) { const f32x2_t v = {lo, hi}; const bf16x2_t b = __builtin_convertvector(v, bf16x2_t); return __builtin_bit_cast(unsigned, b); }
__device__ __forceinline__ u32x4 pack8(const f32x4& v0, const f32x4& v1) { u32x4 w; w.x = cvt_pk_bf16(v0[0], v0[1]); w.y = cvt_pk_bf16(v0[2], v0[3]); w.z = cvt_pk_bf16(v1[0], v1[1]); w.w = cvt_pk_bf16(v1[2], v1[3]); return w; }
__device__ __forceinline__ void unpack8(const u32x4& w, f32x4& v0, f32x4& v1) {
    v0[0] = __uint_as_float(w.x << 16); v0[1] = __uint_as_float(w.x & 0xffff0000u); v0[2] = __uint_as_float(w.y << 16); v0[3] = __uint_as_float(w.y & 0xffff0000u);
    v1[0] = __uint_as_float(w.z << 16); v1[1] = __uint_as_float(w.z & 0xffff0000u); v1[2] = __uint_as_float(w.w << 16); v1[3] = __uint_as_float(w.w & 0xffff0000u); }
__device__ __forceinline__ float sigm(float x) { return __builtin_amdgcn_rcpf(1.0f + __builtin_amdgcn_exp2f(-1.4426950408889634f * x)); }
__device__ __forceinline__ f32x4 sigm4(const f32x4& v) { f32x4 r; r[0] = sigm(v[0]); r[1] = sigm(v[1]); r[2] = sigm(v[2]); r[3] = sigm(v[3]); return r; }

struct EpiPlain {
    static constexpr bool PERM = true;
    bf16_t* O; int ldc;
    __device__ __forceinline__ void operator()(const f32x4 (&acc)[2][2][4][2], const Unit& u, int wr, int wc, int fr, int fq) const {
        const int row0 = u.pm * BM + wr * 64 + fr, col0 = u.pn * BM + wc * 32 + 8 * fq;
#pragma unroll
        for (int ai = 0; ai < 2; ++ai)
#pragma unroll
            for (int m = 0; m < 4; ++m) { bf16_t* rowp = O + (size_t)(row0 + ai * HALF + m * 16) * ldc + col0;
#pragma unroll
                for (int bj = 0; bj < 2; ++bj) *(u32x4*)(rowp + bj * HALF) = pack8(acc[ai][bj][m][0], acc[ai][bj][m][1]); }
    }
};
struct EpiSink {
    static constexpr bool PERM = true;
    __device__ __forceinline__ void operator()(const f32x4 (&acc)[2][2][4][2], const Unit&, int, int, int, int) const {
#pragma unroll
        for (int ai = 0; ai < 2; ++ai)
#pragma unroll
            for (int bj = 0; bj < 2; ++bj)
#pragma unroll
                for (int m = 0; m < 4; ++m) { asm volatile("" :: "v"(acc[ai][bj][m][0]), "v"(acc[ai][bj][m][1])); }
    }
};
struct EpiPlainS {
    static constexpr bool PERM = true;
    bf16_t* O; int ldc, pn8; float s8;
    __device__ __forceinline__ void operator()(const f32x4 (&acc)[2][2][4][2], const Unit& u, int wr, int wc, int fr, int fq) const {
        const int row0 = u.pm * BM + wr * 64 + fr, col0 = u.pn * BM + wc * 32 + 8 * fq; const float sc = (u.pn >= pn8) ? s8 : 1.0f;
#pragma unroll
        for (int ai = 0; ai < 2; ++ai)
#pragma unroll
            for (int m = 0; m < 4; ++m) { bf16_t* rowp = O + (size_t)(row0 + ai * HALF + m * 16) * ldc + col0;
#pragma unroll
                for (int bj = 0; bj < 2; ++bj) *(u32x4*)(rowp + bj * HALF) = pack8(acc[ai][bj][m][0] * sc, acc[ai][bj][m][1] * sc); }
    }
};
struct EpiColScale {
    static constexpr bool PERM = true;
    bf16_t* O; int ldc; const float* scale;
    __device__ __forceinline__ void operator()(const f32x4 (&acc)[2][2][4][2], const Unit& u, int wr, int wc, int fr, int fq) const {
        const int row0 = u.pm * BM + wr * 64 + fr, col0 = u.pn * BM + wc * 32 + 8 * fq;
        f32x4 sv[2][2];
#pragma unroll
        for (int bj = 0; bj < 2; ++bj)
#pragma unroll
            for (int n = 0; n < 2; ++n) sv[bj][n] = *(const f32x4*)(scale + col0 + bj * HALF + 4 * n);
#pragma unroll
        for (int ai = 0; ai < 2; ++ai)
#pragma unroll
            for (int m = 0; m < 4; ++m) { bf16_t* rowp = O + (size_t)(row0 + ai * HALF + m * 16) * ldc + col0;
#pragma unroll
                for (int bj = 0; bj < 2; ++bj) {
#ifdef PROBE_YB8
                    f32x4 a0 = acc[ai][bj][m][0] * sv[bj][0], a1 = acc[ai][bj][m][1] * sv[bj][1];
#pragma unroll
                    for (int e = 0; e < 4; ++e) { a0[e] = __builtin_amdgcn_cvt_f32_fp8(__builtin_amdgcn_cvt_pk_fp8_f32(a0[e], a0[e], 0, false), 0); a1[e] = __builtin_amdgcn_cvt_f32_fp8(__builtin_amdgcn_cvt_pk_fp8_f32(a1[e], a1[e], 0, false), 0); }
                    *(u32x4*)(rowp + bj * HALF) = pack8(a0, a1);
#else
                    *(u32x4*)(rowp + bj * HALF) = pack8(acc[ai][bj][m][0] * sv[bj][0], acc[ai][bj][m][1] * sv[bj][1]);
#endif
                } }
    }
};
struct EpiLora {
    static constexpr bool PERM = true;
    bf16_t* LW; bf16_t* AA; const float* w0; const float* a0;
    __device__ __forceinline__ void operator()(const f32x4 (&acc)[2][2][4][2], const Unit& u, int wr, int wc, int fr, int fq) const {
        const bool isw = u.pn < 4; const int ct = (u.pn & 3) * BM;
        bf16_t* O = isw ? LW : AA; const float* bias = isw ? w0 : a0; const float sc = isw ? -0.6065306597126334f * 1.4426950408889634f : 1.0f;
        const int row0 = u.pm * BM + wr * 64 + fr, col0 = ct + wc * 32 + 8 * fq;
        f32x4 bv[2][2];
#pragma unroll
        for (int bj = 0; bj < 2; ++bj)
#pragma unroll
            for (int n = 0; n < 2; ++n) bv[bj][n] = *(const f32x4*)(bias + col0 + bj * HALF + 4 * n);
#pragma unroll
        for (int ai = 0; ai < 2; ++ai)
#pragma unroll
            for (int m = 0; m < 4; ++m) { bf16_t* rowp = O + (size_t)(row0 + ai * HALF + m * 16) * 1024 + col0;
#pragma unroll
                for (int bj = 0; bj < 2; ++bj) { const f32x4 v0 = sigm4(acc[ai][bj][m][0] + bv[bj][0]) * sc, v1 = sigm4(acc[ai][bj][m][1] + bv[bj][1]) * sc;
                    *(u32x4*)(rowp + bj * HALF) = pack8(v0, v1); } }
    }
};
__device__ __forceinline__ u32x4 ld16_dev(const void* p) { u32x4 v; asm volatile("global_load_dwordx4 %0, %1, off sc0 sc1\n\ts_waitcnt vmcnt(0)" : "=v"(v) : "v"(p) : "memory"); return v; }
struct EpiMerge {
    static constexpr bool PERM = true;
    bf16_t* TS; bf16_t* MG; float gs, s5;
    __device__ __forceinline__ void operator()(const f32x4 (&acc)[2][2][4][2], const Unit& u, int wr, int wc, int fr, int fq) const {
        const int lr0 = wr * 64 + fr, lc0 = wc * 32 + 8 * fq;
        if (!(u.sub & 1)) {
#pragma unroll
            for (int ai = 0; ai < 2; ++ai)
#pragma unroll
                for (int m = 0; m < 4; ++m) { bf16_t* rowp = TS + (size_t)(lr0 + ai * HALF + m * 16) * 256 + lc0;
#pragma unroll
                    for (int bj = 0; bj < 2; ++bj) *(u32x4*)(rowp + bj * HALF) = pack8(sigm4(acc[ai][bj][m][0] * gs), sigm4(acc[ai][bj][m][1] * gs)); }
        } else {
            const bool first = (u.sub == 1); const float bs = (u.sub == 5) ? s5 : 1.0f;
#pragma unroll
            for (int ai = 0; ai < 2; ++ai)
#pragma unroll
                for (int m = 0; m < 4; ++m) { const bf16_t* trow = TS + (size_t)(lr0 + ai * HALF + m * 16) * 256 + lc0;
                    bf16_t* grow = MG + (size_t)(u.pm * BM + lr0 + ai * HALF + m * 16) * 1024 + u.pn * BM + lc0;
#pragma unroll
                    for (int bj = 0; bj < 2; ++bj) { f32x4 t0, t1; unpack8(*(const u32x4*)(trow + bj * HALF), t0, t1);
                        f32x4 r0 = t0 * (acc[ai][bj][m][0] * bs), r1 = t1 * (acc[ai][bj][m][1] * bs);
                        if (!first) { f32x4 g0, g1; unpack8(*(const u32x4*)(grow + bj * HALF), g0, g1); r0 += g0; r1 += g1; }
                        *(u32x4*)(grow + bj * HALF) = pack8(r0, r1); }
                    asm volatile("" ::: "memory"); }
        }
    }
};
struct EpiResF32 {
    static constexpr bool PERM = false;
    const float* base; float* out; int ldc;
    __device__ __forceinline__ void operator()(const f32x4 (&acc)[2][2][4][2], const Unit& u, int wr, int wc, int fr, int fq) const {
        const int row0 = u.pm * BM + wr * 64 + fr, col0 = u.pn * BM + wc * 32 + 4 * fq;
#pragma unroll
        for (int ai = 0; ai < 2; ++ai)
#pragma unroll
            for (int m = 0; m < 4; ++m) { const size_t off = (size_t)(row0 + ai * HALF + m * 16) * ldc + col0;
#pragma unroll
                for (int bj = 0; bj < 2; ++bj)
#pragma unroll
                    for (int n = 0; n < 2; ++n) { const f32x4 b = *(const f32x4*)(base + off + bj * HALF + n * 16); *(f32x4*)(out + off + bj * HALF + n * 16) = b + acc[ai][bj][m][n]; } }
    }
};
struct EpiResBf {
    static constexpr bool PERM = false;
    const float* srcf; bf16_t* xb; int ldo;
    __device__ __forceinline__ void operator()(const f32x4 (&acc)[2][2][4][2], const Unit& u, int wr, int wc, int fr, int fq) const {
        const int row0 = u.pm * BM + wr * 64 + fr, col0 = u.pn * BM + wc * 32 + 4 * fq;
        typedef unsigned u32x2 __attribute__((ext_vector_type(2)));
#pragma unroll
        for (int ai = 0; ai < 2; ++ai)
#pragma unroll
            for (int m = 0; m < 4; ++m) { const int row = row0 + ai * HALF + m * 16;
#pragma unroll
                for (int bj = 0; bj < 2; ++bj)
#pragma unroll
                    for (int n = 0; n < 2; ++n) { const int col = col0 + bj * HALF + n * 16; bf16_t* xp = xb + (size_t)row * ldo + col; f32x4 b;
                        if (srcf) b = *(const f32x4*)(srcf + (size_t)row * 1024 + col);
                        else { const u32x2 w = *(const u32x2*)xp; b = (f32x4){__uint_as_float(w.x << 16), __uint_as_float(w.x & 0xffff0000u), __uint_as_float(w.y << 16), __uint_as_float(w.y & 0xffff0000u)}; }
                        const f32x4 r = b + acc[ai][bj][m][n]; *(u32x2*)xp = (u32x2){cvt_pk_bf16(r[0], r[1]), cvt_pk_bf16(r[2], r[3])}; } }
    }
};
__device__ __forceinline__ float clamp_e4m3(float v) { return v; }
__device__ __forceinline__ unsigned pk4_fp8(float a, float b, float c, float d) { unsigned w = 0u; w = __builtin_amdgcn_cvt_pk_fp8_f32(clamp_e4m3(a), clamp_e4m3(b), w, false); w = __builtin_amdgcn_cvt_pk_fp8_f32(clamp_e4m3(c), clamp_e4m3(d), w, true); return w; }
template <bool OUT8> struct EpiSwiGLU {
    static constexpr bool PERM = true;
    bf16_t* HID; int ldc; float s, so;
    __device__ __forceinline__ void operator()(const f32x4 (&acc)[2][2][4][2], const Unit& u, int wr, int wc, int fr, int fq) const {
        const int row0 = u.pm * BM + wr * 64 + fr, col0 = u.pn * HALF + wc * 32 + 8 * fq;
#pragma unroll
        for (int ai = 0; ai < 2; ++ai)
#pragma unroll
            for (int m = 0; m < 4; ++m) {
                const f32x4 g0 = acc[ai][0][m][0] * s, g1 = acc[ai][0][m][1] * s;
                const f32x4 h0 = g0 * sigm4(g0) * (acc[ai][1][m][0] * (s * so)), h1 = g1 * sigm4(g1) * (acc[ai][1][m][1] * (s * so));
                if constexpr (OUT8) { unsigned char* rowp = (unsigned char*)HID + (size_t)(row0 + ai * HALF + m * 16) * ldc + col0;
                    typedef unsigned u32x2 __attribute__((ext_vector_type(2))); *(u32x2*)rowp = (u32x2){pk4_fp8(h0[0], h0[1], h0[2], h0[3]), pk4_fp8(h1[0], h1[1], h1[2], h1[3])}; }
                else { bf16_t* rowp = HID + (size_t)(row0 + ai * HALF + m * 16) * ldc + col0; *(u32x4*)rowp = pack8(h0, h1); } }
    }
};
struct EpiRowScale {
    static constexpr bool PERM = true;
    bf16_t* O; int ldc; const float* rscale; float cs;
    __device__ __forceinline__ void operator()(const f32x4 (&acc)[2][2][4][2], const Unit& u, int wr, int wc, int fr, int fq) const {
        const int row0 = u.pm * BM + wr * 64 + fr, col0 = u.pn * BM + wc * 32 + 8 * fq;
#pragma unroll
        for (int ai = 0; ai < 2; ++ai)
#pragma unroll
            for (int m = 0; m < 4; ++m) { const int row = row0 + ai * HALF + m * 16; const float s = rscale[row] * cs; bf16_t* rowp = O + (size_t)row * ldc + col0;
#pragma unroll
                for (int bj = 0; bj < 2; ++bj) *(u32x4*)(rowp + bj * HALF) = pack8(acc[ai][bj][m][0] * s, acc[ai][bj][m][1] * s); }
    }
};

typedef int v8i32_t __attribute__((ext_vector_type(8))); typedef int v4i32_t __attribute__((ext_vector_type(4)));
__device__ __forceinline__ v8i32_t cat16(const bf16x8& a, const bf16x8& b) { typedef short s16_t __attribute__((ext_vector_type(16))); const s16_t c = __builtin_shufflevector(a, b, 0, 1, 2, 3, 4, 5, 6, 7, 8, 9, 10, 11, 12, 13, 14, 15); return __builtin_bit_cast(v8i32_t, c); }
template <class Epi, class Sched, bool ALIGN_EPI, bool TWO_LDA = false, bool GATHER = false, bool FP8 = false, bool MIXED = false>
__device__ __forceinline__ void gemm_phase(PG8_LAS unsigned char* lds, const int tid, const int lda0, const int lda1, const int ldb, const Sched& S, const Epi& E) {
    const int wid = __builtin_amdgcn_readfirstlane(tid >> 6), lane = tid & 63, wr = wid >> 2, wc = wid & 3, fr = lane & 15, fq = lane >> 4;
    unsigned voffA0[2], voffA1[2], voffB[2]; int gR[2], gC[2];
#pragma unroll
    for (int i = 0; i < 2; ++i) { int R, C; stage_rc(tid * 16 + i * 8192, R, C); gR[i] = R; gC[i] = C; const int Rb = Epi::PERM ? ((R & ~31) + perm32(R & 31)) : R;
        voffA0[i] = (unsigned)(R * lda0 + C) * 2u; voffA1[i] = TWO_LDA ? (unsigned)(R * lda1 + C) * 2u : 0u; voffB[i] = (unsigned)(Rb * ldb + C) * 2u; }
    const size_t kstep = (size_t)(BK * 2);
    const unsigned hsB = (unsigned)HALF * ldb * 2, hsA0 = (unsigned)HALF * lda0 * 2, hsA1 = (unsigned)HALF * lda1 * 2;
    const unsigned ldsw = (unsigned)wid * 1024u;
    const int aoff = lds_byte(wr * 64 + fr, fq * 8), boff = lds_byte(wc * 32 + fr, fq * 8);
#define PG8_SA(b, h) (((b) * 2 + (h)) * HTB)
#define PG8_SB(b, h) ((4 + (b) * 2 + (h)) * HTB)
#define PG8_STAGE(bufoff, gbase, voff) do { _Pragma("unroll") for (int _i = 0; _i < 2; ++_i) \
        __builtin_amdgcn_global_load_lds((const unsigned*)((const char*)(gbase) + (voff)[_i]), (PG8_LAS unsigned*)(lds + (bufoff) + ldsw + _i * 8192), 16, 0, 0); } while (0)
#define PG8_LDA4(dst, b, h) do { _Pragma("unroll") for (int m = 0; m < 4; ++m) _Pragma("unroll") for (int k = 0; k < 2; ++k) dst[m][k] = *(const PG8_LAS bf16x8*)(lds + PG8_SA(b, h) + aoff + m * 2048 + k * 1024); } while (0)
#define PG8_LDB4(dst, b, h) do { _Pragma("unroll") for (int n = 0; n < 2; ++n) _Pragma("unroll") for (int k = 0; k < 2; ++k) dst[n][k] = *(const PG8_LAS bf16x8*)(lds + PG8_SB(b, h) + boff + n * 2048 + k * 1024); } while (0)
#define PG8_LDA8(dst, b, h) do { _Pragma("unroll") for (int m = 0; m < 4; ++m) { const bf16x8 l0_ = *(const PG8_LAS bf16x8*)(lds + PG8_SA(b, h) + aoff + m * 2048), l1_ = *(const PG8_LAS bf16x8*)(lds + PG8_SA(b, h) + aoff + m * 2048 + 1024); dst##8[m] = cat16(l0_, l1_); } } while (0)
#define PG8_LDB8(dst, b, h) do { _Pragma("unroll") for (int n = 0; n < 2; ++n) { const bf16x8 l0_ = *(const PG8_LAS bf16x8*)(lds + PG8_SB(b, h) + boff + n * 2048), l1_ = *(const PG8_LAS bf16x8*)(lds + PG8_SB(b, h) + boff + n * 2048 + 1024); dst##8[n] = cat16(l0_, l1_); } } while (0)
#define PG8_MMAB(ai, bj, At, Bt) do { __builtin_amdgcn_s_setprio(1); _Pragma("unroll") for (int m = 0; m < 4; ++m) _Pragma("unroll") for (int n = 0; n < 2; ++n) _Pragma("unroll") for (int k = 0; k < 2; ++k) \
        acc[ai][bj][m][n] = __builtin_amdgcn_mfma_f32_16x16x32_bf16(Bt[n][k], At[m][k], acc[ai][bj][m][n], 0, 0, 0); __builtin_amdgcn_s_setprio(0); } while (0)
#define PG8_MMA16A(ai, bj, At, Bt) do { __builtin_amdgcn_s_setprio(1); _Pragma("unroll") for (int k = 0; k < 2; ++k) _Pragma("unroll") for (int m = 0; m < 4; ++m) _Pragma("unroll") for (int n = 0; n < 2; ++n)     \
        asm volatile("v_mfma_f32_16x16x32_bf16 %0, %1, %2, %0" : "+v"(acc[ai][bj][m][n]) : "v"(Bt[n][k]), "v"(At[m][k])); __builtin_amdgcn_s_setprio(0); } while (0)
#define PG8_MMA8(ai, bj, At, Bt) do { __builtin_amdgcn_s_setprio(1); _Pragma("unroll") for (int m = 0; m < 4; ++m) _Pragma("unroll") for (int n = 0; n < 2; ++n) \
        asm volatile("v_mfma_scale_f32_16x16x128_f8f6f4 %0, %1, %2, %0, %3, %3 op_sel_hi:[0,0,0]" : "+v"(acc[ai][bj][m][n]) : "v"(Bt##8[n]), "v"(At##8[m]), "v"(sc127)); __builtin_amdgcn_s_setprio(0); } while (0)
#define PG8_WAIT_V(n) asm volatile("s_waitcnt vmcnt(" #n ")" ::: "memory")
#define PG8_WAIT_L(n) asm volatile("s_waitcnt lgkmcnt(" #n ")" ::: "memory")
#define PG8_BAR __builtin_amdgcn_s_barrier()
#define PG8_SCHED __builtin_amdgcn_sched_barrier(0)
#define PG8_KLOOP(LDA_, LDB_, MMA_) \
        for (int t = 0; t < nt; t += 2) { \
            const bool last = (t == nt - 2); \
            const char* a1 = cA + (size_t)(t + 1) * kstep; \
            const char* a2 = last ? nA : cA + (size_t)(t + 2) * kstep; const char* b2 = last ? nB : cB + (size_t)(t + 2) * kstep; \
            const char* a3 = a2 + kstep; const char* b3 = b2 + kstep; \
            LDB_(B0, 0, 0); LDB_(B1, 0, 1); PG8_SCHED; LDA_(At, 0, 0); PG8_STAGE_A(PG8_SA(1, 1), a1, 1, false); \
            PG8_WAIT_V(8); PG8_WAIT_L(0); PG8_BAR; MMA_(0, 0, At, B0); MMA_(0, 1, At, B1); PG8_BAR; PG8_SCHED; \
            LDA_(At, 0, 1); PG8_STAGE(PG8_SB(0, 0), b2, voffB); PG8_STAGE(PG8_SB(0, 1), b2 + hsB, voffB); PG8_STAGE_A(PG8_SA(0, 0), a2, 0, last); \
            PG8_WAIT_V(8); PG8_WAIT_L(0); PG8_BAR; MMA_(1, 0, At, B0); MMA_(1, 1, At, B1); PG8_BAR; PG8_SCHED; \
            LDB_(B0, 1, 0); LDB_(B1, 1, 1); PG8_SCHED; LDA_(At, 1, 0); PG8_STAGE_A(PG8_SA(0, 1), a2, 1, last); \
            PG8_WAIT_V(8); PG8_WAIT_L(0); PG8_BAR; MMA_(0, 0, At, B0); MMA_(0, 1, At, B1); PG8_BAR; PG8_SCHED; \
            LDA_(At, 1, 1); PG8_STAGE(PG8_SB(1, 0), b3, voffB); PG8_STAGE(PG8_SB(1, 1), b3 + hsB, voffB); PG8_STAGE_A(PG8_SA(1, 0), a3, 0, last); \
            PG8_WAIT_V(8); PG8_WAIT_L(0); PG8_BAR; MMA_(1, 0, At, B0); MMA_(1, 1, At, B1); PG8_BAR; PG8_SCHED; \
        }
    Unit cur, nxt; int ui = 0;
    if (!S.next(0, cur)) return;
    f32x4 acc[2][2][4][2];
#pragma unroll
    for (int a = 0; a < 2; ++a)
#pragma unroll
        for (int b = 0; b < 2; ++b)
#pragma unroll
            for (int m = 0; m < 4; ++m)
#pragma unroll
                for (int n = 0; n < 2; ++n) acc[a][b][m][n] = (f32x4){0.f, 0.f, 0.f, 0.f};
    const int sc127 = 127;
    bf16x8 At[4][2], B0[2][2], B1[2][2]; v8i32_t At8[4], B08[2], B18[2];
    const char* cA; const char* cB; int nt; bool selc;
    S.ops(cur, cA, cB, nt, selc); selc = (TWO_LDA || MIXED) && selc;
    nt = __builtin_amdgcn_readfirstlane(nt); asm volatile("" : "+s"(nt));
    unsigned hsAc = selc ? hsA1 : hsA0;
    unsigned vgc0[2] = {0u, 0u}, vgc1[2] = {0u, 0u}, vgn0[2] = {0u, 0u}, vgn1[2] = {0u, 0u};
    if constexpr (GATHER) {
#pragma unroll
        for (int i = 0; i < 2; ++i) { vgc0[i] = (unsigned)(S.grow(cur, gR[i]) * lda0 + gC[i]) * 2u; vgc1[i] = (unsigned)(S.grow(cur, HALF + gR[i]) * lda0 + gC[i]) * 2u; } }
#define PG8_STAGE_A(bufoff, gbase, hf, nx) do { if constexpr (GATHER) { const unsigned v_[2] = { (nx) ? vgn##hf[0] : vgc##hf[0], (nx) ? vgn##hf[1] : vgc##hf[1] }; PG8_STAGE(bufoff, gbase, v_); } \
        else { const unsigned v_[2] = PG8_VA((nx) ? seln : selc); PG8_STAGE(bufoff, (gbase) + ((hf) ? ((nx) ? hsAn : hsAc) : 0u), v_); } } while (0)
#define PG8_VA(sel) { (TWO_LDA && (sel)) ? voffA1[0] : voffA0[0], (TWO_LDA && (sel)) ? voffA1[1] : voffA0[1] }
    { const bool seln = selc; const unsigned hsAn = hsAc;
    PG8_STAGE(PG8_SB(0, 0), cB, voffB); PG8_STAGE(PG8_SB(0, 1), cB + hsB, voffB); PG8_STAGE_A(PG8_SA(0, 0), cA, 0, false); PG8_STAGE_A(PG8_SA(0, 1), cA, 1, false);
    if (wr == 1) PG8_BAR;
    PG8_WAIT_V(2); PG8_BAR;
    PG8_STAGE(PG8_SB(1, 0), cB + kstep, voffB); PG8_STAGE_A(PG8_SA(1, 0), cA + kstep, 0, false); PG8_STAGE(PG8_SB(1, 1), cB + hsB + kstep, voffB); }
    PG8_WAIT_V(6); PG8_BAR;
    for (;;) {
        const bool has_next = S.next(ui + 1, nxt);
        const char* nA = cA; const char* nB = cB; int ntn = nt; bool seln = selc;
        if (has_next) { S.ops(nxt, nA, nB, ntn, seln); seln = (TWO_LDA || MIXED) && seln; }
        const unsigned hsAn = seln ? hsA1 : hsA0;
        if constexpr (GATHER) {
#pragma unroll
            for (int i = 0; i < 2; ++i) { vgn0[i] = has_next ? (unsigned)(S.grow(nxt, gR[i]) * lda0 + gC[i]) * 2u : vgc0[i]; vgn1[i] = has_next ? (unsigned)(S.grow(nxt, HALF + gR[i]) * lda0 + gC[i]) * 2u : vgc1[i]; } }
        if constexpr (MIXED) { if (selc) { PG8_KLOOP(PG8_LDA8, PG8_LDB8, PG8_MMA8) } else { PG8_KLOOP(PG8_LDA4, PG8_LDB4, PG8_MMA16A) } }
        else if constexpr (FP8) { PG8_KLOOP(PG8_LDA8, PG8_LDB8, PG8_MMA8) }
        else { PG8_KLOOP(PG8_LDA4, PG8_LDB4, PG8_MMAB) }
        if constexpr (ALIGN_EPI) { if (wr == 0) PG8_BAR; }
        if constexpr (FP8 || MIXED) asm volatile("s_nop 15\n\ts_nop 15" ::: "memory");
        { int t_ = tid; asm volatile("" : "+v"(t_)); const int fr_ = t_ & 15, fq_ = (t_ >> 4) & 3; E(acc, cur, wr, wc, fr_, fq_); }
        if (!has_next) break;
#pragma unroll
        for (int a = 0; a < 2; ++a)
#pragma unroll
            for (int b = 0; b < 2; ++b)
#pragma unroll
                for (int m = 0; m < 4; ++m)
#pragma unroll
                    for (int n = 0; n < 2; ++n) acc[a][b][m][n] = (f32x4){0.f, 0.f, 0.f, 0.f};
        cur = nxt; cA = nA; cB = nB; selc = seln; hsAc = hsAn; nt = ntn; ++ui;
        if constexpr (GATHER) { vgc0[0] = vgn0[0]; vgc0[1] = vgn0[1]; vgc1[0] = vgn1[0]; vgc1[1] = vgn1[1]; }
        if constexpr (ALIGN_EPI) { if (wr == 1) PG8_BAR; }
    }
    PG8_WAIT_V(0);
    if constexpr (!ALIGN_EPI) { if (wr == 0) PG8_BAR; }
    PG8_BAR;
#undef PG8_VA
#undef PG8_STAGE_A
#undef PG8_SA
#undef PG8_SB
#undef PG8_STAGE
#undef PG8_MMAB
#undef PG8_MMA8
#undef PG8_MMA16A
#undef PG8_KLOOP
#undef PG8_LDA4
#undef PG8_LDB4
#undef PG8_LDA8
#undef PG8_LDB8
#undef PG8_WAIT_V
#undef PG8_WAIT_L
#undef PG8_BAR
#undef PG8_SCHED
}
}

#include <hip/hip_bf16.h>
#include <cmath>
namespace attn_body {
using bf16=__hip_bfloat16;
using i32x8=__attribute__((ext_vector_type(8)))int;
using i32x4=__attribute__((ext_vector_type(4)))int;
using f32x16=__attribute__((ext_vector_type(16)))float;
using u32x4=__attribute__((ext_vector_type(4)))unsigned;
constexpr int BATCH=8,NHEAD=8,SEQ=8192,D=64,DM=NHEAD*D;
constexpr int Q8P=1024,O8P=4096; constexpr float OSC=64.0f;
constexpr int NW=8,QBLK=32,QB=QBLK*NW,KVBLK=64,NQB=SEQ/QB;
__device__ __forceinline__ int crow(int r,int hi){return (r&3)+8*(r>>2)+4*hi;}
#define SBAR() __builtin_amdgcn_sched_barrier(0)
constexpr int NSLOT=3, SLOTB=4096;
constexpr int LDS_K=0, LDS_V=NSLOT*SLOTB, LDS_WS=2*NSLOT*SLOTB, LDS_OST=LDS_WS+NW*64*4, LDS_BYTES=LDS_OST+NW*4096;
__device__ __forceinline__ void glds16(const void*gsrc,unsigned lds_dst){unsigned keep;
  asm volatile("s_mov_b32 %0, m0\n\ts_mov_b32 m0, %2\n\ts_nop 0\n\tglobal_load_lds_dwordx4 %1, off\n\ts_mov_b32 m0, %0":"=&s"(keep):"v"(gsrc),"s"(lds_dst):"memory");}
#define WAIT_BAR(N) asm volatile("s_waitcnt vmcnt(" #N ") lgkmcnt(0)\n\ts_barrier":::"memory")
typedef __attribute__((address_space(3))) const char* lds_cptr;
__device__ __forceinline__ i32x8 frag32(lds_cptr p){ const i32x4 a=*(const __attribute__((address_space(3))) i32x4*)(p), b=*(const __attribute__((address_space(3))) i32x4*)(p+1024); return (i32x8){a[0],a[1],a[2],a[3],b[0],b[1],b[2],b[3]}; }
#define MFMA_QK(D_,A,B,C) asm volatile("v_mfma_scale_f32_32x32x64_f8f6f4 %0, %1, %2, %3, %4, %5 op_sel_hi:[0,0,0]":"=&v"(D_):"v"(A),"v"(B),"v"(C),"v"(scA),"v"(scB))
#define MFMA_PV(D_,A,B) asm volatile("v_mfma_f32_32x32x64_f8f6f4 %0, %1, %2, %0 cbsz:1":"+v"(D_):"v"(A),"v"(B))

#ifndef ATTN_STORE16
#define ATTN_STORE16(p,v) (*(u32x4*)(p)=(v))
#endif
__device__ __forceinline__ void attn_unit(int tid_in,float negM,int b,int h,int qb,const unsigned char*Q8,const unsigned char*__restrict__ K8,const unsigned char*__restrict__ Vt8,unsigned char*O8,char*shm,const bool do_store=true){
  const int tid=tid_in,lane=tid&63,r32=lane&31,hi=lane>>5; const int wid=__builtin_amdgcn_readfirstlane(tid>>6);
  const long rowbase=(long)b*SEQ; const int q0=qb*QB; const int kvh=h>>2;
  const unsigned lds0=(unsigned)(uintptr_t)shm;
  const bool kw=wid<4;
  const int ki=lane&31, kkey=32*((ki>>2)&1)+16*(lane>>5)+(ki&3)+4*(ki>>3);
  const unsigned char*ksrc=K8+((long)(b*2+kvh)*SEQ+kkey)*64+(wid&3)*16;
  const unsigned char*vsrc=Vt8+((long)(b*2+kvh)*64+lane)*SEQ+(wid&3)*16;
  const unsigned char*dsrc=kw?ksrc:vsrc; const int dstep=kw?KVBLK*64:KVBLK;
  const unsigned ddst=lds0+(kw?LDS_K:LDS_V)+(wid&3)*1024;
  const int NT=SEQ/KVBLK;
  #define DMA(tt,slot) do{ int ti_=(tt); ti_=ti_<NT?ti_:NT-1; glds16(dsrc+(long)ti_*dstep,(unsigned)__builtin_amdgcn_readfirstlane(ddst+(slot))); }while(0)
  const lds_cptr shm3=(lds_cptr)shm; const lds_cptr kp0=shm3+LDS_K+hi*2048+r32*16; const lds_cptr vp0=shm3+LDS_V+hi*2048+r32*16;
  const unsigned char*Qw=Q8+(rowbase+q0+wid*QBLK+r32)*Q8P+h*128+hi*32;
  const i32x4 qa=*(const i32x4*)Qw, qb_=*(const i32x4*)(Qw+16);
  const i32x8 qf=(i32x8){qa[0],qa[1],qa[2],qa[3],qb_[0],qb_[1],qb_[2],qb_[3]};
  if(kw){DMA(0,0);DMA(1,SLOTB);DMA(2,2*SLOTB);}
  f32x16 o[2],ol;o[0]=f32x16{};o[1]=f32x16{};ol=f32x16{};f32x16 negm;
  #pragma unroll
  for(int r=0;r<16;++r)negm[r]=negM;
  asm volatile("":"+v"(negm));
  f32x16 pA0,pA1,pB0,pB1; i32x8 kf0,kf1,vf0,vf1,pw0=(i32x8){0,0,0,0,0,0,0,0},pw1=(i32x8){0,0,0,0,0,0,0,0};
  i32x8 ones; _Pragma("unroll") for(int r=0;r<8;++r)ones[r]=0x38383838; asm volatile("":"+v"(ones));
#ifdef ATT_CODE_EXP
  int scA=127,scB=125; asm volatile("":"+v"(scA),"+v"(scB));
#else
  int scA=127,scB=123; asm volatile("":"+v"(scA),"+v"(scB));
#endif
  int sl_cur=0,sl_next=SLOTB;
  #define ROT() do{sl_cur=sl_next;sl_next=(sl_next==(NSLOT-1)*SLOTB)?0:sl_next+SLOTB;}while(0)
  #define EX(v) __builtin_amdgcn_exp2f(v)
  #define PIN(x) asm volatile("":"+v"(x))
#ifdef ATT_CODE_EXP
  #define PACK2(P,PW,J,LO) do{ _Pragma("unroll") for(int j_=0;j_<2;++j_){ unsigned w_=(unsigned)PW[(J)+j_]; _Pragma("unroll") for(int b_=0;b_<4;++b_) w_=__builtin_amdgcn_cvt_pk_u8_f32(P[(LO)+4*j_+b_],b_,w_); PW[(J)+j_]=(int)w_; } }while(0)
  #define PACK(P,PW,J) do{ PACK2(P,PW,J,0); PACK2(P,PW,(J)+2,8); }while(0)
  #define EXPS(P,LO) do{}while(0)
  #define G1(Y0,Y1,PWN) do{ PACK2(Y0,PWN,0,0); PIN(PWN); }while(0)
  #define G2(Y0,Y1,PWN) do{ PACK2(Y0,PWN,2,8); PIN(PWN); }while(0)
  #define G3(Y0,Y1,PWN) do{ PACK2(Y1,PWN,4,0); PIN(PWN); }while(0)
  #define G4(Y0,Y1,PWN) do{ PACK2(Y1,PWN,6,8); PIN(PWN); }while(0)
  #define G5(Y0,Y1,PWN) do{}while(0)
#else
  #define PK2(P,B,OLD,HIW) __builtin_amdgcn_cvt_pk_bf8_f32(P[B],P[B+1],OLD,HIW)
  #define PACK(P,PW,J) do{ _Pragma("unroll") for(int j_=0;j_<4;++j_){ int w_=PK2(P,4*j_,PW[(J)+j_],false); w_=PK2(P,4*j_+2,w_,true); PW[(J)+j_]=w_; } }while(0)
  #define EXPS(P,LO) do{ _Pragma("unroll") for(int r_=(LO);r_<(LO)+8;++r_)P[r_]=EX(P[r_]); PIN(P); }while(0)
  #define G1(Y0,Y1,PWN) EXPS(Y0,0)
  #define G2(Y0,Y1,PWN) EXPS(Y0,8)
  #define G3(Y0,Y1,PWN) EXPS(Y1,0)
  #define G4(Y0,Y1,PWN) EXPS(Y1,8)
  #define G5(Y0,Y1,PWN) do{ PACK(Y0,PWN,0); PACK(Y1,PWN,4); PIN(PWN); }while(0)
#endif
  if(kw){asm volatile("s_waitcnt vmcnt(2)":::"memory");}else{asm volatile("s_waitcnt vmcnt(0)":::"memory");}
  asm volatile("s_barrier":::"memory");
  kf0=frag32(kp0);kf1=frag32(kp0+512);
  MFMA_QK(pA0,kf0,qf,negm);MFMA_QK(pA1,kf1,qf,negm);asm volatile("s_nop 15\n\ts_nop 7":"+v"(pA0),"+v"(pA1));
  WAIT_BAR(1);
  DMA(kw?3:0,0);
  ROT();
  kf0=frag32(kp0+sl_cur);kf1=frag32(kp0+sl_cur+512);
  WAIT_BAR(1);
  MFMA_QK(pB0,kf0,qf,negm); EXPS(pA0,0); EXPS(pA0,8); SBAR();
  MFMA_QK(pB1,kf1,qf,negm); EXPS(pA1,0); EXPS(pA1,8); SBAR();
  DMA(kw?4:1,sl_cur);
  kf0=frag32(kp0+sl_next);kf1=frag32(kp0+sl_next+512);
  PACK(pA0,pw0,0); PACK(pA1,pw0,4); PIN(pw0);
  WAIT_BAR(1); ROT();
  #define STEP(X0,X1,Y0,Y1,PWN,PWO,t) do{ SBAR(); \
    vf0=frag32(vp0+sl_next); vf1=frag32(vp0+sl_next+512); SBAR(); \
    MFMA_QK(X0,kf0,qf,negm); G1(Y0,Y1,PWN); SBAR(); \
    MFMA_QK(X1,kf1,qf,negm); G2(Y0,Y1,PWN); SBAR(); \
    DMA(kw?(t)+3:(t),sl_cur); \
    kf0=frag32(kp0+sl_next); kf1=frag32(kp0+sl_next+512); SBAR(); \
    MFMA_PV(o[0],PWO,vf0); G3(Y0,Y1,PWN); SBAR(); \
    MFMA_PV(o[1],PWO,vf1); G4(Y0,Y1,PWN); SBAR(); \
    MFMA_PV(ol,PWO,ones); G5(Y0,Y1,PWN); SBAR(); \
    }while(0)
  for(int t=2;t<NT;t+=2){
    STEP(pA0,pA1,pB0,pB1,pw1,pw0,t);     WAIT_BAR(1); ROT();
    STEP(pB0,pB1,pA0,pA1,pw0,pw1,t+1);   WAIT_BAR(1); ROT();
  }
  { vf0=frag32(vp0+sl_next); vf1=frag32(vp0+sl_next+512);
    MFMA_PV(o[0],pw0,vf0); EXPS(pB0,0); EXPS(pB0,8); SBAR();
    MFMA_PV(o[1],pw0,vf1); EXPS(pB1,0); EXPS(pB1,8); SBAR();
    DMA(NT,sl_cur);
    MFMA_PV(ol,pw0,ones); PACK(pB0,pw1,0); PACK(pB1,pw1,4); PIN(pw1);
    WAIT_BAR(1); ROT(); }
  { vf0=frag32(vp0+sl_next); vf1=frag32(vp0+sl_next+512);
    MFMA_PV(o[0],pw1,vf0); MFMA_PV(o[1],pw1,vf1); MFMA_PV(ol,pw1,ones); asm volatile("s_nop 15\n\ts_nop 7":"+v"(o[0]),"+v"(o[1]),"+v"(ol)); }
#ifndef ATT_CODE_EXP
  #undef PK2
#else
  #undef PACK2
#endif
  #undef PACK
  #undef G1
  #undef G2
  #undef G3
  #undef G4
  #undef G5
  #undef EXPS
  #undef PIN
  #undef EX
  #undef STEP
  float rli[16];
  #pragma unroll
  for(int r=0;r<16;++r)rli[r]=__builtin_amdgcn_rcpf(ol[r])*OSC;
  unsigned char*Ow=O8+(rowbase+q0+wid*QBLK)*(long)O8P+h*D;
  { unsigned char*stg=(unsigned char*)(shm+LDS_OST)+wid*2048;
    #pragma unroll
    for(int r=0;r<16;++r){const int orow=crow(r,hi);
      #pragma unroll
      for(int d0=0;d0<2;++d0){ const float v_=o[d0][r]*rli[r]; stg[orow*64+d0*32+r32]=(unsigned char)__builtin_amdgcn_cvt_pk_fp8_f32(v_,v_,0,false); } }
    asm volatile("s_waitcnt lgkmcnt(0)":::"memory");
    #pragma unroll
    for(int i=0;i<2;++i){const int idx=i*64+lane,row=idx>>2,ch=idx&3; const u32x4 v=*(const u32x4*)(stg+row*64+ch*16); if(do_store)ATTN_STORE16(Ow+(long)row*O8P+ch*16,v);} }
  asm volatile("s_waitcnt vmcnt(0) lgkmcnt(0)\n\ts_barrier":::"memory");
  #undef DMA
  #undef ROT
}
constexpr int ATTN_LDS_BYTES=LDS_BYTES;
#undef SBAR
#undef WAIT_BAR
#undef MFMA_QK
#undef MFMA_PV
}

constexpr int NWAVES = 8, NTHR = NWAVES * 64;
constexpr int BATCH = 8, SEQ = 8192, DMODEL = 1024, M = BATCH * SEQ;
constexpr int NPJ = 3328;
constexpr int COL_VL = 1920, COL_POOL = 2048, COL_Q = 2560, COL_K = 3072, COL_V = 3200;
constexpr int NEXP = 16, CAP = 1024, MR = BATCH * NEXP * CAP;
constexpr int NPROJ_IN = 6272;
constexpr float C2Q = 0.125f * 1.4426950408889634f;
constexpr int N_PHASES = 28, PH_PER_LAYER = 13;
constexpr int XBP = 2048;

constexpr size_t MiB = 1u << 20;
constexpr size_t WS_CTL = 0, CTL_ZERO_BYTES = 1 * MiB;
constexpr size_t WS_ROPE = 1 * MiB;
constexpr size_t WS_W = 3 * MiB, WL_STRIDE = 23 * MiB;
constexpr size_t WO_IN = 0, WO_G = 6656 * 1024, WO_LORA = WO_G + 6 * MiB, WO_G2 = WO_LORA + 1 * MiB, WO_PW = WO_G2 + 256 * 1024, WO_BR = WO_PW + 512 * 1024, WO_OUT = WO_BR + 6 * MiB;
constexpr size_t WO_BRA8 = WO_BR + 3 * MiB;
constexpr size_t WO_QKV8 = WO_G + 3 * MiB;
static_assert(WO_OUT + 2 * MiB <= WL_STRIDE && WO_QKV8 + 768 * 2048 <= WO_LORA, "weight map");
constexpr size_t WS_VF = 49 * MiB, WS_AFFT = 113 * MiB, WS_IDX = 117 * MiB, WS_VAL = WS_IDX + 512 * 1024, WS_INV = 118 * MiB, WS_CFB = 122 * MiB;
constexpr size_t ACT = 128 * MiB;
constexpr size_t A_PRJ = ACT, A_R = ACT + 416 * MiB, A_KS = ACT + 480 * MiB, A_VS = ACT + 544 * MiB, A_Q = ACT + 608 * MiB, A_K = ACT + 672 * MiB, A_V = ACT + 688 * MiB,
                 A_TW = ACT + 704 * MiB, A_PL = ACT + 752 * MiB, A_HN1 = ACT + 672 * MiB;
constexpr size_t A_LW = ACT, A_AA = ACT + 128 * MiB, A_G = ACT + 256 * MiB, A_YB = ACT + 320 * MiB, A_YSF = ACT + 704 * MiB, A_YSB = ACT + 768 * MiB;
constexpr size_t A_HN = ACT, A_YA = ACT + 128 * MiB, A_TS = ACT + 192 * MiB, A_MG = ACT + 416 * MiB;
constexpr size_t A_WGU = ACT + 832 * MiB, A_WD = ACT + 384 * MiB, A_XG = ACT + 416 * MiB, A_HID = ACT + 128 * MiB, A_YE = ACT + 416 * MiB;
constexpr size_t WS_END = ACT + 896 * MiB;
constexpr int CW_BAR = 4096;
constexpr int CW_ATTQ = 200000;

constexpr int RING_OFF = 0, RING_BYTES = 131072;
constexpr int LDSCTL_OFF = RING_BYTES, MISC_OFF = LDSCTL_OFF + 320;
constexpr int LDS_BYTES = 147456;

#define GAS __attribute__((address_space(1)))
#define LAS __attribute__((address_space(3)))
typedef unsigned short bf16;
typedef unsigned v4u __attribute__((ext_vector_type(4)));
typedef unsigned v2u __attribute__((ext_vector_type(2)));
typedef float f32x4 __attribute__((ext_vector_type(4)));
typedef float f32x2 __attribute__((ext_vector_type(2)));
typedef GAS unsigned gu32;
#define RLX_AGENT __ATOMIC_RELAXED, __HIP_MEMORY_SCOPE_AGENT
#define LDS_WAIT() asm volatile("s_waitcnt lgkmcnt(0)" ::: "memory")
typedef float f32x2c_t __attribute__((ext_vector_type(2))); typedef __bf16 bf16x2c_t __attribute__((ext_vector_type(2)));
__device__ __forceinline__ unsigned pk2(float lo, float hi) { const f32x2c_t v = {lo, hi}; const bf16x2c_t b = __builtin_convertvector(v, bf16x2c_t); return __builtin_bit_cast(unsigned, b); }
__device__ __forceinline__ unsigned f2bf(float f) { return pk2(f, 0.f) & 0xffffu; }
__device__ __forceinline__ void unp8(const v4u& p, float (&f)[8]) {
    f[0] = __uint_as_float(p.x << 16); f[1] = __uint_as_float(p.x & 0xffff0000u); f[2] = __uint_as_float(p.y << 16); f[3] = __uint_as_float(p.y & 0xffff0000u);
    f[4] = __uint_as_float(p.z << 16); f[5] = __uint_as_float(p.z & 0xffff0000u); f[6] = __uint_as_float(p.w << 16); f[7] = __uint_as_float(p.w & 0xffff0000u); }
__device__ __forceinline__ v4u pk8(const float (&f)[8]) { v4u o; o.x = pk2(f[0], f[1]); o.y = pk2(f[2], f[3]); o.z = pk2(f[4], f[5]); o.w = pk2(f[6], f[7]); return o; }
__device__ __forceinline__ v4u ld16(const bf16* p) { return *(const v4u*)p; }
__device__ __forceinline__ void st16(bf16* p, const v4u& v) { *(v4u*)p = v; }
__device__ __forceinline__ void ldf8(const float* p, float (&f)[8]) { const f32x4 a = *(const f32x4*)p, b = *(const f32x4*)(p + 4); f[0] = a[0]; f[1] = a[1]; f[2] = a[2]; f[3] = a[3]; f[4] = b[0]; f[5] = b[1]; f[6] = b[2]; f[7] = b[3]; }
__device__ __forceinline__ float sigmf(float x) { return __builtin_amdgcn_rcpf(1.0f + __builtin_amdgcn_exp2f(-1.4426950408889634f * x)); }
__device__ __forceinline__ float shx(float v, int m, int lane) { return __builtin_bit_cast(float, __builtin_amdgcn_ds_bpermute((lane ^ m) << 2, __builtin_bit_cast(int, v))); }
__device__ __forceinline__ float shx_from(float v, int src, int lane) { (void)lane; return __builtin_bit_cast(float, __builtin_amdgcn_ds_bpermute((src & 63) << 2, __builtin_bit_cast(int, v))); }
__device__ __forceinline__ int shxi(int v, int m, int lane) { return __builtin_amdgcn_ds_bpermute((lane ^ m) << 2, v); }
__device__ __forceinline__ int shupi(int v, int o, int lane) { return __builtin_amdgcn_ds_bpermute((lane >= o ? lane - o : lane) << 2, v); }
template <int CTRL> __device__ __forceinline__ float dppf(float v) { return __builtin_bit_cast(float, __builtin_amdgcn_update_dpp(0, __builtin_bit_cast(int, v), CTRL, 0xf, 0xf, true)); }
__device__ __forceinline__ float sum8(float v, int lane) { (void)lane; v += dppf<0xB1>(v); v += dppf<0x4E>(v); v += dppf<0x141>(v); return v; }
__device__ __forceinline__ float sum16(float v) { v += dppf<0xB1>(v); v += dppf<0x4E>(v); v += dppf<0x141>(v); v += dppf<0x140>(v); return v; }
__device__ __forceinline__ float max16(float v) { v = fmaxf(v, dppf<0xB1>(v)); v = fmaxf(v, dppf<0x4E>(v)); v = fmaxf(v, dppf<0x141>(v)); v = fmaxf(v, dppf<0x140>(v)); return v; }
__device__ __forceinline__ float sum_rows(float v) {
    { const auto r = __builtin_amdgcn_permlane16_swap(__builtin_bit_cast(unsigned, v), __builtin_bit_cast(unsigned, v), false, false); v = __uint_as_float(r[0]) + __uint_as_float(r[1]); }
    { const auto r = __builtin_amdgcn_permlane32_swap(__builtin_bit_cast(unsigned, v), __builtin_bit_cast(unsigned, v), false, false); v = __uint_as_float(r[0]) + __uint_as_float(r[1]); }
    return v; }
__device__ __forceinline__ float wave_sum(float v, int lane) { (void)lane; return sum_rows(sum16(v)); }


#define XB_TMO      128
#define XB_XCNT(j)  (256  + 64 * (j))
#define XB_XSUB(j)  (1280 + 64 * (j))
#define XB_XGEN(j)  (2304 + 64 * (j))
#define XB_TOP      3328
#define XB_TOPGEN   3392
#define XCD_BAR_WORDS 3456
#define XB_SPIN_CAP (1u << 22)

__device__ __forceinline__ unsigned xb_ld(unsigned* p)              { return __hip_atomic_load(p, __ATOMIC_RELAXED, __HIP_MEMORY_SCOPE_AGENT); }
__device__ __forceinline__ unsigned xb_add(unsigned* p, unsigned v) { return __hip_atomic_fetch_add(p, v, __ATOMIC_RELAXED, __HIP_MEMORY_SCOPE_AGENT); }
__device__ __forceinline__ unsigned xb_xcc_id() { return (unsigned)__builtin_amdgcn_s_getreg((3 << 11) | 20) & 0xFu; }
#define XB_SPIN(cond, bar) do { unsigned _sp = 0; while (cond) { __builtin_amdgcn_s_sleep(1); \
    if ((++_sp & 255u) == 0u) { if (xb_ld(&(bar)[XB_TMO])) break; if (_sp > XB_SPIN_CAP) { atomicAdd(&(bar)[XB_TMO], 1u); break; } } } } while (0)

struct XcdBarrier {
    unsigned* bar; unsigned x;
    volatile LAS unsigned* st;
};

__device__ __forceinline__ XcdBarrier xcd_barrier_post(unsigned* bar, volatile LAS unsigned* st) {
    XcdBarrier b; b.bar = bar; b.x = xb_xcc_id(); b.st = st;
    if (threadIdx.x == 0) (void)xb_add(&bar[XB_XCNT(b.x)], 1u);
    return b;
}
__device__ __forceinline__ void xcd_barrier_complete(unsigned* bar, unsigned x, unsigned& nloc, unsigned& nx) {
    const unsigned G = gridDim.x * gridDim.y * gridDim.z;
    unsigned sum, cnt, mine, sp = 0u;
    for (;;) {
        sum = 0u; cnt = 0u; mine = 0u;
#pragma unroll
        for (unsigned j = 0; j < 16; ++j) { const unsigned c = xb_ld(&bar[XB_XCNT(j)]); sum += c; cnt += (c > 0u) ? 1u : 0u; mine = (j == x) ? c : mine; }
        if (sum == G) break;
        __builtin_amdgcn_s_sleep(1);
        if ((++sp & 255u) == 0u) { if (xb_ld(&bar[XB_TMO])) break; if (sp > XB_SPIN_CAP) { atomicAdd(&bar[XB_TMO], 1u); break; } }
    }
    nloc = mine > 0u ? mine : 1u; nx = cnt > 0u ? cnt : 1u;
}

__device__ __forceinline__ void xcd_barrier(const XcdBarrier& b) {
    asm volatile("s_waitcnt vmcnt(0)" ::: "memory");
    __syncthreads();
    if (threadIdx.x == 0) {
        unsigned* bar = b.bar;
        __builtin_amdgcn_s_waitcnt(0);
        unsigned nloc = b.st[0], nx = b.st[1];
        if (nloc == 0u) { xcd_barrier_complete(bar, b.x, nloc, nx); b.st[0] = nloc; b.st[1] = nx; }
        const unsigned old = xb_add(&bar[XB_XSUB(b.x)], 1u);
        const unsigned gen = old / nloc;
        if (old + 1u == (gen + 1u) * nloc) {
            __builtin_amdgcn_fence(__ATOMIC_RELEASE, "agent");
            asm volatile("s_waitcnt vmcnt(0)" ::: "memory");
            const unsigned og = xb_add(&bar[XB_TOP], 1u);
            const unsigned tg = og / nx;
            if (og + 1u == (tg + 1u) * nx) xb_add(&bar[XB_TOPGEN], 1u);
            else XB_SPIN(xb_ld(&bar[XB_TOPGEN]) == tg, bar);
            __builtin_amdgcn_fence(__ATOMIC_ACQUIRE, "agent");
            xb_add(&bar[XB_XGEN(b.x)], 1u);
            asm volatile("s_waitcnt vmcnt(0)" ::: "memory");
        } else {
            XB_SPIN(xb_ld(&bar[XB_XGEN(b.x)]) == gen, bar);
            __builtin_amdgcn_fence(__ATOMIC_ACQUIRE, "agent");
            asm volatile("s_waitcnt vmcnt(0)" ::: "memory");
        }
    }
    __syncthreads();
}

__device__ __forceinline__ void tr_item(const float* W, int src_ld, int k0, int n0, bf16* WT, int dst_ld, int dst_row0, LAS float* scr, int lane, float sc = 1.0f) {
    float t_[32];
#pragma unroll
    for (int i = 0; i < 32; ++i) t_[i] = W[(size_t)(k0 + 2 * i + (lane >> 5)) * src_ld + n0 + (lane & 31)];
#pragma unroll
    for (int i = 0; i < 32; ++i) scr[(2 * i + (lane >> 5)) * 33 + (lane & 31)] = t_[i] * sc;
    LDS_WAIT(); asm volatile("" ::: "memory");
    const int c = lane & 7;
#pragma unroll
    for (int j = 0; j < 4; ++j) { const int n = (lane >> 3) + 8 * j; const LAS float* s = scr + (8 * c) * 33 + n;
        v4u o; o.x = pk2(s[0 * 33], s[1 * 33]); o.y = pk2(s[2 * 33], s[3 * 33]); o.z = pk2(s[4 * 33], s[5 * 33]); o.w = pk2(s[6 * 33], s[7 * 33]);
        *(GAS v4u*)(WT + (size_t)(dst_row0 + n) * dst_ld + k0 + 8 * c) = o; }
    LDS_WAIT(); asm volatile("" ::: "memory");
}
__device__ __forceinline__ void tr_item8(const float* W, int src_ld, int k0, int n0, unsigned char* WT8, int dst_ld, int dst_row0, float sc, LAS float* scr, int lane) {
    float t_[32];
#pragma unroll
    for (int i = 0; i < 32; ++i) t_[i] = W[(size_t)(k0 + 2 * i + (lane >> 5)) * src_ld + n0 + (lane & 31)];
#pragma unroll
    for (int i = 0; i < 32; ++i) scr[(2 * i + (lane >> 5)) * 33 + (lane & 31)] = t_[i] * sc;
    LDS_WAIT(); asm volatile("" ::: "memory");
#pragma unroll
    for (int j = 0; j < 2; ++j) { const int q = lane + 64 * j, n = q >> 2, c = q & 3; const LAS float* s = scr + (16 * c) * 33 + n; v4u o;
        o.x = pg8::pk4_fp8(s[0 * 33], s[1 * 33], s[2 * 33], s[3 * 33]); o.y = pg8::pk4_fp8(s[4 * 33], s[5 * 33], s[6 * 33], s[7 * 33]);
        o.z = pg8::pk4_fp8(s[8 * 33], s[9 * 33], s[10 * 33], s[11 * 33]); o.w = pg8::pk4_fp8(s[12 * 33], s[13 * 33], s[14 * 33], s[15 * 33]);
        *(GAS v4u*)(WT8 + (size_t)(dst_row0 + n) * dst_ld + k0 + 16 * c) = o; }
    LDS_WAIT(); asm volatile("" ::: "memory");
}
__device__ __forceinline__ void tr_job(const float* W, int src_ld, int col0, int K, int ncols, bf16* WT, int dst_ld, int dst_row0, LAS float* scr, int gw, int NGW, int lane, float sc = 1.0f) {
    const int nblk = ncols / 32, nitems = (K / 64) * nblk;
    for (int it = gw; it < nitems; it += NGW) { const int kb = it / nblk, nb = it - kb * nblk; tr_item(W, src_ld, 64 * kb, col0 + 32 * nb, WT, dst_ld, dst_row0 + 32 * nb, scr, lane, sc); }
}
__device__ __forceinline__ void zero_rows(bf16* WT, int row0, int nrows, int ld, int gtid, int NGT) {
    const int per = ld / 8, n = nrows * per;
    for (int i = gtid; i < n; i += NGT) *(GAS v4u*)(WT + (size_t)(row0 + i / per) * ld + (i % per) * 8) = (v4u){0u, 0u, 0u, 0u};
}

__device__ __forceinline__ void p0_prologue(const float* const* in, unsigned char* ws, LAS unsigned char* lds, int vcu, int G, int tid, int wave, int lane) {
    LAS float* scr = (LAS float*)(lds + RING_OFF + wave * 16384);
    const int gw = vcu * NWAVES + wave, NGW = G * NWAVES, gtid = vcu * NTHR + tid, NGT = G * NTHR;
    { f32x2* rope = (f32x2*)(ws + WS_ROPE);
      for (int i = gtid; i < SEQ * 32; i += NGT) { const int s = i >> 5, p = i & 31, fi = p & 15; const float freq = exp2f(-(float)(2 * fi) * (13.287712379549449f / 32.0f));
          const float pos = (p < 16) ? (float)(s >> 6) : (float)(s & 63); float sn, cs; sincosf(pos * freq, &sn, &cs); rope[i] = (f32x2){cs, sn}; } }
    for (int l = 0; l < 2; ++l) {
        unsigned char* wl = ws + WS_W + (size_t)l * WL_STRIDE;
        const float* w_in = in[2] + (size_t)l * DMODEL * NPROJ_IN;
        bf16* Win_t = (bf16*)(wl + WO_IN); bf16* Wg_t = (bf16*)(wl + WO_G); bf16* Wlo_t = (bf16*)(wl + WO_LORA); bf16* Wg2_t = (bf16*)(wl + WO_G2); bf16* PW_t = (bf16*)(wl + WO_PW);
        bf16* Wbr_t = (bf16*)(wl + WO_BR); bf16* Wout_t = (bf16*)(wl + WO_OUT);
        tr_job(w_in, NPROJ_IN, 0, DMODEL, 1920, Win_t, DMODEL, 0, scr, gw, NGW, lane);
        tr_job(w_in, NPROJ_IN, 1920, DMODEL, 512, Win_t, DMODEL, COL_POOL, scr, gw, NGW, lane);
        { const int nblk = 768 / 32, nitems = (DMODEL / 64) * nblk; unsigned char* Wq8 = wl + WO_QKV8;
          for (int it = gw; it < nitems; it += NGW) { const int kb = it / nblk, nb = it - kb * nblk; tr_item8(w_in, NPROJ_IN, 64 * kb, 2432 + 32 * nb, Wq8, 2048, 32 * nb, 32.0f, scr, lane); } }
        { const int nblk = 3072 / 32, nitems = (DMODEL / 64) * nblk;
          for (int it = gw; it < nitems; it += NGW) { const int kb = it / nblk, nb = it - kb * nblk; tr_item8(w_in, NPROJ_IN, 64 * kb, 3200 + 32 * nb, (unsigned char*)Wg_t, DMODEL, 32 * nb, 32.0f, scr, lane); } }
        if (l == 0) zero_rows(Win_t, 1920, 128, DMODEL, gtid, NGT);
        else { tr_job(in[16], 32, 0, DMODEL, 32, Win_t, DMODEL, COL_VL, scr, gw, NGW, lane); zero_rows(Win_t, 1952, 96, DMODEL, gtid, NGT); }
        tr_job(in[22] + (size_t)l * 512 * 1024, 1024, 0, 512, 1024, Wbr_t, 512, 0, scr, gw, NGW, lane);
        tr_job(in[23] + (size_t)l * 512 * 1024, 1024, 0, 512, 1024, Wbr_t, 512, 1024, scr, gw, NGW, lane);
        #ifndef PROBE_ATT_AMP
#define PROBE_ATT_AMP 1.0f
#endif
        { const float* wa = in[24] + (size_t)l * 512 * 1024; unsigned char* Wa8 = wl + WO_BRA8;
          const int nblk = 1024 / 32, nitems = (512 / 64) * nblk;
          for (int it = gw; it < nitems; it += NGW) { const int kb = it / nblk, nb = it - kb * nblk; tr_item8(wa, 1024, 64 * kb, 32 * nb, Wa8, 1024, 32 * nb, 32.0f, scr, lane); } }
        tr_job(in[25] + (size_t)l * 1024 * 1024, 1024, 0, 1024, 1024, Wout_t, 1024, 0, scr, gw, NGW, lane);
        { const float* w2 = in[6] + (size_t)l * 2 * 64 * 512; const float* a2 = in[8] + (size_t)l * 2 * 64 * 512;
          for (int i = gtid; i < 2048 * 16; i += NGT) { const int n = i >> 4, k0 = (i & 15) * 8; const bool isa = n >= 1024; const int nn = n & 1023, dir = nn >> 9, c = nn & 511, kb = 64 * dir;
              float f[8];
#pragma unroll
              for (int j = 0; j < 8; ++j) { const int k = k0 + j; f[j] = (k >= kb && k < kb + 64) ? (isa ? a2 : w2)[((size_t)dir * 64 + (k - kb)) * 512 + c] : 0.f; }
              *(GAS v4u*)(Wlo_t + (size_t)n * 128 + k0) = pk8(f); } }
        { const float* g2 = in[9] + (size_t)l * 128 * 512;
          for (int i = gtid; i < 512 * 16; i += NGT) { const int n = i >> 4, k0 = (i & 15) * 8; float f[8];
#pragma unroll
              for (int j = 0; j < 8; ++j) f[j] = g2[(size_t)(k0 + j) * 512 + n];
              *(GAS v4u*)(Wg2_t + (size_t)n * 128 + k0) = pk8(f); } }
        { const float* pw = in[18] + (size_t)l * 4 * 128 * 128;
          for (int i = gtid; i < 512 * 64; i += NGT) { const int n = i >> 6, k0 = (i & 63) * 8, g = n >> 7, d = n & 127; float f[8];
#pragma unroll
              for (int j = 0; j < 8; ++j) { const int k = k0 + j; f[j] = ((k >> 7) == g) ? pw[((size_t)g * 128 + (k & 127)) * 128 + d] : 0.f; }
              *(GAS v4u*)(PW_t + (size_t)n * 512 + k0) = pk8(f); } }
    }
}
__device__ __forceinline__ void convert_experts_items(const float* const* in, int l, unsigned char* ws, LAS unsigned char* lds, int it0, int nit, int wave, int lane) {
    LAS float* scr = (LAS float*)(lds + RING_OFF + wave * 16384);
    bf16* Wgu = (bf16*)(ws + A_WGU); bf16* Wd = (bf16*)(ws + A_WD);
    const float* eg = in[28] + (size_t)l * NEXP * 1024 * 1024; const float* eu = in[29] + (size_t)l * NEXP * 1024 * 1024; const float* ed = in[30] + (size_t)l * NEXP * 1024 * 1024;
    for (int it = it0 + wave; it < it0 + nit; it += NWAVES) {
        const int mat = it / (NEXP * 512), r = it - mat * (NEXP * 512), e = r >> 9, q = r & 511, kb = q >> 5, nb = q & 31, n0 = 32 * nb;
        if (mat == 0)      tr_item8(eg + (size_t)e * 1024 * 1024, 1024, 64 * kb, n0, (unsigned char*)Wgu, 1024, e * 2048 + (n0 >> 7) * 256 + (n0 & 127), 32.0f, scr, lane);
        else if (mat == 1) tr_item8(eu + (size_t)e * 1024 * 1024, 1024, 64 * kb, n0, (unsigned char*)Wgu, 1024, e * 2048 + (n0 >> 7) * 256 + 128 + (n0 & 127), 32.0f, scr, lane);
        else               tr_item8(ed + (size_t)e * 1024 * 1024, 1024, 64 * kb, n0, (unsigned char*)Wd, 1024, e * 1024 + n0, 32.0f, scr, lane);
    }
}

template <int MODE, bool XB = false, int NR = 2>
__device__ __forceinline__ void norm_rows(const float* xsrc, float* xdst, bool combine, const bf16* YE, const int* INV, const float* gain, bf16* obf, float* of32, int gw, int NGW, int lane, unsigned char* o8 = nullptr) {
    f32x4 g[4];
#pragma unroll
    for (int j = 0; j < 4; ++j) g[j] = *(const f32x4*)(gain + 4 * lane + 256 * j);
    for (int t0 = gw; t0 < M; t0 += NR * NGW) {
        f32x4 v[NR][4]; int inv[NR];
#pragma unroll
        for (int q = 0; q < NR; ++q) { const int t = t0 + q * NGW;
            if (XB) { const v2u* xr = (const v2u*)((const bf16*)xsrc + (size_t)t * XBP) + lane;
#pragma unroll
                for (int j = 0; j < 4; ++j) { const v2u w = xr[64 * j]; v[q][j] = (f32x4){__uint_as_float(w.x << 16), __uint_as_float(w.x & 0xffff0000u), __uint_as_float(w.y << 16), __uint_as_float(w.y & 0xffff0000u)}; } }
            else { const f32x4* xr = (const f32x4*)(xsrc + (size_t)t * DMODEL) + lane;
#pragma unroll
                for (int j = 0; j < 4; ++j) v[q][j] = xr[64 * j]; }
            inv[q] = (combine && lane < NEXP) ? INV[(size_t)t * NEXP + lane] : -1; }
#pragma unroll
        for (int q = 0; q < NR; ++q) { const int t = t0 + q * NGW;
            if (combine) {
                const int b = t / SEQ;
#pragma unroll
                for (int e_unused = 0; e_unused < 1; ++e_unused) {
                    unsigned mk = (unsigned)(__builtin_amdgcn_ballot_w64(inv[q] >= 0) & 0xffffull);
                    while (mk) { int es[4]; v2u w[4][4];
#pragma unroll
                        for (int u = 0; u < 4; ++u) { es[u] = mk ? (int)__builtin_ctz(mk) : -1; mk = mk ? (mk & (mk - 1u)) : 0u; }
#pragma unroll
                        for (int u = 0; u < 4; ++u) if (es[u] >= 0) { const int c = __builtin_amdgcn_readlane(inv[q], es[u]); const bf16* yr = YE + ((size_t)((b * NEXP + es[u]) * CAP + c)) * DMODEL + 4 * lane;
#pragma unroll
                            for (int j = 0; j < 4; ++j) w[u][j] = *(const v2u*)(yr + 256 * j); }
#pragma unroll
                        for (int u = 0; u < 4; ++u) if (es[u] >= 0) {
#pragma unroll
                            for (int j = 0; j < 4; ++j) { v[q][j][0] += __uint_as_float(w[u][j].x << 16); v[q][j][1] += __uint_as_float(w[u][j].x & 0xffff0000u); v[q][j][2] += __uint_as_float(w[u][j].y << 16); v[q][j][3] += __uint_as_float(w[u][j].y & 0xffff0000u); } } } }
                if (xdst) {
                    if (XB) { v2u* xw = (v2u*)((bf16*)xdst + (size_t)t * XBP) + lane;
#pragma unroll
                        for (int j = 0; j < 4; ++j) xw[64 * j] = (v2u){pk2(v[q][j][0], v[q][j][1]), pk2(v[q][j][2], v[q][j][3])}; }
                    else { f32x4* xw = (f32x4*)(xdst + (size_t)t * DMODEL) + lane;
#pragma unroll
                        for (int j = 0; j < 4; ++j) xw[64 * j] = v[q][j]; } }
            }
            float ss = 0.f;
#pragma unroll
            for (int j = 0; j < 4; ++j) ss += (v[q][j][0] * v[q][j][0] + v[q][j][1] * v[q][j][1]) + (v[q][j][2] * v[q][j][2] + v[q][j][3] * v[q][j][3]);
            const float rstd = __builtin_amdgcn_rsqf(wave_sum(ss, lane) * (1.0f / DMODEL) + 1e-6f);
            if (MODE == 2) { unsigned* o4 = (unsigned*)((unsigned char*)obf + (size_t)t * DMODEL) + lane;
#pragma unroll
                for (int j = 0; j < 4; ++j) { const f32x4 o = v[q][j] * rstd * g[j]; o4[64 * j] = pg8::pk4_fp8(o[0], o[1], o[2], o[3]); } }
            else if (MODE == 0) { v2u* ob_ = (v2u*)(obf + (size_t)t * DMODEL) + lane;
#pragma unroll
                for (int j = 0; j < 4; ++j) { const f32x4 o = v[q][j] * rstd * g[j]; ob_[64 * j] = (v2u){pk2(o[0], o[1]), pk2(o[2], o[3])}; }
                if (o8) { unsigned* e4 = (unsigned*)(o8 + (size_t)t * 4096) + lane;
#pragma unroll
                    for (int j = 0; j < 4; ++j) { const f32x4 o = v[q][j] * rstd * g[j]; e4[64 * j] = pg8::pk4_fp8(o[0], o[1], o[2], o[3]); } } }
            else { f32x4* o4 = (f32x4*)(of32 + (size_t)t * DMODEL) + lane;
#pragma unroll
                for (int j = 0; j < 4; ++j) o4[64 * j] = v[q][j] * rstd * g[j]; }
        }
    }
}

__device__ __forceinline__ v2u pk8_e4m3(const float (&f)[8]) { v2u o; o.x = pg8::pk4_fp8(f[0], f[1], f[2], f[3]); o.y = pg8::pk4_fp8(f[4], f[5], f[6], f[7]); return o; }
__device__ __forceinline__ void p3_prep(int l, const float* const* in, unsigned char* ws, LAS unsigned char* lds, int gw, int NGW, int tid, int lane) {
    const bf16* PRJ = (const bf16*)(ws + A_PRJ);
    bf16* R = (bf16*)(ws + A_R); bf16* KS = (bf16*)(ws + A_KS); bf16* VS = (bf16*)(ws + A_VS); bf16* VF = (bf16*)(ws + WS_VF); bf16* TW = (bf16*)(ws + A_TW); bf16* PL = (bf16*)(ws + A_PL);
    unsigned char* Q8 = ws + A_Q; unsigned char* K8 = ws + A_K; unsigned char* Vt8 = ws + A_V;
    const f32x2* rope = (const f32x2*)(ws + WS_ROPE);
    LAS float* v2L = (LAS float*)(lds + RING_OFF);
    LAS float* mpL = (LAS float*)(lds + RING_OFF + 65536); LAS float* mnL = mpL + 1920;
    if (l == 1) { for (int i = tid; i < 32 * 512; i += NTHR) v2L[i] = in[17][i]; }
    LAS float* gqL = mnL + 1920; LAS float* gkL = gqL + 64; LAS float* v0L = gkL + 64;
    for (int i = tid; i < 1920; i += NTHR) { mpL[i] = in[3][(size_t)l * 1920 + i]; mnL[i] = in[4][(size_t)l * 1920 + i]; }
    if (tid < 64) { gqL[tid] = in[20][(size_t)l * 64 + tid]; gkL[tid] = in[21][(size_t)l * 64 + tid]; }
    v0L[tid] = in[15][tid];
    __syncthreads();
    const int gi = lane >> 4, lo = 1 << gi, hi = lo - 1, pcol = COL_POOL + lane * 8;
    const float tw_k = (lane < 16) ? -2.0f * 1.4426950408889634f : -1.4426950408889634f, tw_m = (lane < 16) ? 2.0f : 1.0f, tw_c = (lane < 16) ? -1.0f : 0.0f; const bool tw_id = (lane >= 16 && lane < 32);
#define P3_LD(base, boff) (*(const v4u*)((const unsigned char*)(base) + (boff)))
#define P3_ST(base, boff, val) (*(v4u*)((unsigned char*)(base) + (boff)) = (val))
    const unsigned ob_nxt0 = (unsigned)((17 * NPJ + lane * 8) * 2), ob_nxt3 = (unsigned)((17 * NPJ + (lane < 48 ? (lane + 192) * 8 : 0)) * 2);
    const unsigned ob_self = (unsigned)((16 * NPJ + pcol) * 2), ob_in = (unsigned)(((17 + hi) * NPJ + pcol) * 2), ob_out = (unsigned)(((16 - lo) * NPJ + pcol) * 2);
    const unsigned ob_q = (unsigned)((16 * NPJ + COL_Q + lane * 8) * 2), ob_k = (unsigned)((16 * NPJ + COL_K + (lane & 15) * 8) * 2), ob_rope = (unsigned)((lane & 7) * 32), ob_l16 = (unsigned)(lane * 16);
    const unsigned ob_q8 = (unsigned)((lane >> 3) * 128 + (lane & 7) * 8), ob_k8 = (unsigned)(((lane >> 3) & 1) * SEQ * 64 + (lane & 7) * 8);
    for (int run = gw; run < M / 32; run += NGW) {
        const int t0 = run * 32, s0 = t0 & (SEQ - 1);
        const bf16* row0 = PRJ + (size_t)t0 * NPJ;
        { unsigned char* vrow = Vt8 + ((size_t)((t0 >> 13) * 2 + (lane >> 5)) * 64 + 2 * (lane & 31)) * SEQ + s0;
#pragma unroll
          for (int hf = 0; hf < 2; ++hf) { unsigned w[16];
#pragma unroll
              for (int i = 0; i < 16; ++i) w[i] = *(const unsigned*)(row0 + (size_t)(hf * 16 + i) * NPJ + COL_V + 2 * lane);
              v4u a, b_;
#pragma unroll
              for (int j = 0; j < 4; ++j) {
                  a[j] = pg8::pk4_fp8(__uint_as_float(w[4 * j] << 16), __uint_as_float(w[4 * j + 1] << 16), __uint_as_float(w[4 * j + 2] << 16), __uint_as_float(w[4 * j + 3] << 16));
                  b_[j] = pg8::pk4_fp8(__uint_as_float(w[4 * j] & 0xffff0000u), __uint_as_float(w[4 * j + 1] & 0xffff0000u), __uint_as_float(w[4 * j + 2] & 0xffff0000u), __uint_as_float(w[4 * j + 3] & 0xffff0000u)); }
              *(v4u*)(vrow + hf * 16) = a; *(v4u*)(vrow + SEQ + hf * 16) = b_; } }
        v4u prv[4], cur[4];
#pragma unroll
        for (int j = 0; j < 4; ++j) { const int c8 = lane + 64 * j, col = (c8 < 240 ? c8 : 0) * 8;
            prv[j] = (s0 > 0) ? ld16(row0 - NPJ + col) : (v4u){0u, 0u, 0u, 0u}; cur[j] = ld16(row0 + col); }
        float psum[8]; int pcnt = 0;
#pragma unroll
        for (int i = 0; i < 8; ++i) psum[i] = 0.f;
#pragma unroll
        for (int hf = 0; hf < 2; ++hf) { v4u pw_[8];
#pragma unroll
            for (int q = 0; q < 8; ++q) { const int dd = hf * 8 + q - 8; const bool ok = (dd >= -lo && dd <= hi && s0 + dd >= 0); pw_[q] = ld16(row0 + (long)(ok ? dd : 0) * NPJ + pcol); }
#pragma unroll
            for (int q = 0; q < 8; ++q) asm volatile("" : "+v"(pw_[q]));
#pragma unroll
            for (int q = 0; q < 8; ++q) { const int dd = hf * 8 + q - 8; const bool ok = (dd >= -lo && dd <= hi && s0 + dd >= 0); float x[8]; unp8(pw_[q], x); const float m_ = ok ? 1.0f : 0.0f; pcnt += ok ? 1 : 0;
#pragma unroll
                for (int i = 0; i < 8; ++i) psum[i] += m_ * x[i]; } }
        for (int ti = 0; ti < 32; ++ti) {
            const int t = t0 + ti, s = s0 + ti; const bf16* rowp = row0 + (size_t)ti * NPJ;
            v4u nxt[4];
            const bf16* rowq = rowp - 16 * NPJ;
#pragma unroll
            for (int j = 0; j < 4; ++j) nxt[j] = (s + 1 < SEQ) ? (j < 3 ? P3_LD(rowq + 512 * j, ob_nxt0) : P3_LD(rowq, ob_nxt3)) : (v4u){0u, 0u, 0u, 0u};
            const v4u pself = P3_LD(rowq, ob_self);
            const bool padd = (s + 1 + hi < SEQ), psub = (s - lo >= 0);
            const v4u pin = padd ? P3_LD(rowq, ob_in) : (v4u){0u, 0u, 0u, 0u};
            const v4u pout = psub ? P3_LD(rowq, ob_out) : (v4u){0u, 0u, 0u, 0u};
            const v4u qraw = P3_LD(rowq, ob_q), kraw = P3_LD(rowq, ob_k);
            const unsigned char* ropes = (const unsigned char*)(rope + (size_t)s * 32); const f32x4 rp0 = *(const f32x4*)(ropes + ob_rope), rp1 = *(const f32x4*)(ropes + ob_rope + 16);
            { float self[8], o[8]; unp8(pself, self); const float ic = __builtin_amdgcn_rcpf((float)pcnt);
#pragma unroll
              for (int i = 0; i < 8; ++i) o[i] = psum[i] * ic - self[i];
              P3_ST(PL + (size_t)t * 512, ob_l16, pk8(o));
              float xin[8], xout[8]; unp8(pin, xin); unp8(pout, xout);
#pragma unroll
              for (int i = 0; i < 8; ++i) psum[i] += xin[i] - xout[i];
              pcnt += (padd ? 1 : 0) - (psub ? 1 : 0); }
            { float x[8], o[8]; const float cs[8] = {rp0[0], rp0[1], rp0[2], rp0[3], rp1[0], rp1[1], rp1[2], rp1[3]};
              unp8(qraw, x);
              float ss = 0.f;
#pragma unroll
              for (int i = 0; i < 8; ++i) ss += x[i] * x[i];
              ss = sum8(ss, lane); const float rms = __builtin_amdgcn_rsqf(ss * (1.0f / 64.0f) + 1e-6f);
#pragma unroll
              for (int i = 0; i < 8; ++i) x[i] = x[i] * rms * gqL[(lane & 7) * 8 + i];
#pragma unroll
              for (int ii = 0; ii < 4; ++ii) { o[2 * ii] = (x[2 * ii] * cs[2 * ii] - x[2 * ii + 1] * cs[2 * ii + 1]) * (C2Q * 16.0f); o[2 * ii + 1] = (x[2 * ii] * cs[2 * ii + 1] + x[2 * ii + 1] * cs[2 * ii]) * (C2Q * 16.0f); }
              *(v2u*)(Q8 + (size_t)t * 1024 + ob_q8) = pk8_e4m3(o);
              unp8(kraw, x);
              ss = 0.f;
#pragma unroll
              for (int i = 0; i < 8; ++i) ss += x[i] * x[i];
              ss = sum8(ss, lane); const float rmk = __builtin_amdgcn_rsqf(ss * (1.0f / 64.0f) + 1e-6f);
#pragma unroll
              for (int i = 0; i < 8; ++i) x[i] = x[i] * rmk * gkL[(lane & 7) * 8 + i];
#pragma unroll
              for (int ii = 0; ii < 4; ++ii) { o[2 * ii] = x[2 * ii] * cs[2 * ii] - x[2 * ii + 1] * cs[2 * ii + 1]; o[2 * ii + 1] = x[2 * ii] * cs[2 * ii + 1] + x[2 * ii + 1] * cs[2 * ii]; }
              if (lane < 16) *(v2u*)(K8 + ((size_t)((t >> 13) * 2) * SEQ + s) * 64 + ob_k8) = pk8_e4m3(o); }
            asm volatile("" ::: "memory");
#pragma unroll
            for (int j = 0; j < 4; ++j) {
                const int c8 = lane + 64 * j, col = c8 * 8;
                if (c8 < 240) {
                    float cu[8], pv[8], nx[8], ps[8];
                    unp8(cur[j], cu); unp8(prv[j], pv); unp8(nxt[j], nx);
                    float a_[8], b_[8]; { const f32x4 m0 = *(const LAS f32x4*)(mpL + col), m1 = *(const LAS f32x4*)(mpL + col + 4), n0 = *(const LAS f32x4*)(mnL + col), n1 = *(const LAS f32x4*)(mnL + col + 4);
                        a_[0] = m0[0]; a_[1] = m0[1]; a_[2] = m0[2]; a_[3] = m0[3]; a_[4] = m1[0]; a_[5] = m1[1]; a_[6] = m1[2]; a_[7] = m1[3]; b_[0] = n0[0]; b_[1] = n0[1]; b_[2] = n0[2]; b_[3] = n0[3]; b_[4] = n1[0]; b_[5] = n1[1]; b_[6] = n1[2]; b_[7] = n1[3]; }
#pragma unroll
                    for (int i = 0; i < 8; ++i) ps[i] = cu[i] + a_[i] * (pv[i] - cu[i]) + b_[i] * (nx[i] - cu[i]);
                    if (j == 0) P3_ST(R + (size_t)t * 512, ob_l16, pk8(ps));
                    else if (j == 1) P3_ST(KS + (size_t)t * 512, ob_l16, pk8(ps));
                    else if (j == 2) { const int cc = col - 1024;
                        if (l == 0) { const v4u o = pk8(ps); P3_ST(VS + (size_t)t * 512, ob_l16, o); P3_ST(VF + (size_t)t * 512, ob_l16, o); }
                        else { float vl[32], mx[8], vf[8];
                            { float t8[8]; unp8(ld16(rowp + COL_VL), t8);
#pragma unroll
                              for (int i = 0; i < 8; ++i) vl[i] = t8[i];
                              unp8(ld16(rowp + COL_VL + 8), t8);
#pragma unroll
                              for (int i = 0; i < 8; ++i) vl[8 + i] = t8[i];
                              unp8(ld16(rowp + COL_VL + 16), t8);
#pragma unroll
                              for (int i = 0; i < 8; ++i) vl[16 + i] = t8[i];
                              unp8(ld16(rowp + COL_VL + 24), t8);
#pragma unroll
                              for (int i = 0; i < 8; ++i) vl[24 + i] = t8[i]; }
                            { const f32x4 z0 = *(const LAS f32x4*)(v0L + cc), z1 = *(const LAS f32x4*)(v0L + cc + 4); mx[0] = z0[0]; mx[1] = z0[1]; mx[2] = z0[2]; mx[3] = z0[3]; mx[4] = z1[0]; mx[5] = z1[1]; mx[6] = z1[2]; mx[7] = z1[3]; }
#pragma unroll
                            for (int k = 0; k < 32; ++k) { const f32x4 w0 = *(const LAS f32x4*)(v2L + k * 512 + cc), w1 = *(const LAS f32x4*)(v2L + k * 512 + cc + 4);
                                mx[0] += vl[k] * w0[0]; mx[1] += vl[k] * w0[1]; mx[2] += vl[k] * w0[2]; mx[3] += vl[k] * w0[3]; mx[4] += vl[k] * w1[0]; mx[5] += vl[k] * w1[1]; mx[6] += vl[k] * w1[2]; mx[7] += vl[k] * w1[3]; }
                            unp8(P3_LD(VF + (size_t)t * 512, ob_l16), vf);
#pragma unroll
                            for (int i = 0; i < 8; ++i) ps[i] = ps[i] + (vf[i] - ps[i]) * sigmf(mx[i]);
                            P3_ST(VS + (size_t)t * 512, ob_l16, pk8(ps)); } }
                    else { float o[8];
#pragma unroll
                        for (int i = 0; i < 8; ++i) { const float x = ps[i];
                            const float sg = __builtin_amdgcn_rcpf(1.0f + __builtin_amdgcn_exp2f(tw_k * __builtin_amdgcn_fmed3f(x, -15.f, 15.f)));
                            const float y = tw_m * sg + tw_c; o[i] = tw_id ? x : y; }
                        P3_ST(TW + (size_t)t * 384, ob_l16, pk8(o)); }
                }
                prv[j] = cur[j]; cur[j] = nxt[j];
            }
        }
    }
#undef P3_LD
#undef P3_ST
}

__device__ __forceinline__ float dpp_add(float x, float y) { return x + y; }
template <int CTRL> __device__ __forceinline__ float dppx(float x) { return __builtin_bit_cast(float, __builtin_amdgcn_update_dpp(0, __builtin_bit_cast(int, x), CTRL, 0xF, 0xF, true)); }
__device__ __forceinline__ float red16(float x) {
    x += dppx<0xB1>(x);
    x += dppx<0x4E>(x);
    x += dppx<0x141>(x);
    x += dppx<0x140>(x);
    return x;
}
__device__ __forceinline__ void scan_chain(int l, int chain, const float* const* in, unsigned char* ws, LAS unsigned char* lds, int tid, int wave, int lane) {
    const int d = chain >> 6, b = (chain >> 3) & 7, h = chain & 7;
    const bf16* R = (const bf16*)(ws + A_R); const bf16* KS = (const bf16*)(ws + A_KS); const bf16* VS = (const bf16*)(ws + A_VS);
    const bf16* LW = (const bf16*)(ws + A_LW); const bf16* AA = (const bf16*)(ws + A_AA);
    bf16* YS = (bf16*)(ws + (d ? A_YSB : A_YSF)); float* CFB = (float*)(ws + WS_CFB) + (size_t)d * M * 8;
    LAS float* kkL = (LAS float*)(lds + RING_OFF); LAS float* wL = kkL + 4096; LAS float* nbL = wL + 4096; LAS float* kdL = nbL + 4096; LAS float* rL = kdL + 4096; LAS float* vL = rL + 4096; LAS float* yL = vL + 4096;
    const int ps = tid >> 3, pc = tid & 7;
    const int pl = lane >> 4, jg = lane & 15, i0 = 2 * (4 * wave + pl);
    float kkc[8], kac[8], rkc[8];
    ldf8(in[10] + (size_t)l * 512 + h * 64 + pc * 8, kkc); ldf8(in[11] + (size_t)l * 512 + h * 64 + pc * 8, kac); ldf8(in[12] + (size_t)l * 512 + h * 64 + pc * 8, rkc);
    float st[2][4];
#pragma unroll
    for (int r = 0; r < 2; ++r)
#pragma unroll
        for (int j = 0; j < 4; ++j) st[r][j] = 0.f;
    v4u rr, kr, vr, lwr, ar;
    { const int tok = d ? (SEQ - 1 - ps) : ps; const size_t t = (size_t)b * SEQ + tok;
      rr = ld16(R + t * 512 + h * 64 + pc * 8); kr = ld16(KS + t * 512 + h * 64 + pc * 8); vr = ld16(VS + t * 512 + h * 64 + pc * 8);
      lwr = ld16(LW + t * 1024 + d * 512 + h * 64 + pc * 8); ar = ld16(AA + t * 1024 + d * 512 + h * 64 + pc * 8); }
    for (int blk = 0; blk < SEQ / 64; ++blk) {
        const int tokp = d ? (SEQ - 1 - (blk * 64 + ps)) : (blk * 64 + ps); const size_t tp = (size_t)b * SEQ + tokp;
        { float r8[8], k8[8], v8[8], lw8[8], a8[8], kk8[8], o[8];
          unp8(rr, r8); unp8(kr, k8); unp8(vr, v8); unp8(lwr, lw8); unp8(ar, a8);
          float ss = 0.f;
#pragma unroll
          for (int i = 0; i < 8; ++i) { kk8[i] = k8[i] * kkc[i]; ss += kk8[i] * kk8[i]; }
          ss = sum8(ss, lane); const float inv = 1.0f / fmaxf(sqrtf(ss), 1e-12f);
          float cf = 0.f;
#pragma unroll
          for (int i = 0; i < 8; ++i) { kk8[i] *= inv; const float kd = k8[i] * (1.0f + (a8[i] - 1.0f) * kac[i]); cf += r8[i] * kd * rkc[i]; o[i] = kd; }
          cf = sum8(cf, lane); if (pc == 0) CFB[tp * 8 + h] = cf;
          LAS float* p;
          p = kkL + ps * 64 + pc * 8; *(LAS f32x4*)p = (f32x4){kk8[0], kk8[1], kk8[2], kk8[3]}; *(LAS f32x4*)(p + 4) = (f32x4){kk8[4], kk8[5], kk8[6], kk8[7]};
          p = kdL + ps * 64 + pc * 8; *(LAS f32x4*)p = (f32x4){o[0], o[1], o[2], o[3]}; *(LAS f32x4*)(p + 4) = (f32x4){o[4], o[5], o[6], o[7]};
          p = wL + ps * 64 + pc * 8; *(LAS f32x4*)p = (f32x4){__expf(lw8[0]), __expf(lw8[1]), __expf(lw8[2]), __expf(lw8[3])}; *(LAS f32x4*)(p + 4) = (f32x4){__expf(lw8[4]), __expf(lw8[5]), __expf(lw8[6]), __expf(lw8[7])};
          p = nbL + ps * 64 + pc * 8; *(LAS f32x4*)p = (f32x4){-kk8[0] * a8[0], -kk8[1] * a8[1], -kk8[2] * a8[2], -kk8[3] * a8[3]}; *(LAS f32x4*)(p + 4) = (f32x4){-kk8[4] * a8[4], -kk8[5] * a8[5], -kk8[6] * a8[6], -kk8[7] * a8[7]};
          p = rL + ps * 64 + pc * 8; *(LAS f32x4*)p = (f32x4){r8[0], r8[1], r8[2], r8[3]}; *(LAS f32x4*)(p + 4) = (f32x4){r8[4], r8[5], r8[6], r8[7]};
          p = vL + ps * 64 + pc * 8; *(LAS f32x4*)p = (f32x4){v8[0], v8[1], v8[2], v8[3]}; *(LAS f32x4*)(p + 4) = (f32x4){v8[4], v8[5], v8[6], v8[7]}; }
        __syncthreads();
        if (blk + 1 < SEQ / 64) { const int tok = d ? (SEQ - 1 - ((blk + 1) * 64 + ps)) : ((blk + 1) * 64 + ps); const size_t t = (size_t)b * SEQ + tok;
            rr = ld16(R + t * 512 + h * 64 + pc * 8); kr = ld16(KS + t * 512 + h * 64 + pc * 8); vr = ld16(VS + t * 512 + h * 64 + pc * 8);
            lwr = ld16(LW + t * 1024 + d * 512 + h * 64 + pc * 8); ar = ld16(AA + t * 1024 + d * 512 + h * 64 + pc * 8); }
#pragma unroll 2
        for (int s = 0; s < 64; ++s) {
            const f32x4 kk4 = *(const LAS f32x4*)(kkL + s * 64 + jg * 4), w4 = *(const LAS f32x4*)(wL + s * 64 + jg * 4), nb4 = *(const LAS f32x4*)(nbL + s * 64 + jg * 4);
            const f32x4 kd4 = *(const LAS f32x4*)(kdL + s * 64 + jg * 4), r4 = *(const LAS f32x4*)(rL + s * 64 + jg * 4);
            const f32x2 v2 = *(const LAS f32x2*)(vL + s * 64 + i0);
            float y[2];
#pragma unroll
            for (int r = 0; r < 2; ++r) {
                float dq = (st[r][0] * kk4[0] + st[r][1] * kk4[1]) + (st[r][2] * kk4[2] + st[r][3] * kk4[3]);
                dq = red16(dq);
                const float vv = v2[r];
#pragma unroll
                for (int j = 0; j < 4; ++j) st[r][j] = st[r][j] * w4[j] + dq * nb4[j] + vv * kd4[j];
                float yq = (st[r][0] * r4[0] + st[r][1] * r4[1]) + (st[r][2] * r4[2] + st[r][3] * r4[3]);
                y[r] = red16(yq);
            }
            if (jg == 0) *(LAS f32x2*)(yL + s * 64 + i0) = (f32x2){y[0], y[1]};
        }
        __syncthreads();
        { const LAS float* p = yL + ps * 64 + pc * 8; const f32x4 a = *(const LAS f32x4*)p, c = *(const LAS f32x4*)(p + 4);
          v4u o; o.x = pk2(a[0], a[1]); o.y = pk2(a[2], a[3]); o.z = pk2(c[0], c[1]); o.w = pk2(c[2], c[3]);
          st16(YS + tp * 512 + h * 64 + pc * 8, o); }
    }
    __syncthreads();
}

__device__ __forceinline__ void p6a_rows(int l, const float* const* in, unsigned char* ws, int gw, int NGW, int lane) {
    const bf16* YSF = (const bf16*)(ws + A_YSF); const bf16* YSB = (const bf16*)(ws + A_YSB); const bf16* VS = (const bf16*)(ws + A_VS); const bf16* Gb = (const bf16*)(ws + A_G);
    const float* CFB = (const float*)(ws + WS_CFB); bf16* YA = (bf16*)(ws + A_YA);
    float lw[8], lb[8]; ldf8(in[13] + (size_t)l * 512 + lane * 8, lw); ldf8(in[14] + (size_t)l * 512 + lane * 8, lb);
    const int head = lane >> 3;
    for (int t0 = gw; t0 < M; t0 += 4 * NGW) {
        v4u ra[4], rb_[4], rv[4], rg[4]; float cfa[4], cfb[4];
#pragma unroll
        for (int q = 0; q < 4; ++q) { const size_t t = (size_t)(t0 + q * NGW);
            ra[q] = ld16(YSF + t * 512 + lane * 8); rb_[q] = ld16(YSB + t * 512 + lane * 8); rv[q] = ld16(VS + t * 512 + lane * 8); rg[q] = ld16(Gb + t * 512 + lane * 8);
            cfa[q] = CFB[t * 8 + head]; cfb[q] = CFB[((size_t)M + t) * 8 + head]; }
#pragma unroll
        for (int q = 0; q < 4; ++q) { const size_t t = (size_t)(t0 + q * NGW);
            float yf[8], yb[8], v[8], g[8], o[8];
            unp8(ra[q], yf); unp8(rb_[q], yb); unp8(rv[q], v); unp8(rg[q], g);
            const float cf = cfa[q] + cfb[q];
            float sm = 0.f;
#pragma unroll
            for (int i = 0; i < 8; ++i) { yf[i] += yb[i]; sm += yf[i]; }
            const float mu = sum8(sm, lane) * (1.0f / 64.0f); float sq = 0.f;
#pragma unroll
            for (int i = 0; i < 8; ++i) { yf[i] -= mu; sq += yf[i] * yf[i]; }
            const float rs = __builtin_amdgcn_rsqf(sum8(sq, lane) * (1.0f / 64.0f) + 64e-5f);
#pragma unroll
            for (int i = 0; i < 8; ++i) o[i] = (yf[i] * rs * lw[i] + lb[i] + cf * v[i]) * g[i];
            st16(YA + t * 512 + lane * 8, pk8(o)); }
    }
}

__device__ __forceinline__ void p8_router(int l, const float* const* in, const float* X, unsigned char* ws, LAS unsigned char* lds, int gw, int NGW, int tid, int lane) {
    LAS bf16* Bh = (LAS bf16*)(lds + RING_OFF); LAS bf16* Bl = Bh + 32 * 64 * 8;
    LAS float* gL = (LAS float*)(lds + RING_OFF + 65536);
    const float* rw = in[27] + (size_t)l * DMODEL * NEXP; const float* gain = in[26] + (size_t)l * DMODEL;
    for (int i = tid; i < 32 * 64; i += NTHR) { const int kk = i >> 6, ln = i & 63, e = ln & 15, kg_ = ln >> 4; float hi8[8], lo8[8];
#pragma unroll
        for (int j = 0; j < 8; ++j) { const int k = 32 * kk + 8 * kg_ + j; const float w = rw[(size_t)k * NEXP + e] * gain[k]; const float wh = __uint_as_float(f2bf(w) << 16); hi8[j] = wh; lo8[j] = w - wh; }
        *(LAS v4u*)(Bh + i * 8) = pk8(hi8); *(LAS v4u*)(Bl + i * 8) = pk8(lo8); }
    for (int i = tid; i < DMODEL; i += NTHR) gL[i] = gain[i];
    __syncthreads();
    unsigned char* HN2 = ws + A_HN; float* AFFT = (float*)(ws + WS_AFFT);
    typedef short bf16x8_t __attribute__((ext_vector_type(8)));
    const int m = lane & 15, kg = lane >> 4;
    for (int tr = gw; tr < M / 16; tr += NGW) {
        const int t0 = tr * 16; const bf16* xrow = (const bf16*)X + (size_t)(t0 + m) * XBP + 8 * kg;
        f32x4 D = {0.f, 0.f, 0.f, 0.f}, D2 = {0.f, 0.f, 0.f, 0.f}; float ss = 0.f;
#define P8_LD(XB_, c_) do { _Pragma("unroll") for (int q = 0; q < 8; ++q) XB_[q] = ld16(xrow + 32 * (8 * (c_) + q)); } while (0)
#define P8_MM(XB_, c_) do { _Pragma("unroll") for (int q = 0; q < 8; ++q) { const int kk = 8 * (c_) + q; const bf16x8_t a = __builtin_bit_cast(bf16x8_t, XB_[q]); \
                const bf16x8_t bh = *(const LAS bf16x8_t*)(Bh + (kk * 64 + lane) * 8), bl = *(const LAS bf16x8_t*)(Bl + (kk * 64 + lane) * 8); \
                D = __builtin_amdgcn_mfma_f32_16x16x32_bf16(a, bh, D, 0, 0, 0); D2 = __builtin_amdgcn_mfma_f32_16x16x32_bf16(a, bl, D2, 0, 0, 0);     \
                float x[8]; unp8(XB_[q], x); _Pragma("unroll") for (int j = 0; j < 8; ++j) ss += x[j] * x[j]; } } while (0)
#define P8_HN(XB_, c_) do { _Pragma("unroll") for (int q = 0; q < 8; ++q) { const int kk = 8 * (c_) + q; float x[8]; unp8(XB_[q], x); const f32x4 g0 = *(const LAS f32x4*)(gL + 32 * kk + 8 * kg), g1 = *(const LAS f32x4*)(gL + 32 * kk + 8 * kg + 4); \
                x[0] *= rstd * g0[0]; x[1] *= rstd * g0[1]; x[2] *= rstd * g0[2]; x[3] *= rstd * g0[3]; x[4] *= rstd * g1[0]; x[5] *= rstd * g1[1]; x[6] *= rstd * g1[2]; x[7] *= rstd * g1[3]; \
                *(v2u*)(hrow + 32 * kk) = pk8_e4m3(x); } } while (0)
        v4u xa[8], xb[8];
        P8_LD(xa, 0);
#pragma nounroll
        for (int c = 0; c < 4; c += 2) { P8_LD(xb, c + 1); P8_MM(xa, c); if (c + 2 < 4) P8_LD(xa, c + 2); else P8_LD(xa, 0); P8_MM(xb, c + 1); }
        D += D2;
        ss = sum_rows(ss);
        const float rstd = __builtin_amdgcn_rsqf(ss * (1.0f / DMODEL) + 1e-6f);
        unsigned char* hrow = HN2 + (size_t)(t0 + m) * DMODEL + 8 * kg;
#pragma nounroll
        for (int c = 0; c < 4; c += 2) { P8_LD(xb, c + 1); P8_HN(xa, c); if (c + 2 < 4) P8_LD(xa, c + 2); P8_HN(xb, c + 1); }
#undef P8_LD
#undef P8_MM
#undef P8_HN
        f32x4 aff;
#pragma unroll
        for (int r = 0; r < 4; ++r) { const float rs = shx_from(rstd, 4 * kg + r, lane); const float lg = D[r] * rs; float mx = lg;
#pragma unroll
            for (int o = 0; o < 1; ++o) mx = max16(mx);
            const float ex = __expf(lg - mx); float se = ex;
#pragma unroll
            for (int o = 0; o < 1; ++o) se = sum16(se);
            aff[r] = ex * __builtin_amdgcn_rcpf(se); }
        const int b = t0 / SEQ, s0 = t0 & (SEQ - 1);
        *(f32x4*)(AFFT + ((size_t)(b * NEXP + m)) * SEQ + s0 + 4 * kg) = aff;
    }
    __syncthreads();
}

__device__ __forceinline__ int block_sum_i(int v, LAS int* tmp, int wave, int lane) {
#pragma unroll
    for (int o = 1; o < 64; o <<= 1) v += shxi(v, o, lane);
    if (lane == 0) tmp[wave] = v;
    __syncthreads();
    int tot = 0;
#pragma unroll
    for (int i = 0; i < NWAVES; ++i) tot += tmp[i];
    __syncthreads();
    return tot;
}
__device__ __forceinline__ int block_excl_scan_i(int v, LAS int* tmp, int wave, int lane) {
    int inc = v;
#pragma unroll
    for (int o = 1; o < 64; o <<= 1) { const int t = shupi(inc, o, lane); if (lane >= o) inc += t; }
    if (lane == 63) tmp[wave] = inc;
    __syncthreads();
    int base = 0;
#pragma unroll
    for (int i = 0; i < NWAVES; ++i) { const int x = tmp[i]; if (i < wave) base += x; }
    __syncthreads();
    return base + inc - v;
}
__device__ __forceinline__ void p9_topk(int be, unsigned char* ws, LAS unsigned char* lds, int tid, int wave, int lane) {
    const float* AFFT = (const float*)(ws + WS_AFFT) + (size_t)be * SEQ; int* IDX = (int*)(ws + WS_IDX) + (size_t)be * CAP; float* VAL = (float*)(ws + WS_VAL) + (size_t)be * CAP;
    int* INV = (int*)(ws + WS_INV); const int b = be / NEXP, e = be - b * NEXP;
    LAS int* tmp = (LAS int*)(lds + RING_OFF);
    unsigned key[16];
#pragma unroll
    for (int q = 0; q < 4; ++q) { const v4u w = *(const v4u*)(AFFT + tid * 16 + q * 4); key[4 * q] = w.x; key[4 * q + 1] = w.y; key[4 * q + 2] = w.z; key[4 * q + 3] = w.w; }
    unsigned T = 0u;
#pragma nounroll
    for (int bit = 30; bit >= 0; --bit) { const unsigned cand = T | (1u << bit); int c = 0;
#pragma unroll
        for (int i = 0; i < 16; ++i) c += (key[i] >= cand) ? 1 : 0;
        if (block_sum_i(c, tmp, wave, lane) >= CAP) T = cand; }
    int ngt = 0, neq = 0;
#pragma unroll
    for (int i = 0; i < 16; ++i) { ngt += (key[i] > T) ? 1 : 0; neq += (key[i] == T) ? 1 : 0; }
    const int need = CAP - block_sum_i(ngt, tmp, wave, lane);
    const int eqb = block_excl_scan_i(neq, tmp, wave, lane);
    int take = need - eqb; take = take < 0 ? 0 : (take > neq ? neq : take);
    int pos = block_excl_scan_i(ngt + take, tmp, wave, lane);
    int er = eqb;
#pragma unroll
    for (int i = 0; i < 16; ++i) { const int s = tid * 16 + i; bool sel = key[i] > T; if (key[i] == T) { sel = er < need; ++er; }
        int w = -1; if (sel) { IDX[pos] = s; VAL[pos] = __uint_as_float(key[i]); w = pos; ++pos; }
        INV[((size_t)b * SEQ + s) * NEXP + e] = w; }
}

__device__ __forceinline__ void p10_gather(unsigned char* ws, int gw, int NGW, int lane) {
    const bf16* HN2 = (const bf16*)(ws + A_HN); bf16* XG = (bf16*)(ws + A_XG); const int* IDX = (const int*)(ws + WS_IDX);
    for (int r = gw; r < MR; r += NGW) { const int b = r / (NEXP * CAP); const int tok = IDX[r];
        const v4u* src = (const v4u*)(HN2 + ((size_t)b * SEQ + tok) * DMODEL); v4u* dst = (v4u*)(XG + (size_t)r * DMODEL);
        const v4u a = src[lane], c = src[lane + 64]; dst[lane] = a; dst[lane + 64] = c; }
}

namespace cs {
typedef short bf16x8 __attribute__((ext_vector_type(8)));
typedef short s16x4 __attribute__((ext_vector_type(4)));
typedef float f32x16 __attribute__((ext_vector_type(16)));
constexpr int LWL = 0;
constexpr int CH0 = 16384, CH_STRIDE = 20992;
constexpr int O_QR = 0, O_BK = 4608, O_BH = 9216, O_KH = 11520, O_V = 13824, O_QH = 16128, O_XX = 18432, O_BNK = 19584, O_GC = 20736;
constexpr int P144 = 72, P72 = 36;
constexpr int YL0 = CH0 + 4 * CH_STRIDE;
static_assert(YL0 + 64 * 144 <= RING_BYTES, "chunk-scan LDS map");
__device__ __forceinline__ int crow(int reg, int h) { return (reg & 3) + 8 * (reg >> 2) + 4 * h; }
__device__ __forceinline__ bf16x8 ld8(const LAS bf16* p) { const s16x4 lo = *(const LAS s16x4*)p, hi = *(const LAS s16x4*)(p + 8); return __builtin_shufflevector(lo, hi, 0, 1, 2, 3, 4, 5, 6, 7); }
__device__ __forceinline__ bf16x8 ld8c(const LAS bf16* p) { const s16x4 lo = *(const LAS s16x4*)p, hi = *(const LAS s16x4*)(p + 4); return __builtin_shufflevector(lo, hi, 0, 1, 2, 3, 4, 5, 6, 7); }
template <bool PERM> __device__ __forceinline__ bf16x8 ldcol(const LAS bf16* p, int h) {
    const LAS bf16* q = p + (PERM ? 4 * h : 8 * h) * P144;
    unsigned e[8];
#pragma unroll
    for (int jj = 0; jj < 8; ++jj) e[jj] = q[((PERM && jj >= 4) ? jj + 4 : jj) * P144];
    v4u w; w.x = e[0] | (e[1] << 16); w.y = e[2] | (e[3] << 16); w.z = e[4] | (e[5] << 16); w.w = e[6] | (e[7] << 16);
    return __builtin_bit_cast(bf16x8, w); }
typedef short v4i16_tr_t __attribute__((ext_vector_type(4)));
template <bool PERM> __device__ __forceinline__ bf16x8 ldcol_tr(const LAS bf16* p0, int r, int h) {
    const int i = r & 15, q = i >> 2, pp = i & 3;
    const LAS bf16* a = p0 + ((PERM ? 4 * h : 8 * h) + q) * P144 + (r & 16) + 4 * pp;
    const s16x4 lo = __builtin_bit_cast(s16x4, __builtin_amdgcn_ds_read_tr16_b64_v4i16((LAS v4i16_tr_t*)a));
    const s16x4 hi = __builtin_bit_cast(s16x4, __builtin_amdgcn_ds_read_tr16_b64_v4i16((LAS v4i16_tr_t*)(a + (PERM ? 8 : 4) * P144)));
    return __builtin_shufflevector(lo, hi, 0, 1, 2, 3, 4, 5, 6, 7); }
__device__ __forceinline__ bf16x8 pack8r(const f32x16& x, int s) {
    v4u p; p.x = pg8::cvt_pk_bf16(x[8 * s], x[8 * s + 1]); p.y = pg8::cvt_pk_bf16(x[8 * s + 2], x[8 * s + 3]); p.z = pg8::cvt_pk_bf16(x[8 * s + 4], x[8 * s + 5]); p.w = pg8::cvt_pk_bf16(x[8 * s + 6], x[8 * s + 7]);
    return __builtin_bit_cast(bf16x8, p); }
#define CS_SYNC() do { asm volatile("s_waitcnt lgkmcnt(0)" ::: "memory"); __builtin_amdgcn_s_barrier(); asm volatile("" ::: "memory"); } while (0)
#define CS_MFMA(a, b, c) __builtin_amdgcn_mfma_f32_32x32x16_bf16((a), (b), (c), 0, 0, 0)
}
__device__ __forceinline__ void scan_chain_chunked(int l, int chain, const float* const* in, unsigned char* ws, LAS unsigned char* lds, int tid, int wave, int lane) {
    using namespace cs;
    const int d = chain >> 6, b = (chain >> 3) & 7, hd = chain & 7;
    const bf16* R = (const bf16*)(ws + A_R); const bf16* KS = (const bf16*)(ws + A_KS); const bf16* VS = (const bf16*)(ws + A_VS);
    const bf16* LW = (const bf16*)(ws + A_LW); const bf16* AA = (const bf16*)(ws + A_AA);
    bf16* YS = (bf16*)(ws + (d ? A_YSB : A_YSF)); float* CFB = (float*)(ws + WS_CFB) + (size_t)d * M * 8;
    LAS float* lwL = (LAS float*)(lds + RING_OFF + LWL);
    const int ps0 = tid >> 3, pc0 = tid & 7;
    const int r0 = lane & 31, h0 = lane >> 5;
    const float* kkcp = in[10] + (size_t)l * 512 + hd * 64; const float* kacp = in[11] + (size_t)l * 512 + hd * 64; const float* rkcp = in[12] + (size_t)l * 512 + hd * 64;
    f32x16 st0, st1;
#pragma unroll
    for (int i = 0; i < 16; ++i) { st0[i] = 0.f; st1[i] = 0.f; }
    v4u rr, kr, vr, lwr, ar;
    { const int tok = d ? (SEQ - 1 - ps0) : ps0; const size_t t = (size_t)b * SEQ + tok;
      rr = ld16(R + t * 512 + hd * 64 + pc0 * 8); kr = ld16(KS + t * 512 + hd * 64 + pc0 * 8); vr = ld16(VS + t * 512 + hd * 64 + pc0 * 8);
      lwr = ld16(LW + t * 1024 + d * 512 + hd * 64 + pc0 * 8); ar = ld16(AA + t * 1024 + d * 512 + hd * 64 + pc0 * 8); }
    for (int blk = 0; blk < SEQ / 64; ++blk) {
        int ps = ps0, pc = pc0, r = r0, h = h0; asm volatile("" : "+v"(ps), "+v"(pc), "+v"(r), "+v"(h));
        const int ch = ps >> 4, sl = ps & 15;

        const int tokp = d ? (SEQ - 1 - (blk * 64 + ps)) : (blk * 64 + ps); const size_t tp = (size_t)b * SEQ + tokp;
        LAS unsigned char* cbase = lds + RING_OFF + CH0 + ch * CH_STRIDE;
        if (blk > 0) { const int tl = (blk - 1) * 64 + ps; const int tok = d ? (SEQ - 1 - tl) : tl;
            const v4u yv = *(const LAS v4u*)((const LAS bf16*)(lds + RING_OFF + YL0) + ps * P144 + pc * 8); st16(YS + ((size_t)b * SEQ + tok) * 512 + hd * 64 + pc * 8, yv); }
        float r8[8], k8[8], v8[8], lw8[8], a8[8], kk8[8], kd8[8], nb8[8], kkc[8], kac[8], rkc[8];
        ldf8(kkcp + pc * 8, kkc); ldf8(kacp + pc * 8, kac); ldf8(rkcp + pc * 8, rkc);
        unp8(rr, r8); unp8(kr, k8); unp8(vr, v8); unp8(lwr, lw8); unp8(ar, a8); const v4u vraw_ = vr; (void)v8;
        { float ss = 0.f;
#pragma unroll
          for (int i = 0; i < 8; ++i) { kk8[i] = k8[i] * kkc[i]; ss += kk8[i] * kk8[i]; }
          ss = sum8(ss, lane); const float inv = 1.0f / fmaxf(sqrtf(ss), 1e-12f);
          float cf = 0.f;
#pragma unroll
          for (int i = 0; i < 8; ++i) { kk8[i] *= inv; kd8[i] = k8[i] * (1.0f + (a8[i] - 1.0f) * kac[i]); cf += r8[i] * kd8[i] * rkc[i]; nb8[i] = -kk8[i] * a8[i]; }
          cf = sum8(cf, lane); if (pc == 0) CFB[tp * 8 + hd] = cf; }
        { LAS float* p = lwL + ps * 64 + pc * 8; *(LAS f32x4*)p = (f32x4){lw8[0], lw8[1], lw8[2], lw8[3]}; *(LAS f32x4*)(p + 4) = (f32x4){lw8[4], lw8[5], lw8[6], lw8[7]}; }
        CS_SYNC();
        if (blk + 1 < SEQ / 64) { const int tok = d ? (SEQ - 1 - ((blk + 1) * 64 + ps)) : ((blk + 1) * 64 + ps); const size_t t = (size_t)b * SEQ + tok;
            rr = ld16(R + t * 512 + hd * 64 + pc * 8); kr = ld16(KS + t * 512 + hd * 64 + pc * 8); vr = ld16(VS + t * 512 + hd * 64 + pc * 8);
            lwr = ld16(LW + t * 1024 + d * 512 + hd * 64 + pc * 8); ar = ld16(AA + t * 1024 + d * 512 + hd * 64 + pc * 8); }
        { float Lex[8], Lt[8];
#pragma unroll
          for (int i = 0; i < 8; ++i) { Lex[i] = 0.f; Lt[i] = 0.f; }
#pragma unroll 4
          for (int u = 0; u < 16; ++u) { const LAS float* p = lwL + (ch * 16 + u) * 64 + pc * 8; const f32x4 x0 = *(const LAS f32x4*)p, x1 = *(const LAS f32x4*)(p + 4);
              const float m = (u < sl) ? 1.0f : 0.0f;
#pragma unroll
              for (int i = 0; i < 4; ++i) { Lt[i] += x0[i]; Lt[4 + i] += x1[i]; Lex[i] += m * x0[i]; Lex[4 + i] += m * x1[i]; } }
          LAS bf16* QRp = (LAS bf16*)(cbase + O_QR); LAS bf16* BKp = (LAS bf16*)(cbase + O_BK);
          float Lin[8], tmp[8], tm2[8];
#pragma unroll
          for (int i = 0; i < 8; ++i) { Lin[i] = Lex[i] + lw8[i]; tmp[i] = kk8[i] * __expf(Lex[i]); }
          *(LAS v4u*)(QRp + sl * P144 + pc * 8) = pk8(tmp);
          asm volatile("" ::: "memory");
#pragma unroll
          for (int i = 0; i < 8; ++i) tmp[i] = r8[i] * __expf(Lin[i]);
          *(LAS v4u*)(QRp + (16 + sl) * P144 + pc * 8) = pk8(tmp);
          asm volatile("" ::: "memory");
#pragma unroll
          for (int i = 0; i < 8; ++i) { const float ig = __expf(-Lin[i]); tmp[i] = nb8[i] * ig; tm2[i] = kd8[i] * ig; }
          *(LAS v4u*)(BKp + sl * P144 + pc * 8) = pk8(tmp); *(LAS v4u*)(BKp + (16 + sl) * P144 + pc * 8) = pk8(tm2);
          asm volatile("" ::: "memory");
#pragma unroll
          for (int i = 0; i < 8; ++i) { const float igc = __expf(Lt[i] - Lin[i]); tmp[i] = nb8[i] * igc; tm2[i] = kd8[i] * igc; }
          *(LAS v4u*)((LAS bf16*)(cbase + O_BH) + sl * P144 + pc * 8) = pk8(tmp); *(LAS v4u*)((LAS bf16*)(cbase + O_KH) + sl * P144 + pc * 8) = pk8(tm2);
          *(LAS v4u*)((LAS bf16*)(cbase + O_V) + sl * P144 + pc * 8) = vraw_;
          if (sl == 15) { LAS float* gp = (LAS float*)(cbase + O_GC) + pc * 8; *(LAS f32x4*)gp = (f32x4){__expf(Lt[0]), __expf(Lt[1]), __expf(Lt[2]), __expf(Lt[3])}; *(LAS f32x4*)(gp + 4) = (f32x4){__expf(Lt[4]), __expf(Lt[5]), __expf(Lt[6]), __expf(Lt[7])}; } }
        CS_SYNC();
#ifndef CS_NO_A
#ifndef CS_REP_A
#define CS_REP_A 1
#endif
        for (int repa_ = 0; repa_ < CS_REP_A; ++repa_) if (wave < 4) {
            LAS unsigned char* cb = lds + RING_OFF + CH0 + wave * CH_STRIDE;
            const LAS bf16* QRp = (const LAS bf16*)(cb + O_QR); const LAS bf16* BKp = (const LAS bf16*)(cb + O_BK); LAS float* AD = (LAS float*)(cb + O_BK);
            f32x16 D;
#pragma unroll
            for (int i = 0; i < 16; ++i) D[i] = 0.f;
#pragma unroll
            for (int ks = 0; ks < 4; ++ks) { const bf16x8 A = *(const LAS bf16x8*)(QRp + r * P144 + ks * 16 + h * 8), B = *(const LAS bf16x8*)(BKp + r * P144 + ks * 16 + h * 8); D = CS_MFMA(A, B, D); }
            asm volatile("s_waitcnt lgkmcnt(0)" ::: "memory");
            LAS float* AnT = (LAS float*)(cb + O_QH);
#pragma unroll
            for (int i = 0; i < 16; ++i) { const int row = crow(i, h), s_ = row & 15, u_ = r & 15; const bool keep = (i < 8) ? (u_ < s_) : (u_ <= s_); const float v = keep ? D[i] : 0.f;
                AD[row * 32 + r] = v; if (i < 8) AnT[r * 16 + row] = v; }
            asm volatile("s_waitcnt lgkmcnt(0)" ::: "memory");
            float x[16];
#pragma unroll
            for (int t = 0; t < 16; ++t) { const float ldv = AD[t * 32 + r]; x[t] = (r < 16) ? ((t == r) ? 1.0f : 0.0f) : ldv; }
#pragma unroll
            for (int s = 0; s < 15; ++s) { const f32x4 a0 = *(const LAS f32x4*)(AnT + s * 16), a1 = *(const LAS f32x4*)(AnT + s * 16 + 4), a2 = *(const LAS f32x4*)(AnT + s * 16 + 8), a3 = *(const LAS f32x4*)(AnT + s * 16 + 12);
                const float an[16] = {a0[0], a0[1], a0[2], a0[3], a1[0], a1[1], a1[2], a1[3], a2[0], a2[1], a2[2], a2[3], a3[0], a3[1], a3[2], a3[3]};
                const float xs = x[s];
#pragma unroll
                for (int t = 0; t < 16; ++t) if (t > s) x[t] += an[t] * xs; }
            LAS bf16* XXp = (LAS bf16*)(cb + O_XX);
            if (h == 0) {
#pragma unroll
                for (int s = 0; s < 16; ++s) XXp[s * P72 + r] = (bf16)f2bf(x[s]); }
            { const int s = lane >> 2, c8 = (lane & 3) * 8; const LAS float* ap = AD + (16 + s) * 32 + c8; const f32x4 y0 = *(const LAS f32x4*)ap, y1 = *(const LAS f32x4*)(ap + 4);
              LAS v2u* bp = (LAS v2u*)((LAS bf16*)(cb + O_BNK) + s * P72 + c8); bp[0] = (v2u){pk2(y0[0], y0[1]), pk2(y0[2], y0[3])}; bp[1] = (v2u){pk2(y1[0], y1[1]), pk2(y1[2], y1[3])}; }
            asm volatile("s_waitcnt lgkmcnt(0)" ::: "memory");
            { LAS bf16* QHp = (LAS bf16*)(cb + O_QH);
              const bf16x8 A = ld8c(XXp + (r & 15) * P72 + 8 * h);
#pragma unroll
              for (int ct = 0; ct < 2; ++ct) { const bf16x8 B = ldcol<false>(QRp + 32 * ct + r, h); f32x16 z;
#pragma unroll
                  for (int i = 0; i < 16; ++i) z[i] = 0.f;
                  z = CS_MFMA(A, B, z);
#pragma unroll
                  for (int i = 0; i < 8; ++i) QHp[crow(i, h) * P144 + 32 * ct + r] = (bf16)f2bf(z[i]); } }
        }
#endif
        CS_SYNC();
#ifndef CS_NO_B
        if (wave < 2) {
            const int c0 = 32 * wave;
#pragma unroll 1
            for (int cc = 0; cc < 4; ++cc) {
                LAS unsigned char* cb = lds + RING_OFF + CH0 + cc * CH_STRIDE;
                const LAS bf16* QRp = (const LAS bf16*)(cb + O_QR); const LAS bf16* QHp = (const LAS bf16*)(cb + O_QH); const LAS bf16* XXp = (const LAS bf16*)(cb + O_XX); const LAS bf16* BNp = (const LAS bf16*)(cb + O_BNK);
                const LAS bf16* Vp = (const LAS bf16*)(cb + O_V); const LAS bf16* BHp = (const LAS bf16*)(cb + O_BH); const LAS bf16* KHp = (const LAS bf16*)(cb + O_KH); const LAS float* GCp = (const LAS float*)(cb + O_GC);
                const int ra = (r & 15) * P144 + 4 * h, rb = (16 + (r & 15)) * P144 + 4 * h, rx = (r & 15) * P72 + 4 * h;
                const bf16x8 qh0 = ld8(QHp + ra), qh1 = ld8(QHp + ra + 16), qh2 = ld8(QHp + ra + 32), qh3 = ld8(QHp + ra + 48);
                const bf16x8 taf = ld8(XXp + rx + 16), vf = ldcol<true>(Vp + c0 + r, h);
                const bf16x8 sb00 = pack8r(st0, 0), sb01 = pack8r(st0, 1), sb10 = pack8r(st1, 0), sb11 = pack8r(st1, 1);
                f32x16 dq;
#pragma unroll
                for (int i = 0; i < 16; ++i) dq[i] = 0.f;
                dq = CS_MFMA(qh0, sb00, dq); dq = CS_MFMA(qh1, sb01, dq); dq = CS_MFMA(qh2, sb10, dq); dq = CS_MFMA(qh3, sb11, dq); dq = CS_MFMA(taf, vf, dq);
                const bf16x8 kh0 = ldcol<true>(KHp + r, h), kh1 = ldcol<true>(KHp + 32 + r, h), bh0 = ldcol<true>(BHp + r, h), bh1 = ldcol<true>(BHp + 32 + r, h);
                { f32x16 acc0, acc1;
#pragma unroll
                  for (int g = 0; g < 4; ++g) { const f32x4 ga = *(const LAS f32x4*)(GCp + 8 * g + 4 * h), gb = *(const LAS f32x4*)(GCp + 32 + 8 * g + 4 * h);
                      acc0[4 * g] = st0[4 * g] * ga[0]; acc0[4 * g + 1] = st0[4 * g + 1] * ga[1]; acc0[4 * g + 2] = st0[4 * g + 2] * ga[2]; acc0[4 * g + 3] = st0[4 * g + 3] * ga[3];
                      acc1[4 * g] = st1[4 * g] * gb[0]; acc1[4 * g + 1] = st1[4 * g + 1] * gb[1]; acc1[4 * g + 2] = st1[4 * g + 2] * gb[2]; acc1[4 * g + 3] = st1[4 * g + 3] * gb[3]; }
                  acc0 = CS_MFMA(kh0, vf, acc0); acc1 = CS_MFMA(kh1, vf, acc1);
                  const bf16x8 dqb = pack8r(dq, 0);
                  acc0 = CS_MFMA(bh0, dqb, acc0); acc1 = CS_MFMA(bh1, dqb, acc1);
                  st0 = acc0; st1 = acc1;
                  f32x16 y;
#pragma unroll
                  for (int i = 0; i < 16; ++i) y[i] = 0.f;
                  y = CS_MFMA(ld8(QRp + rb), sb00, y); y = CS_MFMA(ld8(QRp + rb + 16), sb01, y); y = CS_MFMA(ld8(QRp + rb + 32), sb10, y); y = CS_MFMA(ld8(QRp + rb + 48), sb11, y);
                  y = CS_MFMA(ld8(BNp + rx + 16), vf, y); y = CS_MFMA(ld8(BNp + rx), dqb, y);
                  { LAS bf16* YLp = (LAS bf16*)(lds + RING_OFF + YL0) + (cc * 16) * P144 + c0 + r;
#pragma unroll
                    for (int i = 0; i < 8; i += 2) { const unsigned w = pg8::cvt_pk_bf16(y[i], y[i + 1]); YLp[crow(i, h) * P144] = (bf16)(w & 0xffffu); YLp[crow(i + 1, h) * P144] = (bf16)(w >> 16); } } }
            }
        }
#endif
        CS_SYNC();
    }
    { const int tl = (SEQ / 64 - 1) * 64 + ps0; const int tok = d ? (SEQ - 1 - tl) : tl;
      const v4u yv = *(const LAS v4u*)((const LAS bf16*)(lds + RING_OFF + YL0) + ps0 * P144 + pc0 * 8); st16(YS + ((size_t)b * SEQ + tok) * 512 + hd * 64 + pc0 * 8, yv); }
    CS_SYNC();
}

namespace cp {
constexpr int REG = 16384;
constexpr int O_QR = 0, O_BK = 4608, O_V = 9216, O_QH = 11520, O_XX = 13824, O_BNK = 14976, O_GC = 16128;
constexpr int AD0 = 6 * REG, LW0 = AD0 + 8192, YL0 = LW0 + 16384;
static_assert(YL0 + 8192 <= RING_BYTES, "pipelined chunk-scan LDS map");
}
__device__ __forceinline__ void scan_chain_pipe(int l, int chain, const float* const* in, unsigned char* ws, LAS unsigned char* lds, int tid, int wave, int lane) {
    using namespace cs;
    const int d = chain >> 6, b = (chain >> 3) & 7, hd = chain & 7;
    const bf16* R = (const bf16*)(ws + A_R); const bf16* KS = (const bf16*)(ws + A_KS); const bf16* VS = (const bf16*)(ws + A_VS);
    const bf16* LW = (const bf16*)(ws + A_LW); const bf16* AA = (const bf16*)(ws + A_AA);
    bf16* YS = (bf16*)(ws + (d ? A_YSB : A_YSF)); float* CFB = (float*)(ws + WS_CFB) + (size_t)d * M * 8;
    LAS unsigned char* ring = lds + RING_OFF;
    constexpr int NB = SEQ / 32;
    const bool isprep = wave >= 4;
    const int ps0 = (tid & 255) >> 3, pc0 = tid & 7, r0 = lane & 31, h0 = lane >> 5;
    const float* kkcp = in[10] + (size_t)l * 512 + hd * 64; const float* kacp = in[11] + (size_t)l * 512 + hd * 64; const float* rkcp = in[12] + (size_t)l * 512 + hd * 64;
    f32x16 st0, st1;
#pragma unroll
    for (int i = 0; i < 16; ++i) { st0[i] = 0.f; st1[i] = 0.f; }
#define kk8(i) st0[(i)]
#define r8(i) st0[8 + (i)]
#define nb8(i) st1[(i)]
#define kd8(i) st1[8 + (i)]
    float lw8[8], inc8[8]; v4u vkeep = {0u, 0u, 0u, 0u};
#pragma unroll
    for (int i = 0; i < 8; ++i) { lw8[i] = 0.f; inc8[i] = 0.f; }
    v4u rr = {0u, 0u, 0u, 0u}, kr = rr, vr = rr, lwr = rr, ar = rr;
#define CP_LOADRAW(j) do { const int tok_ = d ? (SEQ - 1 - ((j) * 32 + ps)) : ((j) * 32 + ps); const unsigned t_ = (unsigned)(b * SEQ + tok_); \
        const unsigned o5_ = t_ * 512u + (unsigned)(hd * 64 + pc * 8), o10_ = t_ * 1024u + (unsigned)(d * 512 + hd * 64 + pc * 8);     \
        rr = ld16(R + o5_); kr = ld16(KS + o5_); vr = ld16(VS + o5_); lwr = ld16(LW + o10_); ar = ld16(AA + o10_); } while (0)
#define CP_PREP1(j) do { float k8_[8], a8_[8], kkc_[8], kac_[8], rkc_[8]; \
        { const LAS float* c_ = cstL + pc * 8; const f32x4 a0_ = *(const LAS f32x4*)c_, a1_ = *(const LAS f32x4*)(c_ + 4), b0_ = *(const LAS f32x4*)(c_ + 64), b1_ = *(const LAS f32x4*)(c_ + 68), c0_ = *(const LAS f32x4*)(c_ + 128), c1_ = *(const LAS f32x4*)(c_ + 132); \
          _Pragma("unroll") for (int i = 0; i < 4; ++i) { kkc_[i] = a0_[i]; kkc_[4 + i] = a1_[i]; kac_[i] = b0_[i]; kac_[4 + i] = b1_[i]; rkc_[i] = c0_[i]; rkc_[4 + i] = c1_[i]; } } \
        { float r_[8]; unp8(rr, r_); _Pragma("unroll") for (int i = 0; i < 8; ++i) r8(i) = r_[i]; } unp8(kr, k8_); unp8(lwr, lw8); unp8(ar, a8_); vkeep = vr; \
        float ss_ = 0.f, cf_ = 0.f; _Pragma("unroll") for (int i = 0; i < 8; ++i) { kk8(i) = k8_[i] * kkc_[i]; ss_ += kk8(i) * kk8(i); kd8(i) = k8_[i] * (1.0f + (a8_[i] - 1.0f) * kac_[i]); cf_ += r8(i) * kd8(i) * rkc_[i]; } \
        ss_ = sum8(ss_, lane); cf_ = sum8(cf_, lane); \
        const float inv_ = fminf(__builtin_amdgcn_rsqf(ss_), 1e12f); \
        _Pragma("unroll") for (int i = 0; i < 8; ++i) { kk8(i) *= inv_; nb8(i) = -kk8(i) * a8_[i]; } \
        { const int tok_ = d ? (SEQ - 1 - ((j) * 32 + ps)) : ((j) * 32 + ps); if (pc == 0) CFB[(unsigned)(b * SEQ + tok_) * 8u + (unsigned)hd] = cf_; } \
        _Pragma("unroll") for (int i = 0; i < 8; ++i) inc8[i] = lw8[i]; \
        _Pragma("unroll") for (int off_ = 8; off_ < 64; off_ <<= 1) { float t8_[8]; _Pragma("unroll") for (int i = 0; i < 8; ++i) t8_[i] = shx_from(inc8[i], lane - off_, lane); \
            __builtin_amdgcn_sched_barrier(0);     \
            _Pragma("unroll") for (int i = 0; i < 8; ++i) inc8[i] += (lane >= off_) ? t8_[i] : 0.f; } \
        if ((lane >> 3) == 7) { LAS float* p_ = (LAS float*)(ring + cp::LW0) + ((j) & 1) * 256 + (wave & 3) * 64 + pc * 8; *(LAS f32x4*)p_ = (f32x4){inc8[0], inc8[1], inc8[2], inc8[3]}; *(LAS f32x4*)(p_ + 4) = (f32x4){inc8[4], inc8[5], inc8[6], inc8[7]}; } \
        if ((j) + 1 < NB) CP_LOADRAW((j) + 1); } while (0)
    LAS float* cstL = (LAS float*)(lds + MISC_OFF + 1024);
    if (tid < 192) cstL[tid] = (tid < 64 ? kkcp : (tid < 128 ? kacp : rkcp))[tid & 63];
    CS_SYNC();
    if (isprep) { const int ps = ps0, pc = pc0; CP_LOADRAW(0); CP_PREP1(0); }
    CS_SYNC();
    for (int k = 0; k < NB + 3; ++k) {
        int ps = ps0, pc = pc0, r = r0, h = h0; asm volatile("" : "+v"(ps), "+v"(pc), "+v"(r), "+v"(h));
        if (isprep) {
            const int ch = ps >> 4, sl = ps & 15;
            if (k >= 3) { const int j = k - 3; const int tl = j * 32 + ps; const int tok = d ? (SEQ - 1 - tl) : tl;
                const v4u yv = *(const LAS v4u*)((const LAS bf16*)(ring + cp::YL0) + (j & 1) * 2048 + ps * 64 + pc * 8); st16(YS + ((unsigned)(b * SEQ + tok) * 512u + (unsigned)(hd * 64 + pc * 8)), yv); }
#ifndef CP_REP_P
#define CP_REP_P 1
#endif
            for (int repp_ = 0; repp_ < CP_REP_P; ++repp_) if (k < NB) {
                LAS unsigned char* cbase = ring + ((k % 3) * 2 + ch) * cp::REG;
                const LAS float* WT = (const LAS float*)(ring + cp::LW0) + (k & 1) * 256 + (ch * 2) * 64 + pc * 8;
                float Lex[8], Lt[8];
                { const f32x4 a0 = *(const LAS f32x4*)WT, a1 = *(const LAS f32x4*)(WT + 4), b0 = *(const LAS f32x4*)(WT + 64), b1 = *(const LAS f32x4*)(WT + 68);
                  const float w0[8] = {a0[0], a0[1], a0[2], a0[3], a1[0], a1[1], a1[2], a1[3]}, w1[8] = {b0[0], b0[1], b0[2], b0[3], b1[0], b1[1], b1[2], b1[3]};
                  const float m = (sl >= 8) ? 1.0f : 0.0f;
#pragma unroll
                  for (int i = 0; i < 8; ++i) { Lt[i] = w0[i] + w1[i]; Lex[i] = inc8[i] + m * w0[i] - lw8[i]; } }
                LAS bf16* QRp = (LAS bf16*)(cbase + cp::O_QR); LAS bf16* BKp = (LAS bf16*)(cbase + cp::O_BK);
                float Lin[8], tmp[8], tm2[8];
#pragma unroll
                for (int i = 0; i < 8; ++i) { Lin[i] = Lex[i] + lw8[i]; tmp[i] = kk8(i) * __builtin_amdgcn_exp2f(Lex[i]); }
                *(LAS v4u*)(QRp + sl * P144 + pc * 8) = pk8(tmp);
#pragma unroll
                for (int i = 0; i < 8; ++i) tmp[i] = r8(i) * __builtin_amdgcn_exp2f(Lin[i]);
                *(LAS v4u*)(QRp + (16 + sl) * P144 + pc * 8) = pk8(tmp);
#pragma unroll
                for (int i = 0; i < 8; ++i) { const float ig = __builtin_amdgcn_exp2f(-Lin[i]); tmp[i] = nb8(i) * ig; tm2[i] = kd8(i) * ig; }
                *(LAS v4u*)(BKp + sl * P144 + pc * 8) = pk8(tmp); *(LAS v4u*)(BKp + (16 + sl) * P144 + pc * 8) = pk8(tm2);
                *(LAS v4u*)((LAS bf16*)(cbase + cp::O_V) + sl * P144 + pc * 8) = vkeep;
                if (sl == 15) { LAS float* gp = (LAS float*)(cbase + cp::O_GC) + pc * 8; *(LAS f32x4*)gp = (f32x4){__builtin_amdgcn_exp2f(Lt[0]), __builtin_amdgcn_exp2f(Lt[1]), __builtin_amdgcn_exp2f(Lt[2]), __builtin_amdgcn_exp2f(Lt[3])}; *(LAS f32x4*)(gp + 4) = (f32x4){__builtin_amdgcn_exp2f(Lt[4]), __builtin_amdgcn_exp2f(Lt[5]), __builtin_amdgcn_exp2f(Lt[6]), __builtin_amdgcn_exp2f(Lt[7])}; }
            }
            if (k + 1 < NB) CP_PREP1(k + 1);
        }
        if (wave == 2 || wave == 3) {
#ifndef CP_REP_A
#define CP_REP_A 1
#endif
            for (int repa_ = 0; repa_ < CP_REP_A; ++repa_) if (k >= 1 && k <= NB) {
                const int j = k - 1, ca = wave - 2;
                LAS unsigned char* cb = ring + ((j % 3) * 2 + ca) * cp::REG;
                const LAS bf16* QRp = (const LAS bf16*)(cb + cp::O_QR); const LAS bf16* BKp = (const LAS bf16*)(cb + cp::O_BK); LAS float* AD = (LAS float*)(ring + cp::AD0 + ca * 4096);
                f32x16 D;
#pragma unroll
                for (int i = 0; i < 16; ++i) D[i] = 0.f;
#pragma unroll
                for (int ks = 0; ks < 4; ++ks) { const bf16x8 A = *(const LAS bf16x8*)(QRp + r * P144 + ks * 16 + h * 8), B = *(const LAS bf16x8*)(BKp + r * P144 + ks * 16 + h * 8); D = CS_MFMA(A, B, D); }
                LAS float* AnT = (LAS float*)(cb + cp::O_QH);
#pragma unroll
                for (int i = 0; i < 16; ++i) { const int row = crow(i, h), s_ = row & 15, u_ = r & 15; const bool keep = (i < 8) ? (u_ < s_) : (u_ <= s_); const float v = keep ? D[i] : 0.f;
                    AD[row * 32 + r] = v; if (i < 8) AnT[r * 16 + row] = v; }
                asm volatile("s_waitcnt lgkmcnt(0)" ::: "memory");
                float x[16];
#pragma unroll
                for (int t = 0; t < 16; ++t) x[t] = AD[t * 32 + r];
#pragma unroll
                for (int t = 0; t < 16; ++t) asm volatile("" : "+v"(x[t]));
#pragma unroll
                for (int t = 0; t < 16; ++t) x[t] = (r < 16) ? ((t == r) ? 1.0f : 0.0f) : x[t];
#pragma unroll
                for (int s = 0; s < 15; ++s) { const f32x4 a0 = *(const LAS f32x4*)(AnT + s * 16), a1 = *(const LAS f32x4*)(AnT + s * 16 + 4), a2 = *(const LAS f32x4*)(AnT + s * 16 + 8), a3 = *(const LAS f32x4*)(AnT + s * 16 + 12);
                    const float an[16] = {a0[0], a0[1], a0[2], a0[3], a1[0], a1[1], a1[2], a1[3], a2[0], a2[1], a2[2], a2[3], a3[0], a3[1], a3[2], a3[3]};
                    const float xs = x[s];
#pragma unroll
                    for (int t = 0; t < 16; ++t) if (t > s) x[t] += an[t] * xs; }
                LAS bf16* XXp = (LAS bf16*)(cb + cp::O_XX);
                if (h == 0) {
#pragma unroll
                    for (int s = 0; s < 16; ++s) XXp[s * P72 + r] = (bf16)f2bf(x[s]); }
                { const int s = lane >> 2, c8 = (lane & 3) * 8; const LAS float* ap = AD + (16 + s) * 32 + c8; const f32x4 y0 = *(const LAS f32x4*)ap, y1 = *(const LAS f32x4*)(ap + 4);
                  LAS v2u* bp = (LAS v2u*)((LAS bf16*)(cb + cp::O_BNK) + s * P72 + c8); bp[0] = (v2u){pk2(y0[0], y0[1]), pk2(y0[2], y0[3])}; bp[1] = (v2u){pk2(y1[0], y1[1]), pk2(y1[2], y1[3])}; }
                asm volatile("s_waitcnt lgkmcnt(0)" ::: "memory");
                { LAS bf16* QHp = (LAS bf16*)(cb + cp::O_QH);
                  const bf16x8 A = ld8c(XXp + (r & 15) * P72 + 8 * h);
                  f32x16 z0, z1;
#pragma unroll
                  for (int i = 0; i < 16; ++i) { z0[i] = 0.f; z1[i] = 0.f; }
                  z0 = CS_MFMA(A, ldcol_tr<false>(QRp, r, h), z0); z1 = CS_MFMA(A, ldcol_tr<false>(QRp + 32, r, h), z1);
#pragma unroll
                  for (int i = 0; i < 8; ++i) { QHp[crow(i, h) * P144 + r] = (bf16)f2bf(z0[i]); QHp[crow(i, h) * P144 + 32 + r] = (bf16)f2bf(z1[i]); } }
            }
        }
        if (wave < 2) {
            if (k >= 2 && k <= NB + 1) {
                const int j = k - 2, c0 = 32 * wave;
                const int ra = (r & 15) * P144 + 4 * h, rb = (16 + (r & 15)) * P144 + 4 * h, rx = (r & 15) * P72 + 4 * h;
                LAS unsigned char* cb0 = ring + ((j % 3) * 2 + 0) * cp::REG; LAS unsigned char* cb1 = cb0 + cp::REG;
#define CP_P(cb, off) ((const LAS bf16*)((cb) + (off)))
#define CP_GC(cb, GA, GB) do { _Pragma("unroll") for (int g = 0; g < 4; ++g) { GA[g] = *(const LAS f32x4*)((const LAS float*)((cb) + cp::O_GC) + 8 * g + 4 * h); GB[g] = *(const LAS f32x4*)((const LAS float*)((cb) + cp::O_GC) + 32 + 8 * g + 4 * h); } } while (0)
#define CP_SCALE(GA, GB) do { _Pragma("unroll") for (int g = 0; g < 4; ++g) { \
                    st0[4 * g] = acc0[4 * g] * GA[g][0]; st0[4 * g + 1] = acc0[4 * g + 1] * GA[g][1]; st0[4 * g + 2] = acc0[4 * g + 2] * GA[g][2]; st0[4 * g + 3] = acc0[4 * g + 3] * GA[g][3]; \
                    st1[4 * g] = acc1[4 * g] * GB[g][0]; st1[4 * g + 1] = acc1[4 * g + 1] * GB[g][1]; st1[4 * g + 2] = acc1[4 * g + 2] * GB[g][2]; st1[4 * g + 3] = acc1[4 * g + 3] * GB[g][3]; } } while (0)
                const bf16x8 qh00 = ld8(CP_P(cb0, cp::O_QH) + ra), qh01 = ld8(CP_P(cb0, cp::O_QH) + ra + 16), qh02 = ld8(CP_P(cb0, cp::O_QH) + ra + 32), qh03 = ld8(CP_P(cb0, cp::O_QH) + ra + 48), ta0 = ld8(CP_P(cb0, cp::O_XX) + rx + 16);
                const bf16x8 vf0 = ldcol_tr<true>(CP_P(cb0, cp::O_V) + c0, r, h);
                const bf16x8 kt00 = ldcol_tr<true>(CP_P(cb0, cp::O_BK) + 16 * P144, r, h), kt01 = ldcol_tr<true>(CP_P(cb0, cp::O_BK) + 16 * P144 + 32, r, h), bt00 = ldcol_tr<true>(CP_P(cb0, cp::O_BK), r, h), bt01 = ldcol_tr<true>(CP_P(cb0, cp::O_BK) + 32, r, h);
                f32x4 ga[4], gb[4]; CP_GC(cb0, ga, gb);
                __builtin_amdgcn_sched_barrier(0);
                const bf16x8 s00 = pack8r(st0, 0), s01 = pack8r(st0, 1), s10 = pack8r(st1, 0), s11 = pack8r(st1, 1);
                f32x16 dq;
#pragma unroll
                for (int i = 0; i < 16; ++i) dq[i] = 0.f;
                dq = CS_MFMA(qh00, s00, dq); dq = CS_MFMA(qh01, s01, dq); dq = CS_MFMA(qh02, s10, dq); dq = CS_MFMA(qh03, s11, dq); dq = CS_MFMA(ta0, vf0, dq);
                f32x16 acc0 = st0, acc1 = st1;
                acc0 = CS_MFMA(kt00, vf0, acc0); acc1 = CS_MFMA(kt01, vf0, acc1);
                __builtin_amdgcn_sched_barrier(0);
                const bf16x8 qh10 = ld8(CP_P(cb1, cp::O_QH) + ra), qh11 = ld8(CP_P(cb1, cp::O_QH) + ra + 16), qh12 = ld8(CP_P(cb1, cp::O_QH) + ra + 32), qh13 = ld8(CP_P(cb1, cp::O_QH) + ra + 48), ta1 = ld8(CP_P(cb1, cp::O_XX) + rx + 16);
                const bf16x8 vf1 = ldcol_tr<true>(CP_P(cb1, cp::O_V) + c0, r, h);
                const bf16x8 kt10 = ldcol_tr<true>(CP_P(cb1, cp::O_BK) + 16 * P144, r, h), kt11 = ldcol_tr<true>(CP_P(cb1, cp::O_BK) + 16 * P144 + 32, r, h), bt10 = ldcol_tr<true>(CP_P(cb1, cp::O_BK), r, h), bt11 = ldcol_tr<true>(CP_P(cb1, cp::O_BK) + 32, r, h);
                __builtin_amdgcn_sched_barrier(0);
                const bf16x8 dqb0 = pack8r(dq, 0);
                acc0 = CS_MFMA(bt00, dqb0, acc0); acc1 = CS_MFMA(bt01, dqb0, acc1);
                CP_SCALE(ga, gb);
                __builtin_amdgcn_sched_barrier(0);
                const bf16x8 rt00 = ld8(CP_P(cb0, cp::O_QR) + rb), rt01 = ld8(CP_P(cb0, cp::O_QR) + rb + 16), rt02 = ld8(CP_P(cb0, cp::O_QR) + rb + 32), rt03 = ld8(CP_P(cb0, cp::O_QR) + rb + 48);
                const bf16x8 bn0v = ld8(CP_P(cb0, cp::O_BNK) + rx + 16), bn0d = ld8(CP_P(cb0, cp::O_BNK) + rx);
                __builtin_amdgcn_sched_barrier(0);
                const bf16x8 t00 = pack8r(st0, 0), t01 = pack8r(st0, 1), t10 = pack8r(st1, 0), t11 = pack8r(st1, 1);
                f32x16 dq1, y0;
#pragma unroll
                for (int i = 0; i < 16; ++i) { dq1[i] = 0.f; y0[i] = 0.f; }
                dq1 = CS_MFMA(qh10, t00, dq1);     y0 = CS_MFMA(rt00, s00, y0);
                dq1 = CS_MFMA(qh11, t01, dq1);     y0 = CS_MFMA(rt01, s01, y0);
                dq1 = CS_MFMA(qh12, t10, dq1);     y0 = CS_MFMA(rt02, s10, y0);
                dq1 = CS_MFMA(qh13, t11, dq1);     y0 = CS_MFMA(rt03, s11, y0);
                dq1 = CS_MFMA(ta1, vf1, dq1);      y0 = CS_MFMA(bn0v, vf0, y0);
                acc0 = st0; acc1 = st1;
                acc0 = CS_MFMA(kt10, vf1, acc0); acc1 = CS_MFMA(kt11, vf1, acc1);
                y0 = CS_MFMA(bn0d, dqb0, y0);
                __builtin_amdgcn_sched_barrier(0);
                CP_GC(cb1, ga, gb);
                const bf16x8 rt10 = ld8(CP_P(cb1, cp::O_QR) + rb), rt11 = ld8(CP_P(cb1, cp::O_QR) + rb + 16), rt12 = ld8(CP_P(cb1, cp::O_QR) + rb + 32), rt13 = ld8(CP_P(cb1, cp::O_QR) + rb + 48);
                const bf16x8 bn1v = ld8(CP_P(cb1, cp::O_BNK) + rx + 16), bn1d = ld8(CP_P(cb1, cp::O_BNK) + rx);
                __builtin_amdgcn_sched_barrier(0);
                const bf16x8 dqb1 = pack8r(dq1, 0);
                acc0 = CS_MFMA(bt10, dqb1, acc0); acc1 = CS_MFMA(bt11, dqb1, acc1);
                f32x16 y1;
#pragma unroll
                for (int i = 0; i < 16; ++i) y1[i] = 0.f;
                y1 = CS_MFMA(rt10, t00, y1); y1 = CS_MFMA(rt11, t01, y1); y1 = CS_MFMA(rt12, t10, y1); y1 = CS_MFMA(rt13, t11, y1);
                y1 = CS_MFMA(bn1v, vf1, y1); y1 = CS_MFMA(bn1d, dqb1, y1);
                CP_SCALE(ga, gb);
#undef CP_GC
#undef CP_SCALE
                { LAS bf16* YLp = (LAS bf16*)(ring + cp::YL0) + (j & 1) * 2048 + c0 + r;
#pragma unroll
                  for (int i = 0; i < 8; i += 2) { const unsigned w0 = pg8::cvt_pk_bf16(y0[i], y0[i + 1]), w1 = pg8::cvt_pk_bf16(y1[i], y1[i + 1]);
                      YLp[crow(i, h) * 64] = (bf16)(w0 & 0xffffu); YLp[crow(i + 1, h) * 64] = (bf16)(w0 >> 16); YLp[(16 + crow(i, h)) * 64] = (bf16)(w1 & 0xffffu); YLp[(16 + crow(i + 1, h)) * 64] = (bf16)(w1 >> 16); } }
#undef CP_P
            }
        }
        CS_SYNC();
    }
#undef CP_LOADRAW
#undef kk8
#undef r8
#undef nb8
#undef kd8
#undef CP_PREP1
}

struct Args { const float* in[32]; float* out; unsigned char* ws; int ph_lo, ph_hi, li, pad; };
#ifndef PHMASK
#define PHMASK 0xFFFF
#endif
#define PH_EN(i) (((PHMASK) >> (i)) & 1)
#ifndef DUPMASK
#define DUPMASK 0
#endif
#define REP(i) for (int rep_ = 0; rep_ < ((((DUPMASK) >> (i)) & 1) + 1); ++rep_)
#define PHASE_BEGIN() \
    const int z_ = __builtin_amdgcn_readfirstlane((int)*(volatile LAS unsigned*)(lds + LDSCTL_OFF + 32)); \
    unsigned char* const ws = args.ws + z_; const float* const* const in = args.in + z_; float* const out = args.out + z_; \
    const int tid = (int)threadIdx.x + z_, lane = tid & 63, wave = __builtin_amdgcn_readfirstlane(tid >> 6); \
    const int G = (int)gridDim.x + z_, bx = (int)blockIdx.x + z_, vcu = (G % 8 == 0) ? (bx % 8) * (G / 8) + bx / 8 : bx; \
    const int gw = vcu * NWAVES + wave, NGW = G * NWAVES; (void)ws; (void)in; (void)out; (void)lane; (void)gw; (void)NGW; (void)vcu
#define LAYER_VARS() const float* const xcur = (l == 0) ? in[0] : (const float*)out; unsigned char* const wl = ws + WS_W + (size_t)l * WL_STRIDE; (void)xcur; (void)wl
#define IN(k) (ph_lo_ <= (k) && (k) < ph_hi_)
#ifdef PROBE_SEAM2
#define SEAM_EXTRA xcd_barrier(bar_);
#else
#define SEAM_EXTRA
#endif
#define SEAM(k) do { if (IN(k) && IN((k) + 1)) { const int zz_ = __builtin_amdgcn_readfirstlane((int)*(volatile LAS unsigned*)(lds + LDSCTL_OFF + 32)); XcdBarrier bar_; bar_.bar = (unsigned*)(args.ws + zz_ + WS_CTL) + CW_BAR + (ph_li_ + zz_) * XCD_BAR_WORDS; bar_.x = xb_xcc_id(); bar_.st = (volatile LAS unsigned*)(lds + MISC_OFF) + 8; xcd_barrier(bar_); SEAM_EXTRA } } while (0)

__global__ void __launch_bounds__(NTHR, 2) fwd(Args args) {
    extern __shared__ __attribute__((aligned(16))) unsigned char lds_raw[];
    LAS unsigned char* lds = (LAS unsigned char*)lds_raw;
    const int ph_lo_ = __builtin_amdgcn_readfirstlane(args.ph_lo), ph_hi_ = __builtin_amdgcn_readfirstlane(args.ph_hi), ph_li_ = __builtin_amdgcn_readfirstlane(args.li);
    for (int u = threadIdx.x; u < (LDS_BYTES - LDSCTL_OFF) / 4; u += NTHR) ((LAS unsigned*)(lds + LDSCTL_OFF))[u] = 0u;
    __syncthreads();
    if (ph_hi_ - ph_lo_ > 1) (void)xcd_barrier_post((unsigned*)(args.ws + WS_CTL) + CW_BAR + ph_li_ * XCD_BAR_WORDS, (volatile LAS unsigned*)(lds + MISC_OFF) + 8);

    REP(13) if (PH_EN(13) && IN(0)) { PHASE_BEGIN(); p0_prologue(in, ws, lds, vcu, G, tid, wave, lane); if (!IN(1)) SEAM(0); }

#pragma nounroll
    for (int l = 0; l < 2; ++l) {
        const int pb = 1 + PH_PER_LAYER * l;
        REP(0) if (PH_EN(0) && IN(pb + 0)) { PHASE_BEGIN(); LAYER_VARS();
#ifdef PROBE_NORM2
            if (l == 0) norm_rows<0>(in[0], nullptr, false, nullptr, nullptr, in[1], (bf16*)(ws + A_HN1), nullptr, gw, NGW, lane, (unsigned char*)out + 2048);
            else norm_rows<0, true>(out, nullptr, true, (const bf16*)(ws + A_YE), (const int*)(ws + WS_INV), in[1] + DMODEL, (bf16*)(ws + A_HN1), nullptr, gw, NGW, lane, (unsigned char*)out + 2048);
#endif
            if (l == 0) norm_rows<0>(in[0], nullptr, false, nullptr, nullptr, in[1], (bf16*)(ws + A_HN1), nullptr, gw, NGW, lane, (unsigned char*)out + 2048);
            else norm_rows<0, true>(out, out, true, (const bf16*)(ws + A_YE), (const int*)(ws + WS_INV), in[1] + DMODEL, (bf16*)(ws + A_HN1), nullptr, gw, NGW, lane, (unsigned char*)out + 2048);
            SEAM(pb + 0);
        }
        REP(1) if (PH_EN(1) && IN(pb + 1)) { PHASE_BEGIN(); LAYER_VARS();
            pg8::ProjOrder S{(const char*)(ws + A_HN1), (const char*)(wl + WO_IN), (size_t)((const unsigned char*)out + 2048 - (ws + A_HN1)), (size_t)(WO_QKV8 - WO_IN), 1024, 1024, 1024, M / 256, NPJ / 256, 10, 4096, G, bx};
            pg8::EpiPlainS E{(bf16*)(ws + A_PRJ), NPJ, 10, 1.0f / 32.0f};
#ifdef PROBE_P2_SINK
            if (rep_ == 0) { pg8::EpiSink E0; pg8::gemm_phase<pg8::EpiSink, pg8::ProjOrder, true, true, false, false, true>(lds + RING_OFF, tid, 1024, 2048, 1024, S, E0); } else
#endif
            pg8::gemm_phase<pg8::EpiPlainS, pg8::ProjOrder, true, true, false, false, true>(lds + RING_OFF, tid, 1024, 2048, 1024, S, E);
            SEAM(pb + 1);
        }
        REP(2) if (PH_EN(2) && IN(pb + 2)) { PHASE_BEGIN(); p3_prep(l, in, ws, lds, gw, NGW, tid, lane); SEAM(pb + 2); }
        REP(3) if (PH_EN(3) && IN(pb + 3)) {
#ifndef P4DUP
#define P4DUP 0
#endif
            for (int r4_ = 0; r4_ < 1 + (P4DUP & 1); ++r4_) { PHASE_BEGIN(); LAYER_VARS();
              pg8::LoraOrder S{(const char*)(ws + A_TW), (const char*)(wl + WO_LORA), G, bx};
              pg8::EpiLora E{(bf16*)(ws + A_LW), (bf16*)(ws + A_AA), in[5] + (size_t)l * 1024, in[7] + (size_t)l * 1024};
              pg8::gemm_phase<pg8::EpiLora, pg8::LoraOrder, true>(lds + RING_OFF, tid, 384, 384, 128, S, E); }
            for (int r4_ = 0; r4_ < 1 + ((P4DUP >> 1) & 1); ++r4_) { PHASE_BEGIN(); LAYER_VARS();
              pg8::PlainOrder S{(const char*)(ws + A_TW) + 512, (const char*)(wl + WO_G2), 384, 128, 128, M / 256, 2, G, bx, 0, 1, 0};
              pg8::EpiPlain E{(bf16*)(ws + A_G), 512};
              pg8::gemm_phase<pg8::EpiPlain, pg8::PlainOrder, true>(lds + RING_OFF, tid, 384, 384, 128, S, E); }
            for (int r4_ = 0; r4_ < 1 + ((P4DUP >> 2) & 1); ++r4_) { PHASE_BEGIN(); LAYER_VARS();
              pg8::PoolOrder S{(const char*)(ws + A_PL), (const char*)(wl + WO_PW), G, bx};
              pg8::EpiColScale E{(bf16*)(ws + A_YB), 512, in[19] + (size_t)l * 512};
              pg8::gemm_phase<pg8::EpiColScale, pg8::PoolOrder, true>(lds + RING_OFF, tid, 512, 512, 512, S, E); }
            SEAM(pb + 3);
        }
#if defined(SCAN_SEQ) || defined(SCAN_BLOCKSYNC)
#error "the log-decay rows are in log2 units now: only the pipelined scan reads them that way"
#endif
        REP(4) if (PH_EN(4) && IN(pb + 4)) {
            #ifdef SCAN_SEQ
            { PHASE_BEGIN(); if (bx < 128) scan_chain(l, bx, in, ws, lds, tid, wave, lane); }
#else
            #ifdef SCAN_BLOCKSYNC
            { PHASE_BEGIN(); if (bx < 128) scan_chain_chunked(l, bx, in, ws, lds, tid, wave, lane); }
#else
            { PHASE_BEGIN(); if (bx < 128) scan_chain_pipe(l, bx, in, ws, lds, tid, wave, lane); }
#ifdef DUP_SCAN
            { PHASE_BEGIN(); if (bx < 128) scan_chain_pipe(l, bx, in, ws, lds, tid, wave, lane); }
#endif
#endif
#endif
#ifndef NO_ATTN
            { PHASE_BEGIN();
              volatile LAS int* slot = (volatile LAS int*)(lds + LDSCTL_OFF + 16); gu32* qh = (gu32*)(ws + WS_CTL) + CW_ATTQ + 64 * l;
              float negM; { const float gq = fabsf(in[20][(size_t)l * 64 + lane]), gk = fabsf(in[21][(size_t)l * 64 + lane]); float mq = gq, mk = gk;
#pragma unroll
                for (int o_ = 1; o_ < 64; o_ <<= 1) { mq = fmaxf(mq, shx(mq, o_, lane)); mk = fmaxf(mk, shx(mk, o_, lane)); }
                negM = -(64.0f * 0.125f * 1.4426950408889634f * 1.01f) * mq * mk; negM = __builtin_bit_cast(float, __builtin_amdgcn_readfirstlane(__builtin_bit_cast(int, negM))); }
              const unsigned char* Qp = ws + A_Q; const unsigned char* Kp = ws + A_K; const unsigned char* Vp = ws + A_V;
#ifdef ATT_CODE_EXP
              negM = 4.0f * (negM + 13.0f) + 60.0f;
#else
              negM += 13.0f;
#endif
              for (;;) {
                  if (tid == 0) *slot = (int)__hip_atomic_fetch_add(qh, 1u, RLX_AGENT);
                  __syncthreads();
                  const int item = __builtin_amdgcn_readfirstlane(*slot);
                  __syncthreads();
                  if (item >= 2048 + 1024) break;
                  if (item >= 2048) { convert_experts_items(in, l, ws, lds, (item - 2048) * 24, 24, wave, lane);
#ifdef PROBE_CONV2
                      convert_experts_items(in, l, ws, lds, (item - 2048) * 24, 24, wave, lane);
#endif
                      continue; }
                  const int grp = item >> 7, r = item & 127, b = grp >> 1, h = (grp & 1) * 4 + (r >> 5), qb = r & 31;
#ifdef PROBE_ATT_TWICE
                  attn_body::attn_unit(tid, negM, b, h, qb, Qp, Kp, Vp, (unsigned char*)out + 3072, (char*)lds_raw + RING_OFF, false);
#endif
                  attn_body::attn_unit(tid, negM, b, h, qb, Qp, Kp, Vp, (unsigned char*)out + 3072, (char*)lds_raw + RING_OFF);
              } }
#endif
            SEAM(pb + 4);
        }
        REP(5) if (PH_EN(5) && IN(pb + 5)) { PHASE_BEGIN(); LAYER_VARS();
            p6a_rows(l, in, ws, gw, NGW, lane);
            SEAM(pb + 5);
        }
        REP(6) if (PH_EN(6) && IN(pb + 6)) { PHASE_BEGIN(); LAYER_VARS();
            typedef pg8::MergeOrder<A_HN, A_YA, A_YB, WO_BRA8, WO_G, WO_BR> MOrd;
            MOrd S{(const char*)ws, (const char*)wl, G, bx, (size_t)((const unsigned char*)out + 2048 - ws), (size_t)4096};
            pg8::EpiMerge E{(bf16*)(ws + A_TS) + (size_t)bx * 65536, (bf16*)(ws + A_MG), 1.0f / 32.0f, 1.0f / (32.0f * attn_body::OSC)};
#ifdef PROBE_SINK_P6B
            { pg8::EpiSink E0; pg8::gemm_phase<pg8::EpiSink, MOrd, true, true, false, false, true>(lds + RING_OFF, tid, 512, 2048, 512, S, E0); }
#endif
            pg8::gemm_phase<pg8::EpiMerge, MOrd, true, true, false, false, true>(lds + RING_OFF, tid, 512, 2048, 512, S, E);
            SEAM(pb + 6);
        }
        REP(7) if (PH_EN(7) && IN(pb + 7)) { PHASE_BEGIN(); LAYER_VARS();
            pg8::PlainOrder S{(const char*)(ws + A_MG), (const char*)(wl + WO_OUT), 1024, 1024, 1024, M / 256, 4, G, bx, 0, 1, 0};
            pg8::EpiResBf E{(l == 0) ? in[0] : (const float*)nullptr, (pg8::bf16_t*)out, XBP};
#ifdef PROBE_SINK_P7
            { pg8::EpiSink E0; pg8::gemm_phase<pg8::EpiSink, pg8::PlainOrder, true>(lds + RING_OFF, tid, 1024, 1024, 1024, S, E0); }
#endif
            pg8::gemm_phase<pg8::EpiResBf, pg8::PlainOrder, true>(lds + RING_OFF, tid, 1024, 1024, 1024, S, E);
            SEAM(pb + 7);
        }
        REP(8) if (PH_EN(8) && IN(pb + 8)) {
            { PHASE_BEGIN(); p8_router(l, in, out, ws, lds, gw, NGW, tid, lane); }
            SEAM(pb + 8);
        }
        REP(9) if (PH_EN(9) && IN(pb + 9)) { PHASE_BEGIN(); if (bx < BATCH * NEXP) p9_topk(bx, ws, lds, tid, wave, lane); SEAM(pb + 9); }
        REP(11) if (PH_EN(11) && IN(pb + 11)) { PHASE_BEGIN();
            pg8::GatherOrder S{(const char*)(ws + A_HN), (const char*)(ws + A_WGU), (const int*)(ws + WS_IDX), 512, 512, 512, MR / 256, 8, G, bx, 4, NEXP, NEXP * 4, SEQ, (size_t)2048 * 1024};
            pg8::EpiSwiGLU<true> E{(bf16*)(ws + A_HID), 1024, 1.0f / 32.0f, 16.0f};
            pg8::gemm_phase<pg8::EpiSwiGLU<true>, pg8::GatherOrder, true, false, true, true>(lds + RING_OFF, tid, 512, 512, 512, S, E);
            SEAM(pb + 11);
        }
        REP(12) if (PH_EN(12) && IN(pb + 12)) { PHASE_BEGIN();
            pg8::PlainOrder S{(const char*)(ws + A_HID), (const char*)(ws + A_WD), 512, 512, 512, MR / 256, 4, G, bx, 4, NEXP, (size_t)1024 * 1024};
            pg8::EpiRowScale E{(bf16*)(ws + A_YE), 1024, (const float*)(ws + WS_VAL), 1.0f / 512.0f};
#ifdef PROBE_SINK_P12
            { pg8::EpiSink E0; pg8::gemm_phase<pg8::EpiSink, pg8::PlainOrder, true, false, false, true>(lds + RING_OFF, tid, 512, 512, 512, S, E0); }
#endif
            pg8::gemm_phase<pg8::EpiRowScale, pg8::PlainOrder, true, false, false, true>(lds + RING_OFF, tid, 512, 512, 512, S, E);
            SEAM(pb + 12);
        }
    }
#ifdef DBG_DUMP_OFF
#ifndef DBG_DUMP_ELEMS
#define DBG_DUMP_ELEMS ((size_t)M * DMODEL)
#endif
    if (IN(28)) { PHASE_BEGIN(); const bf16* src = (const bf16*)(ws + (size_t)(DBG_DUMP_OFF)); const size_t gt = (size_t)vcu * NTHR + tid, NGT = (size_t)G * NTHR;
        for (size_t i = gt; i < (size_t)M * DMODEL / 8; i += NGT) { float f[8]; unp8(ld16(src + (i % ((size_t)(DBG_DUMP_ELEMS) / 8)) * 8), f); f32x4* o = (f32x4*)(out + i * 8); o[0] = (f32x4){f[0], f[1], f[2], f[3]}; o[1] = (f32x4){f[4], f[5], f[6], f[7]}; } }
#endif
#ifdef PROBE_NORM2
    if (PH_EN(14) && IN(27)) { PHASE_BEGIN(); norm_rows<0, true>(out, nullptr, true, (const bf16*)(ws + A_YE), (const int*)(ws + WS_INV), in[31], (bf16*)(ws + A_HN1), nullptr, gw, NGW, lane); }
#endif
    if (PH_EN(14) && IN(27)) { PHASE_BEGIN(); norm_rows<1, true>(out, nullptr, true, (const bf16*)(ws + A_YE), (const int*)(ws + WS_INV), in[31], nullptr, out, gw, NGW, lane); }
}
#undef IN
#undef SEAM

#ifndef MK_PER_PHASE
#define MK_PER_PHASE 0
#endif
extern "C" void kernel_launch(void* const* d_in, const int* in_sizes, int n_in, void* d_out, int out_size, void* d_ws, size_t ws_size, hipStream_t stream) {
    static int grid = 0;
    if (grid == 0) {
        if (n_in != 32 || in_sizes[0] != M * DMODEL || out_size != M * DMODEL || ws_size < WS_END) { fprintf(stderr, "kernel_launch: unexpected shapes (n_in %d, in0 %d, out %d, ws %zu)\n", n_in, n_in > 0 ? in_sizes[0] : -1, out_size, ws_size); grid = -1; return; }
        int dev = 0, cus = 0, per_cu = 0;
        if (hipGetDevice(&dev) != hipSuccess || hipDeviceGetAttribute(&cus, hipDeviceAttributeMultiprocessorCount, dev) != hipSuccess) { grid = -1; return; }
        if (hipFuncSetAttribute((const void*)fwd, hipFuncAttributeMaxDynamicSharedMemorySize, LDS_BYTES) != hipSuccess) { fprintf(stderr, "kernel_launch: hipFuncSetAttribute failed\n"); grid = -1; return; }
        if (hipOccupancyMaxActiveBlocksPerMultiprocessor(&per_cu, (const void*)fwd, NTHR, LDS_BYTES) != hipSuccess || per_cu < 1) fprintf(stderr, "kernel_launch: occupancy query reports %d\n", per_cu);
        (void)hipGetLastError();
        grid = cus;
        if (grid > 256) grid = 256;
    }
    if (grid < 0) return;
    if (hipMemsetAsync((char*)d_ws + WS_CTL, 0, CTL_ZERO_BYTES, stream) != hipSuccess) return;
    Args a{};
    for (int i = 0; i < 32; ++i) a.in[i] = (const float*)d_in[i];
    a.out = (float*)d_out; a.ws = (unsigned char*)d_ws; a.pad = 0;
#if MK_PER_PHASE
#ifdef DBG_LAST_PHASE
    for (int p = 0; p <= DBG_LAST_PHASE; ++p) { a.ph_lo = p; a.ph_hi = p + 1; a.li = 0; hipLaunchKernelGGL(fwd, dim3(grid), dim3(NTHR), LDS_BYTES, stream, a); }
#ifdef DBG_DUMP_OFF
    a.ph_lo = 28; a.ph_hi = 29; a.li = 0; hipLaunchKernelGGL(fwd, dim3(grid), dim3(NTHR), LDS_BYTES, stream, a);
#endif
#else
    for (int p = 0; p < N_PHASES; ++p) { a.ph_lo = p; a.ph_hi = p + 1; a.li = 0; hipLaunchKernelGGL(fwd, dim3(grid), dim3(NTHR), LDS_BYTES, stream, a); }
#endif
#else
    a.ph_lo = 0; a.ph_hi = N_PHASES; a.li = 0;
    hipLaunchKernelGGL(fwd, dim3(grid), dim3(NTHR), LDS_BYTES, stream, a);
#endif
    const hipError_t le = hipPeekAtLastError();
    if (le != hipSuccess) fprintf(stderr, "kernel_launch: launch failed: %s\n", hipGetErrorName(le));
}
```

```cpp
#include <hip/hip_runtime.h>
#include <cstdio>
#include <cstdint>
#define ATT_CODE_EXP 1
namespace pg8 {
#define PG8_LAS __attribute__((address_space(3)))
typedef unsigned short bf16_t;
typedef short bf16x8 __attribute__((ext_vector_type(8)));
typedef float f32x4 __attribute__((ext_vector_type(4)));
typedef unsigned u32x4 __attribute__((ext_vector_type(4)));
constexpr int BM = 256, BK = 64, HALF = 128, HTB = HALF * BK * 2  , STAGE_BYTES = 8 * HTB, NXCD = 8, WGM = 8;

__host__ __device__ __forceinline__ int lds_byte(int r, int c) { const int st = (r >> 4) * 2 + (c >> 5), rr = r & 15, cc = c & 31, ob = rr * 64 + cc * 2; return st * 1024 + (ob ^ (((ob >> 9) & 1) << 5)); }
__host__ __device__ __forceinline__ void stage_rc(int b, int& R, int& C) { const int st = b / 1024, sb = b % 1024, swz = sb ^ (((sb >> 9) & 1) << 5); R = (st >> 1) * 16 + swz / 64; C = (st & 1) * 32 + (swz % 64) / 2; }
__host__ __device__ __forceinline__ int perm32(int rho) { const int n = rho >> 4, i = rho & 15; return 8 * (i >> 2) + 4 * n + (i & 3); }

struct Unit { int pm, pn, sub; };

__device__ __forceinline__ bool tile_of(int i, int G, int c, int nM, int nN, int& pm, int& pn) {
    const long L = (long)i * G + c; const int nwg = nM * nN; if (L >= nwg) return false;
    int wgid = (int)L; { const int q = nwg / NXCD, r = nwg % NXCD, xcd = wgid % NXCD, off = wgid / NXCD; wgid = (xcd < r ? xcd * (q + 1) : r * (q + 1) + (xcd - r) * q) + off; }
    const int nig = WGM * nN, gid = wgid / nig, fm = gid * WGM, gsz = (nM - fm) < WGM ? (nM - fm) : WGM;
    pm = fm + ((wgid % nig) % gsz); pn = (wgid % nig) / gsz; return true;
}
struct PlainOrder {
    const char* A; const char* B; int lda, ldb, K, nM, nN, G, c, grp_panels, ngrp; size_t grp_stride;
    __device__ __forceinline__ int grow(const Unit&, int) const { return 0; }
    __device__ __forceinline__ bool next(int i, Unit& u) const { u.sub = 0; return tile_of(i, G, c, nM, nN, u.pm, u.pn); }
    __device__ __forceinline__ void ops(const Unit& u, const char*& a, const char*& b, int& nt, bool& asel) const {
        nt = K / BK; asel = false;
        a = A + (size_t)u.pm * BM * lda * 2;
        b = B + (size_t)u.pn * BM * ldb * 2 + (grp_panels ? (size_t)((u.pm / grp_panels) % ngrp) * grp_stride : (size_t)0);
    }
};
struct PoolOrder {
    const char* A; const char* B; int G, c;
    __device__ __forceinline__ int grow(const Unit&, int) const { return 0; }
    __device__ __forceinline__ bool next(int i, Unit& u) const { u.sub = 0; return tile_of(i, G, c, 65536 / BM, 2, u.pm, u.pn); }
    __device__ __forceinline__ void ops(const Unit& u, const char*& a, const char*& b, int& nt, bool& asel) const {
        nt = 4; asel = false; a = A + (size_t)u.pm * BM * 512 * 2 + (size_t)u.pn * 256 * 2; b = B + (size_t)u.pn * BM * 512 * 2 + (size_t)u.pn * 256 * 2; }
};
struct ProjOrder {
    const char* A; const char* B; size_t a8_off, b8_off; int lda, ldb, K, nM, nN, pn8, a8_pitch, G, c;
    __device__ __forceinline__ int grow(const Unit&, int) const { return 0; }
    __device__ __forceinline__ bool next(int i, Unit& u) const { u.sub = 0; return tile_of(i, G, c, nM, nN, u.pm, u.pn); }
    __device__ __forceinline__ void ops(const Unit& u, const char*& a, const char*& b, int& nt, bool& asel) const {
        asel = u.pn >= pn8; nt = asel ? K / (2 * BK) : K / BK;
        a = A + (asel ? a8_off + (size_t)u.pm * BM * a8_pitch : (size_t)u.pm * BM * lda * 2);
        b = B + (asel ? b8_off + (size_t)(u.pn - pn8) * BM * ldb * 2 : (size_t)u.pn * BM * ldb * 2);
    }
};
struct LoraOrder {
    const char* A; const char* B; int G, c;
    __device__ __forceinline__ int grow(const Unit&, int) const { return 0; }
    __device__ __forceinline__ bool next(int i, Unit& u) const { u.sub = 0; return tile_of(i, G, c, 256, 8, u.pm, u.pn); }
    __device__ __forceinline__ void ops(const Unit& u, const char*& a, const char*& b, int& nt, bool& asel) const {
        nt = 2; asel = false; a = A + (size_t)u.pm * BM * 384 * 2 + (u.pn >= 4 ? 256 : 0); b = B + (size_t)u.pn * BM * 128 * 2; }
};
struct GatherOrder {
    const char* A; const char* B; const int* idx; int lda, ldb, K, nM, nN, G, c, grp_panels, ngrp, panels_per_batch, seq; size_t grp_stride;
    __device__ __forceinline__ bool next(int i, Unit& u) const { u.sub = 0; return tile_of(i, G, c, nM, nN, u.pm, u.pn); }
    __device__ __forceinline__ void ops(const Unit& u, const char*& a, const char*& b, int& nt, bool& asel) const {
        nt = K / BK; asel = false; a = A;
        b = B + (size_t)u.pn * BM * ldb * 2 + (size_t)((u.pm / grp_panels) % ngrp) * grp_stride;
    }
    __device__ __forceinline__ int grow(const Unit& u, int row) const { return (u.pm / panels_per_batch) * seq + idx[u.pm * BM + row]; }
};
template <size_t OHN, size_t OYA, size_t OYB, size_t OYC, size_t OWG, size_t OWBR>
struct MergeOrder {
    const char* base; const char* wbase; int G, c; size_t hn_off, hn_pitch;
    __device__ __forceinline__ int grow(const Unit&, int) const { return 0; }
#ifndef MERGE_NSUB
#define MERGE_NSUB 6
#endif
    __device__ __forceinline__ bool next(int i, Unit& u) const { const int ti = i / MERGE_NSUB; u.sub = i - ti * MERGE_NSUB; return tile_of(ti, G, c, 256, 4, u.pm, u.pn); }
    __device__ __forceinline__ void ops(const Unit& u, const char*& a, const char*& b, int& nt, bool& asel) const {
        const int bb = u.sub >> 1; const size_t wrow = (size_t)(bb * 1024 + u.pn * BM) * 1024, arow = (size_t)u.pm * BM * 1024; nt = 8;
        if (!(u.sub & 1)) { a = base + (hn_off + (size_t)u.pm * BM * hn_pitch); b = wbase + OWG + wrow; asel = true; }
        else if (bb == 2) { a = base + (hn_off + 1024 + (size_t)u.pm * BM * hn_pitch); b = wbase + OYC + (size_t)u.pn * BM * 1024; asel = true; nt = 4; }
        else { const size_t yo = (bb == 0) ? OYA : OYB; a = base + yo + arow; b = wbase + OWBR + wrow; asel = false; }
    }
};

typedef float f32x2_t __attribute__((ext_vector_type(2))); typedef __bf16 bf16x2_t __attribute__((ext_vector_type(2)));
__device__ __forceinline__ unsigned cvt_pk_bf16(float lo, float hi) { const f32x2_t v = {lo, hi}; const bf16x2_t b = __builtin_convertvector(v, bf16x2_t); return __builtin_bit_cast(unsigned, b); }
__device__ __forceinline__ u32x4 pack8(const f32x4& v0, const f32x4& v1) { u32x4 w; w.x = cvt_pk_bf16(v0[0], v0[1]); w.y = cvt_pk_bf16(v0[2], v0[3]); w.z = cvt_pk_bf16(v1[0], v1[1]); w.w = cvt_pk_bf16(v1[2], v1[3]); return w; }
__device__ __forceinline__ void unpack8(const u32x4& w, f32x4& v0, f32x4& v1) {
    v0[0] = __uint_as_float(w.x << 16); v0[1] = __uint_as_float(w.x & 0xffff0000u); v0[2] = __uint_as_float(w.y << 16); v0[3] = __uint_as_float(w.y & 0xffff0000u);
    v1[0] = __uint_as_float(w.z << 16); v1[1] = __uint_as_float(w.z & 0xffff0000u); v1[2] = __uint_as_float(w.w << 16); v1[3] = __uint_as_float(w.w & 0xffff0000u); }
__device__ __forceinline__ float sigm(float x) { return __builtin_amdgcn_rcpf(1.0f + __builtin_amdgcn_exp2f(-1.4426950408889634f * x)); }
__device__ __forceinline__ f32x4 sigm4(const f32x4& v) { f32x4 r; r[0] = sigm(v[0]); r[1] = sigm(v[1]); r[2] = sigm(v[2]); r[3] = sigm(v[3]); return r; }

struct EpiPlain {
    static constexpr bool PERM = true;
    bf16_t* O; int ldc;
    __device__ __forceinline__ void operator()(const f32x4 (&acc)[2][2][4][2], const Unit& u, int wr, int wc, int fr, int fq) const {
        const int row0 = u.pm * BM + wr * 64 + fr, col0 = u.pn * BM + wc * 32 + 8 * fq;
#pragma unroll
        for (int ai = 0; ai < 2; ++ai)
#pragma unroll
            for (int m = 0; m < 4; ++m) { bf16_t* rowp = O + (size_t)(row0 + ai * HALF + m * 16) * ldc + col0;
#pragma unroll
                for (int bj = 0; bj < 2; ++bj) *(u32x4*)(rowp + bj * HALF) = pack8(acc[ai][bj][m][0], acc[ai][bj][m][1]); }
    }
};
struct EpiSink {
    static constexpr bool PERM = true;
    __device__ __forceinline__ void operator()(const f32x4 (&acc)[2][2][4][2], const Unit&, int, int, int, int) const {
#pragma unroll
        for (int ai = 0; ai < 2; ++ai)
#pragma unroll
            for (int bj = 0; bj < 2; ++bj)
#pragma unroll
                for (int m = 0; m < 4; ++m) { asm volatile("" :: "v"(acc[ai][bj][m][0]), "v"(acc[ai][bj][m][1])); }
    }
};
struct EpiPlainS {
    static constexpr bool PERM = true;
    bf16_t* O; int ldc, pn8; float s8;
    __device__ __forceinline__ void operator()(const f32x4 (&acc)[2][2][4][2], const Unit& u, int wr, int wc, int fr, int fq) const {
        const int row0 = u.pm * BM + wr * 64 + fr, col0 = u.pn * BM + wc * 32 + 8 * fq; const float sc = (u.pn >= pn8) ? s8 : 1.0f;
#pragma unroll
        for (int ai = 0; ai < 2; ++ai)
#pragma unroll
            for (int m = 0; m < 4; ++m) { bf16_t* rowp = O + (size_t)(row0 + ai * HALF + m * 16) * ldc + col0;
#pragma unroll
                for (int bj = 0; bj < 2; ++bj) *(u32x4*)(rowp + bj * HALF) = pack8(acc[ai][bj][m][0] * sc, acc[ai][bj][m][1] * sc); }
    }
};
struct EpiColScale {
    static constexpr bool PERM = true;
    bf16_t* O; int ldc; const float* scale;
    __device__ __forceinline__ void operator()(const f32x4 (&acc)[2][2][4][2], const Unit& u, int wr, int wc, int fr, int fq) const {
        const int row0 = u.pm * BM + wr * 64 + fr, col0 = u.pn * BM + wc * 32 + 8 * fq;
        f32x4 sv[2][2];
#pragma unroll
        for (int bj = 0; bj < 2; ++bj)
#pragma unroll
            for (int n = 0; n < 2; ++n) sv[bj][n] = *(const f32x4*)(scale + col0 + bj * HALF + 4 * n);
#pragma unroll
        for (int ai = 0; ai < 2; ++ai)
#pragma unroll
            for (int m = 0; m < 4; ++m) { bf16_t* rowp = O + (size_t)(row0 + ai * HALF + m * 16) * ldc + col0;
#pragma unroll
                for (int bj = 0; bj < 2; ++bj) {
#ifdef PROBE_YB8
                    f32x4 a0 = acc[ai][bj][m][0] * sv[bj][0], a1 = acc[ai][bj][m][1] * sv[bj][1];
#pragma unroll
                    for (int e = 0; e < 4; ++e) { a0[e] = __builtin_amdgcn_cvt_f32_fp8(__builtin_amdgcn_cvt_pk_fp8_f32(a0[e], a0[e], 0, false), 0); a1[e] = __builtin_amdgcn_cvt_f32_fp8(__builtin_amdgcn_cvt_pk_fp8_f32(a1[e], a1[e], 0, false), 0); }
                    *(u32x4*)(rowp + bj * HALF) = pack8(a0, a1);
#else
                    *(u32x4*)(rowp + bj * HALF) = pack8(acc[ai][bj][m][0] * sv[bj][0], acc[ai][bj][m][1] * sv[bj][1]);
#endif
                } }
    }
};
struct EpiLora {
    static constexpr bool PERM = true;
    bf16_t* LW; bf16_t* AA; const float* w0; const float* a0;
    __device__ __forceinline__ void operator()(const f32x4 (&acc)[2][2][4][2], const Unit& u, int wr, int wc, int fr, int fq) const {
        const bool isw = u.pn < 4; const int ct = (u.pn & 3) * BM;
        bf16_t* O = isw ? LW : AA; const float* bias = isw ? w0 : a0; const float sc = isw ? -0.6065306597126334f * 1.4426950408889634f : 1.0f;
        const int row0 = u.pm * BM + wr * 64 + fr, col0 = ct + wc * 32 + 8 * fq;
        f32x4 bv[2][2];
#pragma unroll
        for (int bj = 0; bj < 2; ++bj)
#pragma unroll
            for (int n = 0; n < 2; ++n) bv[bj][n] = *(const f32x4*)(bias + col0 + bj * HALF + 4 * n);
#pragma unroll
        for (int ai = 0; ai < 2; ++ai)
#pragma unroll
            for (int m = 0; m < 4; ++m) { bf16_t* rowp = O + (size_t)(row0 + ai * HALF + m * 16) * 1024 + col0;
#pragma unroll
                for (int bj = 0; bj < 2; ++bj) { const f32x4 v0 = sigm4(acc[ai][bj][m][0] + bv[bj][0]) * sc, v1 = sigm4(acc[ai][bj][m][1] + bv[bj][1]) * sc;
                    *(u32x4*)(rowp + bj * HALF) = pack8(v0, v1); } }
    }
};
__device__ __forceinline__ u32x4 ld16_dev(const void* p) { u32x4 v; asm volatile("global_load_dwordx4 %0, %1, off sc0 sc1\n\ts_waitcnt vmcnt(0)" : "=v"(v) : "v"(p) : "memory"); return v; }
struct EpiMerge {
    static constexpr bool PERM = true;
    bf16_t* TS; bf16_t* MG; float gs, s5;
    __device__ __forceinline__ void operator()(const f32x4 (&acc)[2][2][4][2], const Unit& u, int wr, int wc, int fr, int fq) const {
        const int lr0 = wr * 64 + fr, lc0 = wc * 32 + 8 * fq;
        if (!(u.sub & 1)) {
#pragma unroll
            for (int ai = 0; ai < 2; ++ai)
#pragma unroll
                for (int m = 0; m < 4; ++m) { bf16_t* rowp = TS + (size_t)(lr0 + ai * HALF + m * 16) * 256 + lc0;
#pragma unroll
                    for (int bj = 0; bj < 2; ++bj) *(u32x4*)(rowp + bj * HALF) = pack8(sigm4(acc[ai][bj][m][0] * gs), sigm4(acc[ai][bj][m][1] * gs)); }
        } else {
            const bool first = (u.sub == 1); const float bs = (u.sub == 5) ? s5 : 1.0f;
#pragma unroll
            for (int ai = 0; ai < 2; ++ai)
#pragma unroll
                for (int m = 0; m < 4; ++m) { const bf16_t* trow = TS + (size_t)(lr0 + ai * HALF + m * 16) * 256 + lc0;
                    bf16_t* grow = MG + (size_t)(u.pm * BM + lr0 + ai * HALF + m * 16) * 1024 + u.pn * BM + lc0;
#pragma unroll
                    for (int bj = 0; bj < 2; ++bj) { f32x4 t0, t1; unpack8(*(const u32x4*)(trow + bj * HALF), t0, t1);
                        f32x4 r0 = t0 * (acc[ai][bj][m][0] * bs), r1 = t1 * (acc[ai][bj][m][1] * bs);
                        if (!first) { f32x4 g0, g1; unpack8(*(const u32x4*)(grow + bj * HALF), g0, g1); r0 += g0; r1 += g1; }
                        *(u32x4*)(grow + bj * HALF) = pack8(r0, r1); }
                    asm volatile("" ::: "memory"); }
        }
    }
};
struct EpiResF32 {
    static constexpr bool PERM = false;
    const float* base; float* out; int ldc;
    __device__ __forceinline__ void operator()(const f32x4 (&acc)[2][2][4][2], const Unit& u, int wr, int wc, int fr, int fq) const {
        const int row0 = u.pm * BM + wr * 64 + fr, col0 = u.pn * BM + wc * 32 + 4 * fq;
#pragma unroll
        for (int ai = 0; ai < 2; ++ai)
#pragma unroll
            for (int m = 0; m < 4; ++m) { const size_t off = (size_t)(row0 + ai * HALF + m * 16) * ldc + col0;
#pragma unroll
                for (int bj = 0; bj < 2; ++bj)
#pragma unroll
                    for (int n = 0; n < 2; ++n) { const f32x4 b = *(const f32x4*)(base + off + bj * HALF + n * 16); *(f32x4*)(out + off + bj * HALF + n * 16) = b + acc[ai][bj][m][n]; } }
    }
};
struct EpiResBf {
    static constexpr bool PERM = false;
    const float* srcf; bf16_t* xb; int ldo;
    __device__ __forceinline__ void operator()(const f32x4 (&acc)[2][2][4][2], const Unit& u, int wr, int wc, int fr, int fq) const {
        const int row0 = u.pm * BM + wr * 64 + fr, col0 = u.pn * BM + wc * 32 + 4 * fq;
        typedef unsigned u32x2 __attribute__((ext_vector_type(2)));
#pragma unroll
        for (int ai = 0; ai < 2; ++ai)
#pragma unroll
            for (int m = 0; m < 4; ++m) { const int row = row0 + ai * HALF + m * 16;
#pragma unroll
                for (int bj = 0; bj < 2; ++bj)
#pragma unroll
                    for (int n = 0; n < 2; ++n) { const int col = col0 + bj * HALF + n * 16; bf16_t* xp = xb + (size_t)row * ldo + col; f32x4 b;
                        if (srcf) b = *(const f32x4*)(srcf + (size_t)row * 1024 + col);
                        else { const u32x2 w = *(const u32x2*)xp; b = (f32x4){__uint_as_float(w.x << 16), __uint_as_float(w.x & 0xffff0000u), __uint_as_float(w.y << 16), __uint_as_float(w.y & 0xffff0000u)}; }
                        const f32x4 r = b + acc[ai][bj][m][n]; *(u32x2*)xp = (u32x2){cvt_pk_bf16(r[0], r[1]), cvt_pk_bf16(r[2], r[3])}; } }
    }
};
__device__ __forceinline__ float clamp_e4m3(float v) { return v; }
__device__ __forceinline__ unsigned pk4_fp8(float a, float b, float c, float d) { unsigned w = 0u; w = __builtin_amdgcn_cvt_pk_fp8_f32(clamp_e4m3(a), clamp_e4m3(b), w, false); w = __builtin_amdgcn_cvt_pk_fp8_f32(clamp_e4m3(c), clamp_e4m3(d), w, true); return w; }
template <bool OUT8> struct EpiSwiGLU {
    static constexpr bool PERM = true;
    bf16_t* HID; int ldc; float s, so;
    __device__ __forceinline__ void operator()(const f32x4 (&acc)[2][2][4][2], const Unit& u, int wr, int wc, int fr, int fq) const {
        const int row0 = u.pm * BM + wr * 64 + fr, col0 = u.pn * HALF + wc * 32 + 8 * fq;
#pragma unroll
        for (int ai = 0; ai < 2; ++ai)
#pragma unroll
            for (int m = 0; m < 4; ++m) {
                const f32x4 g0 = acc[ai][0][m][0] * s, g1 = acc[ai][0][m][1] * s;
                const f32x4 h0 = g0 * sigm4(g0) * (acc[ai][1][m][0] * (s * so)), h1 = g1 * sigm4(g1) * (acc[ai][1][m][1] * (s * so));
                if constexpr (OUT8) { unsigned char* rowp = (unsigned char*)HID + (size_t)(row0 + ai * HALF + m * 16) * ldc + col0;
                    typedef unsigned u32x2 __attribute__((ext_vector_type(2))); *(u32x2*)rowp = (u32x2){pk4_fp8(h0[0], h0[1], h0[2], h0[3]), pk4_fp8(h1[0], h1[1], h1[2], h1[3])}; }
                else { bf16_t* rowp = HID + (size_t)(row0 + ai * HALF + m * 16) * ldc + col0; *(u32x4*)rowp = pack8(h0, h1); } }
    }
};
struct EpiRowScale {
    static constexpr bool PERM = true;
    bf16_t* O; int ldc; const float* rscale; float cs;
    __device__ __forceinline__ void operator()(const f32x4 (&acc)[2][2][4][2], const Unit& u, int wr, int wc, int fr, int fq) const {
        const int row0 = u.pm * BM + wr * 64 + fr, col0 = u.pn * BM + wc * 32 + 8 * fq;
#pragma unroll
        for (int ai = 0; ai < 2; ++ai)
#pragma unroll
            for (int m = 0; m < 4; ++m) { const int row = row0 + ai * HALF + m * 16; const float s = rscale[row] * cs; bf16_t* rowp = O + (size_t)row * ldc + col0;
#pragma unroll
                for (int bj = 0; bj < 2; ++bj) *(u32x4*)(rowp + bj * HALF) = pack8(acc[ai][bj][m][0] * s, acc[ai][bj][m][1] * s); }
    }
};

typedef int v8i32_t __attribute__((ext_vector_type(8))); typedef int v4i32_t __attribute__((ext_vector_type(4)));
__device__ __forceinline__ v8i32_t cat16(const bf16x8& a, const bf16x8& b) { typedef short s16_t __attribute__((ext_vector_type(16))); const s16_t c = __builtin_shufflevector(a, b, 0, 1, 2, 3, 4, 5, 6, 7, 8, 9, 10, 11, 12, 13, 14, 15); return __builtin_bit_cast(v8i32_t, c); }
template <class Epi, class Sched, bool ALIGN_EPI, bool TWO_LDA = false, bool GATHER = false, bool FP8 = false, bool MIXED = false>
__device__ __forceinline__ void gemm_phase(PG8_LAS unsigned char* lds, const int tid, const int lda0, const int lda1, const int ldb, const Sched& S, const Epi& E) {
    const int wid = __builtin_amdgcn_readfirstlane(tid >> 6), lane = tid & 63, wr = wid >> 2, wc = wid & 3, fr = lane & 15, fq = lane >> 4;
    unsigned voffA0[2], voffA1[2], voffB[2]; int gR[2], gC[2];
#pragma unroll
    for (int i = 0; i < 2; ++i) { int R, C; stage_rc(tid * 16 + i * 8192, R, C); gR[i] = R; gC[i] = C; const int Rb = Epi::PERM ? ((R & ~31) + perm32(R & 31)) : R;
        voffA0[i] = (unsigned)(R * lda0 + C) * 2u; voffA1[i] = TWO_LDA ? (unsigned)(R * lda1 + C) * 2u : 0u; voffB[i] = (unsigned)(Rb * ldb + C) * 2u; }
    const size_t kstep = (size_t)(BK * 2);
    const unsigned hsB = (unsigned)HALF * ldb * 2, hsA0 = (unsigned)HALF * lda0 * 2, hsA1 = (unsigned)HALF * lda1 * 2;
    const unsigned ldsw = (unsigned)wid * 1024u;
    const int aoff = lds_byte(wr * 64 + fr, fq * 8), boff = lds_byte(wc * 32 + fr, fq * 8);
#define PG8_SA(b, h) (((b) * 2 + (h)) * HTB)
#define PG8_SB(b, h) ((4 + (b) * 2 + (h)) * HTB)
#define PG8_STAGE(bufoff, gbase, voff) do { _Pragma("unroll") for (int _i = 0; _i < 2; ++_i) \
        __builtin_amdgcn_global_load_lds((const unsigned*)((const char*)(gbase) + (voff)[_i]), (PG8_LAS unsigned*)(lds + (bufoff) + ldsw + _i * 8192), 16, 0, 0); } while (0)
#define PG8_LDA4(dst, b, h) do { _Pragma("unroll") for (int m = 0; m < 4; ++m) _Pragma("unroll") for (int k = 0; k < 2; ++k) dst[m][k] = *(const PG8_LAS bf16x8*)(lds + PG8_SA(b, h) + aoff + m * 2048 + k * 1024); } while (0)
#define PG8_LDB4(dst, b, h) do { _Pragma("unroll") for (int n = 0; n < 2; ++n) _Pragma("unroll") for (int k = 0; k < 2; ++k) dst[n][k] = *(const PG8_LAS bf16x8*)(lds + PG8_SB(b, h) + boff + n * 2048 + k * 1024); } while (0)
#define PG8_LDA8(dst, b, h) do { _Pragma("unroll") for (int m = 0; m < 4; ++m) { const bf16x8 l0_ = *(const PG8_LAS bf16x8*)(lds + PG8_SA(b, h) + aoff + m * 2048), l1_ = *(const PG8_LAS bf16x8*)(lds + PG8_SA(b, h) + aoff + m * 2048 + 1024); dst##8[m] = cat16(l0_, l1_); } } while (0)
#define PG8_LDB8(dst, b, h) do { _Pragma("unroll") for (int n = 0; n < 2; ++n) { const bf16x8 l0_ = *(const PG8_LAS bf16x8*)(lds + PG8_SB(b, h) + boff + n * 2048), l1_ = *(const PG8_LAS bf16x8*)(lds + PG8_SB(b, h) + boff + n * 2048 + 1024); dst##8[n] = cat16(l0_, l1_); } } while (0)
#define PG8_MMAB(ai, bj, At, Bt) do { __builtin_amdgcn_s_setprio(1); _Pragma("unroll") for (int m = 0; m < 4; ++m) _Pragma("unroll") for (int n = 0; n < 2; ++n) _Pragma("unroll") for (int k = 0; k < 2; ++k) \
        acc[ai][bj][m][n] = __builtin_amdgcn_mfma_f32_16x16x32_bf16(Bt[n][k], At[m][k], acc[ai][bj][m][n], 0, 0, 0); __builtin_amdgcn_s_setprio(0); } while (0)
#define PG8_MMA16A(ai, bj, At, Bt) do { __builtin_amdgcn_s_setprio(1); _Pragma("unroll") for (int k = 0; k < 2; ++k) _Pragma("unroll") for (int m = 0; m < 4; ++m) _Pragma("unroll") for (int n = 0; n < 2; ++n)     \
        asm volatile("v_mfma_f32_16x16x32_bf16 %0, %1, %2, %0" : "+v"(acc[ai][bj][m][n]) : "v"(Bt[n][k]), "v"(At[m][k])); __builtin_amdgcn_s_setprio(0); } while (0)
#define PG8_MMA8(ai, bj, At, Bt) do { __builtin_amdgcn_s_setprio(1); _Pragma("unroll") for (int m = 0; m < 4; ++m) _Pragma("unroll") for (int n = 0; n < 2; ++n) \
        asm volatile("v_mfma_scale_f32_16x16x128_f8f6f4 %0, %1, %2, %0, %3, %3 op_sel_hi:[0,0,0]" : "+v"(acc[ai][bj][m][n]) : "v"(Bt##8[n]), "v"(At##8[m]), "v"(sc127)); __builtin_amdgcn_s_setprio(0); } while (0)
#define PG8_WAIT_V(n) asm volatile("s_waitcnt vmcnt(" #n ")" ::: "memory")
#define PG8_WAIT_L(n) asm volatile("s_waitcnt lgkmcnt(" #n ")" ::: "memory")
#define PG8_BAR __builtin_amdgcn_s_barrier()
#define PG8_SCHED __builtin_amdgcn_sched_barrier(0)
#define PG8_KLOOP(LDA_, LDB_, MMA_) \
        for (int t = 0; t < nt; t += 2) { \
            const bool last = (t == nt - 2); \
            const char* a1 = cA + (size_t)(t + 1) * kstep; \
            const char* a2 = last ? nA : cA + (size_t)(t + 2) * kstep; const char* b2 = last ? nB : cB + (size_t)(t + 2) * kstep; \
            const char* a3 = a2 + kstep; const char* b3 = b2 + kstep; \
            LDB_(B0, 0, 0); LDB_(B1, 0, 1); PG8_SCHED; LDA_(At, 0, 0); PG8_STAGE_A(PG8_SA(1, 1), a1, 1, false); \
            PG8_WAIT_V(8); PG8_WAIT_L(0); PG8_BAR; MMA_(0, 0, At, B0); MMA_(0, 1, At, B1); PG8_BAR; PG8_SCHED; \
            LDA_(At, 0, 1); PG8_STAGE(PG8_SB(0, 0), b2, voffB); PG8_STAGE(PG8_SB(0, 1), b2 + hsB, voffB); PG8_STAGE_A(PG8_SA(0, 0), a2, 0, last); \
            PG8_WAIT_V(8); PG8_WAIT_L(0); PG8_BAR; MMA_(1, 0, At, B0); MMA_(1, 1, At, B1); PG8_BAR; PG8_SCHED; \
            LDB_(B0, 1, 0); LDB_(B1, 1, 1); PG8_SCHED; LDA_(At, 1, 0); PG8_STAGE_A(PG8_SA(0, 1), a2, 1, last); \
            PG8_WAIT_V(8); PG8_WAIT_L(0); PG8_BAR; MMA_(0, 0, At, B0); MMA_(0, 1, At, B1); PG8_BAR; PG8_SCHED; \
            LDA_(At, 1, 1); PG8_STAGE(PG8_SB(1, 0), b3, voffB); PG8_STAGE(PG8_SB(1, 1), b3 + hsB, voffB); PG8_STAGE_A(PG8_SA(1, 0), a3, 0, last); \
            PG8_WAIT_V(8); PG8_WAIT_L(0); PG8_BAR; MMA_(1, 0, At, B0); MMA_(1, 1, At, B1); PG8_BAR; PG8_SCHED; \
        }
    Unit cur, nxt; int ui = 0;
    if (!S.next(0, cur)) return;
    f32x4 acc[2][2][4][2];
#pragma unroll
    for (int a = 0; a < 2; ++a)
#pragma unroll
        for (int b = 0; b < 2; ++b)
#pragma unroll
            for (int m = 0; m < 4; ++m)
#pragma unroll
                for (int n = 0; n < 2; ++n) acc[a][b][m][n] = (f32x4){0.f, 0.f, 0.f, 0.f};
    const int sc127 = 127;
    bf16x8 At[4][2], B0[2][2], B1[2][2]; v8i32_t At8[4], B08[2], B18[2];
    const char* cA; const char* cB; int nt; bool selc;
    S.ops(cur, cA, cB, nt, selc); selc = (TWO_LDA || MIXED) && selc;
    nt = __builtin_amdgcn_readfirstlane(nt); asm volatile("" : "+s"(nt));
    unsigned hsAc = selc ? hsA1 : hsA0;
    unsigned vgc0[2] = {0u, 0u}, vgc1[2] = {0u, 0u}, vgn0[2] = {0u, 0u}, vgn1[2] = {0u, 0u};
    if constexpr (GATHER) {
#pragma unroll
        for (int i = 0; i < 2; ++i) { vgc0[i] = (unsigned)(S.grow(cur, gR[i]) * lda0 + gC[i]) * 2u; vgc1[i] = (unsigned)(S.grow(cur, HALF + gR[i]) * lda0 + gC[i]) * 2u; } }
#define PG8_STAGE_A(bufoff, gbase, hf, nx) do { if constexpr (GATHER) { const unsigned v_[2] = { (nx) ? vgn##hf[0] : vgc##hf[0], (nx) ? vgn##hf[1] : vgc##hf[1] }; PG8_STAGE(bufoff, gbase, v_); } \
        else { const unsigned v_[2] = PG8_VA((nx) ? seln : selc); PG8_STAGE(bufoff, (gbase) + ((hf) ? ((nx) ? hsAn : hsAc) : 0u), v_); } } while (0)
#define PG8_VA(sel) { (TWO_LDA && (sel)) ? voffA1[0] : voffA0[0], (TWO_LDA && (sel)) ? voffA1[1] : voffA0[1] }
    { const bool seln = selc; const unsigned hsAn = hsAc;
    PG8_STAGE(PG8_SB(0, 0), cB, voffB); PG8_STAGE(PG8_SB(0, 1), cB + hsB, voffB); PG8_STAGE_A(PG8_SA(0, 0), cA, 0, false); PG8_STAGE_A(PG8_SA(0, 1), cA, 1, false);
    if (wr == 1) PG8_BAR;
    PG8_WAIT_V(2); PG8_BAR;
    PG8_STAGE(PG8_SB(1, 0), cB + kstep, voffB); PG8_STAGE_A(PG8_SA(1, 0), cA + kstep, 0, false); PG8_STAGE(PG8_SB(1, 1), cB + hsB + kstep, voffB); }
    PG8_WAIT_V(6); PG8_BAR;
    for (;;) {
        const bool has_next = S.next(ui + 1, nxt);
        const char* nA = cA; const char* nB = cB; int ntn = nt; bool seln = selc;
        if (has_next) { S.ops(nxt, nA, nB, ntn, seln); seln = (TWO_LDA || MIXED) && seln; }
        const unsigned hsAn = seln ? hsA1 : hsA0;
        if constexpr (GATHER) {
#pragma unroll
            for (int i = 0; i < 2; ++i) { vgn0[i] = has_next ? (unsigned)(S.grow(nxt, gR[i]) * lda0 + gC[i]) * 2u : vgc0[i]; vgn1[i] = has_next ? (unsigned)(S.grow(nxt, HALF + gR[i]) * lda0 + gC[i]) * 2u : vgc1[i]; } }
        if constexpr (MIXED) { if (selc) { PG8_KLOOP(PG8_LDA8, PG8_LDB8, PG8_MMA8) } else { PG8_KLOOP(PG8_LDA4, PG8_LDB4, PG8_MMA16A) } }
        else if constexpr (FP8) { PG8_KLOOP(PG8_LDA8, PG8_LDB8, PG8_MMA8) }
        else { PG8_KLOOP(PG8_LDA4, PG8_LDB4, PG8_MMAB) }
        if constexpr (ALIGN_EPI) { if (wr == 0) PG8_BAR; }
        if constexpr (FP8 || MIXED) asm volatile("s_nop 15\n\ts_nop 15" ::: "memory");
        { int t_ = tid; asm volatile("" : "+v"(t_)); const int fr_ = t_ & 15, fq_ = (t_ >> 4) & 3; E(acc, cur, wr, wc, fr_, fq_); }
        if (!has_next) break;
#pragma unroll
        for (int a = 0; a < 2; ++a)
#pragma unroll
            for (int b = 0; b < 2; ++b)
#pragma unroll
                for (int m = 0; m < 4; ++m)
#pragma unroll
                    for (int n = 0; n < 2; ++n) acc[a][b][m][n] = (f32x4){0.f, 0.f, 0.f, 0.f};
        cur = nxt; cA = nA; cB = nB; selc = seln; hsAc = hsAn; nt = ntn; ++ui;
        if constexpr (GATHER) { vgc0[0] = vgn0[0]; vgc0[1] = vgn0[1]; vgc1[0] = vgn1[0]; vgc1[1] = vgn1[1]; }
        if constexpr (ALIGN_EPI) { if (wr == 1) PG8_BAR; }
    }
    PG8_WAIT_V(0);
    if constexpr (!ALIGN_EPI) { if (wr == 0) PG8_BAR; }
    PG8_BAR;
#undef PG8_VA
#undef PG8_STAGE_A
#undef PG8_SA
#undef PG8_SB
#undef PG8_STAGE
#undef PG8_MMAB
#undef PG8_MMA8
#undef PG8_MMA16A
#undef PG8_KLOOP
#undef PG8_LDA4
#undef PG8_LDB4
#undef PG8_LDA8
#undef PG8_LDB8
#undef PG8_WAIT_V
#undef PG8_WAIT_L
#undef PG8_BAR
#undef PG8_SCHED
}
}

#include <hip/hip_bf16.h>
#include <cmath>
namespace attn_body {
using bf16=__hip_bfloat16;
using i32x8=__attribute__((ext_vector_type(8)))int;
using i32x4=__attribute__((ext_vector_type(4)))int;
using f32x16=__attribute__((ext_vector_type(16)))float;
using u32x4=__attribute__((ext_vector_type(4)))unsigned;
constexpr int BATCH=8,NHEAD=8,SEQ=8192,D=64,DM=NHEAD*D;
constexpr int Q8P=1024,O8P=4096; constexpr float OSC=64.0f;
constexpr int NW=8,QBLK=32,QB=QBLK*NW,KVBLK=64,NQB=SEQ/QB;
__device__ __forceinline__ int crow(int r,int hi){return (r&3)+8*(r>>2)+4*hi;}
#define SBAR() __builtin_amdgcn_sched_barrier(0)
constexpr int NSLOT=3, SLOTB=4096;
constexpr int LDS_K=0, LDS_V=NSLOT*SLOTB, LDS_WS=2*NSLOT*SLOTB, LDS_OST=LDS_WS+NW*64*4, LDS_BYTES=LDS_OST+NW*4096;
__device__ __forceinline__ void glds16(const void*gsrc,unsigned lds_dst){unsigned keep;
  asm volatile("s_mov_b32 %0, m0\n\ts_mov_b32 m0, %2\n\ts_nop 0\n\tglobal_load_lds_dwordx4 %1, off\n\ts_mov_b32 m0, %0":"=&s"(keep):"v"(gsrc),"s"(lds_dst):"memory");}
#define WAIT_BAR(N) asm volatile("s_waitcnt vmcnt(" #N ") lgkmcnt(0)\n\ts_barrier":::"memory")
typedef __attribute__((address_space(3))) const char* lds_cptr;
__device__ __forceinline__ i32x8 frag32(lds_cptr p){ const i32x4 a=*(const __attribute__((address_space(3))) i32x4*)(p), b=*(const __attribute__((address_space(3))) i32x4*)(p+1024); return (i32x8){a[0],a[1],a[2],a[3],b[0],b[1],b[2],b[3]}; }
#define MFMA_QK(D_,A,B,C) asm volatile("v_mfma_scale_f32_32x32x64_f8f6f4 %0, %1, %2, %3, %4, %5 op_sel_hi:[0,0,0]":"=&v"(D_):"v"(A),"v"(B),"v"(C),"v"(scA),"v"(scB))
#define MFMA_PV(D_,A,B) asm volatile("v_mfma_f32_32x32x64_f8f6f4 %0, %1, %2, %0 cbsz:1":"+v"(D_):"v"(A),"v"(B))

#ifndef ATTN_STORE16
#define ATTN_STORE16(p,v) (*(u32x4*)(p)=(v))
#endif
__device__ __forceinline__ void attn_unit(int tid_in,float negM,int b,int h,int qb,const unsigned char*Q8,const unsigned char*__restrict__ K8,const unsigned char*__restrict__ Vt8,unsigned char*O8,char*shm,const bool do_store=true){
  const int tid=tid_in,lane=tid&63,r32=lane&31,hi=lane>>5; const int wid=__builtin_amdgcn_readfirstlane(tid>>6);
  const long rowbase=(long)b*SEQ; const int q0=qb*QB; const int kvh=h>>2;
  const unsigned lds0=(unsigned)(uintptr_t)shm;
  const bool kw=wid<4;
  const int ki=lane&31, kkey=32*((ki>>2)&1)+16*(lane>>5)+(ki&3)+4*(ki>>3);
  const unsigned char*ksrc=K8+((long)(b*2+kvh)*SEQ+kkey)*64+(wid&3)*16;
  const unsigned char*vsrc=Vt8+((long)(b*2+kvh)*64+lane)*SEQ+(wid&3)*16;
  const unsigned char*dsrc=kw?ksrc:vsrc; const int dstep=kw?KVBLK*64:KVBLK;
  const unsigned ddst=lds0+(kw?LDS_K:LDS_V)+(wid&3)*1024;
  const int NT=SEQ/KVBLK;
  #define DMA(tt,slot) do{ int ti_=(tt); ti_=ti_<NT?ti_:NT-1; glds16(dsrc+(long)ti_*dstep,(unsigned)__builtin_amdgcn_readfirstlane(ddst+(slot))); }while(0)
  const lds_cptr shm3=(lds_cptr)shm; const lds_cptr kp0=shm3+LDS_K+hi*2048+r32*16; const lds_cptr vp0=shm3+LDS_V+hi*2048+r32*16;
  const unsigned char*Qw=Q8+(rowbase+q0+wid*QBLK+r32)*Q8P+h*128+hi*32;
  const i32x4 qa=*(const i32x4*)Qw, qb_=*(const i32x4*)(Qw+16);
  const i32x8 qf=(i32x8){qa[0],qa[1],qa[2],qa[3],qb_[0],qb_[1],qb_[2],qb_[3]};
  if(kw){DMA(0,0);DMA(1,SLOTB);DMA(2,2*SLOTB);}
  f32x16 o[2],ol;o[0]=f32x16{};o[1]=f32x16{};ol=f32x16{};f32x16 negm;
  #pragma unroll
  for(int r=0;r<16;++r)negm[r]=negM;
  asm volatile("":"+v"(negm));
  f32x16 pA0,pA1,pB0,pB1; i32x8 kf0,kf1,vf0,vf1,pw0=(i32x8){0,0,0,0,0,0,0,0},pw1=(i32x8){0,0,0,0,0,0,0,0};
  i32x8 ones; _Pragma("unroll") for(int r=0;r<8;++r)ones[r]=0x38383838; asm volatile("":"+v"(ones));
#ifdef ATT_CODE_EXP
  int scA=127,scB=125; asm volatile("":"+v"(scA),"+v"(scB));
#else
  int scA=127,scB=123; asm volatile("":"+v"(scA),"+v"(scB));
#endif
  int sl_cur=0,sl_next=SLOTB;
  #define ROT() do{sl_cur=sl_next;sl_next=(sl_next==(NSLOT-1)*SLOTB)?0:sl_next+SLOTB;}while(0)
  #define EX(v) __builtin_amdgcn_exp2f(v)
  #define PIN(x) asm volatile("":"+v"(x))
#ifdef ATT_CODE_EXP
  #define PACK2(P,PW,J,LO) do{ _Pragma("unroll") for(int j_=0;j_<2;++j_){ unsigned w_=(unsigned)PW[(J)+j_]; _Pragma("unroll") for(int b_=0;b_<4;++b_) w_=__builtin_amdgcn_cvt_pk_u8_f32(P[(LO)+4*j_+b_],b_,w_); PW[(J)+j_]=(int)w_; } }while(0)
  #define PACK(P,PW,J) do{ PACK2(P,PW,J,0); PACK2(P,PW,(J)+2,8); }while(0)
  #define EXPS(P,LO) do{}while(0)
  #define G1(Y0,Y1,PWN) do{ PACK2(Y0,PWN,0,0); PIN(PWN); }while(0)
  #define G2(Y0,Y1,PWN) do{ PACK2(Y0,PWN,2,8); PIN(PWN); }while(0)
  #define G3(Y0,Y1,PWN) do{ PACK2(Y1,PWN,4,0); PIN(PWN); }while(0)
  #define G4(Y0,Y1,PWN) do{ PACK2(Y1,PWN,6,8); PIN(PWN); }while(0)
  #define G5(Y0,Y1,PWN) do{}while(0)
#else
  #define PK2(P,B,OLD,HIW) __builtin_amdgcn_cvt_pk_bf8_f32(P[B],P[B+1],OLD,HIW)
  #define PACK(P,PW,J) do{ _Pragma("unroll") for(int j_=0;j_<4;++j_){ int w_=PK2(P,4*j_,PW[(J)+j_],false); w_=PK2(P,4*j_+2,w_,true); PW[(J)+j_]=w_; } }while(0)
  #define EXPS(P,LO) do{ _Pragma("unroll") for(int r_=(LO);r_<(LO)+8;++r_)P[r_]=EX(P[r_]); PIN(P); }while(0)
  #define G1(Y0,Y1,PWN) EXPS(Y0,0)
  #define G2(Y0,Y1,PWN) EXPS(Y0,8)
  #define G3(Y0,Y1,PWN) EXPS(Y1,0)
  #define G4(Y0,Y1,PWN) EXPS(Y1,8)
  #define G5(Y0,Y1,PWN) do{ PACK(Y0,PWN,0); PACK(Y1,PWN,4); PIN(PWN); }while(0)
#endif
  if(kw){asm volatile("s_waitcnt vmcnt(2)":::"memory");}else{asm volatile("s_waitcnt vmcnt(0)":::"memory");}
  asm volatile("s_barrier":::"memory");
  kf0=frag32(kp0);kf1=frag32(kp0+512);
  MFMA_QK(pA0,kf0,qf,negm);MFMA_QK(pA1,kf1,qf,negm);asm volatile("s_nop 15\n\ts_nop 7":"+v"(pA0),"+v"(pA1));
  WAIT_BAR(1);
  DMA(kw?3:0,0);
  ROT();
  kf0=frag32(kp0+sl_cur);kf1=frag32(kp0+sl_cur+512);
  WAIT_BAR(1);
  MFMA_QK(pB0,kf0,qf,negm); EXPS(pA0,0); EXPS(pA0,8); SBAR();
  MFMA_QK(pB1,kf1,qf,negm); EXPS(pA1,0); EXPS(pA1,8); SBAR();
  DMA(kw?4:1,sl_cur);
  kf0=frag32(kp0+sl_next);kf1=frag32(kp0+sl_next+512);
  PACK(pA0,pw0,0); PACK(pA1,pw0,4); PIN(pw0);
  WAIT_BAR(1); ROT();
  #define STEP(X0,X1,Y0,Y1,PWN,PWO,t) do{ SBAR(); \
    vf0=frag32(vp0+sl_next); vf1=frag32(vp0+sl_next+512); SBAR(); \
    MFMA_QK(X0,kf0,qf,negm); G1(Y0,Y1,PWN); SBAR(); \
    MFMA_QK(X1,kf1,qf,negm); G2(Y0,Y1,PWN); SBAR(); \
    DMA(kw?(t)+3:(t),sl_cur); \
    kf0=frag32(kp0+sl_next); kf1=frag32(kp0+sl_next+512); SBAR(); \
    MFMA_PV(o[0],PWO,vf0); G3(Y0,Y1,PWN); SBAR(); \
    MFMA_PV(o[1],PWO,vf1); G4(Y0,Y1,PWN); SBAR(); \
    MFMA_PV(ol,PWO,ones); G5(Y0,Y1,PWN); SBAR(); \
    }while(0)
  for(int t=2;t<NT;t+=2){
    STEP(pA0,pA1,pB0,pB1,pw1,pw0,t);     WAIT_BAR(1); ROT();
    STEP(pB0,pB1,pA0,pA1,pw0,pw1,t+1);   WAIT_BAR(1); ROT();
  }
  { vf0=frag32(vp0+sl_next); vf1=frag32(vp0+sl_next+512);
    MFMA_PV(o[0],pw0,vf0); EXPS(pB0,0); EXPS(pB0,8); SBAR();
    MFMA_PV(o[1],pw0,vf1); EXPS(pB1,0); EXPS(pB1,8); SBAR();
    DMA(NT,sl_cur);
    MFMA_PV(ol,pw0,ones); PACK(pB0,pw1,0); PACK(pB1,pw1,4); PIN(pw1);
    WAIT_BAR(1); ROT(); }
  { vf0=frag32(vp0+sl_next); vf1=frag32(vp0+sl_next+512);
    MFMA_PV(o[0],pw1,vf0); MFMA_PV(o[1],pw1,vf1); MFMA_PV(ol,pw1,ones); asm volatile("s_nop 15\n\ts_nop 7":"+v"(o[0]),"+v"(o[1]),"+v"(ol)); }
#ifndef ATT_CODE_EXP
  #undef PK2
#else
  #undef PACK2
#endif
  #undef PACK
  #undef G1
  #undef G2
  #undef G3
  #undef G4
  #undef G5
  #undef EXPS
  #undef PIN
  #undef EX
  #undef STEP
  float rli[16];
  #pragma unroll
  for(int r=0;r<16;++r)rli[r]=__builtin_amdgcn_rcpf(ol[r])*OSC;
  unsigned char*Ow=O8+(rowbase+q0+wid*QBLK)*(long)O8P+h*D;
  { unsigned char*stg=(unsigned char*)(shm+LDS_OST)+wid*2048;
    #pragma unroll
    for(int r=0;r<16;++r){const int orow=crow(r,hi);
      #pragma unroll
      for(int d0=0;d0<2;++d0){ const float v_=o[d0][r]*rli[r]; stg[orow*64+d0*32+r32]=(unsigned char)__builtin_amdgcn_cvt_pk_fp8_f32(v_,v_,0,false); } }
    asm volatile("s_waitcnt lgkmcnt(0)":::"memory");
    #pragma unroll
    for(int i=0;i<2;++i){const int idx=i*64+lane,row=idx>>2,ch=idx&3; const u32x4 v=*(const u32x4*)(stg+row*64+ch*16); if(do_store)ATTN_STORE16(Ow+(long)row*O8P+ch*16,v);} }
  asm volatile("s_waitcnt vmcnt(0) lgkmcnt(0)\n\ts_barrier":::"memory");
  #undef DMA
  #undef ROT
}
constexpr int ATTN_LDS_BYTES=LDS_BYTES;
#undef SBAR
#undef WAIT_BAR
#undef MFMA_QK
#undef MFMA_PV
}

constexpr int NWAVES = 8, NTHR = NWAVES * 64;
constexpr int BATCH = 8, SEQ = 8192, DMODEL = 1024, M = BATCH * SEQ;
constexpr int NPJ = 3328;
constexpr int COL_VL = 1920, COL_POOL = 2048, COL_Q = 2560, COL_K = 3072, COL_V = 3200;
constexpr int NEXP = 16, CAP = 1024, MR = BATCH * NEXP * CAP;
constexpr int NPROJ_IN = 6272;
constexpr float C2Q = 0.125f * 1.4426950408889634f;
constexpr int N_PHASES = 28, PH_PER_LAYER = 13;
constexpr int XBP = 2048;

constexpr size_t MiB = 1u << 20;
constexpr size_t WS_CTL = 0, CTL_ZERO_BYTES = 1 * MiB;
constexpr size_t WS_ROPE = 1 * MiB;
constexpr size_t WS_W = 3 * MiB, WL_STRIDE = 23 * MiB;
constexpr size_t WO_IN = 0, WO_G = 6656 * 1024, WO_LORA = WO_G + 6 * MiB, WO_G2 = WO_LORA + 1 * MiB, WO_PW = WO_G2 + 256 * 1024, WO_BR = WO_PW + 512 * 1024, WO_OUT = WO_BR + 6 * MiB;
constexpr size_t WO_BRA8 = WO_BR + 3 * MiB;
constexpr size_t WO_QKV8 = WO_G + 3 * MiB;
static_assert(WO_OUT + 2 * MiB <= WL_STRIDE && WO_QKV8 + 768 * 2048 <= WO_LORA, "weight map");
constexpr size_t WS_VF = 49 * MiB, WS_AFFT = 113 * MiB, WS_IDX = 117 * MiB, WS_VAL = WS_IDX + 512 * 1024, WS_INV = 118 * MiB, WS_CFB = 122 * MiB;
constexpr size_t ACT = 128 * MiB;
constexpr size_t A_PRJ = ACT, A_R = ACT + 416 * MiB, A_KS = ACT + 480 * MiB, A_VS = ACT + 544 * MiB, A_Q = ACT + 608 * MiB, A_K = ACT + 672 * MiB, A_V = ACT + 688 * MiB,
                 A_TW = ACT + 704 * MiB, A_PL = ACT + 752 * MiB, A_HN1 = ACT + 672 * MiB;
constexpr size_t A_LW = ACT, A_AA = ACT + 128 * MiB, A_G = ACT + 256 * MiB, A_YB = ACT + 320 * MiB, A_YSF = ACT + 704 * MiB, A_YSB = ACT + 768 * MiB;
constexpr size_t A_HN = ACT, A_YA = ACT + 128 * MiB, A_TS = ACT + 192 * MiB, A_MG = ACT + 416 * MiB;
constexpr size_t A_WGU = ACT + 832 * MiB, A_WD = ACT + 384 * MiB, A_XG = ACT + 416 * MiB, A_HID = ACT + 128 * MiB, A_YE = ACT + 416 * MiB;
constexpr size_t WS_END = ACT + 896 * MiB;
constexpr int CW_BAR = 4096;
constexpr int CW_ATTQ = 200000;

constexpr int RING_OFF = 0, RING_BYTES = 131072;
constexpr int LDSCTL_OFF = RING_BYTES, MISC_OFF = LDSCTL_OFF + 320;
constexpr int LDS_BYTES = 147456;

#define GAS __attribute__((address_space(1)))
#define LAS __attribute__((address_space(3)))
typedef unsigned short bf16;
typedef unsigned v4u __attribute__((ext_vector_type(4)));
typedef unsigned v2u __attribute__((ext_vector_type(2)));
typedef float f32x4 __attribute__((ext_vector_type(4)));
typedef float f32x2 __attribute__((ext_vector_type(2)));
typedef GAS unsigned gu32;
#define RLX_AGENT __ATOMIC_RELAXED, __HIP_MEMORY_SCOPE_AGENT
#define LDS_WAIT() asm volatile("s_waitcnt lgkmcnt(0)" ::: "memory")
typedef float f32x2c_t __attribute__((ext_vector_type(2))); typedef __bf16 bf16x2c_t __attribute__((ext_vector_type(2)));
__device__ __forceinline__ unsigned pk2(float lo, float hi) { const f32x2c_t v = {lo, hi}; const bf16x2c_t b = __builtin_convertvector(v, bf16x2c_t); return __builtin_bit_cast(unsigned, b); }
__device__ __forceinline__ unsigned f2bf(float f) { return pk2(f, 0.f) & 0xffffu; }
__device__ __forceinline__ void unp8(const v4u& p, float (&f)[8]) {
    f[0] = __uint_as_float(p.x << 16); f[1] = __uint_as_float(p.x & 0xffff0000u); f[2] = __uint_as_float(p.y << 16); f[3] = __uint_as_float(p.y & 0xffff0000u);
    f[4] = __uint_as_float(p.z << 16); f[5] = __uint_as_float(p.z & 0xffff0000u); f[6] = __uint_as_float(p.w << 16); f[7] = __uint_as_float(p.w & 0xffff0000u); }
__device__ __forceinline__ v4u pk8(const float (&f)[8]) { v4u o; o.x = pk2(f[0], f[1]); o.y = pk2(f[2], f[3]); o.z = pk2(f[4], f[5]); o.w = pk2(f[6], f[7]); return o; }
__device__ __forceinline__ v4u ld16(const bf16* p) { return *(const v4u*)p; }
__device__ __forceinline__ void st16(bf16* p, const v4u& v) { *(v4u*)p = v; }
__device__ __forceinline__ void ldf8(const float* p, float (&f)[8]) { const f32x4 a = *(const f32x4*)p, b = *(const f32x4*)(p + 4); f[0] = a[0]; f[1] = a[1]; f[2] = a[2]; f[3] = a[3]; f[4] = b[0]; f[5] = b[1]; f[6] = b[2]; f[7] = b[3]; }
__device__ __forceinline__ float sigmf(float x) { return __builtin_amdgcn_rcpf(1.0f + __builtin_amdgcn_exp2f(-1.4426950408889634f * x)); }
__device__ __forceinline__ float shx(float v, int m, int lane) { return __builtin_bit_cast(float, __builtin_amdgcn_ds_bpermute((lane ^ m) << 2, __builtin_bit_cast(int, v))); }
__device__ __forceinline__ float shx_from(float v, int src, int lane) { (void)lane; return __builtin_bit_cast(float, __builtin_amdgcn_ds_bpermute((src & 63) << 2, __builtin_bit_cast(int, v))); }
__device__ __forceinline__ int shxi(int v, int m, int lane) { return __builtin_amdgcn_ds_bpermute((lane ^ m) << 2, v); }
__device__ __forceinline__ int shupi(int v, int o, int lane) { return __builtin_amdgcn_ds_bpermute((lane >= o ? lane - o : lane) << 2, v); }
template <int CTRL> __device__ __forceinline__ float dppf(float v) { return __builtin_bit_cast(float, __builtin_amdgcn_update_dpp(0, __builtin_bit_cast(int, v), CTRL, 0xf, 0xf, true)); }
__device__ __forceinline__ float sum8(float v, int lane) { (void)lane; v += dppf<0xB1>(v); v += dppf<0x4E>(v); v += dppf<0x141>(v); return v; }
__device__ __forceinline__ float sum16(float v) { v += dppf<0xB1>(v); v += dppf<0x4E>(v); v += dppf<0x141>(v); v += dppf<0x140>(v); return v; }
__device__ __forceinline__ float max16(float v) { v = fmaxf(v, dppf<0xB1>(v)); v = fmaxf(v, dppf<0x4E>(v)); v = fmaxf(v, dppf<0x141>(v)); v = fmaxf(v, dppf<0x140>(v)); return v; }
__device__ __forceinline__ float sum_rows(float v) {
    { const auto r = __builtin_amdgcn_permlane16_swap(__builtin_bit_cast(unsigned, v), __builtin_bit_cast(unsigned, v), false, false); v = __uint_as_float(r[0]) + __uint_as_float(r[1]); }
    { const auto r = __builtin_amdgcn_permlane32_swap(__builtin_bit_cast(unsigned, v), __builtin_bit_cast(unsigned, v), false, false); v = __uint_as_float(r[0]) + __uint_as_float(r[1]); }
    return v; }
__device__ __forceinline__ float wave_sum(float v, int lane) { (void)lane; return sum_rows(sum16(v)); }


#define XB_TMO      128
#define XB_XCNT(j)  (256  + 64 * (j))
#define XB_XSUB(j)  (1280 + 64 * (j))
#define XB_XGEN(j)  (2304 + 64 * (j))
#define XB_TOP      3328
#define XB_TOPGEN   3392
#define XCD_BAR_WORDS 3456
#define XB_SPIN_CAP (1u << 22)

__device__ __forceinline__ unsigned xb_ld(unsigned* p)              { return __hip_atomic_load(p, __ATOMIC_RELAXED, __HIP_MEMORY_SCOPE_AGENT); }
__device__ __forceinline__ unsigned xb_add(unsigned* p, unsigned v) { return __hip_atomic_fetch_add(p, v, __ATOMIC_RELAXED, __HIP_MEMORY_SCOPE_AGENT); }
__device__ __forceinline__ unsigned xb_xcc_id() { return (unsigned)__builtin_amdgcn_s_getreg((3 << 11) | 20) & 0xFu; }
#define XB_SPIN(cond, bar) do { unsigned _sp = 0; while (cond) { __builtin_amdgcn_s_sleep(1); \
    if ((++_sp & 255u) == 0u) { if (xb_ld(&(bar)[XB_TMO])) break; if (_sp > XB_SPIN_CAP) { atomicAdd(&(bar)[XB_TMO], 1u); break; } } } } while (0)

struct XcdBarrier {
    unsigned* bar; unsigned x;
    volatile LAS unsigned* st;
};

__device__ __forceinline__ XcdBarrier xcd_barrier_post(unsigned* bar, volatile LAS unsigned* st) {
    XcdBarrier b; b.bar = bar; b.x = xb_xcc_id(); b.st = st;
    if (threadIdx.x == 0) (void)xb_add(&bar[XB_XCNT(b.x)], 1u);
    return b;
}
__device__ __forceinline__ void xcd_barrier_complete(unsigned* bar, unsigned x, unsigned& nloc, unsigned& nx) {
    const unsigned G = gridDim.x * gridDim.y * gridDim.z;
    unsigned sum, cnt, mine, sp = 0u;
    for (;;) {
        sum = 0u; cnt = 0u; mine = 0u;
#pragma unroll
        for (unsigned j = 0; j < 16; ++j) { const unsigned c = xb_ld(&bar[XB_XCNT(j)]); sum += c; cnt += (c > 0u) ? 1u : 0u; mine = (j == x) ? c : mine; }
        if (sum == G) break;
        __builtin_amdgcn_s_sleep(1);
        if ((++sp & 255u) == 0u) { if (xb_ld(&bar[XB_TMO])) break; if (sp > XB_SPIN_CAP) { atomicAdd(&bar[XB_TMO], 1u); break; } }
    }
    nloc = mine > 0u ? mine : 1u; nx = cnt > 0u ? cnt : 1u;
}

__device__ __forceinline__ void xcd_barrier(const XcdBarrier& b) {
    asm volatile("s_waitcnt vmcnt(0)" ::: "memory");
    __syncthreads();
    if (threadIdx.x == 0) {
        unsigned* bar = b.bar;
        __builtin_amdgcn_s_waitcnt(0);
        unsigned nloc = b.st[0], nx = b.st[1];
        if (nloc == 0u) { xcd_barrier_complete(bar, b.x, nloc, nx); b.st[0] = nloc; b.st[1] = nx; }
        const unsigned old = xb_add(&bar[XB_XSUB(b.x)], 1u);
        const unsigned gen = old / nloc;
        if (old + 1u == (gen + 1u) * nloc) {
            __builtin_amdgcn_fence(__ATOMIC_RELEASE, "agent");
            asm volatile("s_waitcnt vmcnt(0)" ::: "memory");
            const unsigned og = xb_add(&bar[XB_TOP], 1u);
            const unsigned tg = og / nx;
            if (og + 1u == (tg + 1u) * nx) xb_add(&bar[XB_TOPGEN], 1u);
            else XB_SPIN(xb_ld(&bar[XB_TOPGEN]) == tg, bar);
            __builtin_amdgcn_fence(__ATOMIC_ACQUIRE, "agent");
            xb_add(&bar[XB_XGEN(b.x)], 1u);
            asm volatile("s_waitcnt vmcnt(0)" ::: "memory");
        } else {
            XB_SPIN(xb_ld(&bar[XB_XGEN(b.x)]) == gen, bar);
            __builtin_amdgcn_fence(__ATOMIC_ACQUIRE, "agent");
            asm volatile("s_waitcnt vmcnt(0)" ::: "memory");
        }
    }
    __syncthreads();
}

__device__ __forceinline__ void tr_item(const float* W, int src_ld, int k0, int n0, bf16* WT, int dst_ld, int dst_row0, LAS float* scr, int lane, float sc = 1.0f) {
    float t_[32];
#pragma unroll
    for (int i = 0; i < 32; ++i) t_[i] = W[(size_t)(k0 + 2 * i + (lane >> 5)) * src_ld + n0 + (lane & 31)];
#pragma unroll
    for (int i = 0; i < 32; ++i) scr[(2 * i + (lane >> 5)) * 33 + (lane & 31)] = t_[i] * sc;
    LDS_WAIT(); asm volatile("" ::: "memory");
    const int c = lane & 7;
#pragma unroll
    for (int j = 0; j < 4; ++j) { const int n = (lane >> 3) + 8 * j; const LAS float* s = scr + (8 * c) * 33 + n;
        v4u o; o.x = pk2(s[0 * 33], s[1 * 33]); o.y = pk2(s[2 * 33], s[3 * 33]); o.z = pk2(s[4 * 33], s[5 * 33]); o.w = pk2(s[6 * 33], s[7 * 33]);
        *(GAS v4u*)(WT + (size_t)(dst_row0 + n) * dst_ld + k0 + 8 * c) = o; }
    LDS_WAIT(); asm volatile("" ::: "memory");
}
__device__ __forceinline__ void tr_item8(const float* W, int src_ld, int k0, int n0, unsigned char* WT8, int dst_ld, int dst_row0, float sc, LAS float* scr, int lane) {
    float t_[32];
#pragma unroll
    for (int i = 0; i < 32; ++i) t_[i] = W[(size_t)(k0 + 2 * i + (lane >> 5)) * src_ld + n0 + (lane & 31)];
#pragma unroll
    for (int i = 0; i < 32; ++i) scr[(2 * i + (lane >> 5)) * 33 + (lane & 31)] = t_[i] * sc;
    LDS_WAIT(); asm volatile("" ::: "memory");
#pragma unroll
    for (int j = 0; j < 2; ++j) { const int q = lane + 64 * j, n = q >> 2, c = q & 3; const LAS float* s = scr + (16 * c) * 33 + n; v4u o;
        o.x = pg8::pk4_fp8(s[0 * 33], s[1 * 33], s[2 * 33], s[3 * 33]); o.y = pg8::pk4_fp8(s[4 * 33], s[5 * 33], s[6 * 33], s[7 * 33]);
        o.z = pg8::pk4_fp8(s[8 * 33], s[9 * 33], s[10 * 33], s[11 * 33]); o.w = pg8::pk4_fp8(s[12 * 33], s[13 * 33], s[14 * 33], s[15 * 33]);
        *(GAS v4u*)(WT8 + (size_t)(dst_row0 + n) * dst_ld + k0 + 16 * c) = o; }
    LDS_WAIT(); asm volatile("" ::: "memory");
}
__device__ __forceinline__ void tr_job(const float* W, int src_ld, int col0, int K, int ncols, bf16* WT, int dst_ld, int dst_row0, LAS float* scr, int gw, int NGW, int lane, float sc = 1.0f) {
    const int nblk = ncols / 32, nitems = (K / 64) * nblk;
    for (int it = gw; it < nitems; it += NGW) { const int kb = it / nblk, nb = it - kb * nblk; tr_item(W, src_ld, 64 * kb, col0 + 32 * nb, WT, dst_ld, dst_row0 + 32 * nb, scr, lane, sc); }
}
__device__ __forceinline__ void zero_rows(bf16* WT, int row0, int nrows, int ld, int gtid, int NGT) {
    const int per = ld / 8, n = nrows * per;
    for (int i = gtid; i < n; i += NGT) *(GAS v4u*)(WT + (size_t)(row0 + i / per) * ld + (i % per) * 8) = (v4u){0u, 0u, 0u, 0u};
}

__device__ __forceinline__ void p0_prologue(const float* const* in, unsigned char* ws, LAS unsigned char* lds, int vcu, int G, int tid, int wave, int lane) {
    LAS float* scr = (LAS float*)(lds + RING_OFF + wave * 16384);
    const int gw = vcu * NWAVES + wave, NGW = G * NWAVES, gtid = vcu * NTHR + tid, NGT = G * NTHR;
    { f32x2* rope = (f32x2*)(ws + WS_ROPE);
      for (int i = gtid; i < SEQ * 32; i += NGT) { const int s = i >> 5, p = i & 31, fi = p & 15; const float freq = exp2f(-(float)(2 * fi) * (13.287712379549449f / 32.0f));
          const float pos = (p < 16) ? (float)(s >> 6) : (float)(s & 63); float sn, cs; sincosf(pos * freq, &sn, &cs); rope[i] = (f32x2){cs, sn}; } }
    for (int l = 0; l < 2; ++l) {
        unsigned char* wl = ws + WS_W + (size_t)l * WL_STRIDE;
        const float* w_in = in[2] + (size_t)l * DMODEL * NPROJ_IN;
        bf16* Win_t = (bf16*)(wl + WO_IN); bf16* Wg_t = (bf16*)(wl + WO_G); bf16* Wlo_t = (bf16*)(wl + WO_LORA); bf16* Wg2_t = (bf16*)(wl + WO_G2); bf16* PW_t = (bf16*)(wl + WO_PW);
        bf16* Wbr_t = (bf16*)(wl + WO_BR); bf16* Wout_t = (bf16*)(wl + WO_OUT);
        tr_job(w_in, NPROJ_IN, 0, DMODEL, 1920, Win_t, DMODEL, 0, scr, gw, NGW, lane);
        tr_job(w_in, NPROJ_IN, 1920, DMODEL, 512, Win_t, DMODEL, COL_POOL, scr, gw, NGW, lane);
        { const int nblk = 768 / 32, nitems = (DMODEL / 64) * nblk; unsigned char* Wq8 = wl + WO_QKV8;
          for (int it = gw; it < nitems; it += NGW) { const int kb = it / nblk, nb = it - kb * nblk; tr_item8(w_in, NPROJ_IN, 64 * kb, 2432 + 32 * nb, Wq8, 2048, 32 * nb, 32.0f, scr, lane); } }
        { const int nblk = 3072 / 32, nitems = (DMODEL / 64) * nblk;
          for (int it = gw; it < nitems; it += NGW) { const int kb = it / nblk, nb = it - kb * nblk; tr_item8(w_in, NPROJ_IN, 64 * kb, 3200 + 32 * nb, (unsigned char*)Wg_t, DMODEL, 32 * nb, 32.0f, scr, lane); } }
        if (l == 0) zero_rows(Win_t, 1920, 128, DMODEL, gtid, NGT);
        else { tr_job(in[16], 32, 0, DMODEL, 32, Win_t, DMODEL, COL_VL, scr, gw, NGW, lane); zero_rows(Win_t, 1952, 96, DMODEL, gtid, NGT); }
        tr_job(in[22] + (size_t)l * 512 * 1024, 1024, 0, 512, 1024, Wbr_t, 512, 0, scr, gw, NGW, lane);
        tr_job(in[23] + (size_t)l * 512 * 1024, 1024, 0, 512, 1024, Wbr_t, 512, 1024, scr, gw, NGW, lane);
        #ifndef PROBE_ATT_AMP
#define PROBE_ATT_AMP 1.0f
#endif
        { const float* wa = in[24] + (size_t)l * 512 * 1024; unsigned char* Wa8 = wl + WO_BRA8;
          const int nblk = 1024 / 32, nitems = (512 / 64) * nblk;
          for (int it = gw; it < nitems; it += NGW) { const int kb = it / nblk, nb = it - kb * nblk; tr_item8(wa, 1024, 64 * kb, 32 * nb, Wa8, 1024, 32 * nb, 32.0f, scr, lane); } }
        tr_job(in[25] + (size_t)l * 1024 * 1024, 1024, 0, 1024, 1024, Wout_t, 1024, 0, scr, gw, NGW, lane);
        { const float* w2 = in[6] + (size_t)l * 2 * 64 * 512; const float* a2 = in[8] + (size_t)l * 2 * 64 * 512;
          for (int i = gtid; i < 2048 * 16; i += NGT) { const int n = i >> 4, k0 = (i & 15) * 8; const bool isa = n >= 1024; const int nn = n & 1023, dir = nn >> 9, c = nn & 511, kb = 64 * dir;
              float f[8];
#pragma unroll
              for (int j = 0; j < 8; ++j) { const int k = k0 + j; f[j] = (k >= kb && k < kb + 64) ? (isa ? a2 : w2)[((size_t)dir * 64 + (k - kb)) * 512 + c] : 0.f; }
              *(GAS v4u*)(Wlo_t + (size_t)n * 128 + k0) = pk8(f); } }
        { const float* g2 = in[9] + (size_t)l * 128 * 512;
          for (int i = gtid; i < 512 * 16; i += NGT) { const int n = i >> 4, k0 = (i & 15) * 8; float f[8];
#pragma unroll
              for (int j = 0; j < 8; ++j) f[j] = g2[(size_t)(k0 + j) * 512 + n];
              *(GAS v4u*)(Wg2_t + (size_t)n * 128 + k0) = pk8(f); } }
        { const float* pw = in[18] + (size_t)l * 4 * 128 * 128;
          for (int i = gtid; i < 512 * 64; i += NGT) { const int n = i >> 6, k0 = (i & 63) * 8, g = n >> 7, d = n & 127; float f[8];
#pragma unroll
              for (int j = 0; j < 8; ++j) { const int k = k0 + j; f[j] = ((k >> 7) == g) ? pw[((size_t)g * 128 + (k & 127)) * 128 + d] : 0.f; }
              *(GAS v4u*)(PW_t + (size_t)n * 512 + k0) = pk8(f); } }
    }
}
__device__ __forceinline__ void convert_experts_items(const float* const* in, int l, unsigned char* ws, LAS unsigned char* lds, int it0, int nit, int wave, int lane) {
    LAS float* scr = (LAS float*)(lds + RING_OFF + wave * 16384);
    bf16* Wgu = (bf16*)(ws + A_WGU); bf16* Wd = (bf16*)(ws + A_WD);
    const float* eg = in[28] + (size_t)l * NEXP * 1024 * 1024; const float* eu = in[29] + (size_t)l * NEXP * 1024 * 1024; const float* ed = in[30] + (size_t)l * NEXP * 1024 * 1024;
    for (int it = it0 + wave; it < it0 + nit; it += NWAVES) {
        const int mat = it / (NEXP * 512), r = it - mat * (NEXP * 512), e = r >> 9, q = r & 511, kb = q >> 5, nb = q & 31, n0 = 32 * nb;
        if (mat == 0)      tr_item8(eg + (size_t)e * 1024 * 1024, 1024, 64 * kb, n0, (unsigned char*)Wgu, 1024, e * 2048 + (n0 >> 7) * 256 + (n0 & 127), 32.0f, scr, lane);
        else if (mat == 1) tr_item8(eu + (size_t)e * 1024 * 1024, 1024, 64 * kb, n0, (unsigned char*)Wgu, 1024, e * 2048 + (n0 >> 7) * 256 + 128 + (n0 & 127), 32.0f, scr, lane);
        else               tr_item8(ed + (size_t)e * 1024 * 1024, 1024, 64 * kb, n0, (unsigned char*)Wd, 1024, e * 1024 + n0, 32.0f, scr, lane);
    }
}

template <int MODE, bool XB = false, int NR = 2>
__device__ __forceinline__ void norm_rows(const float* xsrc, float* xdst, bool combine, const bf16* YE, const int* INV, const float* gain, bf16* obf, float* of32, int gw, int NGW, int lane, unsigned char* o8 = nullptr) {
    f32x4 g[4];
#pragma unroll
    for (int j = 0; j < 4; ++j) g[j] = *(const f32x4*)(gain + 4 * lane + 256 * j);
    for (int t0 = gw; t0 < M; t0 += NR * NGW) {
        f32x4 v[NR][4]; int inv[NR];
#pragma unroll
        for (int q = 0; q < NR; ++q) { const int t = t0 + q * NGW;
            if (XB) { const v2u* xr = (const v2u*)((const bf16*)xsrc + (size_t)t * XBP) + lane;
#pragma unroll
                for (int j = 0; j < 4; ++j) { const v2u w = xr[64 * j]; v[q][j] = (f32x4){__uint_as_float(w.x << 16), __uint_as_float(w.x & 0xffff0000u), __uint_as_float(w.y << 16), __uint_as_float(w.y & 0xffff0000u)}; } }
            else { const f32x4* xr = (const f32x4*)(xsrc + (size_t)t * DMODEL) + lane;
#pragma unroll
                for (int j = 0; j < 4; ++j) v[q][j] = xr[64 * j]; }
            inv[q] = (combine && lane < NEXP) ? INV[(size_t)t * NEXP + lane] : -1; }
#pragma unroll
        for (int q = 0; q < NR; ++q) { const int t = t0 + q * NGW;
            if (combine) {
                const int b = t / SEQ;
#pragma unroll
                for (int e_unused = 0; e_unused < 1; ++e_unused) {
                    unsigned mk = (unsigned)(__builtin_amdgcn_ballot_w64(inv[q] >= 0) & 0xffffull);
                    while (mk) { int es[4]; v2u w[4][4];
#pragma unroll
                        for (int u = 0; u < 4; ++u) { es[u] = mk ? (int)__builtin_ctz(mk) : -1; mk = mk ? (mk & (mk - 1u)) : 0u; }
#pragma unroll
                        for (int u = 0; u < 4; ++u) if (es[u] >= 0) { const int c = __builtin_amdgcn_readlane(inv[q], es[u]); const bf16* yr = YE + ((size_t)((b * NEXP + es[u]) * CAP + c)) * DMODEL + 4 * lane;
#pragma unroll
                            for (int j = 0; j < 4; ++j) w[u][j] = *(const v2u*)(yr + 256 * j); }
#pragma unroll
                        for (int u = 0; u < 4; ++u) if (es[u] >= 0) {
#pragma unroll
                            for (int j = 0; j < 4; ++j) { v[q][j][0] += __uint_as_float(w[u][j].x << 16); v[q][j][1] += __uint_as_float(w[u][j].x & 0xffff0000u); v[q][j][2] += __uint_as_float(w[u][j].y << 16); v[q][j][3] += __uint_as_float(w[u][j].y & 0xffff0000u); } } } }
                if (xdst) {
                    if (XB) { v2u* xw = (v2u*)((bf16*)xdst + (size_t)t * XBP) + lane;
#pragma unroll
                        for (int j = 0; j < 4; ++j) xw[64 * j] = (v2u){pk2(v[q][j][0], v[q][j][1]), pk2(v[q][j][2], v[q][j][3])}; }
                    else { f32x4* xw = (f32x4*)(xdst + (size_t)t * DMODEL) + lane;
#pragma unroll
                        for (int j = 0; j < 4; ++j) xw[64 * j] = v[q][j]; } }
            }
            float ss = 0.f;
#pragma unroll
            for (int j = 0; j < 4; ++j) ss += (v[q][j][0] * v[q][j][0] + v[q][j][1] * v[q][j][1]) + (v[q][j][2] * v[q][j][2] + v[q][j][3] * v[q][j][3]);
            const float rstd = __builtin_amdgcn_rsqf(wave_sum(ss, lane) * (1.0f / DMODEL) + 1e-6f);
            if (MODE == 2) { unsigned* o4 = (unsigned*)((unsigned char*)obf + (size_t)t * DMODEL) + lane;
#pragma unroll
                for (int j = 0; j < 4; ++j) { const f32x4 o = v[q][j] * rstd * g[j]; o4[64 * j] = pg8::pk4_fp8(o[0], o[1], o[2], o[3]); } }
            else if (MODE == 0) { v2u* ob_ = (v2u*)(obf + (size_t)t * DMODEL) + lane;
#pragma unroll
                for (int j = 0; j < 4; ++j) { const f32x4 o = v[q][j] * rstd * g[j]; ob_[64 * j] = (v2u){pk2(o[0], o[1]), pk2(o[2], o[3])}; }
                if (o8) { unsigned* e4 = (unsigned*)(o8 + (size_t)t * 4096) + lane;
#pragma unroll
                    for (int j = 0; j < 4; ++j) { const f32x4 o = v[q][j] * rstd * g[j]; e4[64 * j] = pg8::pk4_fp8(o[0], o[1], o[2], o[3]); } } }
            else { f32x4* o4 = (f32x4*)(of32 + (size_t)t * DMODEL) + lane;
#pragma unroll
                for (int j = 0; j < 4; ++j) o4[64 * j] = v[q][j] * rstd * g[j]; }
        }
    }
}

__device__ __forceinline__ v2u pk8_e4m3(const float (&f)[8]) { v2u o; o.x = pg8::pk4_fp8(f[0], f[1], f[2], f[3]); o.y = pg8::pk4_fp8(f[4], f[5], f[6], f[7]); return o; }
__device__ __forceinline__ void p3_prep(int l, const float* const* in, unsigned char* ws, LAS unsigned char* lds, int gw, int NGW, int tid, int lane) {
    const bf16* PRJ = (const bf16*)(ws + A_PRJ);
    bf16* R = (bf16*)(ws + A_R); bf16* KS = (bf16*)(ws + A_KS); bf16* VS = (bf16*)(ws + A_VS); bf16* VF = (bf16*)(ws + WS_VF); bf16* TW = (bf16*)(ws + A_TW); bf16* PL = (bf16*)(ws + A_PL);
    unsigned char* Q8 = ws + A_Q; unsigned char* K8 = ws + A_K; unsigned char* Vt8 = ws + A_V;
    const f32x2* rope = (const f32x2*)(ws + WS_ROPE);
    LAS float* v2L = (LAS float*)(lds + RING_OFF);
    LAS float* mpL = (LAS float*)(lds + RING_OFF + 65536); LAS float* mnL = mpL + 1920;
    if (l == 1) { for (int i = tid; i < 32 * 512; i += NTHR) v2L[i] = in[17][i]; }
    LAS float* gqL = mnL + 1920; LAS float* gkL = gqL + 64; LAS float* v0L = gkL + 64;
    for (int i = tid; i < 1920; i += NTHR) { mpL[i] = in[3][(size_t)l * 1920 + i]; mnL[i] = in[4][(size_t)l * 1920 + i]; }
    if (tid < 64) { gqL[tid] = in[20][(size_t)l * 64 + tid]; gkL[tid] = in[21][(size_t)l * 64 + tid]; }
    v0L[tid] = in[15][tid];
    __syncthreads();
    const int gi = lane >> 4, lo = 1 << gi, hi = lo - 1, pcol = COL_POOL + lane * 8;
    const float tw_k = (lane < 16) ? -2.0f * 1.4426950408889634f : -1.4426950408889634f, tw_m = (lane < 16) ? 2.0f : 1.0f, tw_c = (lane < 16) ? -1.0f : 0.0f; const bool tw_id = (lane >= 16 && lane < 32);
#define P3_LD(base, boff) (*(const v4u*)((const unsigned char*)(base) + (boff)))
#define P3_ST(base, boff, val) (*(v4u*)((unsigned char*)(base) + (boff)) = (val))
    const unsigned ob_nxt0 = (unsigned)((17 * NPJ + lane * 8) * 2), ob_nxt3 = (unsigned)((17 * NPJ + (lane < 48 ? (lane + 192) * 8 : 0)) * 2);
    const unsigned ob_self = (unsigned)((16 * NPJ + pcol) * 2), ob_in = (unsigned)(((17 + hi) * NPJ + pcol) * 2), ob_out = (unsigned)(((16 - lo) * NPJ + pcol) * 2);
    const unsigned ob_q = (unsigned)((16 * NPJ + COL_Q + lane * 8) * 2), ob_k = (unsigned)((16 * NPJ + COL_K + (lane & 15) * 8) * 2), ob_rope = (unsigned)((lane & 7) * 32), ob_l16 = (unsigned)(lane * 16);
    const unsigned ob_q8 = (unsigned)((lane >> 3) * 128 + (lane & 7) * 8), ob_k8 = (unsigned)(((lane >> 3) & 1) * SEQ * 64 + (lane & 7) * 8);
    for (int run = gw; run < M / 32; run += NGW) {
        const int t0 = run * 32, s0 = t0 & (SEQ - 1);
        const bf16* row0 = PRJ + (size_t)t0 * NPJ;
        { unsigned char* vrow = Vt8 + ((size_t)((t0 >> 13) * 2 + (lane >> 5)) * 64 + 2 * (lane & 31)) * SEQ + s0;
#pragma unroll
          for (int hf = 0; hf < 2; ++hf) { unsigned w[16];
#pragma unroll
              for (int i = 0; i < 16; ++i) w[i] = *(const unsigned*)(row0 + (size_t)(hf * 16 + i) * NPJ + COL_V + 2 * lane);
              v4u a, b_;
#pragma unroll
              for (int j = 0; j < 4; ++j) {
                  a[j] = pg8::pk4_fp8(__uint_as_float(w[4 * j] << 16), __uint_as_float(w[4 * j + 1] << 16), __uint_as_float(w[4 * j + 2] << 16), __uint_as_float(w[4 * j + 3] << 16));
                  b_[j] = pg8::pk4_fp8(__uint_as_float(w[4 * j] & 0xffff0000u), __uint_as_float(w[4 * j + 1] & 0xffff0000u), __uint_as_float(w[4 * j + 2] & 0xffff0000u), __uint_as_float(w[4 * j + 3] & 0xffff0000u)); }
              *(v4u*)(vrow + hf * 16) = a; *(v4u*)(vrow + SEQ + hf * 16) = b_; } }
        v4u prv[4], cur[4];
#pragma unroll
        for (int j = 0; j < 4; ++j) { const int c8 = lane + 64 * j, col = (c8 < 240 ? c8 : 0) * 8;
            prv[j] = (s0 > 0) ? ld16(row0 - NPJ + col) : (v4u){0u, 0u, 0u, 0u}; cur[j] = ld16(row0 + col); }
        float psum[8]; int pcnt = 0;
#pragma unroll
        for (int i = 0; i < 8; ++i) psum[i] = 0.f;
#pragma unroll
        for (int hf = 0; hf < 2; ++hf) { v4u pw_[8];
#pragma unroll
            for (int q = 0; q < 8; ++q) { const int dd = hf * 8 + q - 8; const bool ok = (dd >= -lo && dd <= hi && s0 + dd >= 0); pw_[q] = ld16(row0 + (long)(ok ? dd : 0) * NPJ + pcol); }
#pragma unroll
            for (int q = 0; q < 8; ++q) asm volatile("" : "+v"(pw_[q]));
#pragma unroll
            for (int q = 0; q < 8; ++q) { const int dd = hf * 8 + q - 8; const bool ok = (dd >= -lo && dd <= hi && s0 + dd >= 0); float x[8]; unp8(pw_[q], x); const float m_ = ok ? 1.0f : 0.0f; pcnt += ok ? 1 : 0;
#pragma unroll
                for (int i = 0; i < 8; ++i) psum[i] += m_ * x[i]; } }
        for (int ti = 0; ti < 32; ++ti) {
            const int t = t0 + ti, s = s0 + ti; const bf16* rowp = row0 + (size_t)ti * NPJ;
            v4u nxt[4];
            const bf16* rowq = rowp - 16 * NPJ;
#pragma unroll
            for (int j = 0; j < 4; ++j) nxt[j] = (s + 1 < SEQ) ? (j < 3 ? P3_LD(rowq + 512 * j, ob_nxt0) : P3_LD(rowq, ob_nxt3)) : (v4u){0u, 0u, 0u, 0u};
            const v4u pself = P3_LD(rowq, ob_self);
            const bool padd = (s + 1 + hi < SEQ), psub = (s - lo >= 0);
            const v4u pin = padd ? P3_LD(rowq, ob_in) : (v4u){0u, 0u, 0u, 0u};
            const v4u pout = psub ? P3_LD(rowq, ob_out) : (v4u){0u, 0u, 0u, 0u};
            const v4u qraw = P3_LD(rowq, ob_q), kraw = P3_LD(rowq, ob_k);
            const unsigned char* ropes = (const unsigned char*)(rope + (size_t)s * 32); const f32x4 rp0 = *(const f32x4*)(ropes + ob_rope), rp1 = *(const f32x4*)(ropes + ob_rope + 16);
            { float self[8], o[8]; unp8(pself, self); const float ic = __builtin_amdgcn_rcpf((float)pcnt);
#pragma unroll
              for (int i = 0; i < 8; ++i) o[i] = psum[i] * ic - self[i];
              P3_ST(PL + (size_t)t * 512, ob_l16, pk8(o));
              float xin[8], xout[8]; unp8(pin, xin); unp8(pout, xout);
#pragma unroll
              for (int i = 0; i < 8; ++i) psum[i] += xin[i] - xout[i];
              pcnt += (padd ? 1 : 0) - (psub ? 1 : 0); }
            { float x[8], o[8]; const float cs[8] = {rp0[0], rp0[1], rp0[2], rp0[3], rp1[0], rp1[1], rp1[2], rp1[3]};
              unp8(qraw, x);
              float ss = 0.f;
#pragma unroll
              for (int i = 0; i < 8; ++i) ss += x[i] * x[i];
              ss = sum8(ss, lane); const float rms = __builtin_amdgcn_rsqf(ss * (1.0f / 64.0f) + 1e-6f);
#pragma unroll
              for (int i = 0; i < 8; ++i) x[i] = x[i] * rms * gqL[(lane & 7) * 8 + i];
#pragma unroll
              for (int ii = 0; ii < 4; ++ii) { o[2 * ii] = (x[2 * ii] * cs[2 * ii] - x[2 * ii + 1] * cs[2 * ii + 1]) * (C2Q * 16.0f); o[2 * ii + 1] = (x[2 * ii] * cs[2 * ii + 1] + x[2 * ii + 1] * cs[2 * ii]) * (C2Q * 16.0f); }
              *(v2u*)(Q8 + (size_t)t * 1024 + ob_q8) = pk8_e4m3(o);
              unp8(kraw, x);
              ss = 0.f;
#pragma unroll
              for (int i = 0; i < 8; ++i) ss += x[i] * x[i];
              ss = sum8(ss, lane); const float rmk = __builtin_amdgcn_rsqf(ss * (1.0f / 64.0f) + 1e-6f);
#pragma unroll
              for (int i = 0; i < 8; ++i) x[i] = x[i] * rmk * gkL[(lane & 7) * 8 + i];
#pragma unroll
              for (int ii = 0; ii < 4; ++ii) { o[2 * ii] = x[2 * ii] * cs[2 * ii] - x[2 * ii + 1] * cs[2 * ii + 1]; o[2 * ii + 1] = x[2 * ii] * cs[2 * ii + 1] + x[2 * ii + 1] * cs[2 * ii]; }
              if (lane < 16) *(v2u*)(K8 + ((size_t)((t >> 13) * 2) * SEQ + s) * 64 + ob_k8) = pk8_e4m3(o); }
            asm volatile("" ::: "memory");
#pragma unroll
            for (int j = 0; j < 4; ++j) {
                const int c8 = lane + 64 * j, col = c8 * 8;
                if (c8 < 240) {
                    float cu[8], pv[8], nx[8], ps[8];
                    unp8(cur[j], cu); unp8(prv[j], pv); unp8(nxt[j], nx);
                    float a_[8], b_[8]; { const f32x4 m0 = *(const LAS f32x4*)(mpL + col), m1 = *(const LAS f32x4*)(mpL + col + 4), n0 = *(const LAS f32x4*)(mnL + col), n1 = *(const LAS f32x4*)(mnL + col + 4);
                        a_[0] = m0[0]; a_[1] = m0[1]; a_[2] = m0[2]; a_[3] = m0[3]; a_[4] = m1[0]; a_[5] = m1[1]; a_[6] = m1[2]; a_[7] = m1[3]; b_[0] = n0[0]; b_[1] = n0[1]; b_[2] = n0[2]; b_[3] = n0[3]; b_[4] = n1[0]; b_[5] = n1[1]; b_[6] = n1[2]; b_[7] = n1[3]; }
#pragma unroll
                    for (int i = 0; i < 8; ++i) ps[i] = cu[i] + a_[i] * (pv[i] - cu[i]) + b_[i] * (nx[i] - cu[i]);
                    if (j == 0) P3_ST(R + (size_t)t * 512, ob_l16, pk8(ps));
                    else if (j == 1) P3_ST(KS + (size_t)t * 512, ob_l16, pk8(ps));
                    else if (j == 2) { const int cc = col - 1024;
                        if (l == 0) { const v4u o = pk8(ps); P3_ST(VS + (size_t)t * 512, ob_l16, o); P3_ST(VF + (size_t)t * 512, ob_l16, o); }
                        else { float vl[32], mx[8], vf[8];
                            { float t8[8]; unp8(ld16(rowp + COL_VL), t8);
#pragma unroll
                              for (int i = 0; i < 8; ++i) vl[i] = t8[i];
                              unp8(ld16(rowp + COL_VL + 8), t8);
#pragma unroll
                              for (int i = 0; i < 8; ++i) vl[8 + i] = t8[i];
                              unp8(ld16(rowp + COL_VL + 16), t8);
#pragma unroll
                              for (int i = 0; i < 8; ++i) vl[16 + i] = t8[i];
                              unp8(ld16(rowp + COL_VL + 24), t8);
#pragma unroll
                              for (int i = 0; i < 8; ++i) vl[24 + i] = t8[i]; }
                            { const f32x4 z0 = *(const LAS f32x4*)(v0L + cc), z1 = *(const LAS f32x4*)(v0L + cc + 4); mx[0] = z0[0]; mx[1] = z0[1]; mx[2] = z0[2]; mx[3] = z0[3]; mx[4] = z1[0]; mx[5] = z1[1]; mx[6] = z1[2]; mx[7] = z1[3]; }
#pragma unroll
                            for (int k = 0; k < 32; ++k) { const f32x4 w0 = *(const LAS f32x4*)(v2L + k * 512 + cc), w1 = *(const LAS f32x4*)(v2L + k * 512 + cc + 4);
                                mx[0] += vl[k] * w0[0]; mx[1] += vl[k] * w0[1]; mx[2] += vl[k] * w0[2]; mx[3] += vl[k] * w0[3]; mx[4] += vl[k] * w1[0]; mx[5] += vl[k] * w1[1]; mx[6] += vl[k] * w1[2]; mx[7] += vl[k] * w1[3]; }
                            unp8(P3_LD(VF + (size_t)t * 512, ob_l16), vf);
#pragma unroll
                            for (int i = 0; i < 8; ++i) ps[i] = ps[i] + (vf[i] - ps[i]) * sigmf(mx[i]);
                            P3_ST(VS + (size_t)t * 512, ob_l16, pk8(ps)); } }
                    else { float o[8];
#pragma unroll
                        for (int i = 0; i < 8; ++i) { const float x = ps[i];
                            const float sg = __builtin_amdgcn_rcpf(1.0f + __builtin_amdgcn_exp2f(tw_k * __builtin_amdgcn_fmed3f(x, -15.f, 15.f)));
                            const float y = tw_m * sg + tw_c; o[i] = tw_id ? x : y; }
                        P3_ST(TW + (size_t)t * 384, ob_l16, pk8(o)); }
                }
                prv[j] = cur[j]; cur[j] = nxt[j];
            }
        }
    }
#undef P3_LD
#undef P3_ST
}

__device__ __forceinline__ float dpp_add(float x, float y) { return x + y; }
template <int CTRL> __device__ __forceinline__ float dppx(float x) { return __builtin_bit_cast(float, __builtin_amdgcn_update_dpp(0, __builtin_bit_cast(int, x), CTRL, 0xF, 0xF, true)); }
__device__ __forceinline__ float red16(float x) {
    x += dppx<0xB1>(x);
    x += dppx<0x4E>(x);
    x += dppx<0x141>(x);
    x += dppx<0x140>(x);
    return x;
}
__device__ __forceinline__ void scan_chain(int l, int chain, const float* const* in, unsigned char* ws, LAS unsigned char* lds, int tid, int wave, int lane) {
    const int d = chain >> 6, b = (chain >> 3) & 7, h = chain & 7;
    const bf16* R = (const bf16*)(ws + A_R); const bf16* KS = (const bf16*)(ws + A_KS); const bf16* VS = (const bf16*)(ws + A_VS);
    const bf16* LW = (const bf16*)(ws + A_LW); const bf16* AA = (const bf16*)(ws + A_AA);
    bf16* YS = (bf16*)(ws + (d ? A_YSB : A_YSF)); float* CFB = (float*)(ws + WS_CFB) + (size_t)d * M * 8;
    LAS float* kkL = (LAS float*)(lds + RING_OFF); LAS float* wL = kkL + 4096; LAS float* nbL = wL + 4096; LAS float* kdL = nbL + 4096; LAS float* rL = kdL + 4096; LAS float* vL = rL + 4096; LAS float* yL = vL + 4096;
    const int ps = tid >> 3, pc = tid & 7;
    const int pl = lane >> 4, jg = lane & 15, i0 = 2 * (4 * wave + pl);
    float kkc[8], kac[8], rkc[8];
    ldf8(in[10] + (size_t)l * 512 + h * 64 + pc * 8, kkc); ldf8(in[11] + (size_t)l * 512 + h * 64 + pc * 8, kac); ldf8(in[12] + (size_t)l * 512 + h * 64 + pc * 8, rkc);
    float st[2][4];
#pragma unroll
    for (int r = 0; r < 2; ++r)
#pragma unroll
        for (int j = 0; j < 4; ++j) st[r][j] = 0.f;
    v4u rr, kr, vr, lwr, ar;
    { const int tok = d ? (SEQ - 1 - ps) : ps; const size_t t = (size_t)b * SEQ + tok;
      rr = ld16(R + t * 512 + h * 64 + pc * 8); kr = ld16(KS + t * 512 + h * 64 + pc * 8); vr = ld16(VS + t * 512 + h * 64 + pc * 8);
      lwr = ld16(LW + t * 1024 + d * 512 + h * 64 + pc * 8); ar = ld16(AA + t * 1024 + d * 512 + h * 64 + pc * 8); }
    for (int blk = 0; blk < SEQ / 64; ++blk) {
        const int tokp = d ? (SEQ - 1 - (blk * 64 + ps)) : (blk * 64 + ps); const size_t tp = (size_t)b * SEQ + tokp;
        { float r8[8], k8[8], v8[8], lw8[8], a8[8], kk8[8], o[8];
          unp8(rr, r8); unp8(kr, k8); unp8(vr, v8); unp8(lwr, lw8); unp8(ar, a8);
          float ss = 0.f;
#pragma unroll
          for (int i = 0; i < 8; ++i) { kk8[i] = k8[i] * kkc[i]; ss += kk8[i] * kk8[i]; }
          ss = sum8(ss, lane); const float inv = 1.0f / fmaxf(sqrtf(ss), 1e-12f);
          float cf = 0.f;
#pragma unroll
          for (int i = 0; i < 8; ++i) { kk8[i] *= inv; const float kd = k8[i] * (1.0f + (a8[i] - 1.0f) * kac[i]); cf += r8[i] * kd * rkc[i]; o[i] = kd; }
          cf = sum8(cf, lane); if (pc == 0) CFB[tp * 8 + h] = cf;
          LAS float* p;
          p = kkL + ps * 64 + pc * 8; *(LAS f32x4*)p = (f32x4){kk8[0], kk8[1], kk8[2], kk8[3]}; *(LAS f32x4*)(p + 4) = (f32x4){kk8[4], kk8[5], kk8[6], kk8[7]};
          p = kdL + ps * 64 + pc * 8; *(LAS f32x4*)p = (f32x4){o[0], o[1], o[2], o[3]}; *(LAS f32x4*)(p + 4) = (f32x4){o[4], o[5], o[6], o[7]};
          p = wL + ps * 64 + pc * 8; *(LAS f32x4*)p = (f32x4){__expf(lw8[0]), __expf(lw8[1]), __expf(lw8[2]), __expf(lw8[3])}; *(LAS f32x4*)(p + 4) = (f32x4){__expf(lw8[4]), __expf(lw8[5]), __expf(lw8[6]), __expf(lw8[7])};
          p = nbL + ps * 64 + pc * 8; *(LAS f32x4*)p = (f32x4){-kk8[0] * a8[0], -kk8[1] * a8[1], -kk8[2] * a8[2], -kk8[3] * a8[3]}; *(LAS f32x4*)(p + 4) = (f32x4){-kk8[4] * a8[4], -kk8[5] * a8[5], -kk8[6] * a8[6], -kk8[7] * a8[7]};
          p = rL + ps * 64 + pc * 8; *(LAS f32x4*)p = (f32x4){r8[0], r8[1], r8[2], r8[3]}; *(LAS f32x4*)(p + 4) = (f32x4){r8[4], r8[5], r8[6], r8[7]};
          p = vL + ps * 64 + pc * 8; *(LAS f32x4*)p = (f32x4){v8[0], v8[1], v8[2], v8[3]}; *(LAS f32x4*)(p + 4) = (f32x4){v8[4], v8[5], v8[6], v8[7]}; }
        __syncthreads();
        if (blk + 1 < SEQ / 64) { const int tok = d ? (SEQ - 1 - ((blk + 1) * 64 + ps)) : ((blk + 1) * 64 + ps); const size_t t = (size_t)b * SEQ + tok;
            rr = ld16(R + t * 512 + h * 64 + pc * 8); kr = ld16(KS + t * 512 + h * 64 + pc * 8); vr = ld16(VS + t * 512 + h * 64 + pc * 8);
            lwr = ld16(LW + t * 1024 + d * 512 + h * 64 + pc * 8); ar = ld16(AA + t * 1024 + d * 512 + h * 64 + pc * 8); }
#pragma unroll 2
        for (int s = 0; s < 64; ++s) {
            const f32x4 kk4 = *(const LAS f32x4*)(kkL + s * 64 + jg * 4), w4 = *(const LAS f32x4*)(wL + s * 64 + jg * 4), nb4 = *(const LAS f32x4*)(nbL + s * 64 + jg * 4);
            const f32x4 kd4 = *(const LAS f32x4*)(kdL + s * 64 + jg * 4), r4 = *(const LAS f32x4*)(rL + s * 64 + jg * 4);
            const f32x2 v2 = *(const LAS f32x2*)(vL + s * 64 + i0);
            float y[2];
#pragma unroll
            for (int r = 0; r < 2; ++r) {
                float dq = (st[r][0] * kk4[0] + st[r][1] * kk4[1]) + (st[r][2] * kk4[2] + st[r][3] * kk4[3]);
                dq = red16(dq);
                const float vv = v2[r];
#pragma unroll
                for (int j = 0; j < 4; ++j) st[r][j] = st[r][j] * w4[j] + dq * nb4[j] + vv * kd4[j];
                float yq = (st[r][0] * r4[0] + st[r][1] * r4[1]) + (st[r][2] * r4[2] + st[r][3] * r4[3]);
                y[r] = red16(yq);
            }
            if (jg == 0) *(LAS f32x2*)(yL + s * 64 + i0) = (f32x2){y[0], y[1]};
        }
        __syncthreads();
        { const LAS float* p = yL + ps * 64 + pc * 8; const f32x4 a = *(const LAS f32x4*)p, c = *(const LAS f32x4*)(p + 4);
          v4u o; o.x = pk2(a[0], a[1]); o.y = pk2(a[2], a[3]); o.z = pk2(c[0], c[1]); o.w = pk2(c[2], c[3]);
          st16(YS + tp * 512 + h * 64 + pc * 8, o); }
    }
    __syncthreads();
}

__device__ __forceinline__ void p6a_rows(int l, const float* const* in, unsigned char* ws, int gw, int NGW, int lane) {
    const bf16* YSF = (const bf16*)(ws + A_YSF); const bf16* YSB = (const bf16*)(ws + A_YSB); const bf16* VS = (const bf16*)(ws + A_VS); const bf16* Gb = (const bf16*)(ws + A_G);
    const float* CFB = (const float*)(ws + WS_CFB); bf16* YA = (bf16*)(ws + A_YA);
    float lw[8], lb[8]; ldf8(in[13] + (size_t)l * 512 + lane * 8, lw); ldf8(in[14] + (size_t)l * 512 + lane * 8, lb);
    const int head = lane >> 3;
    for (int t0 = gw; t0 < M; t0 += 4 * NGW) {
        v4u ra[4], rb_[4], rv[4], rg[4]; float cfa[4], cfb[4];
#pragma unroll
        for (int q = 0; q < 4; ++q) { const size_t t = (size_t)(t0 + q * NGW);
            ra[q] = ld16(YSF + t * 512 + lane * 8); rb_[q] = ld16(YSB + t * 512 + lane * 8); rv[q] = ld16(VS + t * 512 + lane * 8); rg[q] = ld16(Gb + t * 512 + lane * 8);
            cfa[q] = CFB[t * 8 + head]; cfb[q] = CFB[((size_t)M + t) * 8 + head]; }
#pragma unroll
        for (int q = 0; q < 4; ++q) { const size_t t = (size_t)(t0 + q * NGW);
            float yf[8], yb[8], v[8], g[8], o[8];
            unp8(ra[q], yf); unp8(rb_[q], yb); unp8(rv[q], v); unp8(rg[q], g);
            const float cf = cfa[q] + cfb[q];
            float sm = 0.f;
#pragma unroll
            for (int i = 0; i < 8; ++i) { yf[i] += yb[i]; sm += yf[i]; }
            const float mu = sum8(sm, lane) * (1.0f / 64.0f); float sq = 0.f;
#pragma unroll
            for (int i = 0; i < 8; ++i) { yf[i] -= mu; sq += yf[i] * yf[i]; }
            const float rs = __builtin_amdgcn_rsqf(sum8(sq, lane) * (1.0f / 64.0f) + 64e-5f);
#pragma unroll
            for (int i = 0; i < 8; ++i) o[i] = (yf[i] * rs * lw[i] + lb[i] + cf * v[i]) * g[i];
            st16(YA + t * 512 + lane * 8, pk8(o)); }
    }
}

__device__ __forceinline__ void p8_router(int l, const float* const* in, const float* X, unsigned char* ws, LAS unsigned char* lds, int gw, int NGW, int tid, int lane) {
    LAS bf16* Bh = (LAS bf16*)(lds + RING_OFF); LAS bf16* Bl = Bh + 32 * 64 * 8;
    LAS float* gL = (LAS float*)(lds + RING_OFF + 65536);
    const float* rw = in[27] + (size_t)l * DMODEL * NEXP; const float* gain = in[26] + (size_t)l * DMODEL;
    for (int i = tid; i < 32 * 64; i += NTHR) { const int kk = i >> 6, ln = i & 63, e = ln & 15, kg_ = ln >> 4; float hi8[8], lo8[8];
#pragma unroll
        for (int j = 0; j < 8; ++j) { const int k = 32 * kk + 8 * kg_ + j; const float w = rw[(size_t)k * NEXP + e] * gain[k]; const float wh = __uint_as_float(f2bf(w) << 16); hi8[j] = wh; lo8[j] = w - wh; }
        *(LAS v4u*)(Bh + i * 8) = pk8(hi8); *(LAS v4u*)(Bl + i * 8) = pk8(lo8); }
    for (int i = tid; i < DMODEL; i += NTHR) gL[i] = gain[i];
    __syncthreads();
    unsigned char* HN2 = ws + A_HN; float* AFFT = (float*)(ws + WS_AFFT);
    typedef short bf16x8_t __attribute__((ext_vector_type(8)));
    const int m = lane & 15, kg = lane >> 4;
    for (int tr = gw; tr < M / 16; tr += NGW) {
        const int t0 = tr * 16; const bf16* xrow = (const bf16*)X + (size_t)(t0 + m) * XBP + 8 * kg;
        f32x4 D = {0.f, 0.f, 0.f, 0.f}, D2 = {0.f, 0.f, 0.f, 0.f}; float ss = 0.f;
#define P8_LD(XB_, c_) do { _Pragma("unroll") for (int q = 0; q < 8; ++q) XB_[q] = ld16(xrow + 32 * (8 * (c_) + q)); } while (0)
#define P8_MM(XB_, c_) do { _Pragma("unroll") for (int q = 0; q < 8; ++q) { const int kk = 8 * (c_) + q; const bf16x8_t a = __builtin_bit_cast(bf16x8_t, XB_[q]); \
                const bf16x8_t bh = *(const LAS bf16x8_t*)(Bh + (kk * 64 + lane) * 8), bl = *(const LAS bf16x8_t*)(Bl + (kk * 64 + lane) * 8); \
                D = __builtin_amdgcn_mfma_f32_16x16x32_bf16(a, bh, D, 0, 0, 0); D2 = __builtin_amdgcn_mfma_f32_16x16x32_bf16(a, bl, D2, 0, 0, 0);     \
                float x[8]; unp8(XB_[q], x); _Pragma("unroll") for (int j = 0; j < 8; ++j) ss += x[j] * x[j]; } } while (0)
#define P8_HN(XB_, c_) do { _Pragma("unroll") for (int q = 0; q < 8; ++q) { const int kk = 8 * (c_) + q; float x[8]; unp8(XB_[q], x); const f32x4 g0 = *(const LAS f32x4*)(gL + 32 * kk + 8 * kg), g1 = *(const LAS f32x4*)(gL + 32 * kk + 8 * kg + 4); \
                x[0] *= rstd * g0[0]; x[1] *= rstd * g0[1]; x[2] *= rstd * g0[2]; x[3] *= rstd * g0[3]; x[4] *= rstd * g1[0]; x[5] *= rstd * g1[1]; x[6] *= rstd * g1[2]; x[7] *= rstd * g1[3]; \
                *(v2u*)(hrow + 32 * kk) = pk8_e4m3(x); } } while (0)
        v4u xa[8], xb[8];
        P8_LD(xa, 0);
#pragma nounroll
        for (int c = 0; c < 4; c += 2) { P8_LD(xb, c + 1); P8_MM(xa, c); if (c + 2 < 4) P8_LD(xa, c + 2); else P8_LD(xa, 0); P8_MM(xb, c + 1); }
        D += D2;
        ss = sum_rows(ss);
        const float rstd = __builtin_amdgcn_rsqf(ss * (1.0f / DMODEL) + 1e-6f);
        unsigned char* hrow = HN2 + (size_t)(t0 + m) * DMODEL + 8 * kg;
#pragma nounroll
        for (int c = 0; c < 4; c += 2) { P8_LD(xb, c + 1); P8_HN(xa, c); if (c + 2 < 4) P8_LD(xa, c + 2); P8_HN(xb, c + 1); }
#undef P8_LD
#undef P8_MM
#undef P8_HN
        f32x4 aff;
#pragma unroll
        for (int r = 0; r < 4; ++r) { const float rs = shx_from(rstd, 4 * kg + r, lane); const float lg = D[r] * rs; float mx = lg;
#pragma unroll
            for (int o = 0; o < 1; ++o) mx = max16(mx);
            const float ex = __expf(lg - mx); float se = ex;
#pragma unroll
            for (int o = 0; o < 1; ++o) se = sum16(se);
            aff[r] = ex * __builtin_amdgcn_rcpf(se); }
        const int b = t0 / SEQ, s0 = t0 & (SEQ - 1);
        *(f32x4*)(AFFT + ((size_t)(b * NEXP + m)) * SEQ + s0 + 4 * kg) = aff;
    }
    __syncthreads();
}

__device__ __forceinline__ int block_sum_i(int v, LAS int* tmp, int wave, int lane) {
#pragma unroll
    for (int o = 1; o < 64; o <<= 1) v += shxi(v, o, lane);
    if (lane == 0) tmp[wave] = v;
    __syncthreads();
    int tot = 0;
#pragma unroll
    for (int i = 0; i < NWAVES; ++i) tot += tmp[i];
    __syncthreads();
    return tot;
}
__device__ __forceinline__ int block_excl_scan_i(int v, LAS int* tmp, int wave, int lane) {
    int inc = v;
#pragma unroll
    for (int o = 1; o < 64; o <<= 1) { const int t = shupi(inc, o, lane); if (lane >= o) inc += t; }
    if (lane == 63) tmp[wave] = inc;
    __syncthreads();
    int base = 0;
#pragma unroll
    for (int i = 0; i < NWAVES; ++i) { const int x = tmp[i]; if (i < wave) base += x; }
    __syncthreads();
    return base + inc - v;
}
__device__ __forceinline__ void p9_topk(int be, unsigned char* ws, LAS unsigned char* lds, int tid, int wave, int lane) {
    const float* AFFT = (const float*)(ws + WS_AFFT) + (size_t)be * SEQ; int* IDX = (int*)(ws + WS_IDX) + (size_t)be * CAP; float* VAL = (float*)(ws + WS_VAL) + (size_t)be * CAP;
    int* INV = (int*)(ws + WS_INV); const int b = be / NEXP, e = be - b * NEXP;
    LAS int* tmp = (LAS int*)(lds + RING_OFF);
    unsigned key[16];
#pragma unroll
    for (int q = 0; q < 4; ++q) { const v4u w = *(const v4u*)(AFFT + tid * 16 + q * 4); key[4 * q] = w.x; key[4 * q + 1] = w.y; key[4 * q + 2] = w.z; key[4 * q + 3] = w.w; }
    unsigned T = 0u;
#pragma nounroll
    for (int bit = 30; bit >= 0; --bit) { const unsigned cand = T | (1u << bit); int c = 0;
#pragma unroll
        for (int i = 0; i < 16; ++i) c += (key[i] >= cand) ? 1 : 0;
        if (block_sum_i(c, tmp, wave, lane) >= CAP) T = cand; }
    int ngt = 0, neq = 0;
#pragma unroll
    for (int i = 0; i < 16; ++i) { ngt += (key[i] > T) ? 1 : 0; neq += (key[i] == T) ? 1 : 0; }
    const int need = CAP - block_sum_i(ngt, tmp, wave, lane);
    const int eqb = block_excl_scan_i(neq, tmp, wave, lane);
    int take = need - eqb; take = take < 0 ? 0 : (take > neq ? neq : take);
    int pos = block_excl_scan_i(ngt + take, tmp, wave, lane);
    int er = eqb;
#pragma unroll
    for (int i = 0; i < 16; ++i) { const int s = tid * 16 + i; bool sel = key[i] > T; if (key[i] == T) { sel = er < need; ++er; }
        int w = -1; if (sel) { IDX[pos] = s; VAL[pos] = __uint_as_float(key[i]); w = pos; ++pos; }
        INV[((size_t)b * SEQ + s) * NEXP + e] = w; }
}

__device__ __forceinline__ void p10_gather(unsigned char* ws, int gw, int NGW, int lane) {
    const bf16* HN2 = (const bf16*)(ws + A_HN); bf16* XG = (bf16*)(ws + A_XG); const int* IDX = (const int*)(ws + WS_IDX);
    for (int r = gw; r < MR; r += NGW) { const int b = r / (NEXP * CAP); const int tok = IDX[r];
        const v4u* src = (const v4u*)(HN2 + ((size_t)b * SEQ + tok) * DMODEL); v4u* dst = (v4u*)(XG + (size_t)r * DMODEL);
        const v4u a = src[lane], c = src[lane + 64]; dst[lane] = a; dst[lane + 64] = c; }
}

namespace cs {
typedef short bf16x8 __attribute__((ext_vector_type(8)));
typedef short s16x4 __attribute__((ext_vector_type(4)));
typedef float f32x16 __attribute__((ext_vector_type(16)));
constexpr int LWL = 0;
constexpr int CH0 = 16384, CH_STRIDE = 20992;
constexpr int O_QR = 0, O_BK = 4608, O_BH = 9216, O_KH = 11520, O_V = 13824, O_QH = 16128, O_XX = 18432, O_BNK = 19584, O_GC = 20736;
constexpr int P144 = 72, P72 = 36;
constexpr int YL0 = CH0 + 4 * CH_STRIDE;
static_assert(YL0 + 64 * 144 <= RING_BYTES, "chunk-scan LDS map");
__device__ __forceinline__ int crow(int reg, int h) { return (reg & 3) + 8 * (reg >> 2) + 4 * h; }
__device__ __forceinline__ bf16x8 ld8(const LAS bf16* p) { const s16x4 lo = *(const LAS s16x4*)p, hi = *(const LAS s16x4*)(p + 8); return __builtin_shufflevector(lo, hi, 0, 1, 2, 3, 4, 5, 6, 7); }
__device__ __forceinline__ bf16x8 ld8c(const LAS bf16* p) { const s16x4 lo = *(const LAS s16x4*)p, hi = *(const LAS s16x4*)(p + 4); return __builtin_shufflevector(lo, hi, 0, 1, 2, 3, 4, 5, 6, 7); }
template <bool PERM> __device__ __forceinline__ bf16x8 ldcol(const LAS bf16* p, int h) {
    const LAS bf16* q = p + (PERM ? 4 * h : 8 * h) * P144;
    unsigned e[8];
#pragma unroll
    for (int jj = 0; jj < 8; ++jj) e[jj] = q[((PERM && jj >= 4) ? jj + 4 : jj) * P144];
    v4u w; w.x = e[0] | (e[1] << 16); w.y = e[2] | (e[3] << 16); w.z = e[4] | (e[5] << 16); w.w = e[6] | (e[7] << 16);
    return __builtin_bit_cast(bf16x8, w); }
typedef short v4i16_tr_t __attribute__((ext_vector_type(4)));
template <bool PERM> __device__ __forceinline__ bf16x8 ldcol_tr(const LAS bf16* p0, int r, int h) {
    const int i = r & 15, q = i >> 2, pp = i & 3;
    const LAS bf16* a = p0 + ((PERM ? 4 * h : 8 * h) + q) * P144 + (r & 16) + 4 * pp;
    const s16x4 lo = __builtin_bit_cast(s16x4, __builtin_amdgcn_ds_read_tr16_b64_v4i16((LAS v4i16_tr_t*)a));
    const s16x4 hi = __builtin_bit_cast(s16x4, __builtin_amdgcn_ds_read_tr16_b64_v4i16((LAS v4i16_tr_t*)(a + (PERM ? 8 : 4) * P144)));
    return __builtin_shufflevector(lo, hi, 0, 1, 2, 3, 4, 5, 6, 7); }
__device__ __forceinline__ bf16x8 pack8r(const f32x16& x, int s) {
    v4u p; p.x = pg8::cvt_pk_bf16(x[8 * s], x[8 * s + 1]); p.y = pg8::cvt_pk_bf16(x[8 * s + 2], x[8 * s + 3]); p.z = pg8::cvt_pk_bf16(x[8 * s + 4], x[8 * s + 5]); p.w = pg8::cvt_pk_bf16(x[8 * s + 6], x[8 * s + 7]);
    return __builtin_bit_cast(bf16x8, p); }
#define CS_SYNC() do { asm volatile("s_waitcnt lgkmcnt(0)" ::: "memory"); __builtin_amdgcn_s_barrier(); asm volatile("" ::: "memory"); } while (0)
#define CS_MFMA(a, b, c) __builtin_amdgcn_mfma_f32_32x32x16_bf16((a), (b), (c), 0, 0, 0)
}
__device__ __forceinline__ void scan_chain_chunked(int l, int chain, const float* const* in, unsigned char* ws, LAS unsigned char* lds, int tid, int wave, int lane) {
    using namespace cs;
    const int d = chain >> 6, b = (chain >> 3) & 7, hd = chain & 7;
    const bf16* R = (const bf16*)(ws + A_R); const bf16* KS = (const bf16*)(ws + A_KS); const bf16* VS = (const bf16*)(ws + A_VS);
    const bf16* LW = (const bf16*)(ws + A_LW); const bf16* AA = (const bf16*)(ws + A_AA);
    bf16* YS = (bf16*)(ws + (d ? A_YSB : A_YSF)); float* CFB = (float*)(ws + WS_CFB) + (size_t)d * M * 8;
    LAS float* lwL = (LAS float*)(lds + RING_OFF + LWL);
    const int ps0 = tid >> 3, pc0 = tid & 7;
    const int r0 = lane & 31, h0 = lane >> 5;
    const float* kkcp = in[10] + (size_t)l * 512 + hd * 64; const float* kacp = in[11] + (size_t)l * 512 + hd * 64; const float* rkcp = in[12] + (size_t)l * 512 + hd * 64;
    f32x16 st0, st1;
#pragma unroll
    for (int i = 0; i < 16; ++i) { st0[i] = 0.f; st1[i] = 0.f; }
    v4u rr, kr, vr, lwr, ar;
    { const int tok = d ? (SEQ - 1 - ps0) : ps0; const size_t t = (size_t)b * SEQ + tok;
      rr = ld16(R + t * 512 + hd * 64 + pc0 * 8); kr = ld16(KS + t * 512 + hd * 64 + pc0 * 8); vr = ld16(VS + t * 512 + hd * 64 + pc0 * 8);
      lwr = ld16(LW + t * 1024 + d * 512 + hd * 64 + pc0 * 8); ar = ld16(AA + t * 1024 + d * 512 + hd * 64 + pc0 * 8); }
    for (int blk = 0; blk < SEQ / 64; ++blk) {
        int ps = ps0, pc = pc0, r = r0, h = h0; asm volatile("" : "+v"(ps), "+v"(pc), "+v"(r), "+v"(h));
        const int ch = ps >> 4, sl = ps & 15;

        const int tokp = d ? (SEQ - 1 - (blk * 64 + ps)) : (blk * 64 + ps); const size_t tp = (size_t)b * SEQ + tokp;
        LAS unsigned char* cbase = lds + RING_OFF + CH0 + ch * CH_STRIDE;
        if (blk > 0) { const int tl = (blk - 1) * 64 + ps; const int tok = d ? (SEQ - 1 - tl) : tl;
            const v4u yv = *(const LAS v4u*)((const LAS bf16*)(lds + RING_OFF + YL0) + ps * P144 + pc * 8); st16(YS + ((size_t)b * SEQ + tok) * 512 + hd * 64 + pc * 8, yv); }
        float r8[8], k8[8], v8[8], lw8[8], a8[8], kk8[8], kd8[8], nb8[8], kkc[8], kac[8], rkc[8];
        ldf8(kkcp + pc * 8, kkc); ldf8(kacp + pc * 8, kac); ldf8(rkcp + pc * 8, rkc);
        unp8(rr, r8); unp8(kr, k8); unp8(vr, v8); unp8(lwr, lw8); unp8(ar, a8); const v4u vraw_ = vr; (void)v8;
        { float ss = 0.f;
#pragma unroll
          for (int i = 0; i < 8; ++i) { kk8[i] = k8[i] * kkc[i]; ss += kk8[i] * kk8[i]; }
          ss = sum8(ss, lane); const float inv = 1.0f / fmaxf(sqrtf(ss), 1e-12f);
          float cf = 0.f;
#pragma unroll
          for (int i = 0; i < 8; ++i) { kk8[i] *= inv; kd8[i] = k8[i] * (1.0f + (a8[i] - 1.0f) * kac[i]); cf += r8[i] * kd8[i] * rkc[i]; nb8[i] = -kk8[i] * a8[i]; }
          cf = sum8(cf, lane); if (pc == 0) CFB[tp * 8 + hd] = cf; }
        { LAS float* p = lwL + ps * 64 + pc * 8; *(LAS f32x4*)p = (f32x4){lw8[0], lw8[1], lw8[2], lw8[3]}; *(LAS f32x4*)(p + 4) = (f32x4){lw8[4], lw8[5], lw8[6], lw8[7]}; }
        CS_SYNC();
        if (blk + 1 < SEQ / 64) { const int tok = d ? (SEQ - 1 - ((blk + 1) * 64 + ps)) : ((blk + 1) * 64 + ps); const size_t t = (size_t)b * SEQ + tok;
            rr = ld16(R + t * 512 + hd * 64 + pc * 8); kr = ld16(KS + t * 512 + hd * 64 + pc * 8); vr = ld16(VS + t * 512 + hd * 64 + pc * 8);
            lwr = ld16(LW + t * 1024 + d * 512 + hd * 64 + pc * 8); ar = ld16(AA + t * 1024 + d * 512 + hd * 64 + pc * 8); }
        { float Lex[8], Lt[8];
#pragma unroll
          for (int i = 0; i < 8; ++i) { Lex[i] = 0.f; Lt[i] = 0.f; }
#pragma unroll 4
          for (int u = 0; u < 16; ++u) { const LAS float* p = lwL + (ch * 16 + u) * 64 + pc * 8; const f32x4 x0 = *(const LAS f32x4*)p, x1 = *(const LAS f32x4*)(p + 4);
              const float m = (u < sl) ? 1.0f : 0.0f;
#pragma unroll
              for (int i = 0; i < 4; ++i) { Lt[i] += x0[i]; Lt[4 + i] += x1[i]; Lex[i] += m * x0[i]; Lex[4 + i] += m * x1[i]; } }
          LAS bf16* QRp = (LAS bf16*)(cbase + O_QR); LAS bf16* BKp = (LAS bf16*)(cbase + O_BK);
          float Lin[8], tmp[8], tm2[8];
#pragma unroll
          for (int i = 0; i < 8; ++i) { Lin[i] = Lex[i] + lw8[i]; tmp[i] = kk8[i] * __expf(Lex[i]); }
          *(LAS v4u*)(QRp + sl * P144 + pc * 8) = pk8(tmp);
          asm volatile("" ::: "memory");
#pragma unroll
          for (int i = 0; i < 8; ++i) tmp[i] = r8[i] * __expf(Lin[i]);
          *(LAS v4u*)(QRp + (16 + sl) * P144 + pc * 8) = pk8(tmp);
          asm volatile("" ::: "memory");
#pragma unroll
          for (int i = 0; i < 8; ++i) { const float ig = __expf(-Lin[i]); tmp[i] = nb8[i] * ig; tm2[i] = kd8[i] * ig; }
          *(LAS v4u*)(BKp + sl * P144 + pc * 8) = pk8(tmp); *(LAS v4u*)(BKp + (16 + sl) * P144 + pc * 8) = pk8(tm2);
          asm volatile("" ::: "memory");
#pragma unroll
          for (int i = 0; i < 8; ++i) { const float igc = __expf(Lt[i] - Lin[i]); tmp[i] = nb8[i] * igc; tm2[i] = kd8[i] * igc; }
          *(LAS v4u*)((LAS bf16*)(cbase + O_BH) + sl * P144 + pc * 8) = pk8(tmp); *(LAS v4u*)((LAS bf16*)(cbase + O_KH) + sl * P144 + pc * 8) = pk8(tm2);
          *(LAS v4u*)((LAS bf16*)(cbase + O_V) + sl * P144 + pc * 8) = vraw_;
          if (sl == 15) { LAS float* gp = (LAS float*)(cbase + O_GC) + pc * 8; *(LAS f32x4*)gp = (f32x4){__expf(Lt[0]), __expf(Lt[1]), __expf(Lt[2]), __expf(Lt[3])}; *(LAS f32x4*)(gp + 4) = (f32x4){__expf(Lt[4]), __expf(Lt[5]), __expf(Lt[6]), __expf(Lt[7])}; } }
        CS_SYNC();
#ifndef CS_NO_A
#ifndef CS_REP_A
#define CS_REP_A 1
#endif
        for (int repa_ = 0; repa_ < CS_REP_A; ++repa_) if (wave < 4) {
            LAS unsigned char* cb = lds + RING_OFF + CH0 + wave * CH_STRIDE;
            const LAS bf16* QRp = (const LAS bf16*)(cb + O_QR); const LAS bf16* BKp = (const LAS bf16*)(cb + O_BK); LAS float* AD = (LAS float*)(cb + O_BK);
            f32x16 D;
#pragma unroll
            for (int i = 0; i < 16; ++i) D[i] = 0.f;
#pragma unroll
            for (int ks = 0; ks < 4; ++ks) { const bf16x8 A = *(const LAS bf16x8*)(QRp + r * P144 + ks * 16 + h * 8), B = *(const LAS bf16x8*)(BKp + r * P144 + ks * 16 + h * 8); D = CS_MFMA(A, B, D); }
            asm volatile("s_waitcnt lgkmcnt(0)" ::: "memory");
            LAS float* AnT = (LAS float*)(cb + O_QH);
#pragma unroll
            for (int i = 0; i < 16; ++i) { const int row = crow(i, h), s_ = row & 15, u_ = r & 15; const bool keep = (i < 8) ? (u_ < s_) : (u_ <= s_); const float v = keep ? D[i] : 0.f;
                AD[row * 32 + r] = v; if (i < 8) AnT[r * 16 + row] = v; }
            asm volatile("s_waitcnt lgkmcnt(0)" ::: "memory");
            float x[16];
#pragma unroll
            for (int t = 0; t < 16; ++t) { const float ldv = AD[t * 32 + r]; x[t] = (r < 16) ? ((t == r) ? 1.0f : 0.0f) : ldv; }
#pragma unroll
            for (int s = 0; s < 15; ++s) { const f32x4 a0 = *(const LAS f32x4*)(AnT + s * 16), a1 = *(const LAS f32x4*)(AnT + s * 16 + 4), a2 = *(const LAS f32x4*)(AnT + s * 16 + 8), a3 = *(const LAS f32x4*)(AnT + s * 16 + 12);
                const float an[16] = {a0[0], a0[1], a0[2], a0[3], a1[0], a1[1], a1[2], a1[3], a2[0], a2[1], a2[2], a2[3], a3[0], a3[1], a3[2], a3[3]};
                const float xs = x[s];
#pragma unroll
                for (int t = 0; t < 16; ++t) if (t > s) x[t] += an[t] * xs; }
            LAS bf16* XXp = (LAS bf16*)(cb + O_XX);
            if (h == 0) {
#pragma unroll
                for (int s = 0; s < 16; ++s) XXp[s * P72 + r] = (bf16)f2bf(x[s]); }
            { const int s = lane >> 2, c8 = (lane & 3) * 8; const LAS float* ap = AD + (16 + s) * 32 + c8; const f32x4 y0 = *(const LAS f32x4*)ap, y1 = *(const LAS f32x4*)(ap + 4);
              LAS v2u* bp = (LAS v2u*)((LAS bf16*)(cb + O_BNK) + s * P72 + c8); bp[0] = (v2u){pk2(y0[0], y0[1]), pk2(y0[2], y0[3])}; bp[1] = (v2u){pk2(y1[0], y1[1]), pk2(y1[2], y1[3])}; }
            asm volatile("s_waitcnt lgkmcnt(0)" ::: "memory");
            { LAS bf16* QHp = (LAS bf16*)(cb + O_QH);
              const bf16x8 A = ld8c(XXp + (r & 15) * P72 + 8 * h);
#pragma unroll
              for (int ct = 0; ct < 2; ++ct) { const bf16x8 B = ldcol<false>(QRp + 32 * ct + r, h); f32x16 z;
#pragma unroll
                  for (int i = 0; i < 16; ++i) z[i] = 0.f;
                  z = CS_MFMA(A, B, z);
#pragma unroll
                  for (int i = 0; i < 8; ++i) QHp[crow(i, h) * P144 + 32 * ct + r] = (bf16)f2bf(z[i]); } }
        }
#endif
        CS_SYNC();
#ifndef CS_NO_B
        if (wave < 2) {
            const int c0 = 32 * wave;
#pragma unroll 1
            for (int cc = 0; cc < 4; ++cc) {
                LAS unsigned char* cb = lds + RING_OFF + CH0 + cc * CH_STRIDE;
                const LAS bf16* QRp = (const LAS bf16*)(cb + O_QR); const LAS bf16* QHp = (const LAS bf16*)(cb + O_QH); const LAS bf16* XXp = (const LAS bf16*)(cb + O_XX); const LAS bf16* BNp = (const LAS bf16*)(cb + O_BNK);
                const LAS bf16* Vp = (const LAS bf16*)(cb + O_V); const LAS bf16* BHp = (const LAS bf16*)(cb + O_BH); const LAS bf16* KHp = (const LAS bf16*)(cb + O_KH); const LAS float* GCp = (const LAS float*)(cb + O_GC);
                const int ra = (r & 15) * P144 + 4 * h, rb = (16 + (r & 15)) * P144 + 4 * h, rx = (r & 15) * P72 + 4 * h;
                const bf16x8 qh0 = ld8(QHp + ra), qh1 = ld8(QHp + ra + 16), qh2 = ld8(QHp + ra + 32), qh3 = ld8(QHp + ra + 48);
                const bf16x8 taf = ld8(XXp + rx + 16), vf = ldcol<true>(Vp + c0 + r, h);
                const bf16x8 sb00 = pack8r(st0, 0), sb01 = pack8r(st0, 1), sb10 = pack8r(st1, 0), sb11 = pack8r(st1, 1);
                f32x16 dq;
#pragma unroll
                for (int i = 0; i < 16; ++i) dq[i] = 0.f;
                dq = CS_MFMA(qh0, sb00, dq); dq = CS_MFMA(qh1, sb01, dq); dq = CS_MFMA(qh2, sb10, dq); dq = CS_MFMA(qh3, sb11, dq); dq = CS_MFMA(taf, vf, dq);
                const bf16x8 kh0 = ldcol<true>(KHp + r, h), kh1 = ldcol<true>(KHp + 32 + r, h), bh0 = ldcol<true>(BHp + r, h), bh1 = ldcol<true>(BHp + 32 + r, h);
                { f32x16 acc0, acc1;
#pragma unroll
                  for (int g = 0; g < 4; ++g) { const f32x4 ga = *(const LAS f32x4*)(GCp + 8 * g + 4 * h), gb = *(const LAS f32x4*)(GCp + 32 + 8 * g + 4 * h);
                      acc0[4 * g] = st0[4 * g] * ga[0]; acc0[4 * g + 1] = st0[4 * g + 1] * ga[1]; acc0[4 * g + 2] = st0[4 * g + 2] * ga[2]; acc0[4 * g + 3] = st0[4 * g + 3] * ga[3];
                      acc1[4 * g] = st1[4 * g] * gb[0]; acc1[4 * g + 1] = st1[4 * g + 1] * gb[1]; acc1[4 * g + 2] = st1[4 * g + 2] * gb[2]; acc1[4 * g + 3] = st1[4 * g + 3] * gb[3]; }
                  acc0 = CS_MFMA(kh0, vf, acc0); acc1 = CS_MFMA(kh1, vf, acc1);
                  const bf16x8 dqb = pack8r(dq, 0);
                  acc0 = CS_MFMA(bh0, dqb, acc0); acc1 = CS_MFMA(bh1, dqb, acc1);
                  st0 = acc0; st1 = acc1;
                  f32x16 y;
#pragma unroll
                  for (int i = 0; i < 16; ++i) y[i] = 0.f;
                  y = CS_MFMA(ld8(QRp + rb), sb00, y); y = CS_MFMA(ld8(QRp + rb + 16), sb01, y); y = CS_MFMA(ld8(QRp + rb + 32), sb10, y); y = CS_MFMA(ld8(QRp + rb + 48), sb11, y);
                  y = CS_MFMA(ld8(BNp + rx + 16), vf, y); y = CS_MFMA(ld8(BNp + rx), dqb, y);
                  { LAS bf16* YLp = (LAS bf16*)(lds + RING_OFF + YL0) + (cc * 16) * P144 + c0 + r;
#pragma unroll
                    for (int i = 0; i < 8; i += 2) { const unsigned w = pg8::cvt_pk_bf16(y[i], y[i + 1]); YLp[crow(i, h) * P144] = (bf16)(w & 0xffffu); YLp[crow(i + 1, h) * P144] = (bf16)(w >> 16); } } }
            }
        }
#endif
        CS_SYNC();
    }
    { const int tl = (SEQ / 64 - 1) * 64 + ps0; const int tok = d ? (SEQ - 1 - tl) : tl;
      const v4u yv = *(const LAS v4u*)((const LAS bf16*)(lds + RING_OFF + YL0) + ps0 * P144 + pc0 * 8); st16(YS + ((size_t)b * SEQ + tok) * 512 + hd * 64 + pc0 * 8, yv); }
    CS_SYNC();
}

namespace cp {
constexpr int REG = 16384;
constexpr int O_QR = 0, O_BK = 4608, O_V = 9216, O_QH = 11520, O_XX = 13824, O_BNK = 14976, O_GC = 16128;
constexpr int AD0 = 6 * REG, LW0 = AD0 + 8192, YL0 = LW0 + 16384;
static_assert(YL0 + 8192 <= RING_BYTES, "pipelined chunk-scan LDS map");
}
__device__ __forceinline__ void scan_chain_pipe(int l, int chain, const float* const* in, unsigned char* ws, LAS unsigned char* lds, int tid, int wave, int lane) {
    using namespace cs;
    const int d = chain >> 6, b = (chain >> 3) & 7, hd = chain & 7;
    const bf16* R = (const bf16*)(ws + A_R); const bf16* KS = (const bf16*)(ws + A_KS); const bf16* VS = (const bf16*)(ws + A_VS);
    const bf16* LW = (const bf16*)(ws + A_LW); const bf16* AA = (const bf16*)(ws + A_AA);
    bf16* YS = (bf16*)(ws + (d ? A_YSB : A_YSF)); float* CFB = (float*)(ws + WS_CFB) + (size_t)d * M * 8;
    LAS unsigned char* ring = lds + RING_OFF;
    constexpr int NB = SEQ / 32;
    const bool isprep = wave >= 4;
    const int ps0 = (tid & 255) >> 3, pc0 = tid & 7, r0 = lane & 31, h0 = lane >> 5;
    const float* kkcp = in[10] + (size_t)l * 512 + hd * 64; const float* kacp = in[11] + (size_t)l * 512 + hd * 64; const float* rkcp = in[12] + (size_t)l * 512 + hd * 64;
    f32x16 st0, st1;
#pragma unroll
    for (int i = 0; i < 16; ++i) { st0[i] = 0.f; st1[i] = 0.f; }
#define kk8(i) st0[(i)]
#define r8(i) st0[8 + (i)]
#define nb8(i) st1[(i)]
#define kd8(i) st1[8 + (i)]
    float lw8[8], inc8[8]; v4u vkeep = {0u, 0u, 0u, 0u};
#pragma unroll
    for (int i = 0; i < 8; ++i) { lw8[i] = 0.f; inc8[i] = 0.f; }
    v4u rr = {0u, 0u, 0u, 0u}, kr = rr, vr = rr, lwr = rr, ar = rr;
#define CP_LOADRAW(j) do { const int tok_ = d ? (SEQ - 1 - ((j) * 32 + ps)) : ((j) * 32 + ps); const unsigned t_ = (unsigned)(b * SEQ + tok_); \
        const unsigned o5_ = t_ * 512u + (unsigned)(hd * 64 + pc * 8), o10_ = t_ * 1024u + (unsigned)(d * 512 + hd * 64 + pc * 8);     \
        rr = ld16(R + o5_); kr = ld16(KS + o5_); vr = ld16(VS + o5_); lwr = ld16(LW + o10_); ar = ld16(AA + o10_); } while (0)
#define CP_PREP1(j) do { float k8_[8], a8_[8], kkc_[8], kac_[8], rkc_[8]; \
        { const LAS float* c_ = cstL + pc * 8; const f32x4 a0_ = *(const LAS f32x4*)c_, a1_ = *(const LAS f32x4*)(c_ + 4), b0_ = *(const LAS f32x4*)(c_ + 64), b1_ = *(const LAS f32x4*)(c_ + 68), c0_ = *(const LAS f32x4*)(c_ + 128), c1_ = *(const LAS f32x4*)(c_ + 132); \
          _Pragma("unroll") for (int i = 0; i < 4; ++i) { kkc_[i] = a0_[i]; kkc_[4 + i] = a1_[i]; kac_[i] = b0_[i]; kac_[4 + i] = b1_[i]; rkc_[i] = c0_[i]; rkc_[4 + i] = c1_[i]; } } \
        { float r_[8]; unp8(rr, r_); _Pragma("unroll") for (int i = 0; i < 8; ++i) r8(i) = r_[i]; } unp8(kr, k8_); unp8(lwr, lw8); unp8(ar, a8_); vkeep = vr; \
        float ss_ = 0.f, cf_ = 0.f; _Pragma("unroll") for (int i = 0; i < 8; ++i) { kk8(i) = k8_[i] * kkc_[i]; ss_ += kk8(i) * kk8(i); kd8(i) = k8_[i] * (1.0f + (a8_[i] - 1.0f) * kac_[i]); cf_ += r8(i) * kd8(i) * rkc_[i]; } \
        ss_ = sum8(ss_, lane); cf_ = sum8(cf_, lane); \
        const float inv_ = fminf(__builtin_amdgcn_rsqf(ss_), 1e12f); \
        _Pragma("unroll") for (int i = 0; i < 8; ++i) { kk8(i) *= inv_; nb8(i) = -kk8(i) * a8_[i]; } \
        { const int tok_ = d ? (SEQ - 1 - ((j) * 32 + ps)) : ((j) * 32 + ps); if (pc == 0) CFB[(unsigned)(b * SEQ + tok_) * 8u + (unsigned)hd] = cf_; } \
        _Pragma("unroll") for (int i = 0; i < 8; ++i) inc8[i] = lw8[i]; \
        _Pragma("unroll") for (int off_ = 8; off_ < 64; off_ <<= 1) { float t8_[8]; _Pragma("unroll") for (int i = 0; i < 8; ++i) t8_[i] = shx_from(inc8[i], lane - off_, lane); \
            __builtin_amdgcn_sched_barrier(0);     \
            _Pragma("unroll") for (int i = 0; i < 8; ++i) inc8[i] += (lane >= off_) ? t8_[i] : 0.f; } \
        if ((lane >> 3) == 7) { LAS float* p_ = (LAS float*)(ring + cp::LW0) + ((j) & 1) * 256 + (wave & 3) * 64 + pc * 8; *(LAS f32x4*)p_ = (f32x4){inc8[0], inc8[1], inc8[2], inc8[3]}; *(LAS f32x4*)(p_ + 4) = (f32x4){inc8[4], inc8[5], inc8[6], inc8[7]}; } \
        if ((j) + 1 < NB) CP_LOADRAW((j) + 1); } while (0)
    LAS float* cstL = (LAS float*)(lds + MISC_OFF + 1024);
    if (tid < 192) cstL[tid] = (tid < 64 ? kkcp : (tid < 128 ? kacp : rkcp))[tid & 63];
    CS_SYNC();
    if (isprep) { const int ps = ps0, pc = pc0; CP_LOADRAW(0); CP_PREP1(0); }
    CS_SYNC();
    for (int k = 0; k < NB + 3; ++k) {
        int ps = ps0, pc = pc0, r = r0, h = h0; asm volatile("" : "+v"(ps), "+v"(pc), "+v"(r), "+v"(h));
        if (isprep) {
            const int ch = ps >> 4, sl = ps & 15;
            if (k >= 3) { const int j = k - 3; const int tl = j * 32 + ps; const int tok = d ? (SEQ - 1 - tl) : tl;
                const v4u yv = *(const LAS v4u*)((const LAS bf16*)(ring + cp::YL0) + (j & 1) * 2048 + ps * 64 + pc * 8); st16(YS + ((unsigned)(b * SEQ + tok) * 512u + (unsigned)(hd * 64 + pc * 8)), yv); }
#ifndef CP_REP_P
#define CP_REP_P 1
#endif
            for (int repp_ = 0; repp_ < CP_REP_P; ++repp_) if (k < NB) {
                LAS unsigned char* cbase = ring + ((k % 3) * 2 + ch) * cp::REG;
                const LAS float* WT = (const LAS float*)(ring + cp::LW0) + (k & 1) * 256 + (ch * 2) * 64 + pc * 8;
                float Lex[8], Lt[8];
                { const f32x4 a0 = *(const LAS f32x4*)WT, a1 = *(const LAS f32x4*)(WT + 4), b0 = *(const LAS f32x4*)(WT + 64), b1 = *(const LAS f32x4*)(WT + 68);
                  const float w0[8] = {a0[0], a0[1], a0[2], a0[3], a1[0], a1[1], a1[2], a1[3]}, w1[8] = {b0[0], b0[1], b0[2], b0[3], b1[0], b1[1], b1[2], b1[3]};
                  const float m = (sl >= 8) ? 1.0f : 0.0f;
#pragma unroll
                  for (int i = 0; i < 8; ++i) { Lt[i] = w0[i] + w1[i]; Lex[i] = inc8[i] + m * w0[i] - lw8[i]; } }
                LAS bf16* QRp = (LAS bf16*)(cbase + cp::O_QR); LAS bf16* BKp = (LAS bf16*)(cbase + cp::O_BK);
                float Lin[8], tmp[8], tm2[8];
#pragma unroll
                for (int i = 0; i < 8; ++i) { Lin[i] = Lex[i] + lw8[i]; tmp[i] = kk8(i) * __builtin_amdgcn_exp2f(Lex[i]); }
                *(LAS v4u*)(QRp + sl * P144 + pc * 8) = pk8(tmp);
#pragma unroll
                for (int i = 0; i < 8; ++i) tmp[i] = r8(i) * __builtin_amdgcn_exp2f(Lin[i]);
                *(LAS v4u*)(QRp + (16 + sl) * P144 + pc * 8) = pk8(tmp);
#pragma unroll
                for (int i = 0; i < 8; ++i) { const float ig = __builtin_amdgcn_exp2f(-Lin[i]); tmp[i] = nb8(i) * ig; tm2[i] = kd8(i) * ig; }
                *(LAS v4u*)(BKp + sl * P144 + pc * 8) = pk8(tmp); *(LAS v4u*)(BKp + (16 + sl) * P144 + pc * 8) = pk8(tm2);
                *(LAS v4u*)((LAS bf16*)(cbase + cp::O_V) + sl * P144 + pc * 8) = vkeep;
                if (sl == 15) { LAS float* gp = (LAS float*)(cbase + cp::O_GC) + pc * 8; *(LAS f32x4*)gp = (f32x4){__builtin_amdgcn_exp2f(Lt[0]), __builtin_amdgcn_exp2f(Lt[1]), __builtin_amdgcn_exp2f(Lt[2]), __builtin_amdgcn_exp2f(Lt[3])}; *(LAS f32x4*)(gp + 4) = (f32x4){__builtin_amdgcn_exp2f(Lt[4]), __builtin_amdgcn_exp2f(Lt[5]), __builtin_amdgcn_exp2f(Lt[6]), __builtin_amdgcn_exp2f(Lt[7])}; }
            }
            if (k + 1 < NB) CP_PREP1(k + 1);
        }
        if (wave == 2 || wave == 3) {
#ifndef CP_REP_A
#define CP_REP_A 1
#endif
            for (int repa_ = 0; repa_ < CP_REP_A; ++repa_) if (k >= 1 && k <= NB) {
                const int j = k - 1, ca = wave - 2;
                LAS unsigned char* cb = ring + ((j % 3) * 2 + ca) * cp::REG;
                const LAS bf16* QRp = (const LAS bf16*)(cb + cp::O_QR); const LAS bf16* BKp = (const LAS bf16*)(cb + cp::O_BK); LAS float* AD = (LAS float*)(ring + cp::AD0 + ca * 4096);
                f32x16 D;
#pragma unroll
                for (int i = 0; i < 16; ++i) D[i] = 0.f;
#pragma unroll
                for (int ks = 0; ks < 4; ++ks) { const bf16x8 A = *(const LAS bf16x8*)(QRp + r * P144 + ks * 16 + h * 8), B = *(const LAS bf16x8*)(BKp + r * P144 + ks * 16 + h * 8); D = CS_MFMA(A, B, D); }
                LAS float* AnT = (LAS float*)(cb + cp::O_QH);
#pragma unroll
                for (int i = 0; i < 16; ++i) { const int row = crow(i, h), s_ = row & 15, u_ = r & 15; const bool keep = (i < 8) ? (u_ < s_) : (u_ <= s_); const float v = keep ? D[i] : 0.f;
                    AD[row * 32 + r] = v; if (i < 8) AnT[r * 16 + row] = v; }
                asm volatile("s_waitcnt lgkmcnt(0)" ::: "memory");
                float x[16];
#pragma unroll
                for (int t = 0; t < 16; ++t) x[t] = AD[t * 32 + r];
#pragma unroll
                for (int t = 0; t < 16; ++t) asm volatile("" : "+v"(x[t]));
#pragma unroll
                for (int t = 0; t < 16; ++t) x[t] = (r < 16) ? ((t == r) ? 1.0f : 0.0f) : x[t];
#pragma unroll
                for (int s = 0; s < 15; ++s) { const f32x4 a0 = *(const LAS f32x4*)(AnT + s * 16), a1 = *(const LAS f32x4*)(AnT + s * 16 + 4), a2 = *(const LAS f32x4*)(AnT + s * 16 + 8), a3 = *(const LAS f32x4*)(AnT + s * 16 + 12);
                    const float an[16] = {a0[0], a0[1], a0[2], a0[3], a1[0], a1[1], a1[2], a1[3], a2[0], a2[1], a2[2], a2[3], a3[0], a3[1], a3[2], a3[3]};
                    const float xs = x[s];
#pragma unroll
                    for (int t = 0; t < 16; ++t) if (t > s) x[t] += an[t] * xs; }
                LAS bf16* XXp = (LAS bf16*)(cb + cp::O_XX);
                if (h == 0) {
#pragma unroll
                    for (int s = 0; s < 16; ++s) XXp[s * P72 + r] = (bf16)f2bf(x[s]); }
                { const int s = lane >> 2, c8 = (lane & 3) * 8; const LAS float* ap = AD + (16 + s) * 32 + c8; const f32x4 y0 = *(const LAS f32x4*)ap, y1 = *(const LAS f32x4*)(ap + 4);
                  LAS v2u* bp = (LAS v2u*)((LAS bf16*)(cb + cp::O_BNK) + s * P72 + c8); bp[0] = (v2u){pk2(y0[0], y0[1]), pk2(y0[2], y0[3])}; bp[1] = (v2u){pk2(y1[0], y1[1]), pk2(y1[2], y1[3])}; }
                asm volatile("s_waitcnt lgkmcnt(0)" ::: "memory");
                { LAS bf16* QHp = (LAS bf16*)(cb + cp::O_QH);
                  const bf16x8 A = ld8c(XXp + (r & 15) * P72 + 8 * h);
                  f32x16 z0, z1;
#pragma unroll
                  for (int i = 0; i < 16; ++i) { z0[i] = 0.f; z1[i] = 0.f; }
                  z0 = CS_MFMA(A, ldcol_tr<false>(QRp, r, h), z0); z1 = CS_MFMA(A, ldcol_tr<false>(QRp + 32, r, h), z1);
#pragma unroll
                  for (int i = 0; i < 8; ++i) { QHp[crow(i, h) * P144 + r] = (bf16)f2bf(z0[i]); QHp[crow(i, h) * P144 + 32 + r] = (bf16)f2bf(z1[i]); } }
            }
        }
        if (wave < 2) {
            if (k >= 2 && k <= NB + 1) {
                const int j = k - 2, c0 = 32 * wave;
                const int ra = (r & 15) * P144 + 4 * h, rb = (16 + (r & 15)) * P144 + 4 * h, rx = (r & 15) * P72 + 4 * h;
                LAS unsigned char* cb0 = ring + ((j % 3) * 2 + 0) * cp::REG; LAS unsigned char* cb1 = cb0 + cp::REG;
#define CP_P(cb, off) ((const LAS bf16*)((cb) + (off)))
#define CP_GC(cb, GA, GB) do { _Pragma("unroll") for (int g = 0; g < 4; ++g) { GA[g] = *(const LAS f32x4*)((const LAS float*)((cb) + cp::O_GC) + 8 * g + 4 * h); GB[g] = *(const LAS f32x4*)((const LAS float*)((cb) + cp::O_GC) + 32 + 8 * g + 4 * h); } } while (0)
#define CP_SCALE(GA, GB) do { _Pragma("unroll") for (int g = 0; g < 4; ++g) { \
                    st0[4 * g] = acc0[4 * g] * GA[g][0]; st0[4 * g + 1] = acc0[4 * g + 1] * GA[g][1]; st0[4 * g + 2] = acc0[4 * g + 2] * GA[g][2]; st0[4 * g + 3] = acc0[4 * g + 3] * GA[g][3]; \
                    st1[4 * g] = acc1[4 * g] * GB[g][0]; st1[4 * g + 1] = acc1[4 * g + 1] * GB[g][1]; st1[4 * g + 2] = acc1[4 * g + 2] * GB[g][2]; st1[4 * g + 3] = acc1[4 * g + 3] * GB[g][3]; } } while (0)
                const bf16x8 qh00 = ld8(CP_P(cb0, cp::O_QH) + ra), qh01 = ld8(CP_P(cb0, cp::O_QH) + ra + 16), qh02 = ld8(CP_P(cb0, cp::O_QH) + ra + 32), qh03 = ld8(CP_P(cb0, cp::O_QH) + ra + 48), ta0 = ld8(CP_P(cb0, cp::O_XX) + rx + 16);
                const bf16x8 vf0 = ldcol_tr<true>(CP_P(cb0, cp::O_V) + c0, r, h);
                const bf16x8 kt00 = ldcol_tr<true>(CP_P(cb0, cp::O_BK) + 16 * P144, r, h), kt01 = ldcol_tr<true>(CP_P(cb0, cp::O_BK) + 16 * P144 + 32, r, h), bt00 = ldcol_tr<true>(CP_P(cb0, cp::O_BK), r, h), bt01 = ldcol_tr<true>(CP_P(cb0, cp::O_BK) + 32, r, h);
                f32x4 ga[4], gb[4]; CP_GC(cb0, ga, gb);
                __builtin_amdgcn_sched_barrier(0);
                const bf16x8 s00 = pack8r(st0, 0), s01 = pack8r(st0, 1), s10 = pack8r(st1, 0), s11 = pack8r(st1, 1);
                f32x16 dq;
#pragma unroll
                for (int i = 0; i < 16; ++i) dq[i] = 0.f;
                dq = CS_MFMA(qh00, s00, dq); dq = CS_MFMA(qh01, s01, dq); dq = CS_MFMA(qh02, s10, dq); dq = CS_MFMA(qh03, s11, dq); dq = CS_MFMA(ta0, vf0, dq);
                f32x16 acc0 = st0, acc1 = st1;
                acc0 = CS_MFMA(kt00, vf0, acc0); acc1 = CS_MFMA(kt01, vf0, acc1);
                __builtin_amdgcn_sched_barrier(0);
                const bf16x8 qh10 = ld8(CP_P(cb1, cp::O_QH) + ra), qh11 = ld8(CP_P(cb1, cp::O_QH) + ra + 16), qh12 = ld8(CP_P(cb1, cp::O_QH) + ra + 32), qh13 = ld8(CP_P(cb1, cp::O_QH) + ra + 48), ta1 = ld8(CP_P(cb1, cp::O_XX) + rx + 16);
                const bf16x8 vf1 = ldcol_tr<true>(CP_P(cb1, cp::O_V) + c0, r, h);
                const bf16x8 kt10 = ldcol_tr<true>(CP_P(cb1, cp::O_BK) + 16 * P144, r, h), kt11 = ldcol_tr<true>(CP_P(cb1, cp::O_BK) + 16 * P144 + 32, r, h), bt10 = ldcol_tr<true>(CP_P(cb1, cp::O_BK), r, h), bt11 = ldcol_tr<true>(CP_P(cb1, cp::O_BK) + 32, r, h);
                __builtin_amdgcn_sched_barrier(0);
                const bf16x8 dqb0 = pack8r(dq, 0);
                acc0 = CS_MFMA(bt00, dqb0, acc0); acc1 = CS_MFMA(bt01, dqb0, acc1);
                CP_SCALE(ga, gb);
                __builtin_amdgcn_sched_barrier(0);
                const bf16x8 rt00 = ld8(CP_P(cb0, cp::O_QR) + rb), rt01 = ld8(CP_P(cb0, cp::O_QR) + rb + 16), rt02 = ld8(CP_P(cb0, cp::O_QR) + rb + 32), rt03 = ld8(CP_P(cb0, cp::O_QR) + rb + 48);
                const bf16x8 bn0v = ld8(CP_P(cb0, cp::O_BNK) + rx + 16), bn0d = ld8(CP_P(cb0, cp::O_BNK) + rx);
                __builtin_amdgcn_sched_barrier(0);
                const bf16x8 t00 = pack8r(st0, 0), t01 = pack8r(st0, 1), t10 = pack8r(st1, 0), t11 = pack8r(st1, 1);
                f32x16 dq1, y0;
#pragma unroll
                for (int i = 0; i < 16; ++i) { dq1[i] = 0.f; y0[i] = 0.f; }
                dq1 = CS_MFMA(qh10, t00, dq1);     y0 = CS_MFMA(rt00, s00, y0);
                dq1 = CS_MFMA(qh11, t01, dq1);     y0 = CS_MFMA(rt01, s01, y0);
                dq1 = CS_MFMA(qh12, t10, dq1);     y0 = CS_MFMA(rt02, s10, y0);
                dq1 = CS_MFMA(qh13, t11, dq1);     y0 = CS_MFMA(rt03, s11, y0);
                dq1 = CS_MFMA(ta1, vf1, dq1);      y0 = CS_MFMA(bn0v, vf0, y0);
                acc0 = st0; acc1 = st1;
                acc0 = CS_MFMA(kt10, vf1, acc0); acc1 = CS_MFMA(kt11, vf1, acc1);
                y0 = CS_MFMA(bn0d, dqb0, y0);
                __builtin_amdgcn_sched_barrier(0);
                CP_GC(cb1, ga, gb);
                const bf16x8 rt10 = ld8(CP_P(cb1, cp::O_QR) + rb), rt11 = ld8(CP_P(cb1, cp::O_QR) + rb + 16), rt12 = ld8(CP_P(cb1, cp::O_QR) + rb + 32), rt13 = ld8(CP_P(cb1, cp::O_QR) + rb + 48);
                const bf16x8 bn1v = ld8(CP_P(cb1, cp::O_BNK) + rx + 16), bn1d = ld8(CP_P(cb1, cp::O_BNK) + rx);
                __builtin_amdgcn_sched_barrier(0);
                const bf16x8 dqb1 = pack8r(dq1, 0);
                acc0 = CS_MFMA(bt10, dqb1, acc0); acc1 = CS_MFMA(bt11, dqb1, acc1);
                f32x16 y1;
#pragma unroll
                for (int i = 0; i < 16; ++i) y1[i] = 0.f;
                y1 = CS_MFMA(rt10, t00, y1); y1 = CS_MFMA(rt11, t01, y1); y1 = CS_MFMA(rt12, t10, y1); y1 = CS_MFMA(rt13, t11, y1);
                y1 = CS_MFMA(bn1v, vf1, y1); y1 = CS_MFMA(bn1d, dqb1, y1);
                CP_SCALE(ga, gb);
#undef CP_GC
#undef CP_SCALE
                { LAS bf16* YLp = (LAS bf16*)(ring + cp::YL0) + (j & 1) * 2048 + c0 + r;
#pragma unroll
                  for (int i = 0; i < 8; i += 2) { const unsigned w0 = pg8::cvt_pk_bf16(y0[i], y0[i + 1]), w1 = pg8::cvt_pk_bf16(y1[i], y1[i + 1]);
                      YLp[crow(i, h) * 64] = (bf16)(w0 & 0xffffu); YLp[crow(i + 1, h) * 64] = (bf16)(w0 >> 16); YLp[(16 + crow(i, h)) * 64] = (bf16)(w1 & 0xffffu); YLp[(16 + crow(i + 1, h)) * 64] = (bf16)(w1 >> 16); } }
#undef CP_P
            }
        }
        CS_SYNC();
    }
#undef CP_LOADRAW
#undef kk8
#undef r8
#undef nb8
#undef kd8
#undef CP_PREP1
}

struct Args { const float* in[32]; float* out; unsigned char* ws; int ph_lo, ph_hi, li, pad; };
#ifndef PHMASK
#define PHMASK 0xFFFF
#endif
#define PH_EN(i) (((PHMASK) >> (i)) & 1)
#ifndef DUPMASK
#define DUPMASK 0
#endif
#define REP(i) for (int rep_ = 0; rep_ < ((((DUPMASK) >> (i)) & 1) + 1); ++rep_)
#define PHASE_BEGIN() \
    const int z_ = __builtin_amdgcn_readfirstlane((int)*(volatile LAS unsigned*)(lds + LDSCTL_OFF + 32)); \
    unsigned char* const ws = args.ws + z_; const float* const* const in = args.in + z_; float* const out = args.out + z_; \
    const int tid = (int)threadIdx.x + z_, lane = tid & 63, wave = __builtin_amdgcn_readfirstlane(tid >> 6); \
    const int G = (int)gridDim.x + z_, bx = (int)blockIdx.x + z_, vcu = (G % 8 == 0) ? (bx % 8) * (G / 8) + bx / 8 : bx; \
    const int gw = vcu * NWAVES + wave, NGW = G * NWAVES; (void)ws; (void)in; (void)out; (void)lane; (void)gw; (void)NGW; (void)vcu
#define LAYER_VARS() const float* const xcur = (l == 0) ? in[0] : (const float*)out; unsigned char* const wl = ws + WS_W + (size_t)l * WL_STRIDE; (void)xcur; (void)wl
#define IN(k) (ph_lo_ <= (k) && (k) < ph_hi_)
#ifdef PROBE_SEAM2
#define SEAM_EXTRA xcd_barrier(bar_);
#else
#define SEAM_EXTRA
#endif
#define SEAM(k) do { if (IN(k) && IN((k) + 1)) { const int zz_ = __builtin_amdgcn_readfirstlane((int)*(volatile LAS unsigned*)(lds + LDSCTL_OFF + 32)); XcdBarrier bar_; bar_.bar = (unsigned*)(args.ws + zz_ + WS_CTL) + CW_BAR + (ph_li_ + zz_) * XCD_BAR_WORDS; bar_.x = xb_xcc_id(); bar_.st = (volatile LAS unsigned*)(lds + MISC_OFF) + 8; xcd_barrier(bar_); SEAM_EXTRA } } while (0)

__global__ void __launch_bounds__(NTHR, 2) fwd(Args args) {
    extern __shared__ __attribute__((aligned(16))) unsigned char lds_raw[];
    LAS unsigned char* lds = (LAS unsigned char*)lds_raw;
    const int ph_lo_ = __builtin_amdgcn_readfirstlane(args.ph_lo), ph_hi_ = __builtin_amdgcn_readfirstlane(args.ph_hi), ph_li_ = __builtin_amdgcn_readfirstlane(args.li);
    for (int u = threadIdx.x; u < (LDS_BYTES - LDSCTL_OFF) / 4; u += NTHR) ((LAS unsigned*)(lds + LDSCTL_OFF))[u] = 0u;
    __syncthreads();
    if (ph_hi_ - ph_lo_ > 1) (void)xcd_barrier_post((unsigned*)(args.ws + WS_CTL) + CW_BAR + ph_li_ * XCD_BAR_WORDS, (volatile LAS unsigned*)(lds + MISC_OFF) + 8);

    REP(13) if (PH_EN(13) && IN(0)) { PHASE_BEGIN(); p0_prologue(in, ws, lds, vcu, G, tid, wave, lane); if (!IN(1)) SEAM(0); }

#pragma nounroll
    for (int l = 0; l < 2; ++l) {
        const int pb = 1 + PH_PER_LAYER * l;
        REP(0) if (PH_EN(0) && IN(pb + 0)) { PHASE_BEGIN(); LAYER_VARS();
#ifdef PROBE_NORM2
            if (l == 0) norm_rows<0>(in[0], nullptr, false, nullptr, nullptr, in[1], (bf16*)(ws + A_HN1), nullptr, gw, NGW, lane, (unsigned char*)out + 2048);
            else norm_rows<0, true>(out, nullptr, true, (const bf16*)(ws + A_YE), (const int*)(ws + WS_INV), in[1] + DMODEL, (bf16*)(ws + A_HN1), nullptr, gw, NGW, lane, (unsigned char*)out + 2048);
#endif
            if (l == 0) norm_rows<0>(in[0], nullptr, false, nullptr, nullptr, in[1], (bf16*)(ws + A_HN1), nullptr, gw, NGW, lane, (unsigned char*)out + 2048);
            else norm_rows<0, true>(out, out, true, (const bf16*)(ws + A_YE), (const int*)(ws + WS_INV), in[1] + DMODEL, (bf16*)(ws + A_HN1), nullptr, gw, NGW, lane, (unsigned char*)out + 2048);
            SEAM(pb + 0);
        }
        REP(1) if (PH_EN(1) && IN(pb + 1)) { PHASE_BEGIN(); LAYER_VARS();
            pg8::ProjOrder S{(const char*)(ws + A_HN1), (const char*)(wl + WO_IN), (size_t)((const unsigned char*)out + 2048 - (ws + A_HN1)), (size_t)(WO_QKV8 - WO_IN), 1024, 1024, 1024, M / 256, NPJ / 256, 10, 4096, G, bx};
            pg8::EpiPlainS E{(bf16*)(ws + A_PRJ), NPJ, 10, 1.0f / 32.0f};
#ifdef PROBE_P2_SINK
            if (rep_ == 0) { pg8::EpiSink E0; pg8::gemm_phase<pg8::EpiSink, pg8::ProjOrder, true, true, false, false, true>(lds + RING_OFF, tid, 1024, 2048, 1024, S, E0); } else
#endif
            pg8::gemm_phase<pg8::EpiPlainS, pg8::ProjOrder, true, true, false, false, true>(lds + RING_OFF, tid, 1024, 2048, 1024, S, E);
            SEAM(pb + 1);
        }
        REP(2) if (PH_EN(2) && IN(pb + 2)) { PHASE_BEGIN(); p3_prep(l, in, ws, lds, gw, NGW, tid, lane); SEAM(pb + 2); }
        REP(3) if (PH_EN(3) && IN(pb + 3)) {
#ifndef P4DUP
#define P4DUP 0
#endif
            for (int r4_ = 0; r4_ < 1 + (P4DUP & 1); ++r4_) { PHASE_BEGIN(); LAYER_VARS();
              pg8::LoraOrder S{(const char*)(ws + A_TW), (const char*)(wl + WO_LORA), G, bx};
              pg8::EpiLora E{(bf16*)(ws + A_LW), (bf16*)(ws + A_AA), in[5] + (size_t)l * 1024, in[7] + (size_t)l * 1024};
              pg8::gemm_phase<pg8::EpiLora, pg8::LoraOrder, true>(lds + RING_OFF, tid, 384, 384, 128, S, E); }
            for (int r4_ = 0; r4_ < 1 + ((P4DUP >> 1) & 1); ++r4_) { PHASE_BEGIN(); LAYER_VARS();
              pg8::PlainOrder S{(const char*)(ws + A_TW) + 512, (const char*)(wl + WO_G2), 384, 128, 128, M / 256, 2, G, bx, 0, 1, 0};
              pg8::EpiPlain E{(bf16*)(ws + A_G), 512};
              pg8::gemm_phase<pg8::EpiPlain, pg8::PlainOrder, true>(lds + RING_OFF, tid, 384, 384, 128, S, E); }
            for (int r4_ = 0; r4_ < 1 + ((P4DUP >> 2) & 1); ++r4_) { PHASE_BEGIN(); LAYER_VARS();
              pg8::PoolOrder S{(const char*)(ws + A_PL), (const char*)(wl + WO_PW), G, bx};
              pg8::EpiColScale E{(bf16*)(ws + A_YB), 512, in[19] + (size_t)l * 512};
              pg8::gemm_phase<pg8::EpiColScale, pg8::PoolOrder, true>(lds + RING_OFF, tid, 512, 512, 512, S, E); }
            SEAM(pb + 3);
        }
#if defined(SCAN_SEQ) || defined(SCAN_BLOCKSYNC)
#error "the log-decay rows are in log2 units now: only the pipelined scan reads them that way"
#endif
        REP(4) if (PH_EN(4) && IN(pb + 4)) {
            #ifdef SCAN_SEQ
            { PHASE_BEGIN(); if (bx < 128) scan_chain(l, bx, in, ws, lds, tid, wave, lane); }
#else
            #ifdef SCAN_BLOCKSYNC
            { PHASE_BEGIN(); if (bx < 128) scan_chain_chunked(l, bx, in, ws, lds, tid, wave, lane); }
#else
            { PHASE_BEGIN(); if (bx < 128) scan_chain_pipe(l, bx, in, ws, lds, tid, wave, lane); }
#ifdef DUP_SCAN
            { PHASE_BEGIN(); if (bx < 128) scan_chain_pipe(l, bx, in, ws, lds, tid, wave, lane); }
#endif
#endif
#endif
#ifndef NO_ATTN
            { PHASE_BEGIN();
              volatile LAS int* slot = (volatile LAS int*)(lds + LDSCTL_OFF + 16); gu32* qh = (gu32*)(ws + WS_CTL) + CW_ATTQ + 64 * l;
              float negM; { const float gq = fabsf(in[20][(size_t)l * 64 + lane]), gk = fabsf(in[21][(size_t)l * 64 + lane]); float mq = gq, mk = gk;
#pragma unroll
                for (int o_ = 1; o_ < 64; o_ <<= 1) { mq = fmaxf(mq, shx(mq, o_, lane)); mk = fmaxf(mk, shx(mk, o_, lane)); }
                negM = -(64.0f * 0.125f * 1.4426950408889634f * 1.01f) * mq * mk; negM = __builtin_bit_cast(float, __builtin_amdgcn_readfirstlane(__builtin_bit_cast(int, negM))); }
              const unsigned char* Qp = ws + A_Q; const unsigned char* Kp = ws + A_K; const unsigned char* Vp = ws + A_V;
#ifdef ATT_CODE_EXP
              negM = 4.0f * (negM + 13.0f) + 60.0f;
#else
              negM += 13.0f;
#endif
              for (;;) {
                  if (tid == 0) *slot = (int)__hip_atomic_fetch_add(qh, 1u, RLX_AGENT);
                  __syncthreads();
                  const int item = __builtin_amdgcn_readfirstlane(*slot);
                  __syncthreads();
                  if (item >= 2048 + 1024) break;
                  if (item >= 2048) { convert_experts_items(in, l, ws, lds, (item - 2048) * 24, 24, wave, lane);
#ifdef PROBE_CONV2
                      convert_experts_items(in, l, ws, lds, (item - 2048) * 24, 24, wave, lane);
#endif
                      continue; }
                  const int grp = item >> 7, r = item & 127, b = grp >> 1, h = (grp & 1) * 4 + (r >> 5), qb = r & 31;
#ifdef PROBE_ATT_TWICE
                  attn_body::attn_unit(tid, negM, b, h, qb, Qp, Kp, Vp, (unsigned char*)out + 3072, (char*)lds_raw + RING_OFF, false);
#endif
                  attn_body::attn_unit(tid, negM, b, h, qb, Qp, Kp, Vp, (unsigned char*)out + 3072, (char*)lds_raw + RING_OFF);
              } }
#endif
            SEAM(pb + 4);
        }
        REP(5) if (PH_EN(5) && IN(pb + 5)) { PHASE_BEGIN(); LAYER_VARS();
            p6a_rows(l, in, ws, gw, NGW, lane);
            SEAM(pb + 5);
        }
        REP(6) if (PH_EN(6) && IN(pb + 6)) { PHASE_BEGIN(); LAYER_VARS();
            typedef pg8::MergeOrder<A_HN, A_YA, A_YB, WO_BRA8, WO_G, WO_BR> MOrd;
            MOrd S{(const char*)ws, (const char*)wl, G, bx, (size_t)((const unsigned char*)out + 2048 - ws), (size_t)4096};
            pg8::EpiMerge E{(bf16*)(ws + A_TS) + (size_t)bx * 65536, (bf16*)(ws + A_MG), 1.0f / 32.0f, 1.0f / (32.0f * attn_body::OSC)};
#ifdef PROBE_SINK_P6B
            { pg8::EpiSink E0; pg8::gemm_phase<pg8::EpiSink, MOrd, true, true, false, false, true>(lds + RING_OFF, tid, 512, 2048, 512, S, E0); }
#endif
            pg8::gemm_phase<pg8::EpiMerge, MOrd, true, true, false, false, true>(lds + RING_OFF, tid, 512, 2048, 512, S, E);
            SEAM(pb + 6);
        }
        REP(7) if (PH_EN(7) && IN(pb + 7)) { PHASE_BEGIN(); LAYER_VARS();
            pg8::PlainOrder S{(const char*)(ws + A_MG), (const char*)(wl + WO_OUT), 1024, 1024, 1024, M / 256, 4, G, bx, 0, 1, 0};
            pg8::EpiResBf E{(l == 0) ? in[0] : (const float*)nullptr, (pg8::bf16_t*)out, XBP};
#ifdef PROBE_SINK_P7
            { pg8::EpiSink E0; pg8::gemm_phase<pg8::EpiSink, pg8::PlainOrder, true>(lds + RING_OFF, tid, 1024, 1024, 1024, S, E0); }
#endif
            pg8::gemm_phase<pg8::EpiResBf, pg8::PlainOrder, true>(lds + RING_OFF, tid, 1024, 1024, 1024, S, E);
            SEAM(pb + 7);
        }
        REP(8) if (PH_EN(8) && IN(pb + 8)) {
            { PHASE_BEGIN(); p8_router(l, in, out, ws, lds, gw, NGW, tid, lane); }
            SEAM(pb + 8);
        }
        REP(9) if (PH_EN(9) && IN(pb + 9)) { PHASE_BEGIN(); if (bx < BATCH * NEXP) p9_topk(bx, ws, lds, tid, wave, lane); SEAM(pb + 9); }
        REP(11) if (PH_EN(11) && IN(pb + 11)) { PHASE_BEGIN();
            pg8::GatherOrder S{(const char*)(ws + A_HN), (const char*)(ws + A_WGU), (const int*)(ws + WS_IDX), 512, 512, 512, MR / 256, 8, G, bx, 4, NEXP, NEXP * 4, SEQ, (size_t)2048 * 1024};
            pg8::EpiSwiGLU<true> E{(bf16*)(ws + A_HID), 1024, 1.0f / 32.0f, 16.0f};
            pg8::gemm_phase<pg8::EpiSwiGLU<true>, pg8::GatherOrder, true, false, true, true>(lds + RING_OFF, tid, 512, 512, 512, S, E);
            SEAM(pb + 11);
        }
        REP(12) if (PH_EN(12) && IN(pb + 12)) { PHASE_BEGIN();
            pg8::PlainOrder S{(const char*)(ws + A_HID), (const char*)(ws + A_WD), 512, 512, 512, MR / 256, 4, G, bx, 4, NEXP, (size_t)1024 * 1024};
            pg8::EpiRowScale E{(bf16*)(ws + A_YE), 1024, (const float*)(ws + WS_VAL), 1.0f / 512.0f};
#ifdef PROBE_SINK_P12
            { pg8::EpiSink E0; pg8::gemm_phase<pg8::EpiSink, pg8::PlainOrder, true, false, false, true>(lds + RING_OFF, tid, 512, 512, 512, S, E0); }
#endif
            pg8::gemm_phase<pg8::EpiRowScale, pg8::PlainOrder, true, false, false, true>(lds + RING_OFF, tid, 512, 512, 512, S, E);
            SEAM(pb + 12);
        }
    }
#ifdef DBG_DUMP_OFF
#ifndef DBG_DUMP_ELEMS
#define DBG_DUMP_ELEMS ((size_t)M * DMODEL)
#endif
    if (IN(28)) { PHASE_BEGIN(); const bf16* src = (const bf16*)(ws + (size_t)(DBG_DUMP_OFF)); const size_t gt = (size_t)vcu * NTHR + tid, NGT = (size_t)G * NTHR;
        for (size_t i = gt; i < (size_t)M * DMODEL / 8; i += NGT) { float f[8]; unp8(ld16(src + (i % ((size_t)(DBG_DUMP_ELEMS) / 8)) * 8), f); f32x4* o = (f32x4*)(out + i * 8); o[0] = (f32x4){f[0], f[1], f[2], f[3]}; o[1] = (f32x4){f[4], f[5], f[6], f[7]}; } }
#endif
#ifdef PROBE_NORM2
    if (PH_EN(14) && IN(27)) { PHASE_BEGIN(); norm_rows<0, true>(out, nullptr, true, (const bf16*)(ws + A_YE), (const int*)(ws + WS_INV), in[31], (bf16*)(ws + A_HN1), nullptr, gw, NGW, lane); }
#endif
    if (PH_EN(14) && IN(27)) { PHASE_BEGIN(); norm_rows<1, true>(out, nullptr, true, (const bf16*)(ws + A_YE), (const int*)(ws + WS_INV), in[31], nullptr, out, gw, NGW, lane); }
}
#undef IN
#undef SEAM

#ifndef MK_PER_PHASE
#define MK_PER_PHASE 0
#endif
extern "C" void kernel_launch(void* const* d_in, const int* in_sizes, int n_in, void* d_out, int out_size, void* d_ws, size_t ws_size, hipStream_t stream) {
    static int grid = 0;
    if (grid == 0) {
        if (n_in != 32 || in_sizes[0] != M * DMODEL || out_size != M * DMODEL || ws_size < WS_END) { fprintf(stderr, "kernel_launch: unexpected shapes (n_in %d, in0 %d, out %d, ws %zu)\n", n_in, n_in > 0 ? in_sizes[0] : -1, out_size, ws_size); grid = -1; return; }
        int dev = 0, cus = 0, per_cu = 0;
        if (hipGetDevice(&dev) != hipSuccess || hipDeviceGetAttribute(&cus, hipDeviceAttributeMultiprocessorCount, dev) != hipSuccess) { grid = -1; return; }
        if (hipFuncSetAttribute((const void*)fwd, hipFuncAttributeMaxDynamicSharedMemorySize, LDS_BYTES) != hipSuccess) { fprintf(stderr, "kernel_launch: hipFuncSetAttribute failed\n"); grid = -1; return; }
        if (hipOccupancyMaxActiveBlocksPerMultiprocessor(&per_cu, (const void*)fwd, NTHR, LDS_BYTES) != hipSuccess || per_cu < 1) fprintf(stderr, "kernel_launch: occupancy query reports %d\n", per_cu);
        (void)hipGetLastError();
        grid = cus;
        if (grid > 256) grid = 256;
    }
    if (grid < 0) return;
    if (hipMemsetAsync((char*)d_ws + WS_CTL, 0, CTL_ZERO_BYTES, stream) != hipSuccess) return;
    Args a{};
    for (int i = 0; i < 32; ++i) a.in[i] = (const float*)d_in[i];
    a.out = (float*)d_out; a.ws = (unsigned char*)d_ws; a.pad = 0;
#if MK_PER_PHASE
#ifdef DBG_LAST_PHASE
    for (int p = 0; p <= DBG_LAST_PHASE; ++p) { a.ph_lo = p; a.ph_hi = p + 1; a.li = 0; hipLaunchKernelGGL(fwd, dim3(grid), dim3(NTHR), LDS_BYTES, stream, a); }
#ifdef DBG_DUMP_OFF
    a.ph_lo = 28; a.ph_hi = 29; a.li = 0; hipLaunchKernelGGL(fwd, dim3(grid), dim3(NTHR), LDS_BYTES, stream, a);
#endif
#else
    for (int p = 0; p < N_PHASES; ++p) { a.ph_lo = p; a.ph_hi = p + 1; a.li = 0; hipLaunchKernelGGL(fwd, dim3(grid), dim3(NTHR), LDS_BYTES, stream, a); }
#endif
#else
    a.ph_lo = 0; a.ph_hi = N_PHASES; a.li = 0;
    hipLaunchKernelGGL(fwd, dim3(grid), dim3(NTHR), LDS_BYTES, stream, a);
#endif
    const hipError_t le = hipPeekAtLastError();
    if (le != hipSuccess) fprintf(stderr, "kernel_launch: launch failed: %s\n", hipGetErrorName(le));
}
```
